# Optimizing an MI355X kernel written in HIP

```python
import math
import jax, jax.numpy as jnp
from jax import lax
import numpy as np

D_MODEL = 1024
BATCH = 8
SEQ = 4096
DEPTH = 2

CTX_LEN = 256
GRID_W = 64
HEAD_DIM = 64
ATTN_WIDTH = D_MODEL // 2
N_HEADS = ATTN_WIDTH // HEAD_DIM
N_KV_HEADS = N_HEADS // 4
WINDOW = 128
ATTN_BLOCK = 128
ROPE_BASE = 10000.0
POOL_WINDOWS = (2, 4, 8, 16)
POOL_WIDTH = D_MODEL // 4
POOL_GROUP = POOL_WIDTH // 4
RET_HEADS = 4
RET_WIDTH = D_MODEL // 4
RET_DV = RET_WIDTH // RET_HEADS
RET_DK = RET_DV // 2
RET_CHUNK = 128
MIX_WIDTH = ATTN_WIDTH + POOL_WIDTH + RET_WIDTH
IN_SPLITS = (ATTN_WIDTH, N_KV_HEADS * HEAD_DIM, N_KV_HEADS * HEAD_DIM, POOL_WIDTH,
             RET_HEADS * RET_DK, RET_HEADS * RET_DK, RET_WIDTH, RET_WIDTH)
IN_WIDTH = ATTN_WIDTH + 2 * N_KV_HEADS * HEAD_DIM + POOL_WIDTH + 2 * RET_HEADS * RET_DK + 2 * RET_WIDTH
FFN_DIM = ((8 * D_MODEL // 3 + 127) // 128) * 128
N_EXPERTS = 8
TOP_K = 2
LN_EPS = 1e-5
NEG_INF = -1e30

kernel_name = "hybrid_flow_block"


def layer_norm(x, g, b):
    xf = x.astype(jnp.float32)
    mu = jnp.mean(xf, -1, keepdims=True)
    var = jnp.mean(jnp.square(xf - mu), -1, keepdims=True)
    y = (xf - mu) * lax.rsqrt(var + LN_EPS) * g.astype(jnp.float32) + b.astype(jnp.float32)
    return y.astype(x.dtype)


def head_norm(o):
    mu = jnp.mean(o, -1, keepdims=True)
    var = jnp.mean(jnp.square(o - mu), -1, keepdims=True)
    return (o - mu) * lax.rsqrt(var + LN_EPS)


def axial_rope(x, row, col):
    half = HEAD_DIM // 2
    quarter = half // 2
    inv = ROPE_BASE ** (-jnp.arange(quarter, dtype=jnp.float32) / quarter)

    def rot(xp, pos):
        ang = pos.astype(jnp.float32)[:, None] * inv[None, :]
        cos = jnp.cos(ang)[None, :, None, :]
        sin = jnp.sin(ang)[None, :, None, :]
        x1, x2 = xp[..., :quarter], xp[..., quarter:]
        return jnp.concatenate([x1 * cos - x2 * sin, x1 * sin + x2 * cos], -1)

    xf = x.astype(jnp.float32)
    return jnp.concatenate([rot(xf[..., :half], row), rot(xf[..., half:], col)], -1).astype(x.dtype)


def sink_softmax(sink, scores):
    B, KV, G, Q, _ = scores.shape
    sk = jnp.broadcast_to(sink.astype(jnp.float32).reshape(1, KV, G, 1, 1), (B, KV, G, Q, 1))
    p = jax.nn.softmax(jnp.concatenate([sk, scores], -1), axis=-1)
    return p[..., 1:]


def band_attention(q, k, v, kc, vc, sink):
    B, L, H, hd = q.shape
    KV = k.shape[2]
    G = H // KV
    nb = L // ATTN_BLOCK
    span = 3 * ATTN_BLOCK
    scale = hd ** -0.5
    qb = jnp.moveaxis(q.reshape(B, nb, ATTN_BLOCK, KV, G, hd), 1, 0)
    pad = ((0, 0), (ATTN_BLOCK, ATTN_BLOCK), (0, 0), (0, 0))
    kp = jnp.pad(k, pad)
    vp = jnp.pad(v, pad)

    def block(args):
        i, qi = args
        start = i * ATTN_BLOCK
        ki = lax.dynamic_slice_in_dim(kp, start, span, axis=1)
        vi = lax.dynamic_slice_in_dim(vp, start, span, axis=1)
        qpos = start + jnp.arange(ATTN_BLOCK)
        kpos = start - ATTN_BLOCK + jnp.arange(span)
        ok = (kpos[None, :] >= 0) & (kpos[None, :] < L) & (jnp.abs(qpos[:, None] - kpos[None, :]) <= WINDOW)
        s_loc = jnp.einsum('bqkgd,bjkd->bkgqj', qi, ki).astype(jnp.float32) * scale
        s_loc = jnp.where(ok, s_loc, NEG_INF)
        s_ctx = jnp.einsum('bqkgd,bjkd->bkgqj', qi, kc).astype(jnp.float32) * scale
        p = sink_softmax(sink, jnp.concatenate([s_loc, s_ctx], -1)).astype(v.dtype)
        return (jnp.einsum('bkgqj,bjkd->bqkgd', p[..., :span], vi)
                + jnp.einsum('bkgqj,bjkd->bqkgd', p[..., span:], vc))

    o = lax.map(block, (jnp.arange(nb), qb))
    return jnp.moveaxis(o, 0, 1).reshape(B, L, H * hd)


def ctx_attention(qc, kc, vc, sink):
    B, Lc, H, hd = qc.shape
    KV = kc.shape[2]
    G = H // KV
    qr = qc.reshape(B, Lc, KV, G, hd)
    s = jnp.einsum('bqkgd,bjkd->bkgqj', qr, kc).astype(jnp.float32) * hd ** -0.5
    p = sink_softmax(sink, s).astype(vc.dtype)
    return jnp.einsum('bkgqj,bjkd->bqkgd', p, vc).reshape(B, Lc, H * hd)


def pool_mix(u, pool_w, pool_scale):
    B, L, _ = u.shape
    t = jnp.arange(L)
    uf = u.astype(jnp.float32)
    cs = jnp.pad(jnp.cumsum(uf, axis=1), ((0, 0), (1, 0), (0, 0)))
    outs = []
    for g, w in enumerate(POOL_WINDOWS):
        sl = slice(g * POOL_GROUP, (g + 1) * POOL_GROUP)
        ug, csg = uf[..., sl], cs[..., sl]
        lo = jnp.clip(t - w // 2, 0, L)
        hi = jnp.clip(t + w - w // 2, 0, L)
        cnt = (hi - lo).astype(jnp.float32)[None, :, None]
        mean = (jnp.take(csg, hi, axis=1) - jnp.take(csg, lo, axis=1)) / cnt
        outs.append(jnp.einsum('blc,cd->bld', (mean - ug).astype(u.dtype), pool_w[g]))
    return jnp.concatenate(outs, -1) * pool_scale


def retention_scan(q, k, v, log_g, state0):
    B, L, H, dk = q.shape
    dv = v.shape[-1]
    C = RET_CHUNK
    nc = L // C
    qc = q.astype(jnp.float32).reshape(B, nc, C, H, dk)
    kc = k.astype(jnp.float32).reshape(B, nc, C, H, dk)
    vc = v.astype(jnp.float32).reshape(B, nc, C, H, dv)
    n = jnp.arange(C, dtype=jnp.float32)
    rel = n[:, None] - n[None, :]
    dmask = jnp.where(rel >= 0, jnp.exp(log_g[:, None, None] * jnp.maximum(rel, 0.0)), 0.0)
    intra = jnp.einsum('bcnhd,bcmhd->bchnm', qc, kc) * dmask
    o_intra = jnp.einsum('bchnm,bcmhe->bcnhe', intra, vc)
    w_state = jnp.exp(log_g[None, :] * (C - 1 - n)[:, None])
    kv = jnp.einsum('bcmhd,bcmhe->cbhde', kc * w_state[:, :, None], vc)
    chunk_decay = jnp.exp(log_g * C)[None, :, None, None]

    def step(S, kv_i):
        return chunk_decay * S + kv_i, S

    s_fin, s_prev = lax.scan(step, state0, kv)
    q_dec = qc * jnp.exp(log_g[None, :] * (n + 1)[:, None])[:, :, None]
    o_cross = jnp.einsum('bcnhd,cbhde->bcnhe', q_dec, s_prev)
    return (o_intra + o_cross).reshape(B, L, H, dv), s_fin


def retention_state(k, v, log_g):
    L = k.shape[1]
    t = jnp.arange(L, dtype=jnp.float32)
    w = jnp.exp(log_g[None, :] * (L - 1 - t)[:, None])
    return jnp.einsum('blhd,blhe->bhde', k.astype(jnp.float32) * w[None, :, :, None], v.astype(jnp.float32))


def flip(t):
    return jnp.flip(t, axis=1)


def heads(t, n):
    return t.reshape(t.shape[0], t.shape[1], n, -1)


def mixer(h, hc, w_in, sink, pool_w, pool_scale, lg_f, lg_b, w_out, need_ctx):
    B, L, _ = h.shape
    ROWS = L // GRID_W
    row = jnp.repeat(jnp.arange(ROWS), GRID_W)
    col = jnp.tile(jnp.arange(GRID_W), ROWS)
    cuts = [int(s) for s in np.cumsum(IN_SPLITS)[:-1]]
    q, k, v, u, rq, rk, rv, rg = jnp.split(h @ w_in, cuts, axis=-1)
    qc, kc, vc, uc, rqc, rkc, rvc, rgc = jnp.split(hc @ w_in, cuts, axis=-1)

    q = axial_rope(heads(q, N_HEADS), row, col)
    k = axial_rope(heads(k, N_KV_HEADS), row, col)
    v = heads(v, N_KV_HEADS)
    kc, vc = heads(kc, N_KV_HEADS), heads(vc, N_KV_HEADS)
    attn = band_attention(q, k, v, kc, vc, sink)

    pool = pool_mix(u, pool_w, pool_scale)

    lg_f = lg_f.astype(jnp.float32)
    lg_b = lg_b.astype(jnp.float32)
    rscale = RET_DK ** -0.5
    rq, rk, rv = heads(rq, RET_HEADS), heads(rk, RET_HEADS) * rscale, heads(rv, RET_HEADS)
    rqc, rkc, rvc = heads(rqc, RET_HEADS), heads(rkc, RET_HEADS) * rscale, heads(rvc, RET_HEADS)
    if need_ctx:
        zero = jnp.zeros((B, RET_HEADS, RET_DK, RET_DV), jnp.float32)
        ocf, s_f = retention_scan(rqc, rkc, rvc, lg_f, zero)
        ocb, s_b = retention_scan(flip(rqc), flip(rkc), flip(rvc), lg_b, zero)
    else:
        s_f = retention_state(rkc, rvc, lg_f)
        s_b = retention_state(flip(rkc), flip(rvc), lg_b)
    olf, _ = retention_scan(rq, rk, rv, lg_f, s_f)
    olb, _ = retention_scan(flip(rq), flip(rk), flip(rv), lg_b, s_b)
    ret = jax.nn.silu(rg) * head_norm(olf + flip(olb)).reshape(B, L, RET_WIDTH).astype(rg.dtype)

    y = jnp.concatenate([attn, pool, ret], -1) @ w_out
    if not need_ctx:
        return y, None
    Lc = hc.shape[1]
    attn_c = ctx_attention(heads(qc, N_HEADS), kc, vc, sink)
    pool_c = pool_mix(uc, pool_w, pool_scale)
    ret_c = jax.nn.silu(rgc) * head_norm(ocf + flip(ocb)).reshape(B, Lc, RET_WIDTH).astype(rgc.dtype)
    yc = jnp.concatenate([attn_c, pool_c, ret_c], -1) @ w_out
    return y, yc


def swiglu(t, wg, wu, wd):
    return (jax.nn.silu(t @ wg) * (t @ wu)) @ wd


def moe_ffn(t, router, wg, wu, wd):
    shape = t.shape
    tf = t.reshape(-1, shape[-1])
    logits = (tf @ router).astype(jnp.float32)
    top_v, top_i = lax.top_k(logits, TOP_K)
    top_w = jax.nn.softmax(top_v, axis=-1)
    gates = jnp.sum(jax.nn.one_hot(top_i, N_EXPERTS, dtype=jnp.float32) * top_w[..., None], axis=1)
    gates = gates.astype(t.dtype)
    y = jnp.zeros_like(tf)
    for e in range(N_EXPERTS):
        y = y + gates[:, e:e + 1] * swiglu(tf, wg[e], wu[e], wd[e])
    return y.reshape(shape)


def channel_mixer(t, i, ffn_w_gate, ffn_w_up, ffn_w_down, moe_router, moe_w_gate, moe_w_up, moe_w_down):
    j = i // 2
    if i % 2 == 0:
        return swiglu(t, ffn_w_gate[j], ffn_w_up[j], ffn_w_down[j])
    return moe_ffn(t, moe_router[j], moe_w_gate[j], moe_w_up[j], moe_w_down[j])


def setup_inputs(seed: int = 0) -> dict:
    key = jax.random.key(seed)
    ks = jax.random.split(key, 32)
    f32 = jnp.float32

    def nrm(k, shape, s):
        return jax.random.normal(k, shape, f32) * s

    beta = (8.0 * DEPTH) ** -0.25
    nd, nm = (DEPTH + 1) // 2, DEPTH // 2
    base_decay = jnp.log(1.0 - 2.0 ** (-5.0 - jnp.arange(RET_HEADS, dtype=f32)))
    D = D_MODEL
    return {
        "x": nrm(ks[0], (BATCH, SEQ, D), 1.0),
        "c": nrm(ks[1], (BATCH, D), 1.0),
        "ctx": nrm(ks[2], (BATCH, CTX_LEN, D), 1.0),
        "c_ctx": nrm(ks[3], (D,), 1.0),
        "w_mod": nrm(ks[4], (DEPTH, D, 6 * D), D ** -0.5),
        "b_mod": nrm(ks[5], (DEPTH, 6 * D), 0.02),
        "w_in": nrm(ks[6], (DEPTH, D, IN_WIDTH), D ** -0.5),
        "attn_sink": nrm(ks[7], (DEPTH, N_HEADS), 0.5),
        "pool_w": nrm(ks[8], (DEPTH, len(POOL_WINDOWS), POOL_GROUP, POOL_GROUP), POOL_GROUP ** -0.5),
        "pool_scale": 1.0 + nrm(ks[9], (DEPTH, POOL_WIDTH), 0.1),
        "ret_log_decay_fwd": base_decay[None, :] * jnp.exp(nrm(ks[10], (DEPTH, RET_HEADS), 0.1)),
        "ret_log_decay_bwd": base_decay[None, :] * jnp.exp(nrm(ks[11], (DEPTH, RET_HEADS), 0.1)),
        "w_out": nrm(ks[12], (DEPTH, MIX_WIDTH, D), beta * MIX_WIDTH ** -0.5),
        "ln1_g": 1.0 + nrm(ks[13], (DEPTH, D), 0.02),
        "ln1_b": nrm(ks[14], (DEPTH, D), 0.02),
        "ln2_g": 1.0 + nrm(ks[15], (DEPTH, D), 0.02),
        "ln2_b": nrm(ks[16], (DEPTH, D), 0.02),
        "ffn_w_gate": nrm(ks[17], (nd, D, FFN_DIM), D ** -0.5),
        "ffn_w_up": nrm(ks[18], (nd, D, FFN_DIM), D ** -0.5),
        "ffn_w_down": nrm(ks[19], (nd, FFN_DIM, D), beta * FFN_DIM ** -0.5),
        "moe_router": nrm(ks[20], (nm, D, N_EXPERTS), D ** -0.5),
        "moe_w_gate": nrm(ks[21], (nm, N_EXPERTS, D, FFN_DIM), D ** -0.5),
        "moe_w_up": nrm(ks[22], (nm, N_EXPERTS, D, FFN_DIM), D ** -0.5),
        "moe_w_down": nrm(ks[23], (nm, N_EXPERTS, FFN_DIM, D), beta * FFN_DIM ** -0.5),
    }


def reference(x, c, ctx, c_ctx, w_mod, b_mod, w_in, attn_sink, pool_w, pool_scale,
              ret_log_decay_fwd, ret_log_decay_bwd, w_out, ln1_g, ln1_b, ln2_g, ln2_b,
              ffn_w_gate, ffn_w_up, ffn_w_down, moe_router, moe_w_gate, moe_w_up, moe_w_down):
    alpha = (2.0 * DEPTH) ** 0.25
    xc = ctx
    for i in range(DEPTH):
        last = i == DEPTH - 1
        mod = (jax.nn.silu(c) @ w_mod[i] + b_mod[i])[:, None, :]
        modc = (jax.nn.silu(c_ctx) @ w_mod[i] + b_mod[i])[None, None, :]
        sh1, sc1, g1, sh2, sc2, g2 = jnp.split(mod, 6, axis=-1)
        sh1c, sc1c, g1c, sh2c, sc2c, g2c = jnp.split(modc, 6, axis=-1)

        y, yc = mixer(x * (1 + sc1) + sh1, xc * (1 + sc1c) + sh1c, w_in[i], attn_sink[i],
                      pool_w[i], pool_scale[i], ret_log_decay_fwd[i], ret_log_decay_bwd[i],
                      w_out[i], not last)
        x = layer_norm(alpha * x + g1 * y, ln1_g[i], ln1_b[i])
        f = channel_mixer(x * (1 + sc2) + sh2, i, ffn_w_gate, ffn_w_up, ffn_w_down,
                          moe_router, moe_w_gate, moe_w_up, moe_w_down)
        x = layer_norm(alpha * x + g2 * f, ln2_g[i], ln2_b[i])
        if not last:
            xc = layer_norm(alpha * xc + g1c * yc, ln1_g[i], ln1_b[i])
            fc = channel_mixer(xc * (1 + sc2c) + sh2c, i, ffn_w_gate, ffn_w_up, ffn_w_down,
                               moe_router, moe_w_gate, moe_w_up, moe_w_down)
            xc = layer_norm(alpha * xc + g2c * fc, ln2_g[i], ln2_b[i])
    return x
```

```cpp
#include <hip/hip_runtime.h>
#include <cstdio>
#include <cstdint>
#define MK_N_LAUNCHES 28
__device__ __forceinline__ int opq(int v) { asm volatile("" : "+v"(v)); return v; }
namespace pg8 {
#define PG8_LAS __attribute__((address_space(3)))
typedef unsigned short bf16_t;
typedef short bf16x8 __attribute__((ext_vector_type(8)));
typedef float f32x4 __attribute__((ext_vector_type(4)));
typedef float f32x2 __attribute__((ext_vector_type(2)));
typedef unsigned u32x4 __attribute__((ext_vector_type(4)));
constexpr int BM = 256, BK = 64, HALF = 128, HTB = HALF * BK * 2  , STAGE_BYTES = 8 * HTB, NXCD = 8, WGM = 8;

__host__ __device__ __forceinline__ int lds_byte(int r, int c) { const int st = (r >> 4) * 2 + (c >> 5), rr = r & 15, cc = c & 31, ob = rr * 64 + cc * 2; return st * 1024 + (ob ^ (((ob >> 9) & 1) << 5)); }
__host__ __device__ __forceinline__ void stage_rc(int b, int& R, int& C) { const int st = b / 1024, sb = b % 1024, swz = sb ^ (((sb >> 9) & 1) << 5); R = (st >> 1) * 16 + swz / 64; C = (st & 1) * 32 + (swz % 64) / 2; }
__host__ __device__ __forceinline__ int perm32(int rho) { const int n = rho >> 4, i = rho & 15; return 8 * (i >> 2) + 4 * n + (i & 3); }

struct Unit { int pm, pn, e, rt, cnt; const char* ab; const char* bb; };

__device__ __forceinline__ bool tile_order(int i, int G, int c, int nM, int nN, int& pm, int& pn) {
    const int nwg = nM * nN; const long L = (long)i * G + c; if (L >= nwg) return false;
    int wgid = (int)L; { const int q = nwg / NXCD, r = nwg % NXCD, xcd = wgid % NXCD, off = wgid / NXCD; wgid = (xcd < r ? xcd * (q + 1) : r * (q + 1) + (xcd - r) * q) + off; }
    const int nig = WGM * nN, gid = wgid / nig, fm = gid * WGM, gsz = (nM - fm) < WGM ? (nM - fm) : WGM;
    pm = fm + ((wgid % nig) % gsz); pn = (wgid % nig) / gsz; return true;
}
struct StaticOrder {
    static constexpr bool GATHER = false;
    int nM, nN, G, c, K; const char* A; const char* Bt;
    __device__ __forceinline__ void init(const void* A_, const void* Bt_, int M, int N, int K_, int G_, int c_) { A = (const char*)A_; Bt = (const char*)Bt_; nM = M / BM; nN = N / BM; K = K_; G = G_; c = c_; }
    __device__ __forceinline__ bool next(int i, Unit& u) const {
        int pm, pn; if (!tile_order(i, G, c, nM, nN, pm, pn)) return false;
        u.pm = pm; u.pn = pn; u.e = 0; u.rt = pm; u.cnt = 1 << 30; u.ab = A + (size_t)pm * BM * K * 2; u.bb = Bt + (size_t)pn * BM * K * 2; return true;
    }
    __device__ __forceinline__ void aoff(const Unit&, const int (&R)[2], const int (&C)[2], unsigned (&va)[2][2]) const {
#pragma unroll
        for (int h = 0; h < 2; ++h)
#pragma unroll
            for (int i = 0; i < 2; ++i) va[h][i] = (unsigned)((R[i] + HALF * h) * K + C[i]) * 2u;
    }
};

__device__ __forceinline__ unsigned cvt_pk_bf16(float lo, float hi) { unsigned r; asm volatile("v_cvt_pk_bf16_f32 %0, %1, %2" : "=v"(r) : "v"(lo), "v"(hi)); return r; }

template <class Epi, class Sched>
__device__ __forceinline__ void gemm_phase(PG8_LAS unsigned char* lds, const int K, const Sched& S, const Epi& E) {
    const int tid = opq((int)threadIdx.x), wid = __builtin_amdgcn_readfirstlane(tid >> 6), lane = tid & 63, wr = wid >> 2, wc = wid & 3, fr = lane & 15, fq = lane >> 4;
    const int nt = K / BK;
    int R[2], C[2]; unsigned voffB[2];
#pragma unroll
    for (int i = 0; i < 2; ++i) { stage_rc(tid * 16 + i * 8192, R[i], C[i]); const int Rb = Epi::PERM ? ((R[i] & ~31) + perm32(R[i] & 31)) : R[i]; voffB[i] = (unsigned)(Rb * K + C[i]) * 2u; }
    const size_t kstep = (size_t)(BK * 2);
    const size_t hstep = (size_t)HALF * K * 2;
    const unsigned ldsw = (unsigned)wid * 1024u;
    const int aoff = lds_byte(wr * 64 + fr, fq * 8), boff = lds_byte(wc * 32 + fr, fq * 8);
#define PG8_SA(b, h) (((b) * 2 + (h)) * HTB)
#define PG8_SB(b, h) ((4 + (b) * 2 + (h)) * HTB)
#define PG8_STAGE(bufoff, gbase, voff) do { _Pragma("unroll") for (int _i = 0; _i < 2; ++_i) \
        __builtin_amdgcn_global_load_lds((const unsigned*)((const char*)(gbase) + (voff)[_i]), (PG8_LAS unsigned*)(lds + (bufoff) + ldsw + _i * 8192), 16, 0, 0); } while (0)
#define PG8_LDA(dst, b, h) do { _Pragma("unroll") for (int m = 0; m < 4; ++m) _Pragma("unroll") for (int k = 0; k < 2; ++k) dst[m][k] = *(const PG8_LAS bf16x8*)(lds + PG8_SA(b, h) + aoff + m * 2048 + k * 1024); } while (0)
#define PG8_LDB(dst, b, h) do { _Pragma("unroll") for (int n = 0; n < 2; ++n) _Pragma("unroll") for (int k = 0; k < 2; ++k) dst[n][k] = *(const PG8_LAS bf16x8*)(lds + PG8_SB(b, h) + boff + n * 2048 + k * 1024); } while (0)
#define PG8_MMA(ai, bj, At, Bt) do { __builtin_amdgcn_s_setprio(1); _Pragma("unroll") for (int m = 0; m < 4; ++m) _Pragma("unroll") for (int n = 0; n < 2; ++n) _Pragma("unroll") for (int k = 0; k < 2; ++k) \
        acc[ai][bj][m][n] = __builtin_amdgcn_mfma_f32_16x16x32_bf16(Bt[n][k], At[m][k], acc[ai][bj][m][n], 0, 0, 0); __builtin_amdgcn_s_setprio(0); } while (0)
#define PG8_WAIT_V(n) asm volatile("s_waitcnt vmcnt(" #n ")" ::: "memory")
#define PG8_WAIT_L(n) asm volatile("s_waitcnt lgkmcnt(" #n ")" ::: "memory")
#define PG8_BAR __builtin_amdgcn_s_barrier()
#define PG8_SCHED __builtin_amdgcn_sched_barrier(0)
    Unit cur, nxt; int ui = 0;
    if (!S.next(0, cur)) return;
    unsigned va[2][2], nva[2][2];
    S.aoff(cur, R, C, va);
    f32x4 acc[2][2][4][2];
#pragma unroll
    for (int a = 0; a < 2; ++a)
#pragma unroll
        for (int b = 0; b < 2; ++b)
#pragma unroll
            for (int m = 0; m < 4; ++m)
#pragma unroll
                for (int n = 0; n < 2; ++n) acc[a][b][m][n] = (f32x4){0.f, 0.f, 0.f, 0.f};
    bf16x8 At[4][2], B0[2][2], B1[2][2];
    const char* cA = cur.ab; const char* cB = cur.bb;
    PG8_STAGE(PG8_SB(0, 0), cB, voffB); PG8_STAGE(PG8_SB(0, 1), cB + hstep, voffB); PG8_STAGE(PG8_SA(0, 0), cA, va[0]); PG8_STAGE(PG8_SA(0, 1), cA, va[1]);
    if (wr == 1) PG8_BAR;
    PG8_WAIT_V(2); PG8_BAR;
    PG8_STAGE(PG8_SB(1, 0), cB + kstep, voffB); PG8_STAGE(PG8_SA(1, 0), cA + kstep, va[0]); PG8_STAGE(PG8_SB(1, 1), cB + hstep + kstep, voffB);
    PG8_WAIT_V(6); PG8_BAR;
    for (;;) {
        const bool has_next = S.next(ui + 1, nxt);
        const char* nA = has_next ? nxt.ab : cA; const char* nB = has_next ? nxt.bb : cB;
        if constexpr (Sched::GATHER) {
            if (has_next) S.aoff(nxt, R, C, nva);
            else {
#pragma unroll
                for (int h = 0; h < 2; ++h)
#pragma unroll
                    for (int i = 0; i < 2; ++i) nva[h][i] = va[h][i]; } }
        for (int t = 0; t < nt; t += 2) {
            const bool last = (t == nt - 2);
            const char* a1 = cA + (size_t)(t + 1) * kstep;
            const char* a2 = last ? nA : cA + (size_t)(t + 2) * kstep; const char* b2 = last ? nB : cB + (size_t)(t + 2) * kstep;
            const char* a3 = a2 + kstep; const char* b3 = b2 + kstep;
            unsigned x0[2], x1[2];
#pragma unroll
            for (int i = 0; i < 2; ++i) { if constexpr (Sched::GATHER) { x0[i] = last ? nva[0][i] : va[0][i]; x1[i] = last ? nva[1][i] : va[1][i]; } else { x0[i] = va[0][i]; x1[i] = va[1][i]; } }
            PG8_LDB(B0, 0, 0); PG8_LDB(B1, 0, 1); PG8_SCHED; PG8_LDA(At, 0, 0); PG8_STAGE(PG8_SA(1, 1), a1, va[1]);
            PG8_WAIT_V(8); PG8_WAIT_L(0); PG8_BAR; PG8_MMA(0, 0, At, B0); PG8_MMA(0, 1, At, B1); PG8_BAR; PG8_SCHED;
            PG8_LDA(At, 0, 1); PG8_STAGE(PG8_SB(0, 0), b2, voffB); PG8_STAGE(PG8_SB(0, 1), b2 + hstep, voffB); PG8_STAGE(PG8_SA(0, 0), a2, x0);
            PG8_WAIT_V(8); PG8_WAIT_L(0); PG8_BAR; PG8_MMA(1, 0, At, B0); PG8_MMA(1, 1, At, B1); PG8_BAR; PG8_SCHED;
            PG8_LDB(B0, 1, 0); PG8_LDB(B1, 1, 1); PG8_SCHED; PG8_LDA(At, 1, 0); PG8_STAGE(PG8_SA(0, 1), a2, x1);
            PG8_WAIT_V(8); PG8_WAIT_L(0); PG8_BAR; PG8_MMA(0, 0, At, B0); PG8_MMA(0, 1, At, B1); PG8_BAR; PG8_SCHED;
            PG8_LDA(At, 1, 1); PG8_STAGE(PG8_SB(1, 0), b3, voffB); PG8_STAGE(PG8_SB(1, 1), b3 + hstep, voffB); PG8_STAGE(PG8_SA(1, 0), a3, x0);
            PG8_WAIT_V(8); PG8_WAIT_L(0); PG8_BAR; PG8_MMA(1, 0, At, B0); PG8_MMA(1, 1, At, B1); PG8_BAR; PG8_SCHED;
        }
        if (wr == 0) PG8_BAR;
        E(acc, cur, wr, wc, fr, fq);
        if (!has_next) break;
#pragma unroll
        for (int a = 0; a < 2; ++a)
#pragma unroll
            for (int b = 0; b < 2; ++b)
#pragma unroll
                for (int m = 0; m < 4; ++m)
#pragma unroll
                    for (int n = 0; n < 2; ++n) acc[a][b][m][n] = (f32x4){0.f, 0.f, 0.f, 0.f};
        cur = nxt; cA = nA; cB = nB; ++ui;
        if constexpr (Sched::GATHER) {
#pragma unroll
            for (int h = 0; h < 2; ++h)
#pragma unroll
                for (int i = 0; i < 2; ++i) va[h][i] = nva[h][i]; }
        if (wr == 1) PG8_BAR;
    }
    PG8_WAIT_V(0);
    PG8_BAR;
#undef PG8_SA
#undef PG8_SB
#undef PG8_STAGE
#undef PG8_LDA
#undef PG8_LDB
#undef PG8_MMA
#undef PG8_WAIT_V
#undef PG8_WAIT_L
#undef PG8_BAR
#undef PG8_SCHED
}
}
constexpr int D = 1024, NB = 8, SEQ = 4096, CTXL = 256, NL = NB * SEQ, NC = NB * CTXL, MT = NL + NC;
constexpr int INW = 1792, FF = 2816, NE = 8;
constexpr int C_Q = 0, C_K = 512, C_V = 640, C_U = 768, C_RQ = 1024, C_RK = 1152, C_RV = 1280, C_RG = 1536;
constexpr int NCHK = 34;
constexpr float LN_EPS = 1e-5f, LOG2E = 1.4426950408889634f;
constexpr float QSCALE = 0.125f * LOG2E;
constexpr float RSCALE = 0.17677669529663687f;
constexpr float ALPHA = 1.4142135623730951f;
constexpr int LCAP = 32768;

namespace pg8 {
__device__ __forceinline__ void store8(bf16_t* p, f32x4 v0, f32x4 v1) {
    u32x4 w; w.x = cvt_pk_bf16(v0[0], v0[1]); w.y = cvt_pk_bf16(v0[2], v0[3]); w.z = cvt_pk_bf16(v1[0], v1[1]); w.w = cvt_pk_bf16(v1[2], v1[3]); *(u32x4*)p = w;
}
struct EpiBf16 {
    static constexpr bool PERM = true;
    bf16_t* O; int ldc;
    __device__ __forceinline__ void operator()(const f32x4 (&acc)[2][2][4][2], const Unit& u, int wr, int wc, int fr, int fq) const {
        const int row0 = u.pm * BM + wr * 64 + fr, col0 = u.pn * BM + wc * 32 + 8 * fq;
#pragma unroll
        for (int ai = 0; ai < 2; ++ai)
#pragma unroll
            for (int m = 0; m < 4; ++m) { bf16_t* rowp = O + (size_t)(row0 + ai * HALF + m * 16) * ldc + col0;
#pragma unroll
                for (int bj = 0; bj < 2; ++bj) store8(rowp + bj * HALF, acc[ai][bj][m][0], acc[ai][bj][m][1]); }
    }
};
struct EpiInProj {
    static constexpr bool PERM = true;
    bf16_t* O; const float* rc; const float* rs;
    __device__ __forceinline__ void operator()(const f32x4 (&acc)[2][2][4][2], const Unit& u, int wr, int wc, int fr, int fq) const {
        const int row0 = u.pm * BM + wr * 64 + fr; const bool lat = u.pm < (NL / BM);
#pragma unroll
        for (int bj = 0; bj < 2; ++bj) {
            const int seg = 2 * u.pn + bj;
            const bool rope = lat && seg <= 4; const float sc = seg <= 3 ? QSCALE : (seg == 9 ? RSCALE : 1.0f);
#pragma unroll
            for (int ai = 0; ai < 2; ++ai)
#pragma unroll
                for (int m = 0; m < 4; ++m) { const int row = row0 + ai * HALF + m * 16;
                    f32x4 v0 = acc[ai][bj][m][0], v1 = acc[ai][bj][m][1];
                    if (rope) { const int t = row & (SEQ - 1); const int pos = (wc & 1) ? (t & 63) : (t >> 6);
                        const f32x4 c4 = *(const f32x4*)(rc + pos * 16 + 4 * fq), s4 = *(const f32x4*)(rs + pos * 16 + 4 * fq);
                        const f32x4 o0 = v0 * c4 - v1 * s4, o1 = v0 * s4 + v1 * c4; v0 = o0; v1 = o1; }
                    v0 = v0 * sc; v1 = v1 * sc;
                    store8(O + (size_t)row * INW + seg * HALF + wc * 32 + 8 * fq, v0, v1); }
        }
    }
};
struct EpiSwiGLU {
    static constexpr bool PERM = true;
    bf16_t* H; int ldh;
    __device__ __forceinline__ void operator()(const f32x4 (&acc)[2][2][4][2], const Unit& u, int wr, int wc, int fr, int fq) const {
        const int row0 = u.pm * BM + wr * 64 + fr, col0 = u.pn * HALF + wc * 32 + 8 * fq;
#pragma unroll
        for (int ai = 0; ai < 2; ++ai)
#pragma unroll
            for (int m = 0; m < 4; ++m) { f32x4 h[2];
#pragma unroll
                for (int n = 0; n < 2; ++n) { const f32x4 g = acc[ai][0][m][n], up = acc[ai][1][m][n];
#pragma unroll
                    for (int i = 0; i < 4; ++i) h[n][i] = g[i] * __builtin_amdgcn_rcpf(1.0f + __builtin_amdgcn_exp2f(-LOG2E * g[i])) * up[i]; }
                store8(H + (size_t)(row0 + ai * HALF + m * 16) * ldh + col0, h[0], h[1]); }
    }
};
struct EpiMoeDown {
    static constexpr bool PERM = true;
    bf16_t* Y; const int* list; const float* lgate;
    __device__ __forceinline__ void operator()(const f32x4 (&acc)[2][2][4][2], const Unit& u, int wr, int wc, int fr, int fq) const {
        const int col0 = u.pn * BM + wc * 32 + 8 * fq;
#pragma unroll
        for (int ai = 0; ai < 2; ++ai)
#pragma unroll
            for (int m = 0; m < 4; ++m) { const int pos = u.rt * BM + ai * HALF + wr * 64 + m * 16 + fr;
                if (pos < u.cnt) { const int ent = list[u.e * LCAP + pos]; const float g = lgate[u.e * LCAP + pos];
                    bf16_t* rowp = Y + ((size_t)(ent & 1) * NL + (size_t)(ent >> 1)) * D + col0;
#pragma unroll
                    for (int bj = 0; bj < 2; ++bj) store8(rowp + bj * HALF, acc[ai][bj][m][0] * g, acc[ai][bj][m][1] * g); } }
    }
};
template <bool GATHER_> struct MoeOrder {
    static constexpr bool GATHER = GATHER_;
    int nrt, nN, G, c, K, T0; int pre[NE + 1]; int cnt[NE];
    const char* A; const char* Bt; size_t bstride; const int* list;
    __device__ __forceinline__ bool next(int i, Unit& u) const {
        int pm, pn; if (nrt <= 0 || !tile_order(i, G, c, nrt, nN, pm, pn)) return false;
        const int T = T0 + pm; int e = 0;
#pragma unroll
        for (int j = 1; j < NE; ++j) e += (T >= pre[j]) ? 1 : 0;
        int p0 = pre[0], ce = cnt[0];
#pragma unroll
        for (int j = 1; j < NE; ++j) { p0 = (e == j) ? pre[j] : p0; ce = (e == j) ? cnt[j] : ce; }
        u.pm = pm; u.pn = pn; u.e = e; u.rt = T - p0; u.cnt = ce;
        u.ab = GATHER ? A : A + (size_t)pm * BM * K * 2; u.bb = Bt + (size_t)e * bstride + (size_t)pn * BM * K * 2; return true;
    }
    __device__ __forceinline__ void aoff(const Unit& u, const int (&R)[2], const int (&C)[2], unsigned (&va)[2][2]) const {
#pragma unroll
        for (int h = 0; h < 2; ++h)
#pragma unroll
            for (int i = 0; i < 2; ++i) {
                if (GATHER) { const int pos = u.rt * BM + R[i] + HALF * h; const int tok = pos < u.cnt ? (list[u.e * LCAP + pos] >> 1) : 0; va[h][i] = (unsigned)(tok * K + C[i]) * 2u; }
                else va[h][i] = (unsigned)((R[i] + HALF * h) * K + C[i]) * 2u; }
    }
};
}
constexpr size_t MiB = 1u << 20;
constexpr size_t WS_CTL = 0, CTL_ZERO_BYTES = 1 * MiB;
constexpr size_t WS_MOD = 1 * MiB;
constexpr size_t WS_ROPE = 1 * MiB + 512 * 1024;
constexpr size_t WS_LIST = 2 * MiB, WS_LGATE = 3 * MiB;
constexpr size_t WS_KVS = 8 * MiB;
constexpr size_t WS_XC = 26 * MiB;
constexpr size_t WS_WIN = 34 * MiB, WS_WOUT = 41 * MiB, WS_FGU = 45 * MiB, WS_FD = 56 * MiB, WS_MGU = 62 * MiB, WS_MD = 150 * MiB;
constexpr size_t WS_ACT = 194 * MiB;
constexpr size_t WS_PROJ = 262 * MiB, WS_MIX = 381 * MiB;
constexpr size_t WS_HID = 262 * MiB;
constexpr size_t WS_Y = 262 * MiB, WS_HIDS = 390 * MiB;
constexpr size_t WS_END = 478 * MiB;
static_assert(WS_WIN + (size_t)2 * INW * D * 2 <= WS_WOUT && WS_FGU + (size_t)2 * FF * D * 2 <= WS_FD && WS_FD + (size_t)FF * D * 2 <= WS_MGU && WS_MGU + (size_t)NE * 2 * FF * D * 2 <= WS_MD && WS_MD + (size_t)NE * FF * D * 2 <= WS_ACT, "weights map");
static_assert(WS_ACT + (size_t)MT * D * 2 <= WS_PROJ && WS_PROJ + (size_t)MT * INW * 2 <= WS_MIX && WS_MIX + (size_t)MT * D * 2 <= WS_END && WS_HID + (size_t)MT * FF * 2 <= WS_END, "act map");
static_assert(WS_Y + (size_t)2 * NL * D * 2 <= WS_HIDS && WS_HIDS + (size_t)64 * 256 * FF * 2 <= WS_END && WS_KVS + (size_t)2 * 32 * NCHK * 2048 * 4 <= WS_XC, "moe map");
constexpr int CW_TMO = 0;
constexpr int CW_GCNT = 1024;
constexpr int CW_BAR = 4096;

constexpr int RING_BYTES = 131072;
constexpr int SCR_BYTES = 155648;
constexpr int MISC_OFF = SCR_BYTES;
constexpr int LDS_BYTES = SCR_BYTES + 256;

#define GAS __attribute__((address_space(1)))
#define LAS __attribute__((address_space(3)))
typedef unsigned short bf16;
typedef unsigned v4u __attribute__((ext_vector_type(4)));
typedef unsigned v2u __attribute__((ext_vector_type(2)));
typedef float f32x4 __attribute__((ext_vector_type(4)));
typedef __bf16 bf16x2_t __attribute__((ext_vector_type(2)));
typedef float f32x2_t __attribute__((ext_vector_type(2)));
#define RLX_AGENT __ATOMIC_RELAXED, __HIP_MEMORY_SCOPE_AGENT
__device__ __forceinline__ unsigned pk2(float lo, float hi) { f32x2_t v = {lo, hi}; bf16x2_t b = __builtin_convertvector(v, bf16x2_t); return __builtin_bit_cast(unsigned, b); }
__device__ __forceinline__ float bflo(unsigned w) { return __uint_as_float(w << 16); }
__device__ __forceinline__ float bfhi(unsigned w) { return __uint_as_float(w & 0xffff0000u); }
__device__ __forceinline__ float dot2bf(unsigned a, unsigned b, float c) { return __builtin_amdgcn_fdot2_f32_bf16(__builtin_bit_cast(bf16x2_t, a), __builtin_bit_cast(bf16x2_t, b), c, false); }
__device__ __forceinline__ float wave_sum(float v) {
#pragma unroll
    for (int o = 1; o < 64; o <<= 1) v += __shfl_xor(v, o);
    return v;
}

#define XB_TMO      128
#define XB_XCNT(j)  (256  + 64 * (j))
#define XB_XSUB(j)  (1280 + 64 * (j))
#define XB_XGEN(j)  (2304 + 64 * (j))
#define XB_TOP      3328
#define XB_TOPGEN   3392
#define XCD_BAR_WORDS 3456
#define XB_SPIN_CAP (1u << 18)
__device__ __forceinline__ unsigned xb_ld(unsigned* p)              { return __hip_atomic_load(p, __ATOMIC_RELAXED, __HIP_MEMORY_SCOPE_AGENT); }
__device__ __forceinline__ unsigned xb_add(unsigned* p, unsigned v) { return __hip_atomic_fetch_add(p, v, __ATOMIC_RELAXED, __HIP_MEMORY_SCOPE_AGENT); }
__device__ __forceinline__ unsigned xb_xcc_id() { return (unsigned)__builtin_amdgcn_s_getreg((3 << 11) | 20) & 0xFu; }
#define XB_SPIN(cond, bar) do { unsigned _sp = 0; while (cond) { __builtin_amdgcn_s_sleep(1); \
    if ((++_sp & 255u) == 0u) { if (xb_ld(&(bar)[XB_TMO])) break; if (_sp > XB_SPIN_CAP) { atomicAdd(&(bar)[XB_TMO], 1u); break; } } } } while (0)
struct XcdBarrier { unsigned* bar; unsigned x; volatile LAS unsigned* st; };
__device__ __forceinline__ XcdBarrier xcd_barrier_post(unsigned* bar, volatile LAS unsigned* st) {
    XcdBarrier b; b.bar = bar; b.x = xb_xcc_id(); b.st = st;
    if (threadIdx.x == 0) (void)xb_add(&bar[XB_XCNT(b.x)], 1u);
    return b;
}
__device__ __forceinline__ void xcd_barrier_complete(unsigned* bar, unsigned x, unsigned& nloc, unsigned& nx) {
    const unsigned G = gridDim.x * gridDim.y * gridDim.z;
    unsigned sum, cnt, mine, sp = 0u;
    for (;;) {
        sum = 0u; cnt = 0u; mine = 0u;
#pragma unroll
        for (unsigned j = 0; j < 16; ++j) { const unsigned c = xb_ld(&bar[XB_XCNT(j)]); sum += c; cnt += (c > 0u) ? 1u : 0u; mine = (j == x) ? c : mine; }
        if (sum == G) break;
        __builtin_amdgcn_s_sleep(1);
        if ((++sp & 255u) == 0u) { if (xb_ld(&bar[XB_TMO])) break; if (sp > XB_SPIN_CAP) { atomicAdd(&bar[XB_TMO], 1u); break; } }
    }
    nloc = mine > 0u ? mine : 1u; nx = cnt > 0u ? cnt : 1u;
}
__device__ __forceinline__ void xcd_barrier(const XcdBarrier& b) {
    asm volatile("s_waitcnt vmcnt(0)" ::: "memory");
    __syncthreads();
    if (threadIdx.x == 0) {
        unsigned* bar = b.bar;
        __builtin_amdgcn_s_waitcnt(0);
        unsigned nloc = b.st[0], nx = b.st[1];
        if (nloc == 0u) { xcd_barrier_complete(bar, b.x, nloc, nx); b.st[0] = nloc; b.st[1] = nx; }
        const unsigned old = xb_add(&bar[XB_XSUB(b.x)], 1u);
        const unsigned gen = old / nloc;
        if (old + 1u == (gen + 1u) * nloc) {
            __builtin_amdgcn_fence(__ATOMIC_RELEASE, "agent");
            asm volatile("s_waitcnt vmcnt(0)" ::: "memory");
            const unsigned og = xb_add(&bar[XB_TOP], 1u);
            const unsigned tg = og / nx;
            if (og + 1u == (tg + 1u) * nx) xb_add(&bar[XB_TOPGEN], 1u);
            else XB_SPIN(xb_ld(&bar[XB_TOPGEN]) == tg, bar);
            __builtin_amdgcn_fence(__ATOMIC_ACQUIRE, "agent");
            xb_add(&bar[XB_XGEN(b.x)], 1u);
            asm volatile("s_waitcnt vmcnt(0)" ::: "memory");
        } else {
            XB_SPIN(xb_ld(&bar[XB_XGEN(b.x)]) == gen, bar);
            __builtin_amdgcn_fence(__ATOMIC_ACQUIRE, "agent");
            asm volatile("s_waitcnt vmcnt(0)" ::: "memory");
        }
    }
    __syncthreads();
}

constexpr int NWAVES = 8, NTHR = 512;
struct Frame {
    LAS unsigned char* lds;
    int tid, lane, wave, vcu, G;
    unsigned char* ws; float* out;
    const float *x, *c, *ctx, *c_ctx, *w_mod, *b_mod, *w_in, *sink, *pool_w, *pool_scale, *lgf, *lgb, *w_out, *ln1_g, *ln1_b, *ln2_g, *ln2_b;
    const float *fw_gate, *fw_up, *fw_down, *router, *mw_gate, *mw_up, *mw_down;
};
#define WSP(T, off) ((T*)(F.ws + (off)))

template <class RowMap>
__device__ __forceinline__ void transpose_item(const float* W, int K, int N, bf16* WT, const RowMap& rowmap, LAS float* scr, int item, int lane) {
    const int nblk = N / 32, kb = item / nblk, nb = item % nblk, k0 = 64 * kb, n0 = 32 * nb;
#pragma unroll 8
    for (int i = 0; i < 32; ++i) { const int kk = 2 * i + (lane >> 5); scr[kk * 33 + (lane & 31)] = W[(size_t)(k0 + kk) * N + n0 + (lane & 31)]; }
    asm volatile("s_waitcnt lgkmcnt(0)" ::: "memory");
    const int c = lane & 7;
#pragma unroll
    for (int j = 0; j < 4; ++j) { const int n = (lane >> 3) + 8 * j; const LAS float* s = scr + (8 * c) * 33 + n;
        v4u o; o.x = pk2(s[0 * 33], s[1 * 33]); o.y = pk2(s[2 * 33], s[3 * 33]); o.z = pk2(s[4 * 33], s[5 * 33]); o.w = pk2(s[6 * 33], s[7 * 33]);
        *(GAS v4u*)(WT + (size_t)rowmap(n0 + n) * K + k0 + 8 * c) = o; }
    asm volatile("s_waitcnt lgkmcnt(0)" ::: "memory");
}
struct MapId { __device__ __forceinline__ int operator()(int n) const { return n; } };
struct MapInProj {
    __device__ __forceinline__ int operator()(int n) const { if (n >= C_V) return n; const int dd = n & 31, j = dd & 15, x2 = dd >> 4; return (n & ~31) + 8 * (j >> 2) + 4 * x2 + (j & 3); } };
struct MapGU { int up; __device__ __forceinline__ int operator()(int n) const { return 256 * (n >> 7) + 128 * up + (n & 127); } };

__device__ __forceinline__ void p_prep(Frame& F) {
    const int tid = opq(F.tid), lane = tid & 63, wave = F.wave;
    LAS float* sv = (LAS float*)F.lds;
    LAS float* red = sv + 1024 * 12;
    bool have_sv = false;
    for (int un = blockIdx.x; un < 2 * 96; un += F.G) {
        if (!have_sv) {
            for (int idx = tid; idx < 9 * 1024; idx += NTHR) { const int r = idx >> 10, k = idx & 1023; const float v = r < 8 ? F.c[r * 1024 + k] : F.c_ctx[k]; sv[k * 12 + r] = v / (1.0f + __expf(-v)); }
            have_sv = true; __syncthreads();
        }
        const int layer = un / 96, cc = un % 96, col = cc * 64 + lane;
        float acc[9];
#pragma unroll
        for (int r = 0; r < 9; ++r) acc[r] = 0.f;
        const float* wp = F.w_mod + ((size_t)layer * 1024 + wave * 128) * 6144 + col;
#pragma unroll 8
        for (int kk = 0; kk < 128; ++kk) { const float wv = wp[(size_t)kk * 6144]; const LAS float* s = sv + (wave * 128 + kk) * 12;
            const f32x4 s0 = *(const LAS f32x4*)s, s1 = *(const LAS f32x4*)(s + 4); const float s8 = s[8];
            acc[0] += s0[0] * wv; acc[1] += s0[1] * wv; acc[2] += s0[2] * wv; acc[3] += s0[3] * wv; acc[4] += s1[0] * wv; acc[5] += s1[1] * wv; acc[6] += s1[2] * wv; acc[7] += s1[3] * wv; acc[8] += s8 * wv; }
#pragma unroll
        for (int r = 0; r < 9; ++r) red[(wave * 9 + r) * 64 + lane] = acc[r];
        __syncthreads();
        for (int idx = tid; idx < 9 * 64; idx += NTHR) { const int r = idx >> 6, ln = idx & 63; float s = F.b_mod[layer * 6144 + cc * 64 + ln];
#pragma unroll
            for (int w = 0; w < 8; ++w) s += red[(w * 9 + r) * 64 + ln];
            WSP(float, WS_MOD)[(size_t)(layer * 9 + r) * 6144 + cc * 64 + ln] = s; }
        __syncthreads();
    }
    if (blockIdx.x == F.G - 1) { for (int idx = tid; idx < 1024; idx += NTHR) { const int pos = idx >> 4, j = idx & 15; const float inv = powf(10000.0f, -(float)j / 16.0f); const float ang = (float)pos * inv;
            WSP(float, WS_ROPE)[idx] = cosf(ang); WSP(float, WS_ROPE)[1024 + idx] = sinf(ang); } }
    __syncthreads();
    LAS float* scr = (LAS float*)(F.lds + wave * 16384);
    const int gw = F.vcu * NWAVES + wave, NGW = F.G * NWAVES;
    constexpr int I_IN = (D / 64) * (INW / 32), I_OUT = (D / 64) * (D / 32), I_GU = (D / 64) * (FF / 32), I_DN = (FF / 64) * (D / 32);
    constexpr int NITEMS = 2 * (I_IN + I_OUT) + (1 + NE) * (2 * I_GU + I_DN);
    for (int it = gw; it < NITEMS; it += NGW) {
        int r = it;
        if (r < 2 * I_IN) { const int l = r / I_IN; transpose_item(F.w_in + (size_t)l * D * INW, D, INW, WSP(bf16, WS_WIN) + (size_t)l * INW * D, MapInProj{}, scr, r % I_IN, lane); continue; } r -= 2 * I_IN;
        if (r < 2 * I_OUT) { const int l = r / I_OUT; transpose_item(F.w_out + (size_t)l * D * D, D, D, WSP(bf16, WS_WOUT) + (size_t)l * D * D, MapId{}, scr, r % I_OUT, lane); continue; } r -= 2 * I_OUT;
        const int per = 2 * I_GU + I_DN, m = r / per; r %= per;
        const float* wg = m == 0 ? F.fw_gate : F.mw_gate + (size_t)(m - 1) * D * FF; const float* wu = m == 0 ? F.fw_up : F.mw_up + (size_t)(m - 1) * D * FF; const float* wd = m == 0 ? F.fw_down : F.mw_down + (size_t)(m - 1) * FF * D;
        bf16* gu = m == 0 ? WSP(bf16, WS_FGU) : WSP(bf16, WS_MGU) + (size_t)(m - 1) * 2 * FF * D; bf16* dn = m == 0 ? WSP(bf16, WS_FD) : WSP(bf16, WS_MD) + (size_t)(m - 1) * FF * D;
        if (r < I_GU) { transpose_item(wg, D, FF, gu, MapGU{0}, scr, r, lane); continue; } r -= I_GU;
        if (r < I_GU) { transpose_item(wu, D, FF, gu, MapGU{1}, scr, r, lane); continue; } r -= I_GU;
        transpose_item(wd, FF, D, dn, MapId{}, scr, r, lane);
    }
}

__device__ __forceinline__ void row_load_f32(const float* p, int lane, f32x4 (&v)[4]) {
#pragma unroll
    for (int j = 0; j < 4; ++j) v[j] = *(const f32x4*)(p + 4 * lane + 256 * j);
}
__device__ __forceinline__ void row_load_bf16(const bf16* p, int lane, f32x4 (&v)[4]) {
#pragma unroll
    for (int j = 0; j < 4; ++j) { const v2u w = *(const v2u*)(p + 4 * lane + 256 * j); v[j] = (f32x4){bflo(w.x), bfhi(w.x), bflo(w.y), bfhi(w.y)}; }
}
__device__ __forceinline__ void row_store_bf16(bf16* p, int lane, const f32x4 (&v)[4]) {
#pragma unroll
    for (int j = 0; j < 4; ++j) { v2u w; w.x = pk2(v[j][0], v[j][1]); w.y = pk2(v[j][2], v[j][3]); *(v2u*)(p + 4 * lane + 256 * j) = w; }
}
__device__ __forceinline__ void row_store_f32(float* p, int lane, const f32x4 (&v)[4]) {
#pragma unroll
    for (int j = 0; j < 4; ++j) *(f32x4*)(p + 4 * lane + 256 * j) = v[j];
}
__device__ __forceinline__ void row_ln(f32x4 (&v)[4], const float* g, const float* b, int lane) {
    float s = 0.f;
#pragma unroll
    for (int j = 0; j < 4; ++j) s += (v[j][0] + v[j][1]) + (v[j][2] + v[j][3]);
    const float mean = wave_sum(s) * (1.0f / D); float q = 0.f;
#pragma unroll
    for (int j = 0; j < 4; ++j) { v[j] = v[j] - mean; q += (v[j][0] * v[j][0] + v[j][1] * v[j][1]) + (v[j][2] * v[j][2] + v[j][3] * v[j][3]); }
    const float rstd = 1.0f / sqrtf(wave_sum(q) * (1.0f / D) + LN_EPS);
#pragma unroll
    for (int j = 0; j < 4; ++j) { const f32x4 gg = *(const f32x4*)(g + 4 * lane + 256 * j), bb = *(const f32x4*)(b + 4 * lane + 256 * j); v[j] = v[j] * rstd * gg + bb; }
}
__device__ __forceinline__ const float* modp(Frame& F, int layer, int mr, int part) { return WSP(float, WS_MOD) + (size_t)(layer * 9 + mr) * 6144 + part * 1024; }
__device__ __forceinline__ void row_modulate(f32x4 (&v)[4], const float* sh, const float* sc, int lane) {
#pragma unroll
    for (int j = 0; j < 4; ++j) { const f32x4 a = *(const f32x4*)(sc + 4 * lane + 256 * j), b = *(const f32x4*)(sh + 4 * lane + 256 * j); v[j] = v[j] * (1.0f + a) + b; }
}
__device__ __forceinline__ void p_h0(Frame& F) {
    const int gw = F.vcu * NWAVES + F.wave, NGW = F.G * NWAVES, lane = opq(F.lane);
    for (int r = gw; r < MT; r += NGW) { const int mr = r < NL ? (r >> 12) : 8; const float* xr = r < NL ? F.x + (size_t)r * D : F.ctx + (size_t)(r - NL) * D;
        f32x4 v[4]; row_load_f32(xr, lane, v); row_modulate(v, modp(F, 0, mr, 0), modp(F, 0, mr, 1), lane); row_store_bf16(WSP(bf16, WS_ACT) + (size_t)r * D, lane, v); }
}
__device__ __forceinline__ void p_ln1(Frame& F, int layer) {
    const int lane = opq(F.lane);
    if (layer == 0) {
        const int gw = F.vcu * NWAVES + F.wave, NGW = F.G * NWAVES;
        for (int r = gw; r < MT; r += NGW) { const int mr = r < NL ? (r >> 12) : 8; const float* xr = r < NL ? F.x + (size_t)r * D : F.ctx + (size_t)(r - NL) * D;
            float* xo = r < NL ? F.out + (size_t)r * D : WSP(float, WS_XC) + (size_t)(r - NL) * D; bf16* ar = WSP(bf16, WS_ACT) + (size_t)r * D;
            f32x4 v[4], y[4]; row_load_f32(xr, lane, v); row_load_bf16(ar, lane, y); const float* g1 = modp(F, 0, mr, 2);
#pragma unroll
            for (int j = 0; j < 4; ++j) v[j] = ALPHA * v[j] + *(const f32x4*)(g1 + 4 * lane + 256 * j) * y[j];
            row_ln(v, F.ln1_g, F.ln1_b, lane); row_store_f32(xo, lane, v);
            row_modulate(v, modp(F, 0, mr, 3), modp(F, 0, mr, 4), lane); row_store_bf16(ar, lane, v); }
        return;
    }
    LAS int* lcnt = (LAS int*)F.lds; LAS int* lbase = lcnt + 8; LAS int* rinfo = lcnt + 16;
    float rt[16][8];
#pragma unroll
    for (int j = 0; j < 4; ++j)
#pragma unroll
        for (int q = 0; q < 4; ++q) { const float* rp = F.router + (size_t)(4 * lane + 256 * j + q) * 8; const f32x4 a = *(const f32x4*)rp, b = *(const f32x4*)(rp + 4);
            rt[j * 4 + q][0] = a[0]; rt[j * 4 + q][1] = a[1]; rt[j * 4 + q][2] = a[2]; rt[j * 4 + q][3] = a[3]; rt[j * 4 + q][4] = b[0]; rt[j * 4 + q][5] = b[1]; rt[j * 4 + q][6] = b[2]; rt[j * 4 + q][7] = b[3]; }
    for (int rb = blockIdx.x; rb < NL / 128; rb += F.G) {
        if (F.tid < 8) lcnt[F.tid] = 0;
        __syncthreads();
        for (int i = 0; i < 16; ++i) { const int rl = F.wave * 16 + i, r = rb * 128 + rl, mr = r >> 12;
            float* xo = F.out + (size_t)r * D; bf16* ar = WSP(bf16, WS_ACT) + (size_t)r * D;
            f32x4 v[4], y[4]; row_load_f32(xo, lane, v); row_load_bf16(ar, lane, y); const float* g1 = modp(F, 1, mr, 2);
#pragma unroll
            for (int j = 0; j < 4; ++j) v[j] = ALPHA * v[j] + *(const f32x4*)(g1 + 4 * lane + 256 * j) * y[j];
            row_ln(v, F.ln1_g + D, F.ln1_b + D, lane); row_store_f32(xo, lane, v);
            row_modulate(v, modp(F, 1, mr, 3), modp(F, 1, mr, 4), lane); row_store_bf16(ar, lane, v);
            float lg[8];
#pragma unroll
            for (int e = 0; e < 8; ++e) { float s = 0.f;
#pragma unroll
                for (int j = 0; j < 4; ++j)
#pragma unroll
                    for (int q = 0; q < 4; ++q) s += v[j][q] * rt[j * 4 + q][e];
                lg[e] = wave_sum(s); }
            int i1 = 0; float v1 = lg[0];
#pragma unroll
            for (int e = 1; e < 8; ++e) if (lg[e] > v1) { v1 = lg[e]; i1 = e; }
            int i2 = -1; float v2 = -3.0e38f;
#pragma unroll
            for (int e = 0; e < 8; ++e) if (e != i1 && lg[e] > v2) { v2 = lg[e]; i2 = e; }
            const float ex = __expf(v2 - v1), w1 = 1.0f / (1.0f + ex), w2 = ex / (1.0f + ex);
            if (lane == 0) { const int p1 = __hip_atomic_fetch_add(lcnt + i1, 1, __ATOMIC_RELAXED, __HIP_MEMORY_SCOPE_WORKGROUP), p2 = __hip_atomic_fetch_add(lcnt + i2, 1, __ATOMIC_RELAXED, __HIP_MEMORY_SCOPE_WORKGROUP);
                LAS int* ri = rinfo + rl * 6; ri[0] = i1; ri[1] = p1; ri[2] = __float_as_int(w1); ri[3] = i2; ri[4] = p2; ri[5] = __float_as_int(w2); }
        }
        __syncthreads();
        if (F.tid < 8) lbase[F.tid] = (int)__hip_atomic_fetch_add((unsigned*)(WSP(unsigned, WS_CTL) + CW_GCNT + 64 * F.tid), (unsigned)lcnt[F.tid], RLX_AGENT);
        __syncthreads();
        if (F.tid < 256) { const int rl = F.tid >> 1, s = F.tid & 1; const LAS int* ri = rinfo + rl * 6 + 3 * s; const int e = ri[0], pos = lbase[e] + ri[1];
            WSP(int, WS_LIST)[e * LCAP + pos] = ((rb * 128 + rl) << 1) | s; WSP(float, WS_LGATE)[e * LCAP + pos] = __int_as_float(ri[2]); }
        __syncthreads();
    }
}
__device__ __forceinline__ void p_ln2_l0(Frame& F) {
    const int lane = opq(F.lane), gw = F.vcu * NWAVES + F.wave, NGW = F.G * NWAVES;
    for (int r = gw; r < MT; r += NGW) { const int mr = r < NL ? (r >> 12) : 8;
        float* xo = r < NL ? F.out + (size_t)r * D : WSP(float, WS_XC) + (size_t)(r - NL) * D; bf16* ar = WSP(bf16, WS_ACT) + (size_t)r * D;
        f32x4 v[4], y[4]; row_load_f32(xo, lane, v); row_load_bf16(ar, lane, y); const float* g2 = modp(F, 0, mr, 5);
#pragma unroll
        for (int j = 0; j < 4; ++j) v[j] = ALPHA * v[j] + *(const f32x4*)(g2 + 4 * lane + 256 * j) * y[j];
        row_ln(v, F.ln2_g, F.ln2_b, lane); row_store_f32(xo, lane, v);
        row_modulate(v, modp(F, 1, mr, 0), modp(F, 1, mr, 1), lane); row_store_bf16(ar, lane, v); }
}
__device__ __forceinline__ void p_final(Frame& F) {
    const int lane = opq(F.lane), gw = F.vcu * NWAVES + F.wave, NGW = F.G * NWAVES;
    for (int r = gw; r < NL; r += NGW) { const int mr = r >> 12; float* xo = F.out + (size_t)r * D;
        f32x4 v[4], y0[4], y1[4]; row_load_f32(xo, lane, v); row_load_bf16(WSP(bf16, WS_Y) + (size_t)r * D, lane, y0); row_load_bf16(WSP(bf16, WS_Y) + (size_t)(NL + r) * D, lane, y1); const float* g2 = modp(F, 1, mr, 5);
#pragma unroll
        for (int j = 0; j < 4; ++j) v[j] = ALPHA * v[j] + *(const f32x4*)(g2 + 4 * lane + 256 * j) * (y0[j] + y1[j]);
        row_ln(v, F.ln2_g + D, F.ln2_b + D, lane); row_store_f32(xo, lane, v); }
}
__device__ __forceinline__ void attn_naive_unit(Frame& F, int layer, int b, int qb, int kvh, bool isctx) {
    const int tid = opq(F.tid), qq = tid & 127, g = tid >> 7, head = kvh * 4 + g;
    const bf16* P = WSP(bf16, WS_PROJ);
    const int qrow = isctx ? NL + b * CTXL + qb * 128 + qq : b * SEQ + qb * 128 + qq;
    LAS unsigned* kt = (LAS unsigned*)F.lds;
    LAS unsigned* vt = kt + 64 * 32;
    unsigned q[32];
#pragma unroll
    for (int i = 0; i < 8; ++i) { const v4u w = *(const v4u*)(P + (size_t)qrow * INW + head * 64 + i * 8); q[4 * i] = w.x; q[4 * i + 1] = w.y; q[4 * i + 2] = w.z; q[4 * i + 3] = w.w; }
    float m = F.sink[layer * 8 + head] * LOG2E, l = 1.0f, o[64];
#pragma unroll
    for (int d = 0; d < 64; ++d) o[d] = 0.f;
    const int qpos = qb * 128 + qq;
    for (int tile = isctx ? 6 : 0; tile < 10; ++tile) {
        int krow0, kpos0 = 0; const bool local = tile < 6;
        if (local) { kpos0 = qb * 128 - 128 + 64 * tile; if (kpos0 < 0 || kpos0 >= SEQ) continue; krow0 = b * SEQ + kpos0; }
        else krow0 = NL + b * CTXL + 64 * (tile - 6);
        __syncthreads();
        { const int r = tid >> 3, ch = tid & 7; const bf16* src = P + (size_t)(krow0 + r) * INW + kvh * 64 + ch * 8;
          *(LAS v4u*)(kt + r * 32 + ch * 4) = *(const v4u*)(src + C_K); *(LAS v4u*)(vt + r * 32 + ch * 4) = *(const v4u*)(src + C_V); }
        __syncthreads();
        for (int j = 0; j < 64; ++j) {
            float s = 0.f;
#pragma unroll
            for (int i = 0; i < 32; ++i) s = dot2bf(q[i], kt[j * 32 + i], s);
            const int dlt = qpos - (kpos0 + j); const bool valid = !local || (dlt <= 128 && dlt >= -128);
            if (valid) {
                if (s > m) { const float f = __builtin_amdgcn_exp2f(m - s); l *= f;
#pragma unroll
                    for (int d = 0; d < 64; ++d) o[d] *= f;
                    m = s; }
                const float p = __builtin_amdgcn_exp2f(s - m); l += p;
#pragma unroll
                for (int i = 0; i < 32; ++i) { const unsigned w = vt[j * 32 + i]; o[2 * i] += p * bflo(w); o[2 * i + 1] += p * bfhi(w); }
            }
        }
    }
    const float rl = 1.0f / l;
    bf16* dst = WSP(bf16, WS_MIX) + (size_t)qrow * D + head * 64;
#pragma unroll
    for (int i = 0; i < 8; ++i) { v4u w; w.x = pk2(o[8 * i] * rl, o[8 * i + 1] * rl); w.y = pk2(o[8 * i + 2] * rl, o[8 * i + 3] * rl); w.z = pk2(o[8 * i + 4] * rl, o[8 * i + 5] * rl); w.w = pk2(o[8 * i + 6] * rl, o[8 * i + 7] * rl); *(v4u*)(dst + 8 * i) = w; }
    __syncthreads();
}
__device__ __forceinline__ void pool_naive_unit(Frame& F, int layer, int s, int blk) {
    const int tid = opq(F.tid); const bool isctx = s >= 8; const int b = s & 7, len = isctx ? CTXL : SEQ, row0 = isctx ? NL + b * CTXL : b * SEQ, t0 = blk * 128;
    const bf16* P = WSP(bf16, WS_PROJ);
    LAS float* ub = (LAS float*)F.lds;
    LAS float* pwb = ub + 144 * 64;
    LAS float* db = pwb + 64 * 64;
    for (int g = 0; g < 4; ++g) { const int hw = 1 << g;
        __syncthreads();
        for (int idx = tid; idx < 144 * 8; idx += NTHR) { const int rr = idx >> 3, ch = idx & 7, t = t0 - 8 + rr; v4u w = (v4u){0u, 0u, 0u, 0u};
            if (t >= 0 && t < len) w = *(const v4u*)(P + (size_t)(row0 + t) * INW + C_U + g * 64 + ch * 8);
            LAS float* d = ub + rr * 64 + ch * 8; d[0] = bflo(w.x); d[1] = bfhi(w.x); d[2] = bflo(w.y); d[3] = bfhi(w.y); d[4] = bflo(w.z); d[5] = bfhi(w.z); d[6] = bflo(w.w); d[7] = bfhi(w.w); }
        for (int idx = tid; idx < 4096; idx += NTHR) pwb[idx] = F.pool_w[(size_t)(layer * 4 + g) * 4096 + idx];
        __syncthreads();
        for (int idx = tid; idx < 8192; idx += NTHR) { const int t = idx >> 6, c = idx & 63, tt = t0 + t; const int lo = max(tt - hw, 0), hi = min(tt + hw, len); float sum = 0.f;
            for (int p = lo; p < hi; ++p) sum += ub[(p - t0 + 8) * 64 + c];
            db[t * 65 + c] = sum / (float)(hi - lo) - ub[(t + 8) * 64 + c]; }
        __syncthreads();
        const int t = tid & 127, dq = tid >> 7; float acc[16];
#pragma unroll
        for (int i = 0; i < 16; ++i) acc[i] = 0.f;
        for (int c = 0; c < 64; ++c) { const float xv = db[t * 65 + c];
#pragma unroll
            for (int i = 0; i < 16; ++i) acc[i] += xv * pwb[c * 64 + dq * 16 + i]; }
        const float* ps = F.pool_scale + layer * 256 + g * 64 + dq * 16;
        bf16* dst = WSP(bf16, WS_MIX) + (size_t)(row0 + t0 + t) * D + 512 + g * 64 + dq * 16;
#pragma unroll
        for (int i = 0; i < 2; ++i) { v4u w; w.x = pk2(acc[8 * i] * ps[8 * i], acc[8 * i + 1] * ps[8 * i + 1]); w.y = pk2(acc[8 * i + 2] * ps[8 * i + 2], acc[8 * i + 3] * ps[8 * i + 3]);
            w.z = pk2(acc[8 * i + 4] * ps[8 * i + 4], acc[8 * i + 5] * ps[8 * i + 5]); w.w = pk2(acc[8 * i + 6] * ps[8 * i + 6], acc[8 * i + 7] * ps[8 * i + 7]); *(v4u*)(dst + 8 * i) = w; }
    }
    __syncthreads();
}
__device__ __forceinline__ int chunk_row0(int b, int cid) { return cid < 2 ? NL + b * CTXL + cid * 128 : b * SEQ + (cid - 2) * 128; }
__device__ __forceinline__ void kv_naive_unit(Frame& F, int layer, int b, int h, int cid) {
    const int tid = opq(F.tid); const bf16* P = WSP(bf16, WS_PROJ); const int row0 = chunk_row0(b, cid);
    LAS float* kf = (LAS float*)F.lds;
    LAS float* vf = kf + 128 * 32;
    LAS float* wf = vf + 128 * 64;
    const float lgf = F.lgf[layer * 4 + h], lgb = F.lgb[layer * 4 + h];
    __syncthreads();
    { const int r = tid >> 2, ch = tid & 3; const v4u w = *(const v4u*)(P + (size_t)(row0 + r) * INW + C_RK + h * 32 + ch * 8); LAS float* d = kf + r * 32 + ch * 8;
      d[0] = bflo(w.x); d[1] = bfhi(w.x); d[2] = bflo(w.y); d[3] = bfhi(w.y); d[4] = bflo(w.z); d[5] = bfhi(w.z); d[6] = bflo(w.w); d[7] = bfhi(w.w); }
    for (int idx = tid; idx < 1024; idx += NTHR) { const int r = idx >> 3, ch = idx & 7; const v4u w = *(const v4u*)(P + (size_t)(row0 + r) * INW + C_RV + h * 64 + ch * 8); LAS float* d = vf + r * 64 + ch * 8;
      d[0] = bflo(w.x); d[1] = bfhi(w.x); d[2] = bflo(w.y); d[3] = bfhi(w.y); d[4] = bflo(w.z); d[5] = bfhi(w.z); d[6] = bflo(w.w); d[7] = bfhi(w.w); }
    if (tid < 128) { wf[tid] = __expf(lgf * (float)(127 - tid)); wf[128 + tid] = __expf(lgb * (float)tid); }
    __syncthreads();
    const int i = tid >> 4, e0 = (tid & 15) * 4; f32x4 af = (f32x4){0.f, 0.f, 0.f, 0.f}, ab = af;
    for (int m = 0; m < 128; ++m) { const float kk = kf[m * 32 + i]; const f32x4 vv = *(const LAS f32x4*)(vf + m * 64 + e0); af += (kk * wf[m]) * vv; ab += (kk * wf[128 + m]) * vv; }
    float* dst = WSP(float, WS_KVS) + ((size_t)(b * 4 + h) * NCHK + cid) * 2048 + i * 64 + e0;
    *(f32x4*)dst = af; *(f32x4*)(dst + (size_t)32 * NCHK * 2048) = ab;
    __syncthreads();
}
__device__ __forceinline__ void p_scan(Frame& F, int layer) {
    for (int gid = blockIdx.x * NTHR + opq(F.tid); gid < 2 * 32 * 2048; gid += F.G * NTHR) {
        const int dir = gid >> 16, bh = (gid >> 11) & 31, e = gid & 2047; const float lg = (dir ? F.lgb : F.lgf)[layer * 4 + (bh & 3)]; const float G = __expf(lg * 128.0f);
        float* base = WSP(float, WS_KVS) + ((size_t)(dir * 32 + bh) * NCHK) * 2048 + e;
        float kv[NCHK];
#pragma unroll
        for (int c = 0; c < NCHK; ++c) kv[c] = base[(size_t)c * 2048];
        float S = 0.f;
        if (dir == 0) {
#pragma unroll
            for (int c = 0; c < NCHK; ++c) { base[(size_t)c * 2048] = S; S = G * S + kv[c]; }
        } else {
            base[2048] = S; S = G * S + kv[1]; base[0] = S; S = G * S + kv[0];
#pragma unroll
            for (int c = NCHK - 1; c >= 2; --c) { base[(size_t)c * 2048] = S; S = G * S + kv[c]; }
        }
    }
}
__device__ __forceinline__ void ret_naive_unit(Frame& F, int layer, int b, int h, int cid) {
    const int tid = opq(F.tid); const bf16* P = WSP(bf16, WS_PROJ); const int row0 = chunk_row0(b, cid);
    LAS float* kf = (LAS float*)F.lds;
    LAS float* qf = kf + 128 * 33;
    LAS float* vf = qf + 128 * 33;
    LAS float* Am = vf + 128 * 64;
    LAS float* Sf = Am + 128 * 129;
    LAS float* red = Sf + 2 * 2048;
    const float lgf = F.lgf[layer * 4 + h], lgb = F.lgb[layer * 4 + h];
    __syncthreads();
    { const int r = tid >> 2, ch = tid & 3; const v4u w = *(const v4u*)(P + (size_t)(row0 + r) * INW + C_RK + h * 32 + ch * 8); LAS float* d = kf + r * 33 + ch * 8;
      d[0] = bflo(w.x); d[1] = bfhi(w.x); d[2] = bflo(w.y); d[3] = bfhi(w.y); d[4] = bflo(w.z); d[5] = bfhi(w.z); d[6] = bflo(w.w); d[7] = bfhi(w.w); }
    { const int r = tid >> 2, ch = tid & 3; const v4u w = *(const v4u*)(P + (size_t)(row0 + r) * INW + C_RQ + h * 32 + ch * 8); LAS float* d = qf + r * 33 + ch * 8;
      d[0] = bflo(w.x); d[1] = bfhi(w.x); d[2] = bflo(w.y); d[3] = bfhi(w.y); d[4] = bflo(w.z); d[5] = bfhi(w.z); d[6] = bflo(w.w); d[7] = bfhi(w.w); }
    for (int idx = tid; idx < 1024; idx += NTHR) { const int r = idx >> 3, ch = idx & 7; const v4u w = *(const v4u*)(P + (size_t)(row0 + r) * INW + C_RV + h * 64 + ch * 8); LAS float* d = vf + r * 64 + ch * 8;
      d[0] = bflo(w.x); d[1] = bfhi(w.x); d[2] = bflo(w.y); d[3] = bfhi(w.y); d[4] = bflo(w.z); d[5] = bfhi(w.z); d[6] = bflo(w.w); d[7] = bfhi(w.w); }
    { const float* sp = WSP(float, WS_KVS) + ((size_t)(b * 4 + h) * NCHK + cid) * 2048;
      for (int idx = tid; idx < 2048; idx += NTHR) { Sf[idx] = sp[idx]; Sf[2048 + idx] = sp[(size_t)32 * NCHK * 2048 + idx]; } }
    const int n = tid & 127, qt = tid >> 7;
    __syncthreads();
#pragma unroll 1
    for (int mm = 0; mm < 32; ++mm) { const int m = qt * 32 + mm; float s = 0.f;
#pragma unroll 8
        for (int d = 0; d < 32; ++d) s += qf[n * 33 + d] * kf[m * 33 + d];
        const float w = m < n ? __expf(lgf * (float)(n - m)) : (m > n ? __expf(lgb * (float)(m - n)) : 2.0f);
        Am[n * 129 + m] = s * w; }
    __syncthreads();
    float o[16];
#pragma unroll
    for (int i = 0; i < 16; ++i) o[i] = 0.f;
#pragma unroll 2
    for (int m = 0; m < 128; ++m) { const float a = Am[n * 129 + m];
#pragma unroll
        for (int i = 0; i < 4; ++i) { const f32x4 vv = *(const LAS f32x4*)(vf + m * 64 + qt * 16 + 4 * i); o[4 * i] += a * vv[0]; o[4 * i + 1] += a * vv[1]; o[4 * i + 2] += a * vv[2]; o[4 * i + 3] += a * vv[3]; } }
    const float cf = __expf(lgf * (float)(n + 1)), cb = __expf(lgb * (float)(128 - n));
#pragma unroll 2
    for (int d = 0; d < 32; ++d) { const float qv = qf[n * 33 + d]; const float q1 = qv * cf, q2 = qv * cb;
#pragma unroll
        for (int i = 0; i < 4; ++i) { const f32x4 sf = *(const LAS f32x4*)(Sf + d * 64 + qt * 16 + 4 * i), sb = *(const LAS f32x4*)(Sf + 2048 + d * 64 + qt * 16 + 4 * i);
            o[4 * i] += q1 * sf[0] + q2 * sb[0]; o[4 * i + 1] += q1 * sf[1] + q2 * sb[1]; o[4 * i + 2] += q1 * sf[2] + q2 * sb[2]; o[4 * i + 3] += q1 * sf[3] + q2 * sb[3]; } }
    float s = 0.f;
#pragma unroll
    for (int i = 0; i < 16; ++i) s += o[i];
    red[n * 4 + qt] = s;
    __syncthreads();
    const float mean = (red[n * 4] + red[n * 4 + 1] + red[n * 4 + 2] + red[n * 4 + 3]) * (1.0f / 64.0f);
    __syncthreads();
    float qd = 0.f;
#pragma unroll
    for (int i = 0; i < 16; ++i) { o[i] -= mean; qd += o[i] * o[i]; }
    red[n * 4 + qt] = qd;
    __syncthreads();
    const float rstd = 1.0f / sqrtf((red[n * 4] + red[n * 4 + 1] + red[n * 4 + 2] + red[n * 4 + 3]) * (1.0f / 64.0f) + LN_EPS);
    const bf16* rgp = P + (size_t)(row0 + n) * INW + C_RG + h * 64 + qt * 16; bf16* dst = WSP(bf16, WS_MIX) + (size_t)(row0 + n) * D + 768 + h * 64 + qt * 16;
#pragma unroll
    for (int i = 0; i < 2; ++i) { const v4u w = *(const v4u*)(rgp + 8 * i); const float r8[8] = {bflo(w.x), bfhi(w.x), bflo(w.y), bfhi(w.y), bflo(w.z), bfhi(w.z), bflo(w.w), bfhi(w.w)}; float y8[8];
#pragma unroll
        for (int k = 0; k < 8; ++k) y8[k] = r8[k] / (1.0f + __expf(-r8[k])) * (o[8 * i + k] * rstd);
        v4u ow; ow.x = pk2(y8[0], y8[1]); ow.y = pk2(y8[2], y8[3]); ow.z = pk2(y8[4], y8[5]); ow.w = pk2(y8[6], y8[7]); *(v4u*)(dst + 8 * i) = ow; }
    __syncthreads();
}
__device__ __forceinline__ void p_mix_naive(Frame& F, int layer) {
    const int n_att = 512 + (layer == 0 ? 32 : 0);
    for (int u = blockIdx.x; u < n_att; u += F.G) {
        if (u < 512) attn_naive_unit(F, layer, u >> 6, (u >> 1) & 31, u & 1, false);
        else { const int v = u - 512; attn_naive_unit(F, layer, v >> 2, (v >> 1) & 1, v & 1, true); }
    }
    const int n_pool = 256 + (layer == 0 ? 16 : 0);
    for (int u = blockIdx.x; u < n_pool; u += F.G) { if (u < 256) pool_naive_unit(F, layer, u >> 5, u & 31); else pool_naive_unit(F, layer, 8 + ((u - 256) >> 1), (u - 256) & 1); }
    for (int u = blockIdx.x; u < 32 * NCHK; u += F.G) kv_naive_unit(F, layer, u / (4 * NCHK), (u / NCHK) & 3, u % NCHK);
}
__device__ __forceinline__ void p_ret_naive(Frame& F, int layer) {
    for (int u = blockIdx.x; u < 32 * NCHK; u += F.G) { const int cid = u % NCHK; if (layer == 1 && cid < 2) continue; ret_naive_unit(F, layer, u / (4 * NCHK), (u / NCHK) & 3, cid); }
}
#ifndef MK_N_LAUNCHES
#define MK_N_LAUNCHES 1
#endif
constexpr int NPHASE = 28;
struct Args { const float* in[24]; float* out; unsigned char* ws; int ph_lo, ph_hi; };

__device__ __forceinline__ void moe_tiles(Frame& F, int (&pre)[NE + 1], int (&cnt)[NE]) {
    int acc = 0;
#pragma unroll
    for (int e = 0; e < NE; ++e) { const int c = __builtin_amdgcn_readfirstlane((int)__hip_atomic_load(WSP(unsigned, WS_CTL) + CW_GCNT + 64 * e, RLX_AGENT)); cnt[e] = c; pre[e] = acc; acc += (c + 255) >> 8; }
    pre[NE] = acc;
}

#define IN(k) (lo <= (k) && (k) < hi)
#define SEAM(k) do { if (IN(k) && IN((k) + 1)) xcd_barrier(bar); } while (0)
template <int layer> __device__ __forceinline__ void layer_front(Frame& F, const XcdBarrier& bar, const int lo, const int hi) {
        const int pb = 2 + 9 * layer;
        if (IN(pb)) {
            pg8::StaticOrder S; S.init(WSP(bf16, WS_ACT), WSP(bf16, WS_WIN) + (size_t)layer * INW * D, MT, INW, D, F.G, (int)blockIdx.x);
            pg8::EpiInProj E{WSP(bf16, WS_PROJ), WSP(float, WS_ROPE), WSP(float, WS_ROPE) + 1024};
            pg8::gemm_phase(F.lds, D, S, E);
        } SEAM(pb);
        if (IN(pb + 1)) { p_mix_naive(F, layer); } SEAM(pb + 1);
        if (IN(pb + 2)) { p_scan(F, layer); } SEAM(pb + 2);
        if (IN(pb + 3)) { p_ret_naive(F, layer); } SEAM(pb + 3);
        if (IN(pb + 4)) {
            pg8::StaticOrder S; S.init(WSP(bf16, WS_MIX), WSP(bf16, WS_WOUT) + (size_t)layer * D * D, layer == 0 ? MT : NL, D, D, F.G, (int)blockIdx.x);
            pg8::EpiBf16 E{WSP(bf16, WS_ACT), D};
            pg8::gemm_phase(F.lds, D, S, E);
        } SEAM(pb + 4);
        if (IN(pb + 5)) { p_ln1(F, layer); } SEAM(pb + 5);
        if constexpr (layer == 0) {
        if (IN(8)) {
            pg8::StaticOrder S; S.init(WSP(bf16, WS_ACT), WSP(bf16, WS_FGU), MT, 2 * FF, D, F.G, (int)blockIdx.x);
            pg8::EpiSwiGLU E{WSP(bf16, WS_HID), FF};
            pg8::gemm_phase(F.lds, D, S, E);
        } SEAM(8);
        if (IN(9)) {
            pg8::StaticOrder S; S.init(WSP(bf16, WS_HID), WSP(bf16, WS_FD), MT, D, FF, F.G, (int)blockIdx.x);
            pg8::EpiBf16 E{WSP(bf16, WS_ACT), D};
            pg8::gemm_phase(F.lds, FF, S, E);
        } SEAM(9);
        if (IN(10)) { p_ln2_l0(F); } SEAM(10);
        }
}

__global__ void __launch_bounds__(NTHR, 2) hybrid_fwd(Args args) {
    extern __shared__ __attribute__((aligned(16))) unsigned char lds_raw[];
    Frame F;
    F.lds = (LAS unsigned char*)lds_raw;
    F.tid = threadIdx.x; F.lane = F.tid & 63; F.wave = __builtin_amdgcn_readfirstlane(F.tid >> 6);
    F.G = gridDim.x; { const int bx = blockIdx.x; F.vcu = (F.G % 8 == 0) ? (bx % 8) * (F.G / 8) + bx / 8 : bx; }
    F.ws = args.ws; F.out = args.out;
    F.x = args.in[0]; F.c = args.in[1]; F.ctx = args.in[2]; F.c_ctx = args.in[3]; F.w_mod = args.in[4]; F.b_mod = args.in[5]; F.w_in = args.in[6]; F.sink = args.in[7];
    F.pool_w = args.in[8]; F.pool_scale = args.in[9]; F.lgf = args.in[10]; F.lgb = args.in[11]; F.w_out = args.in[12]; F.ln1_g = args.in[13]; F.ln1_b = args.in[14]; F.ln2_g = args.in[15]; F.ln2_b = args.in[16];
    F.fw_gate = args.in[17]; F.fw_up = args.in[18]; F.fw_down = args.in[19]; F.router = args.in[20]; F.mw_gate = args.in[21]; F.mw_up = args.in[22]; F.mw_down = args.in[23];
    volatile LAS unsigned* MISC = (volatile LAS unsigned*)(F.lds + MISC_OFF);
    if (F.tid < 64) MISC[F.tid] = 0u;
    __syncthreads();
    const int lo = args.ph_lo, hi = args.ph_hi;
    XcdBarrier bar; bar.bar = WSP(unsigned, WS_CTL) + CW_BAR; bar.x = 0; bar.st = nullptr;
    if (hi - lo > 1) bar = xcd_barrier_post(WSP(unsigned, WS_CTL) + CW_BAR, MISC + 8);

    if (IN(0)) { p_prep(F); } SEAM(0);
    if (IN(1)) { p_h0(F); } SEAM(1);
    layer_front<0>(F, bar, lo, hi);
    layer_front<1>(F, bar, lo, hi);
    for (int s = 0; s < 5; ++s) {
        if (IN(17 + 2 * s)) {
            pg8::MoeOrder<true> S; moe_tiles(F, S.pre, S.cnt);
            S.T0 = 64 * s; S.nrt = min(S.pre[NE] - S.T0, 64); S.nN = 2 * FF / 256; S.G = F.G; S.c = (int)blockIdx.x; S.K = D;
            S.A = (const char*)WSP(bf16, WS_ACT); S.Bt = (const char*)WSP(bf16, WS_MGU); S.bstride = (size_t)2 * FF * D * 2; S.list = WSP(int, WS_LIST);
            pg8::EpiSwiGLU E{WSP(bf16, WS_HIDS), FF};
            pg8::gemm_phase(F.lds, D, S, E);
        } SEAM(17 + 2 * s);
        if (IN(18 + 2 * s)) {
            pg8::MoeOrder<false> S; moe_tiles(F, S.pre, S.cnt);
            S.T0 = 64 * s; S.nrt = min(S.pre[NE] - S.T0, 64); S.nN = D / 256; S.G = F.G; S.c = (int)blockIdx.x; S.K = FF;
            S.A = (const char*)WSP(bf16, WS_HIDS); S.Bt = (const char*)WSP(bf16, WS_MD); S.bstride = (size_t)FF * D * 2; S.list = WSP(int, WS_LIST);
            pg8::EpiMoeDown E{WSP(bf16, WS_Y), WSP(int, WS_LIST), WSP(float, WS_LGATE)};
            pg8::gemm_phase(F.lds, FF, S, E);
        } SEAM(18 + 2 * s);
    }
    if (IN(27)) { p_final(F); }
#undef IN
#undef SEAM
}

extern "C" void kernel_launch(void* const* d_in, const int* in_sizes, int n_in, void* d_out, int out_size, void* d_ws, size_t ws_size, hipStream_t stream) {
    static int grid = 0;
    if (grid == 0) {
        if (n_in != 24 || out_size != NL * D || ws_size < WS_END) { fprintf(stderr, "kernel_launch: unexpected shapes (n_in %d, out %d, ws %zu < %zu); nothing launched\n", n_in, out_size, ws_size, (size_t)WS_END); grid = -1; return; }
        int dev = 0, cus = 0, per_cu = 0;
        if (hipGetDevice(&dev) != hipSuccess || hipDeviceGetAttribute(&cus, hipDeviceAttributeMultiprocessorCount, dev) != hipSuccess) { grid = -1; return; }
        if (hipFuncSetAttribute((const void*)hybrid_fwd, hipFuncAttributeMaxDynamicSharedMemorySize, LDS_BYTES) != hipSuccess) { fprintf(stderr, "kernel_launch: hipFuncSetAttribute failed\n"); grid = -1; return; }
        if (hipOccupancyMaxActiveBlocksPerMultiprocessor(&per_cu, (const void*)hybrid_fwd, NTHR, LDS_BYTES) != hipSuccess || per_cu < 1) { fprintf(stderr, "kernel_launch: occupancy query says %d\n", per_cu); }
        (void)hipGetLastError();
        grid = cus;
    }
    if (grid < 0) return;
    if (hipMemsetAsync((char*)d_ws + WS_CTL, 0, CTL_ZERO_BYTES, stream) != hipSuccess) return;
    Args a{};
    for (int i = 0; i < 24; ++i) a.in[i] = (const float*)d_in[i];
    a.out = (float*)d_out; a.ws = (unsigned char*)d_ws;
#if MK_N_LAUNCHES == 1
    a.ph_lo = 0; a.ph_hi = NPHASE;
    hipLaunchKernelGGL(hybrid_fwd, dim3(grid), dim3(NTHR), LDS_BYTES, stream, a);
#else
    for (int p = 0; p < NPHASE; ++p) { a.ph_lo = p; a.ph_hi = p + 1; hipLaunchKernelGGL(hybrid_fwd, dim3(grid), dim3(NTHR), LDS_BYTES, stream, a); }
#endif
}
```

```cpp
#include <hip/hip_runtime.h>
#include <cstdio>
#include <cstdint>
#define MK_N_LAUNCHES 1
__device__ __forceinline__ int opq(int v) { asm volatile("" : "+v"(v)); return v; }
namespace pg8 {
#define PG8_LAS __attribute__((address_space(3)))
typedef unsigned short bf16_t;
typedef short bf16x8 __attribute__((ext_vector_type(8)));
typedef float f32x4 __attribute__((ext_vector_type(4)));
typedef float f32x2 __attribute__((ext_vector_type(2)));
typedef unsigned u32x4 __attribute__((ext_vector_type(4)));
constexpr int BM = 256, BK = 64, HALF = 128, HTB = HALF * BK * 2  , STAGE_BYTES = 8 * HTB, NXCD = 8, WGM = 8;

__host__ __device__ __forceinline__ int lds_byte(int r, int c) { const int st = (r >> 4) * 2 + (c >> 5), rr = r & 15, cc = c & 31, ob = rr * 64 + cc * 2; return st * 1024 + (ob ^ (((ob >> 9) & 1) << 5)); }
__host__ __device__ __forceinline__ void stage_rc(int b, int& R, int& C) { const int st = b / 1024, sb = b % 1024, swz = sb ^ (((sb >> 9) & 1) << 5); R = (st >> 1) * 16 + swz / 64; C = (st & 1) * 32 + (swz % 64) / 2; }
__host__ __device__ __forceinline__ int perm32(int rho) { const int n = rho >> 4, i = rho & 15; return 8 * (i >> 2) + 4 * n + (i & 3); }

struct Unit { int pm, pn, e, rt, cnt; const char* ab; const char* bb; };

__device__ __forceinline__ bool tile_order(int i, int G, int c, int nM, int nN, int& pm, int& pn) {
    const int nwg = nM * nN; const long L = (long)i * G + c; if (L >= nwg) return false;
    int wgid = (int)L; { const int q = nwg / NXCD, r = nwg % NXCD, xcd = wgid % NXCD, off = wgid / NXCD; wgid = (xcd < r ? xcd * (q + 1) : r * (q + 1) + (xcd - r) * q) + off; }
    const int nig = WGM * nN, gid = wgid / nig, fm = gid * WGM, gsz = (nM - fm) < WGM ? (nM - fm) : WGM;
    pm = fm + ((wgid % nig) % gsz); pn = (wgid % nig) / gsz; return true;
}
struct StaticOrder {
    static constexpr bool GATHER = false;
    int nM, nN, G, c, K; const char* A; const char* Bt;
    __device__ __forceinline__ void init(const void* A_, const void* Bt_, int M, int N, int K_, int G_, int c_) { A = (const char*)A_; Bt = (const char*)Bt_; nM = M / BM; nN = N / BM; K = K_; G = G_; c = c_; }
    __device__ __forceinline__ bool next(int i, Unit& u) const {
        int pm, pn; if (!tile_order(i, G, c, nM, nN, pm, pn)) return false;
        u.pm = pm; u.pn = pn; u.e = 0; u.rt = pm; u.cnt = 1 << 30; u.ab = A + (size_t)pm * BM * K * 2; u.bb = Bt + (size_t)pn * BM * K * 2; return true;
    }
    __device__ __forceinline__ void aoff(const Unit&, const int (&R)[2], const int (&C)[2], unsigned (&va)[2][2]) const {
#pragma unroll
        for (int h = 0; h < 2; ++h)
#pragma unroll
            for (int i = 0; i < 2; ++i) va[h][i] = (unsigned)((R[i] + HALF * h) * K + C[i]) * 2u;
    }
};

__device__ __forceinline__ unsigned cvt_pk_bf16(float lo, float hi) { unsigned r; asm volatile("v_cvt_pk_bf16_f32 %0, %1, %2" : "=v"(r) : "v"(lo), "v"(hi)); return r; }

template <class Epi, class Sched>
__device__ __forceinline__ void gemm_phase(PG8_LAS unsigned char* lds, const int K, const Sched& S, const Epi& E) {
    const int tid = opq((int)threadIdx.x), wid = __builtin_amdgcn_readfirstlane(tid >> 6), lane = tid & 63, wr = wid >> 2, wc = wid & 3, fr = lane & 15, fq = lane >> 4;
    const int nt = K / BK;
    int R[2], C[2]; unsigned voffB[2];
#pragma unroll
    for (int i = 0; i < 2; ++i) { stage_rc(tid * 16 + i * 8192, R[i], C[i]); const int Rb = Epi::PERM ? ((R[i] & ~31) + perm32(R[i] & 31)) : R[i]; voffB[i] = (unsigned)(Rb * K + C[i]) * 2u; }
    const size_t kstep = (size_t)(BK * 2);
    const size_t hstep = (size_t)HALF * K * 2;
    const unsigned ldsw = (unsigned)wid * 1024u;
    const int aoff = lds_byte(wr * 64 + fr, fq * 8), boff = lds_byte(wc * 32 + fr, fq * 8);
#define PG8_SA(b, h) (((b) * 2 + (h)) * HTB)
#define PG8_SB(b, h) ((4 + (b) * 2 + (h)) * HTB)
#define PG8_STAGE(bufoff, gbase, voff) do { _Pragma("unroll") for (int _i = 0; _i < 2; ++_i) \
        __builtin_amdgcn_global_load_lds((const unsigned*)((const char*)(gbase) + (voff)[_i]), (PG8_LAS unsigned*)(lds + (bufoff) + ldsw + _i * 8192), 16, 0, 0); } while (0)
#define PG8_LDA(dst, b, h) do { _Pragma("unroll") for (int m = 0; m < 4; ++m) _Pragma("unroll") for (int k = 0; k < 2; ++k) dst[m][k] = *(const PG8_LAS bf16x8*)(lds + PG8_SA(b, h) + aoff + m * 2048 + k * 1024); } while (0)
#define PG8_LDB(dst, b, h) do { _Pragma("unroll") for (int n = 0; n < 2; ++n) _Pragma("unroll") for (int k = 0; k < 2; ++k) dst[n][k] = *(const PG8_LAS bf16x8*)(lds + PG8_SB(b, h) + boff + n * 2048 + k * 1024); } while (0)
#define PG8_MMA(ai, bj, At, Bt) do { __builtin_amdgcn_s_setprio(1); _Pragma("unroll") for (int m = 0; m < 4; ++m) _Pragma("unroll") for (int n = 0; n < 2; ++n) _Pragma("unroll") for (int k = 0; k < 2; ++k) \
        acc[ai][bj][m][n] = __builtin_amdgcn_mfma_f32_16x16x32_bf16(Bt[n][k], At[m][k], acc[ai][bj][m][n], 0, 0, 0); __builtin_amdgcn_s_setprio(0); } while (0)
#define PG8_WAIT_V(n) asm volatile("s_waitcnt vmcnt(" #n ")" ::: "memory")
#define PG8_WAIT_L(n) asm volatile("s_waitcnt lgkmcnt(" #n ")" ::: "memory")
#define PG8_BAR __builtin_amdgcn_s_barrier()
#define PG8_SCHED __builtin_amdgcn_sched_barrier(0)
    Unit cur, nxt; int ui = 0;
    if (!S.next(0, cur)) return;
    unsigned va[2][2], nva[2][2];
    S.aoff(cur, R, C, va);
    f32x4 acc[2][2][4][2];
#pragma unroll
    for (int a = 0; a < 2; ++a)
#pragma unroll
        for (int b = 0; b < 2; ++b)
#pragma unroll
            for (int m = 0; m < 4; ++m)
#pragma unroll
                for (int n = 0; n < 2; ++n) acc[a][b][m][n] = (f32x4){0.f, 0.f, 0.f, 0.f};
    bf16x8 At[4][2], B0[2][2], B1[2][2];
    const char* cA = cur.ab; const char* cB = cur.bb;
    PG8_STAGE(PG8_SB(0, 0), cB, voffB); PG8_STAGE(PG8_SB(0, 1), cB + hstep, voffB); PG8_STAGE(PG8_SA(0, 0), cA, va[0]); PG8_STAGE(PG8_SA(0, 1), cA, va[1]);
    if (wr == 1) PG8_BAR;
    PG8_WAIT_V(2); PG8_BAR;
    PG8_STAGE(PG8_SB(1, 0), cB + kstep, voffB); PG8_STAGE(PG8_SA(1, 0), cA + kstep, va[0]); PG8_STAGE(PG8_SB(1, 1), cB + hstep + kstep, voffB);
    PG8_WAIT_V(6); PG8_BAR;
    for (;;) {
        const bool has_next = S.next(ui + 1, nxt);
        const char* nA = has_next ? nxt.ab : cA; const char* nB = has_next ? nxt.bb : cB;
        if constexpr (Sched::GATHER) {
            if (has_next) S.aoff(nxt, R, C, nva);
            else {
#pragma unroll
                for (int h = 0; h < 2; ++h)
#pragma unroll
                    for (int i = 0; i < 2; ++i) nva[h][i] = va[h][i]; } }
        for (int t = 0; t < nt; t += 2) {
            const bool last = (t == nt - 2);
            const char* a1 = cA + (size_t)(t + 1) * kstep;
            const char* a2 = last ? nA : cA + (size_t)(t + 2) * kstep; const char* b2 = last ? nB : cB + (size_t)(t + 2) * kstep;
            const char* a3 = a2 + kstep; const char* b3 = b2 + kstep;
            unsigned x0[2], x1[2];
#pragma unroll
            for (int i = 0; i < 2; ++i) { if constexpr (Sched::GATHER) { x0[i] = last ? nva[0][i] : va[0][i]; x1[i] = last ? nva[1][i] : va[1][i]; } else { x0[i] = va[0][i]; x1[i] = va[1][i]; } }
            PG8_LDB(B0, 0, 0); PG8_LDB(B1, 0, 1); PG8_SCHED; PG8_LDA(At, 0, 0); PG8_STAGE(PG8_SA(1, 1), a1, va[1]);
            PG8_WAIT_V(8); PG8_WAIT_L(0); PG8_BAR; PG8_MMA(0, 0, At, B0); PG8_MMA(0, 1, At, B1); PG8_BAR; PG8_SCHED;
            PG8_LDA(At, 0, 1); PG8_STAGE(PG8_SB(0, 0), b2, voffB); PG8_STAGE(PG8_SB(0, 1), b2 + hstep, voffB); PG8_STAGE(PG8_SA(0, 0), a2, x0);
            PG8_WAIT_V(8); PG8_WAIT_L(0); PG8_BAR; PG8_MMA(1, 0, At, B0); PG8_MMA(1, 1, At, B1); PG8_BAR; PG8_SCHED;
            PG8_LDB(B0, 1, 0); PG8_LDB(B1, 1, 1); PG8_SCHED; PG8_LDA(At, 1, 0); PG8_STAGE(PG8_SA(0, 1), a2, x1);
            PG8_WAIT_V(8); PG8_WAIT_L(0); PG8_BAR; PG8_MMA(0, 0, At, B0); PG8_MMA(0, 1, At, B1); PG8_BAR; PG8_SCHED;
            PG8_LDA(At, 1, 1); PG8_STAGE(PG8_SB(1, 0), b3, voffB); PG8_STAGE(PG8_SB(1, 1), b3 + hstep, voffB); PG8_STAGE(PG8_SA(1, 0), a3, x0);
            PG8_WAIT_V(8); PG8_WAIT_L(0); PG8_BAR; PG8_MMA(1, 0, At, B0); PG8_MMA(1, 1, At, B1); PG8_BAR; PG8_SCHED;
        }
        if (wr == 0) PG8_BAR;
        E(acc, cur, wr, wc, fr, fq);
        if (!has_next) break;
#pragma unroll
        for (int a = 0; a < 2; ++a)
#pragma unroll
            for (int b = 0; b < 2; ++b)
#pragma unroll
                for (int m = 0; m < 4; ++m)
#pragma unroll
                    for (int n = 0; n < 2; ++n) acc[a][b][m][n] = (f32x4){0.f, 0.f, 0.f, 0.f};
        cur = nxt; cA = nA; cB = nB; ++ui;
        if constexpr (Sched::GATHER) {
#pragma unroll
            for (int h = 0; h < 2; ++h)
#pragma unroll
                for (int i = 0; i < 2; ++i) va[h][i] = nva[h][i]; }
        if (wr == 1) PG8_BAR;
    }
    PG8_WAIT_V(0);
    PG8_BAR;
#undef PG8_SA
#undef PG8_SB
#undef PG8_STAGE
#undef PG8_LDA
#undef PG8_LDB
#undef PG8_MMA
#undef PG8_WAIT_V
#undef PG8_WAIT_L
#undef PG8_BAR
#undef PG8_SCHED
}
}
constexpr int D = 1024, NB = 8, SEQ = 4096, CTXL = 256, NL = NB * SEQ, NC = NB * CTXL, MT = NL + NC;
constexpr int INW = 1792, FF = 2816, NE = 8;
constexpr int C_Q = 0, C_K = 512, C_V = 640, C_U = 768, C_RQ = 1024, C_RK = 1152, C_RV = 1280, C_RG = 1536;
constexpr int NCHK = 34;
constexpr float LN_EPS = 1e-5f, LOG2E = 1.4426950408889634f;
constexpr float QSCALE = 0.125f * LOG2E;
constexpr float RSCALE = 0.17677669529663687f;
constexpr float ALPHA = 1.4142135623730951f;
constexpr int LCAP = 32768;

namespace pg8 {
__device__ __forceinline__ void store8(bf16_t* p, f32x4 v0, f32x4 v1) {
    u32x4 w; w.x = cvt_pk_bf16(v0[0], v0[1]); w.y = cvt_pk_bf16(v0[2], v0[3]); w.z = cvt_pk_bf16(v1[0], v1[1]); w.w = cvt_pk_bf16(v1[2], v1[3]); *(u32x4*)p = w;
}
struct EpiBf16 {
    static constexpr bool PERM = true;
    bf16_t* O; int ldc;
    __device__ __forceinline__ void operator()(const f32x4 (&acc)[2][2][4][2], const Unit& u, int wr, int wc, int fr, int fq) const {
        const int row0 = u.pm * BM + wr * 64 + fr, col0 = u.pn * BM + wc * 32 + 8 * fq;
#pragma unroll
        for (int ai = 0; ai < 2; ++ai)
#pragma unroll
            for (int m = 0; m < 4; ++m) { bf16_t* rowp = O + (size_t)(row0 + ai * HALF + m * 16) * ldc + col0;
#pragma unroll
                for (int bj = 0; bj < 2; ++bj) store8(rowp + bj * HALF, acc[ai][bj][m][0], acc[ai][bj][m][1]); }
    }
};
struct EpiInProj {
    static constexpr bool PERM = true;
    bf16_t* O; const float* rc; const float* rs;
    __device__ __forceinline__ void operator()(const f32x4 (&acc)[2][2][4][2], const Unit& u, int wr, int wc, int fr, int fq) const {
        const int row0 = u.pm * BM + wr * 64 + fr; const bool lat = u.pm < (NL / BM);
#pragma unroll
        for (int bj = 0; bj < 2; ++bj) {
            const int seg = 2 * u.pn + bj;
            const bool rope = lat && seg <= 4; const float sc = seg <= 3 ? QSCALE : (seg == 9 ? RSCALE : 1.0f);
#pragma unroll
            for (int ai = 0; ai < 2; ++ai)
#pragma unroll
                for (int m = 0; m < 4; ++m) { const int row = row0 + ai * HALF + m * 16;
                    f32x4 v0 = acc[ai][bj][m][0], v1 = acc[ai][bj][m][1];
                    if (rope) { const int t = row & (SEQ - 1); const int pos = (wc & 1) ? (t & 63) : (t >> 6);
                        const f32x4 c4 = *(const f32x4*)(rc + pos * 16 + 4 * fq), s4 = *(const f32x4*)(rs + pos * 16 + 4 * fq);
                        const f32x4 o0 = v0 * c4 - v1 * s4, o1 = v0 * s4 + v1 * c4; v0 = o0; v1 = o1; }
                    v0 = v0 * sc; v1 = v1 * sc;
                    store8(O + (size_t)row * INW + seg * HALF + wc * 32 + 8 * fq, v0, v1); }
        }
    }
};
struct EpiSwiGLU {
    static constexpr bool PERM = true;
    bf16_t* H; int ldh;
    __device__ __forceinline__ void operator()(const f32x4 (&acc)[2][2][4][2], const Unit& u, int wr, int wc, int fr, int fq) const {
        const int row0 = u.pm * BM + wr * 64 + fr, col0 = u.pn * HALF + wc * 32 + 8 * fq;
#pragma unroll
        for (int ai = 0; ai < 2; ++ai)
#pragma unroll
            for (int m = 0; m < 4; ++m) { f32x4 h[2];
#pragma unroll
                for (int n = 0; n < 2; ++n) { const f32x4 g = acc[ai][0][m][n], up = acc[ai][1][m][n];
#pragma unroll
                    for (int i = 0; i < 4; ++i) h[n][i] = g[i] * __builtin_amdgcn_rcpf(1.0f + __builtin_amdgcn_exp2f(-LOG2E * g[i])) * up[i]; }
                store8(H + (size_t)(row0 + ai * HALF + m * 16) * ldh + col0, h[0], h[1]); }
    }
};
struct EpiMoeDown {
    static constexpr bool PERM = true;
    bf16_t* Y; const int* list; const float* lgate;
    __device__ __forceinline__ void operator()(const f32x4 (&acc)[2][2][4][2], const Unit& u, int wr, int wc, int fr, int fq) const {
        const int col0 = u.pn * BM + wc * 32 + 8 * fq;
#pragma unroll
        for (int ai = 0; ai < 2; ++ai)
#pragma unroll
            for (int m = 0; m < 4; ++m) { const int pos = u.rt * BM + ai * HALF + wr * 64 + m * 16 + fr;
                if (pos < u.cnt) { const int ent = list[u.e * LCAP + pos]; const float g = lgate[u.e * LCAP + pos];
                    bf16_t* rowp = Y + ((size_t)(ent & 1) * NL + (size_t)(ent >> 1)) * D + col0;
#pragma unroll
                    for (int bj = 0; bj < 2; ++bj) store8(rowp + bj * HALF, acc[ai][bj][m][0] * g, acc[ai][bj][m][1] * g); } }
    }
};
template <bool GATHER_> struct MoeOrder {
    static constexpr bool GATHER = GATHER_;
    int nrt, nN, G, c, K, T0; int pre[NE + 1]; int cnt[NE];
    const char* A; const char* Bt; size_t bstride; const int* list;
    __device__ __forceinline__ bool next(int i, Unit& u) const {
        int pm, pn; if (nrt <= 0 || !tile_order(i, G, c, nrt, nN, pm, pn)) return false;
        const int T = T0 + pm; int e = 0;
#pragma unroll
        for (int j = 1; j < NE; ++j) e += (T >= pre[j]) ? 1 : 0;
        int p0 = pre[0], ce = cnt[0];
#pragma unroll
        for (int j = 1; j < NE; ++j) { p0 = (e == j) ? pre[j] : p0; ce = (e == j) ? cnt[j] : ce; }
        u.pm = pm; u.pn = pn; u.e = e; u.rt = T - p0; u.cnt = ce;
        u.ab = GATHER ? A : A + (size_t)pm * BM * K * 2; u.bb = Bt + (size_t)e * bstride + (size_t)pn * BM * K * 2; return true;
    }
    __device__ __forceinline__ void aoff(const Unit& u, const int (&R)[2], const int (&C)[2], unsigned (&va)[2][2]) const {
#pragma unroll
        for (int h = 0; h < 2; ++h)
#pragma unroll
            for (int i = 0; i < 2; ++i) {
                if (GATHER) { const int pos = u.rt * BM + R[i] + HALF * h; const int tok = pos < u.cnt ? (list[u.e * LCAP + pos] >> 1) : 0; va[h][i] = (unsigned)(tok * K + C[i]) * 2u; }
                else va[h][i] = (unsigned)((R[i] + HALF * h) * K + C[i]) * 2u; }
    }
};
}
constexpr size_t MiB = 1u << 20;
constexpr size_t WS_CTL = 0, CTL_ZERO_BYTES = 1 * MiB;
constexpr size_t WS_MOD = 1 * MiB;
constexpr size_t WS_ROPE = 1 * MiB + 512 * 1024;
constexpr size_t WS_LIST = 2 * MiB, WS_LGATE = 3 * MiB;
constexpr size_t WS_KVS = 8 * MiB;
constexpr size_t WS_XC = 26 * MiB;
constexpr size_t WS_WIN = 34 * MiB, WS_WOUT = 41 * MiB, WS_FGU = 45 * MiB, WS_FD = 56 * MiB, WS_MGU = 62 * MiB, WS_MD = 150 * MiB;
constexpr size_t WS_ACT = 194 * MiB;
constexpr size_t WS_PROJ = 262 * MiB, WS_MIX = 381 * MiB;
constexpr size_t WS_HID = 262 * MiB;
constexpr size_t WS_Y = 262 * MiB, WS_HIDS = 390 * MiB;
constexpr size_t WS_END = 478 * MiB;
static_assert(WS_WIN + (size_t)2 * INW * D * 2 <= WS_WOUT && WS_FGU + (size_t)2 * FF * D * 2 <= WS_FD && WS_FD + (size_t)FF * D * 2 <= WS_MGU && WS_MGU + (size_t)NE * 2 * FF * D * 2 <= WS_MD && WS_MD + (size_t)NE * FF * D * 2 <= WS_ACT, "weights map");
static_assert(WS_ACT + (size_t)MT * D * 2 <= WS_PROJ && WS_PROJ + (size_t)MT * INW * 2 <= WS_MIX && WS_MIX + (size_t)MT * D * 2 <= WS_END && WS_HID + (size_t)MT * FF * 2 <= WS_END, "act map");
static_assert(WS_Y + (size_t)2 * NL * D * 2 <= WS_HIDS && WS_HIDS + (size_t)64 * 256 * FF * 2 <= WS_END && WS_KVS + (size_t)2 * 32 * NCHK * 2048 * 4 <= WS_XC, "moe map");
constexpr int CW_TMO = 0;
constexpr int CW_GCNT = 1024;
constexpr int CW_BAR = 4096;

constexpr int RING_BYTES = 131072;
constexpr int SCR_BYTES = 155648;
constexpr int MISC_OFF = SCR_BYTES;
constexpr int LDS_BYTES = SCR_BYTES + 256;

#define GAS __attribute__((address_space(1)))
#define LAS __attribute__((address_space(3)))
typedef unsigned short bf16;
typedef unsigned v4u __attribute__((ext_vector_type(4)));
typedef unsigned v2u __attribute__((ext_vector_type(2)));
typedef float f32x4 __attribute__((ext_vector_type(4)));
typedef __bf16 bf16x2_t __attribute__((ext_vector_type(2)));
typedef float f32x2_t __attribute__((ext_vector_type(2)));
#define RLX_AGENT __ATOMIC_RELAXED, __HIP_MEMORY_SCOPE_AGENT
__device__ __forceinline__ unsigned pk2(float lo, float hi) { f32x2_t v = {lo, hi}; bf16x2_t b = __builtin_convertvector(v, bf16x2_t); return __builtin_bit_cast(unsigned, b); }
__device__ __forceinline__ float bflo(unsigned w) { return __uint_as_float(w << 16); }
__device__ __forceinline__ float bfhi(unsigned w) { return __uint_as_float(w & 0xffff0000u); }
__device__ __forceinline__ float dot2bf(unsigned a, unsigned b, float c) { return __builtin_amdgcn_fdot2_f32_bf16(__builtin_bit_cast(bf16x2_t, a), __builtin_bit_cast(bf16x2_t, b), c, false); }
__device__ __forceinline__ float wave_sum(float v) {
#pragma unroll
    for (int o = 1; o < 64; o <<= 1) v += __shfl_xor(v, o);
    return v;
}

#define XB_TMO      128
#define XB_XCNT(j)  (256  + 64 * (j))
#define XB_XSUB(j)  (1280 + 64 * (j))
#define XB_XGEN(j)  (2304 + 64 * (j))
#define XB_TOP      3328
#define XB_TOPGEN   3392
#define XCD_BAR_WORDS 3456
#define XB_SPIN_CAP (1u << 18)
__device__ __forceinline__ unsigned xb_ld(unsigned* p)              { return __hip_atomic_load(p, __ATOMIC_RELAXED, __HIP_MEMORY_SCOPE_AGENT); }
__device__ __forceinline__ unsigned xb_add(unsigned* p, unsigned v) { return __hip_atomic_fetch_add(p, v, __ATOMIC_RELAXED, __HIP_MEMORY_SCOPE_AGENT); }
__device__ __forceinline__ unsigned xb_xcc_id() { return (unsigned)__builtin_amdgcn_s_getreg((3 << 11) | 20) & 0xFu; }
#define XB_SPIN(cond, bar) do { unsigned _sp = 0; while (cond) { __builtin_amdgcn_s_sleep(1); \
    if ((++_sp & 255u) == 0u) { if (xb_ld(&(bar)[XB_TMO])) break; if (_sp > XB_SPIN_CAP) { atomicAdd(&(bar)[XB_TMO], 1u); break; } } } } while (0)
struct XcdBarrier { unsigned* bar; unsigned x; volatile LAS unsigned* st; };
__device__ __forceinline__ XcdBarrier xcd_barrier_post(unsigned* bar, volatile LAS unsigned* st) {
    XcdBarrier b; b.bar = bar; b.x = xb_xcc_id(); b.st = st;
    if (threadIdx.x == 0) (void)xb_add(&bar[XB_XCNT(b.x)], 1u);
    return b;
}
__device__ __forceinline__ void xcd_barrier_complete(unsigned* bar, unsigned x, unsigned& nloc, unsigned& nx) {
    const unsigned G = gridDim.x * gridDim.y * gridDim.z;
    unsigned sum, cnt, mine, sp = 0u;
    for (;;) {
        sum = 0u; cnt = 0u; mine = 0u;
#pragma unroll
        for (unsigned j = 0; j < 16; ++j) { const unsigned c = xb_ld(&bar[XB_XCNT(j)]); sum += c; cnt += (c > 0u) ? 1u : 0u; mine = (j == x) ? c : mine; }
        if (sum == G) break;
        __builtin_amdgcn_s_sleep(1);
        if ((++sp & 255u) == 0u) { if (xb_ld(&bar[XB_TMO])) break; if (sp > XB_SPIN_CAP) { atomicAdd(&bar[XB_TMO], 1u); break; } }
    }
    nloc = mine > 0u ? mine : 1u; nx = cnt > 0u ? cnt : 1u;
}
__device__ __forceinline__ void xcd_barrier(const XcdBarrier& b) {
    asm volatile("s_waitcnt vmcnt(0)" ::: "memory");
    __syncthreads();
    if (threadIdx.x == 0) {
        unsigned* bar = b.bar;
        __builtin_amdgcn_s_waitcnt(0);
        unsigned nloc = b.st[0], nx = b.st[1];
        if (nloc == 0u) { xcd_barrier_complete(bar, b.x, nloc, nx); b.st[0] = nloc; b.st[1] = nx; }
        const unsigned old = xb_add(&bar[XB_XSUB(b.x)], 1u);
        const unsigned gen = old / nloc;
        if (old + 1u == (gen + 1u) * nloc) {
            __builtin_amdgcn_fence(__ATOMIC_RELEASE, "agent");
            asm volatile("s_waitcnt vmcnt(0)" ::: "memory");
            const unsigned og = xb_add(&bar[XB_TOP], 1u);
            const unsigned tg = og / nx;
            if (og + 1u == (tg + 1u) * nx) xb_add(&bar[XB_TOPGEN], 1u);
            else XB_SPIN(xb_ld(&bar[XB_TOPGEN]) == tg, bar);
            __builtin_amdgcn_fence(__ATOMIC_ACQUIRE, "agent");
            xb_add(&bar[XB_XGEN(b.x)], 1u);
            asm volatile("s_waitcnt vmcnt(0)" ::: "memory");
        } else {
            XB_SPIN(xb_ld(&bar[XB_XGEN(b.x)]) == gen, bar);
            __builtin_amdgcn_fence(__ATOMIC_ACQUIRE, "agent");
            asm volatile("s_waitcnt vmcnt(0)" ::: "memory");
        }
    }
    __syncthreads();
}

constexpr int NWAVES = 8, NTHR = 512;
struct Frame {
    LAS unsigned char* lds;
    int tid, lane, wave, vcu, G;
    unsigned char* ws; float* out;
    const float *x, *c, *ctx, *c_ctx, *w_mod, *b_mod, *w_in, *sink, *pool_w, *pool_scale, *lgf, *lgb, *w_out, *ln1_g, *ln1_b, *ln2_g, *ln2_b;
    const float *fw_gate, *fw_up, *fw_down, *router, *mw_gate, *mw_up, *mw_down;
};
#define WSP(T, off) ((T*)(F.ws + (off)))

template <class RowMap>
__device__ __forceinline__ void transpose_item(const float* W, int K, int N, bf16* WT, const RowMap& rowmap, LAS float* scr, int item, int lane) {
    const int nblk = N / 32, kb = item / nblk, nb = item % nblk, k0 = 64 * kb, n0 = 32 * nb;
#pragma unroll 8
    for (int i = 0; i < 32; ++i) { const int kk = 2 * i + (lane >> 5); scr[kk * 33 + (lane & 31)] = W[(size_t)(k0 + kk) * N + n0 + (lane & 31)]; }
    asm volatile("s_waitcnt lgkmcnt(0)" ::: "memory");
    const int c = lane & 7;
#pragma unroll
    for (int j = 0; j < 4; ++j) { const int n = (lane >> 3) + 8 * j; const LAS float* s = scr + (8 * c) * 33 + n;
        v4u o; o.x = pk2(s[0 * 33], s[1 * 33]); o.y = pk2(s[2 * 33], s[3 * 33]); o.z = pk2(s[4 * 33], s[5 * 33]); o.w = pk2(s[6 * 33], s[7 * 33]);
        *(GAS v4u*)(WT + (size_t)rowmap(n0 + n) * K + k0 + 8 * c) = o; }
    asm volatile("s_waitcnt lgkmcnt(0)" ::: "memory");
}
struct MapId { __device__ __forceinline__ int operator()(int n) const { return n; } };
struct MapInProj {
    __device__ __forceinline__ int operator()(int n) const { if (n >= C_V) return n; const int dd = n & 31, j = dd & 15, x2 = dd >> 4; return (n & ~31) + 8 * (j >> 2) + 4 * x2 + (j & 3); } };
struct MapGU { int up; __device__ __forceinline__ int operator()(int n) const { return 256 * (n >> 7) + 128 * up + (n & 127); } };

__device__ __forceinline__ void p_prep(Frame& F) {
    const int tid = opq(F.tid), lane = tid & 63, wave = F.wave;
    LAS float* sv = (LAS float*)F.lds;
    LAS float* red = sv + 1024 * 12;
    bool have_sv = false;
    for (int un = blockIdx.x; un < 2 * 96; un += F.G) {
        if (!have_sv) {
            for (int idx = tid; idx < 9 * 1024; idx += NTHR) { const int r = idx >> 10, k = idx & 1023; const float v = r < 8 ? F.c[r * 1024 + k] : F.c_ctx[k]; sv[k * 12 + r] = v / (1.0f + __expf(-v)); }
            have_sv = true; __syncthreads();
        }
        const int layer = un / 96, cc = un % 96, col = cc * 64 + lane;
        float acc[9];
#pragma unroll
        for (int r = 0; r < 9; ++r) acc[r] = 0.f;
        const float* wp = F.w_mod + ((size_t)layer * 1024 + wave * 128) * 6144 + col;
#pragma unroll 8
        for (int kk = 0; kk < 128; ++kk) { const float wv = wp[(size_t)kk * 6144]; const LAS float* s = sv + (wave * 128 + kk) * 12;
            const f32x4 s0 = *(const LAS f32x4*)s, s1 = *(const LAS f32x4*)(s + 4); const float s8 = s[8];
            acc[0] += s0[0] * wv; acc[1] += s0[1] * wv; acc[2] += s0[2] * wv; acc[3] += s0[3] * wv; acc[4] += s1[0] * wv; acc[5] += s1[1] * wv; acc[6] += s1[2] * wv; acc[7] += s1[3] * wv; acc[8] += s8 * wv; }
#pragma unroll
        for (int r = 0; r < 9; ++r) red[(wave * 9 + r) * 64 + lane] = acc[r];
        __syncthreads();
        for (int idx = tid; idx < 9 * 64; idx += NTHR) { const int r = idx >> 6, ln = idx & 63; float s = F.b_mod[layer * 6144 + cc * 64 + ln];
#pragma unroll
            for (int w = 0; w < 8; ++w) s += red[(w * 9 + r) * 64 + ln];
            WSP(float, WS_MOD)[(size_t)(layer * 9 + r) * 6144 + cc * 64 + ln] = s; }
        __syncthreads();
    }
    if (blockIdx.x == F.G - 1) { for (int idx = tid; idx < 1024; idx += NTHR) { const int pos = idx >> 4, j = idx & 15; const float inv = powf(10000.0f, -(float)j / 16.0f); const float ang = (float)pos * inv;
            WSP(float, WS_ROPE)[idx] = cosf(ang); WSP(float, WS_ROPE)[1024 + idx] = sinf(ang); } }
    __syncthreads();
    LAS float* scr = (LAS float*)(F.lds + wave * 16384);
    const int gw = F.vcu * NWAVES + wave, NGW = F.G * NWAVES;
    constexpr int I_IN = (D / 64) * (INW / 32), I_OUT = (D / 64) * (D / 32), I_GU = (D / 64) * (FF / 32), I_DN = (FF / 64) * (D / 32);
    constexpr int NITEMS = 2 * (I_IN + I_OUT) + (1 + NE) * (2 * I_GU + I_DN);
    for (int it = gw; it < NITEMS; it += NGW) {
        int r = it;
        if (r < 2 * I_IN) { const int l = r / I_IN; transpose_item(F.w_in + (size_t)l * D * INW, D, INW, WSP(bf16, WS_WIN) + (size_t)l * INW * D, MapInProj{}, scr, r % I_IN, lane); continue; } r -= 2 * I_IN;
        if (r < 2 * I_OUT) { const int l = r / I_OUT; transpose_item(F.w_out + (size_t)l * D * D, D, D, WSP(bf16, WS_WOUT) + (size_t)l * D * D, MapId{}, scr, r % I_OUT, lane); continue; } r -= 2 * I_OUT;
        const int per = 2 * I_GU + I_DN, m = r / per; r %= per;
        const float* wg = m == 0 ? F.fw_gate : F.mw_gate + (size_t)(m - 1) * D * FF; const float* wu = m == 0 ? F.fw_up : F.mw_up + (size_t)(m - 1) * D * FF; const float* wd = m == 0 ? F.fw_down : F.mw_down + (size_t)(m - 1) * FF * D;
        bf16* gu = m == 0 ? WSP(bf16, WS_FGU) : WSP(bf16, WS_MGU) + (size_t)(m - 1) * 2 * FF * D; bf16* dn = m == 0 ? WSP(bf16, WS_FD) : WSP(bf16, WS_MD) + (size_t)(m - 1) * FF * D;
        if (r < I_GU) { transpose_item(wg, D, FF, gu, MapGU{0}, scr, r, lane); continue; } r -= I_GU;
        if (r < I_GU) { transpose_item(wu, D, FF, gu, MapGU{1}, scr, r, lane); continue; } r -= I_GU;
        transpose_item(wd, FF, D, dn, MapId{}, scr, r, lane);
    }
}

__device__ __forceinline__ void row_load_f32(const float* p, int lane, f32x4 (&v)[4]) {
#pragma unroll
    for (int j = 0; j < 4; ++j) v[j] = *(const f32x4*)(p + 4 * lane + 256 * j);
}
__device__ __forceinline__ void row_load_bf16(const bf16* p, int lane, f32x4 (&v)[4]) {
#pragma unroll
    for (int j = 0; j < 4; ++j) { const v2u w = *(const v2u*)(p + 4 * lane + 256 * j); v[j] = (f32x4){bflo(w.x), bfhi(w.x), bflo(w.y), bfhi(w.y)}; }
}
__device__ __forceinline__ void row_store_bf16(bf16* p, int lane, const f32x4 (&v)[4]) {
#pragma unroll
    for (int j = 0; j < 4; ++j) { v2u w; w.x = pk2(v[j][0], v[j][1]); w.y = pk2(v[j][2], v[j][3]); *(v2u*)(p + 4 * lane + 256 * j) = w; }
}
__device__ __forceinline__ void row_store_f32(float* p, int lane, const f32x4 (&v)[4]) {
#pragma unroll
    for (int j = 0; j < 4; ++j) *(f32x4*)(p + 4 * lane + 256 * j) = v[j];
}
__device__ __forceinline__ void row_ln(f32x4 (&v)[4], const float* g, const float* b, int lane) {
    float s = 0.f;
#pragma unroll
    for (int j = 0; j < 4; ++j) s += (v[j][0] + v[j][1]) + (v[j][2] + v[j][3]);
    const float mean = wave_sum(s) * (1.0f / D); float q = 0.f;
#pragma unroll
    for (int j = 0; j < 4; ++j) { v[j] = v[j] - mean; q += (v[j][0] * v[j][0] + v[j][1] * v[j][1]) + (v[j][2] * v[j][2] + v[j][3] * v[j][3]); }
    const float rstd = 1.0f / sqrtf(wave_sum(q) * (1.0f / D) + LN_EPS);
#pragma unroll
    for (int j = 0; j < 4; ++j) { const f32x4 gg = *(const f32x4*)(g + 4 * lane + 256 * j), bb = *(const f32x4*)(b + 4 * lane + 256 * j); v[j] = v[j] * rstd * gg + bb; }
}
__device__ __forceinline__ const float* modp(Frame& F, int layer, int mr, int part) { return WSP(float, WS_MOD) + (size_t)(layer * 9 + mr) * 6144 + part * 1024; }
__device__ __forceinline__ void row_modulate(f32x4 (&v)[4], const float* sh, const float* sc, int lane) {
#pragma unroll
    for (int j = 0; j < 4; ++j) { const f32x4 a = *(const f32x4*)(sc + 4 * lane + 256 * j), b = *(const f32x4*)(sh + 4 * lane + 256 * j); v[j] = v[j] * (1.0f + a) + b; }
}
__device__ __forceinline__ void p_h0(Frame& F) {
    const int gw = F.vcu * NWAVES + F.wave, NGW = F.G * NWAVES, lane = opq(F.lane);
    for (int r = gw; r < MT; r += NGW) { const int mr = r < NL ? (r >> 12) : 8; const float* xr = r < NL ? F.x + (size_t)r * D : F.ctx + (size_t)(r - NL) * D;
        f32x4 v[4]; row_load_f32(xr, lane, v); row_modulate(v, modp(F, 0, mr, 0), modp(F, 0, mr, 1), lane); row_store_bf16(WSP(bf16, WS_ACT) + (size_t)r * D, lane, v); }
}
__device__ __forceinline__ void p_ln1(Frame& F, int layer) {
    const int lane = opq(F.lane);
    if (layer == 0) {
        const int gw = F.vcu * NWAVES + F.wave, NGW = F.G * NWAVES;
        for (int r = gw; r < MT; r += NGW) { const int mr = r < NL ? (r >> 12) : 8; const float* xr = r < NL ? F.x + (size_t)r * D : F.ctx + (size_t)(r - NL) * D;
            float* xo = r < NL ? F.out + (size_t)r * D : WSP(float, WS_XC) + (size_t)(r - NL) * D; bf16* ar = WSP(bf16, WS_ACT) + (size_t)r * D;
            f32x4 v[4], y[4]; row_load_f32(xr, lane, v); row_load_bf16(ar, lane, y); const float* g1 = modp(F, 0, mr, 2);
#pragma unroll
            for (int j = 0; j < 4; ++j) v[j] = ALPHA * v[j] + *(const f32x4*)(g1 + 4 * lane + 256 * j) * y[j];
            row_ln(v, F.ln1_g, F.ln1_b, lane); row_store_f32(xo, lane, v);
            row_modulate(v, modp(F, 0, mr, 3), modp(F, 0, mr, 4), lane); row_store_bf16(ar, lane, v); }
        return;
    }
    LAS int* lcnt = (LAS int*)F.lds; LAS int* lbase = lcnt + 8; LAS int* rinfo = lcnt + 16;
    float rt[16][8];
#pragma unroll
    for (int j = 0; j < 4; ++j)
#pragma unroll
        for (int q = 0; q < 4; ++q) { const float* rp = F.router + (size_t)(4 * lane + 256 * j + q) * 8; const f32x4 a = *(const f32x4*)rp, b = *(const f32x4*)(rp + 4);
            rt[j * 4 + q][0] = a[0]; rt[j * 4 + q][1] = a[1]; rt[j * 4 + q][2] = a[2]; rt[j * 4 + q][3] = a[3]; rt[j * 4 + q][4] = b[0]; rt[j * 4 + q][5] = b[1]; rt[j * 4 + q][6] = b[2]; rt[j * 4 + q][7] = b[3]; }
    for (int rb = blockIdx.x; rb < NL / 128; rb += F.G) {
        if (F.tid < 8) lcnt[F.tid] = 0;
        __syncthreads();
        for (int i = 0; i < 16; ++i) { const int rl = F.wave * 16 + i, r = rb * 128 + rl, mr = r >> 12;
            float* xo = F.out + (size_t)r * D; bf16* ar = WSP(bf16, WS_ACT) + (size_t)r * D;
            f32x4 v[4], y[4]; row_load_f32(xo, lane, v); row_load_bf16(ar, lane, y); const float* g1 = modp(F, 1, mr, 2);
#pragma unroll
            for (int j = 0; j < 4; ++j) v[j] = ALPHA * v[j] + *(const f32x4*)(g1 + 4 * lane + 256 * j) * y[j];
            row_ln(v, F.ln1_g + D, F.ln1_b + D, lane); row_store_f32(xo, lane, v);
            row_modulate(v, modp(F, 1, mr, 3), modp(F, 1, mr, 4), lane); row_store_bf16(ar, lane, v);
            float lg[8];
#pragma unroll
            for (int e = 0; e < 8; ++e) { float s = 0.f;
#pragma unroll
                for (int j = 0; j < 4; ++j)
#pragma unroll
                    for (int q = 0; q < 4; ++q) s += v[j][q] * rt[j * 4 + q][e];
                lg[e] = wave_sum(s); }
            int i1 = 0; float v1 = lg[0];
#pragma unroll
            for (int e = 1; e < 8; ++e) if (lg[e] > v1) { v1 = lg[e]; i1 = e; }
            int i2 = -1; float v2 = -3.0e38f;
#pragma unroll
            for (int e = 0; e < 8; ++e) if (e != i1 && lg[e] > v2) { v2 = lg[e]; i2 = e; }
            const float ex = __expf(v2 - v1), w1 = 1.0f / (1.0f + ex), w2 = ex / (1.0f + ex);
            if (lane == 0) { const int p1 = __hip_atomic_fetch_add(lcnt + i1, 1, __ATOMIC_RELAXED, __HIP_MEMORY_SCOPE_WORKGROUP), p2 = __hip_atomic_fetch_add(lcnt + i2, 1, __ATOMIC_RELAXED, __HIP_MEMORY_SCOPE_WORKGROUP);
                LAS int* ri = rinfo + rl * 6; ri[0] = i1; ri[1] = p1; ri[2] = __float_as_int(w1); ri[3] = i2; ri[4] = p2; ri[5] = __float_as_int(w2); }
        }
        __syncthreads();
        if (F.tid < 8) lbase[F.tid] = (int)__hip_atomic_fetch_add((unsigned*)(WSP(unsigned, WS_CTL) + CW_GCNT + 64 * F.tid), (unsigned)lcnt[F.tid], RLX_AGENT);
        __syncthreads();
        if (F.tid < 256) { const int rl = F.tid >> 1, s = F.tid & 1; const LAS int* ri = rinfo + rl * 6 + 3 * s; const int e = ri[0], pos = lbase[e] + ri[1];
            WSP(int, WS_LIST)[e * LCAP + pos] = ((rb * 128 + rl) << 1) | s; WSP(float, WS_LGATE)[e * LCAP + pos] = __int_as_float(ri[2]); }
        __syncthreads();
    }
}
__device__ __forceinline__ void p_ln2_l0(Frame& F) {
    const int lane = opq(F.lane), gw = F.vcu * NWAVES + F.wave, NGW = F.G * NWAVES;
    for (int r = gw; r < MT; r += NGW) { const int mr = r < NL ? (r >> 12) : 8;
        float* xo = r < NL ? F.out + (size_t)r * D : WSP(float, WS_XC) + (size_t)(r - NL) * D; bf16* ar = WSP(bf16, WS_ACT) + (size_t)r * D;
        f32x4 v[4], y[4]; row_load_f32(xo, lane, v); row_load_bf16(ar, lane, y); const float* g2 = modp(F, 0, mr, 5);
#pragma unroll
        for (int j = 0; j < 4; ++j) v[j] = ALPHA * v[j] + *(const f32x4*)(g2 + 4 * lane + 256 * j) * y[j];
        row_ln(v, F.ln2_g, F.ln2_b, lane); row_store_f32(xo, lane, v);
        row_modulate(v, modp(F, 1, mr, 0), modp(F, 1, mr, 1), lane); row_store_bf16(ar, lane, v); }
}
__device__ __forceinline__ void p_final(Frame& F) {
    const int lane = opq(F.lane), gw = F.vcu * NWAVES + F.wave, NGW = F.G * NWAVES;
    for (int r = gw; r < NL; r += NGW) { const int mr = r >> 12; float* xo = F.out + (size_t)r * D;
        f32x4 v[4], y0[4], y1[4]; row_load_f32(xo, lane, v); row_load_bf16(WSP(bf16, WS_Y) + (size_t)r * D, lane, y0); row_load_bf16(WSP(bf16, WS_Y) + (size_t)(NL + r) * D, lane, y1); const float* g2 = modp(F, 1, mr, 5);
#pragma unroll
        for (int j = 0; j < 4; ++j) v[j] = ALPHA * v[j] + *(const f32x4*)(g2 + 4 * lane + 256 * j) * (y0[j] + y1[j]);
        row_ln(v, F.ln2_g + D, F.ln2_b + D, lane); row_store_f32(xo, lane, v); }
}
__device__ __forceinline__ void attn_naive_unit(Frame& F, int layer, int b, int qb, int kvh, bool isctx) {
    const int tid = opq(F.tid), qq = tid & 127, g = tid >> 7, head = kvh * 4 + g;
    const bf16* P = WSP(bf16, WS_PROJ);
    const int qrow = isctx ? NL + b * CTXL + qb * 128 + qq : b * SEQ + qb * 128 + qq;
    LAS unsigned* kt = (LAS unsigned*)F.lds;
    LAS unsigned* vt = kt + 64 * 32;
    unsigned q[32];
#pragma unroll
    for (int i = 0; i < 8; ++i) { const v4u w = *(const v4u*)(P + (size_t)qrow * INW + head * 64 + i * 8); q[4 * i] = w.x; q[4 * i + 1] = w.y; q[4 * i + 2] = w.z; q[4 * i + 3] = w.w; }
    float m = F.sink[layer * 8 + head] * LOG2E, l = 1.0f, o[64];
#pragma unroll
    for (int d = 0; d < 64; ++d) o[d] = 0.f;
    const int qpos = qb * 128 + qq;
    for (int tile = isctx ? 6 : 0; tile < 10; ++tile) {
        int krow0, kpos0 = 0; const bool local = tile < 6;
        if (local) { kpos0 = qb * 128 - 128 + 64 * tile; if (kpos0 < 0 || kpos0 >= SEQ) continue; krow0 = b * SEQ + kpos0; }
        else krow0 = NL + b * CTXL + 64 * (tile - 6);
        __syncthreads();
        { const int r = tid >> 3, ch = tid & 7; const bf16* src = P + (size_t)(krow0 + r) * INW + kvh * 64 + ch * 8;
          *(LAS v4u*)(kt + r * 32 + ch * 4) = *(const v4u*)(src + C_K); *(LAS v4u*)(vt + r * 32 + ch * 4) = *(const v4u*)(src + C_V); }
        __syncthreads();
        for (int j = 0; j < 64; ++j) {
            float s = 0.f;
#pragma unroll
            for (int i = 0; i < 32; ++i) s = dot2bf(q[i], kt[j * 32 + i], s);
            const int dlt = qpos - (kpos0 + j); const bool valid = !local || (dlt <= 128 && dlt >= -128);
            if (valid) {
                if (s > m) { const float f = __builtin_amdgcn_exp2f(m - s); l *= f;
#pragma unroll
                    for (int d = 0; d < 64; ++d) o[d] *= f;
                    m = s; }
                const float p = __builtin_amdgcn_exp2f(s - m); l += p;
#pragma unroll
                for (int i = 0; i < 32; ++i) { const unsigned w = vt[j * 32 + i]; o[2 * i] += p * bflo(w); o[2 * i + 1] += p * bfhi(w); }
            }
        }
    }
    const float rl = 1.0f / l;
    bf16* dst = WSP(bf16, WS_MIX) + (size_t)qrow * D + head * 64;
#pragma unroll
    for (int i = 0; i < 8; ++i) { v4u w; w.x = pk2(o[8 * i] * rl, o[8 * i + 1] * rl); w.y = pk2(o[8 * i + 2] * rl, o[8 * i + 3] * rl); w.z = pk2(o[8 * i + 4] * rl, o[8 * i + 5] * rl); w.w = pk2(o[8 * i + 6] * rl, o[8 * i + 7] * rl); *(v4u*)(dst + 8 * i) = w; }
    __syncthreads();
}
__device__ __forceinline__ void pool_naive_unit(Frame& F, int layer, int s, int blk) {
    const int tid = opq(F.tid); const bool isctx = s >= 8; const int b = s & 7, len = isctx ? CTXL : SEQ, row0 = isctx ? NL + b * CTXL : b * SEQ, t0 = blk * 128;
    const bf16* P = WSP(bf16, WS_PROJ);
    LAS float* ub = (LAS float*)F.lds;
    LAS float* pwb = ub + 144 * 64;
    LAS float* db = pwb + 64 * 64;
    for (int g = 0; g < 4; ++g) { const int hw = 1 << g;
        __syncthreads();
        for (int idx = tid; idx < 144 * 8; idx += NTHR) { const int rr = idx >> 3, ch = idx & 7, t = t0 - 8 + rr; v4u w = (v4u){0u, 0u, 0u, 0u};
            if (t >= 0 && t < len) w = *(const v4u*)(P + (size_t)(row0 + t) * INW + C_U + g * 64 + ch * 8);
            LAS float* d = ub + rr * 64 + ch * 8; d[0] = bflo(w.x); d[1] = bfhi(w.x); d[2] = bflo(w.y); d[3] = bfhi(w.y); d[4] = bflo(w.z); d[5] = bfhi(w.z); d[6] = bflo(w.w); d[7] = bfhi(w.w); }
        for (int idx = tid; idx < 4096; idx += NTHR) pwb[idx] = F.pool_w[(size_t)(layer * 4 + g) * 4096 + idx];
        __syncthreads();
        for (int idx = tid; idx < 8192; idx += NTHR) { const int t = idx >> 6, c = idx & 63, tt = t0 + t; const int lo = max(tt - hw, 0), hi = min(tt + hw, len); float sum = 0.f;
            for (int p = lo; p < hi; ++p) sum += ub[(p - t0 + 8) * 64 + c];
            db[t * 65 + c] = sum / (float)(hi - lo) - ub[(t + 8) * 64 + c]; }
        __syncthreads();
        const int t = tid & 127, dq = tid >> 7; float acc[16];
#pragma unroll
        for (int i = 0; i < 16; ++i) acc[i] = 0.f;
        for (int c = 0; c < 64; ++c) { const float xv = db[t * 65 + c];
#pragma unroll
            for (int i = 0; i < 16; ++i) acc[i] += xv * pwb[c * 64 + dq * 16 + i]; }
        const float* ps = F.pool_scale + layer * 256 + g * 64 + dq * 16;
        bf16* dst = WSP(bf16, WS_MIX) + (size_t)(row0 + t0 + t) * D + 512 + g * 64 + dq * 16;
#pragma unroll
        for (int i = 0; i < 2; ++i) { v4u w; w.x = pk2(acc[8 * i] * ps[8 * i], acc[8 * i + 1] * ps[8 * i + 1]); w.y = pk2(acc[8 * i + 2] * ps[8 * i + 2], acc[8 * i + 3] * ps[8 * i + 3]);
            w.z = pk2(acc[8 * i + 4] * ps[8 * i + 4], acc[8 * i + 5] * ps[8 * i + 5]); w.w = pk2(acc[8 * i + 6] * ps[8 * i + 6], acc[8 * i + 7] * ps[8 * i + 7]); *(v4u*)(dst + 8 * i) = w; }
    }
    __syncthreads();
}
__device__ __forceinline__ int chunk_row0(int b, int cid) { return cid < 2 ? NL + b * CTXL + cid * 128 : b * SEQ + (cid - 2) * 128; }
__device__ __forceinline__ void kv_naive_unit(Frame& F, int layer, int b, int h, int cid) {
    const int tid = opq(F.tid); const bf16* P = WSP(bf16, WS_PROJ); const int row0 = chunk_row0(b, cid);
    LAS float* kf = (LAS float*)F.lds;
    LAS float* vf = kf + 128 * 32;
    LAS float* wf = vf + 128 * 64;
    const float lgf = F.lgf[layer * 4 + h], lgb = F.lgb[layer * 4 + h];
    __syncthreads();
    { const int r = tid >> 2, ch = tid & 3; const v4u w = *(const v4u*)(P + (size_t)(row0 + r) * INW + C_RK + h * 32 + ch * 8); LAS float* d = kf + r * 32 + ch * 8;
      d[0] = bflo(w.x); d[1] = bfhi(w.x); d[2] = bflo(w.y); d[3] = bfhi(w.y); d[4] = bflo(w.z); d[5] = bfhi(w.z); d[6] = bflo(w.w); d[7] = bfhi(w.w); }
    for (int idx = tid; idx < 1024; idx += NTHR) { const int r = idx >> 3, ch = idx & 7; const v4u w = *(const v4u*)(P + (size_t)(row0 + r) * INW + C_RV + h * 64 + ch * 8); LAS float* d = vf + r * 64 + ch * 8;
      d[0] = bflo(w.x); d[1] = bfhi(w.x); d[2] = bflo(w.y); d[3] = bfhi(w.y); d[4] = bflo(w.z); d[5] = bfhi(w.z); d[6] = bflo(w.w); d[7] = bfhi(w.w); }
    if (tid < 128) { wf[tid] = __expf(lgf * (float)(127 - tid)); wf[128 + tid] = __expf(lgb * (float)tid); }
    __syncthreads();
    const int i = tid >> 4, e0 = (tid & 15) * 4; f32x4 af = (f32x4){0.f, 0.f, 0.f, 0.f}, ab = af;
    for (int m = 0; m < 128; ++m) { const float kk = kf[m * 32 + i]; const f32x4 vv = *(const LAS f32x4*)(vf + m * 64 + e0); af += (kk * wf[m]) * vv; ab += (kk * wf[128 + m]) * vv; }
    float* dst = WSP(float, WS_KVS) + ((size_t)(b * 4 + h) * NCHK + cid) * 2048 + i * 64 + e0;
    *(f32x4*)dst = af; *(f32x4*)(dst + (size_t)32 * NCHK * 2048) = ab;
    __syncthreads();
}
__device__ __forceinline__ void p_scan(Frame& F, int layer) {
    for (int gid = blockIdx.x * NTHR + opq(F.tid); gid < 2 * 32 * 2048; gid += F.G * NTHR) {
        const int dir = gid >> 16, bh = (gid >> 11) & 31, e = gid & 2047; const float lg = (dir ? F.lgb : F.lgf)[layer * 4 + (bh & 3)]; const float G = __expf(lg * 128.0f);
        float* base = WSP(float, WS_KVS) + ((size_t)(dir * 32 + bh) * NCHK) * 2048 + e;
        float kv[NCHK];
#pragma unroll
        for (int c = 0; c < NCHK; ++c) kv[c] = base[(size_t)c * 2048];
        float S = 0.f;
        if (dir == 0) {
#pragma unroll
            for (int c = 0; c < NCHK; ++c) { base[(size_t)c * 2048] = S; S = G * S + kv[c]; }
        } else {
            base[2048] = S; S = G * S + kv[1]; base[0] = S; S = G * S + kv[0];
#pragma unroll
            for (int c = NCHK - 1; c >= 2; --c) { base[(size_t)c * 2048] = S; S = G * S + kv[c]; }
        }
    }
}
__device__ __forceinline__ void ret_naive_unit(Frame& F, int layer, int b, int h, int cid) {
    const int tid = opq(F.tid); const bf16* P = WSP(bf16, WS_PROJ); const int row0 = chunk_row0(b, cid);
    LAS float* kf = (LAS float*)F.lds;
    LAS float* qf = kf + 128 * 33;
    LAS float* vf = qf + 128 * 33;
    LAS float* Am = vf + 128 * 64;
    LAS float* Sf = Am + 128 * 129;
    LAS float* red = Sf + 2 * 2048;
    const float lgf = F.lgf[layer * 4 + h], lgb = F.lgb[layer * 4 + h];
    __syncthreads();
    { const int r = tid >> 2, ch = tid & 3; const v4u w = *(const v4u*)(P + (size_t)(row0 + r) * INW + C_RK + h * 32 + ch * 8); LAS float* d = kf + r * 33 + ch * 8;
      d[0] = bflo(w.x); d[1] = bfhi(w.x); d[2] = bflo(w.y); d[3] = bfhi(w.y); d[4] = bflo(w.z); d[5] = bfhi(w.z); d[6] = bflo(w.w); d[7] = bfhi(w.w); }
    { const int r = tid >> 2, ch = tid & 3; const v4u w = *(const v4u*)(P + (size_t)(row0 + r) * INW + C_RQ + h * 32 + ch * 8); LAS float* d = qf + r * 33 + ch * 8;
      d[0] = bflo(w.x); d[1] = bfhi(w.x); d[2] = bflo(w.y); d[3] = bfhi(w.y); d[4] = bflo(w.z); d[5] = bfhi(w.z); d[6] = bflo(w.w); d[7] = bfhi(w.w); }
    for (int idx = tid; idx < 1024; idx += NTHR) { const int r = idx >> 3, ch = idx & 7; const v4u w = *(const v4u*)(P + (size_t)(row0 + r) * INW + C_RV + h * 64 + ch * 8); LAS float* d = vf + r * 64 + ch * 8;
      d[0] = bflo(w.x); d[1] = bfhi(w.x); d[2] = bflo(w.y); d[3] = bfhi(w.y); d[4] = bflo(w.z); d[5] = bfhi(w.z); d[6] = bflo(w.w); d[7] = bfhi(w.w); }
    { const float* sp = WSP(float, WS_KVS) + ((size_t)(b * 4 + h) * NCHK + cid) * 2048;
      for (int idx = tid; idx < 2048; idx += NTHR) { Sf[idx] = sp[idx]; Sf[2048 + idx] = sp[(size_t)32 * NCHK * 2048 + idx]; } }
    const int n = tid & 127, qt = tid >> 7;
    __syncthreads();
#pragma unroll 1
    for (int mm = 0; mm < 32; ++mm) { const int m = qt * 32 + mm; float s = 0.f;
#pragma unroll 8
        for (int d = 0; d < 32; ++d) s += qf[n * 33 + d] * kf[m * 33 + d];
        const float w = m < n ? __expf(lgf * (float)(n - m)) : (m > n ? __expf(lgb * (float)(m - n)) : 2.0f);
        Am[n * 129 + m] = s * w; }
    __syncthreads();
    float o[16];
#pragma unroll
    for (int i = 0; i < 16; ++i) o[i] = 0.f;
#pragma unroll 2
    for (int m = 0; m < 128; ++m) { const float a = Am[n * 129 + m];
#pragma unroll
        for (int i = 0; i < 4; ++i) { const f32x4 vv = *(const LAS f32x4*)(vf + m * 64 + qt * 16 + 4 * i); o[4 * i] += a * vv[0]; o[4 * i + 1] += a * vv[1]; o[4 * i + 2] += a * vv[2]; o[4 * i + 3] += a * vv[3]; } }
    const float cf = __expf(lgf * (float)(n + 1)), cb = __expf(lgb * (float)(128 - n));
#pragma unroll 2
    for (int d = 0; d < 32; ++d) { const float qv = qf[n * 33 + d]; const float q1 = qv * cf, q2 = qv * cb;
#pragma unroll
        for (int i = 0; i < 4; ++i) { const f32x4 sf = *(const LAS f32x4*)(Sf + d * 64 + qt * 16 + 4 * i), sb = *(const LAS f32x4*)(Sf + 2048 + d * 64 + qt * 16 + 4 * i);
            o[4 * i] += q1 * sf[0] + q2 * sb[0]; o[4 * i + 1] += q1 * sf[1] + q2 * sb[1]; o[4 * i + 2] += q1 * sf[2] + q2 * sb[2]; o[4 * i + 3] += q1 * sf[3] + q2 * sb[3]; } }
    float s = 0.f;
#pragma unroll
    for (int i = 0; i < 16; ++i) s += o[i];
    red[n * 4 + qt] = s;
    __syncthreads();
    const float mean = (red[n * 4] + red[n * 4 + 1] + red[n * 4 + 2] + red[n * 4 + 3]) * (1.0f / 64.0f);
    __syncthreads();
    float qd = 0.f;
#pragma unroll
    for (int i = 0; i < 16; ++i) { o[i] -= mean; qd += o[i] * o[i]; }
    red[n * 4 + qt] = qd;
    __syncthreads();
    const float rstd = 1.0f / sqrtf((red[n * 4] + red[n * 4 + 1] + red[n * 4 + 2] + red[n * 4 + 3]) * (1.0f / 64.0f) + LN_EPS);
    const bf16* rgp = P + (size_t)(row0 + n) * INW + C_RG + h * 64 + qt * 16; bf16* dst = WSP(bf16, WS_MIX) + (size_t)(row0 + n) * D + 768 + h * 64 + qt * 16;
#pragma unroll
    for (int i = 0; i < 2; ++i) { const v4u w = *(const v4u*)(rgp + 8 * i); const float r8[8] = {bflo(w.x), bfhi(w.x), bflo(w.y), bfhi(w.y), bflo(w.z), bfhi(w.z), bflo(w.w), bfhi(w.w)}; float y8[8];
#pragma unroll
        for (int k = 0; k < 8; ++k) y8[k] = r8[k] / (1.0f + __expf(-r8[k])) * (o[8 * i + k] * rstd);
        v4u ow; ow.x = pk2(y8[0], y8[1]); ow.y = pk2(y8[2], y8[3]); ow.z = pk2(y8[4], y8[5]); ow.w = pk2(y8[6], y8[7]); *(v4u*)(dst + 8 * i) = ow; }
    __syncthreads();
}
__device__ __forceinline__ void p_mix_naive(Frame& F, int layer) {
    const int n_att = 512 + (layer == 0 ? 32 : 0);
    for (int u = blockIdx.x; u < n_att; u += F.G) {
        if (u < 512) attn_naive_unit(F, layer, u >> 6, (u >> 1) & 31, u & 1, false);
        else { const int v = u - 512; attn_naive_unit(F, layer, v >> 2, (v >> 1) & 1, v & 1, true); }
    }
    const int n_pool = 256 + (layer == 0 ? 16 : 0);
    for (int u = blockIdx.x; u < n_pool; u += F.G) { if (u < 256) pool_naive_unit(F, layer, u >> 5, u & 31); else pool_naive_unit(F, layer, 8 + ((u - 256) >> 1), (u - 256) & 1); }
    for (int u = blockIdx.x; u < 32 * NCHK; u += F.G) kv_naive_unit(F, layer, u / (4 * NCHK), (u / NCHK) & 3, u % NCHK);
}
__device__ __forceinline__ void p_ret_naive(Frame& F, int layer) {
    for (int u = blockIdx.x; u < 32 * NCHK; u += F.G) { const int cid = u % NCHK; if (layer == 1 && cid < 2) continue; ret_naive_unit(F, layer, u / (4 * NCHK), (u / NCHK) & 3, cid); }
}
#ifndef MK_N_LAUNCHES
#define MK_N_LAUNCHES 1
#endif
constexpr int NPHASE = 28;
struct Args { const float* in[24]; float* out; unsigned char* ws; int ph_lo, ph_hi; };

__device__ __forceinline__ void moe_tiles(Frame& F, int (&pre)[NE + 1], int (&cnt)[NE]) {
    int acc = 0;
#pragma unroll
    for (int e = 0; e < NE; ++e) { const int c = __builtin_amdgcn_readfirstlane((int)__hip_atomic_load(WSP(unsigned, WS_CTL) + CW_GCNT + 64 * e, RLX_AGENT)); cnt[e] = c; pre[e] = acc; acc += (c + 255) >> 8; }
    pre[NE] = acc;
}

#define IN(k) (lo <= (k) && (k) < hi)
#define SEAM(k) do { if (IN(k) && IN((k) + 1)) xcd_barrier(bar); } while (0)
template <int layer> __device__ __forceinline__ void layer_front(Frame& F, const XcdBarrier& bar, const int lo, const int hi) {
        const int pb = 2 + 9 * layer;
        if (IN(pb)) {
            pg8::StaticOrder S; S.init(WSP(bf16, WS_ACT), WSP(bf16, WS_WIN) + (size_t)layer * INW * D, MT, INW, D, F.G, (int)blockIdx.x);
            pg8::EpiInProj E{WSP(bf16, WS_PROJ), WSP(float, WS_ROPE), WSP(float, WS_ROPE) + 1024};
            pg8::gemm_phase(F.lds, D, S, E);
        } SEAM(pb);
        if (IN(pb + 1)) { p_mix_naive(F, layer); } SEAM(pb + 1);
        if (IN(pb + 2)) { p_scan(F, layer); } SEAM(pb + 2);
        if (IN(pb + 3)) { p_ret_naive(F, layer); } SEAM(pb + 3);
        if (IN(pb + 4)) {
            pg8::StaticOrder S; S.init(WSP(bf16, WS_MIX), WSP(bf16, WS_WOUT) + (size_t)layer * D * D, layer == 0 ? MT : NL, D, D, F.G, (int)blockIdx.x);
            pg8::EpiBf16 E{WSP(bf16, WS_ACT), D};
            pg8::gemm_phase(F.lds, D, S, E);
        } SEAM(pb + 4);
        if (IN(pb + 5)) { p_ln1(F, layer); } SEAM(pb + 5);
        if constexpr (layer == 0) {
        if (IN(8)) {
            pg8::StaticOrder S; S.init(WSP(bf16, WS_ACT), WSP(bf16, WS_FGU), MT, 2 * FF, D, F.G, (int)blockIdx.x);
            pg8::EpiSwiGLU E{WSP(bf16, WS_HID), FF};
            pg8::gemm_phase(F.lds, D, S, E);
        } SEAM(8);
        if (IN(9)) {
            pg8::StaticOrder S; S.init(WSP(bf16, WS_HID), WSP(bf16, WS_FD), MT, D, FF, F.G, (int)blockIdx.x);
            pg8::EpiBf16 E{WSP(bf16, WS_ACT), D};
            pg8::gemm_phase(F.lds, FF, S, E);
        } SEAM(9);
        if (IN(10)) { p_ln2_l0(F); } SEAM(10);
        }
}

__global__ void __launch_bounds__(NTHR, 2) hybrid_fwd(Args args) {
    extern __shared__ __attribute__((aligned(16))) unsigned char lds_raw[];
    Frame F;
    F.lds = (LAS unsigned char*)lds_raw;
    F.tid = threadIdx.x; F.lane = F.tid & 63; F.wave = __builtin_amdgcn_readfirstlane(F.tid >> 6);
    F.G = gridDim.x; { const int bx = blockIdx.x; F.vcu = (F.G % 8 == 0) ? (bx % 8) * (F.G / 8) + bx / 8 : bx; }
    F.ws = args.ws; F.out = args.out;
    F.x = args.in[0]; F.c = args.in[1]; F.ctx = args.in[2]; F.c_ctx = args.in[3]; F.w_mod = args.in[4]; F.b_mod = args.in[5]; F.w_in = args.in[6]; F.sink = args.in[7];
    F.pool_w = args.in[8]; F.pool_scale = args.in[9]; F.lgf = args.in[10]; F.lgb = args.in[11]; F.w_out = args.in[12]; F.ln1_g = args.in[13]; F.ln1_b = args.in[14]; F.ln2_g = args.in[15]; F.ln2_b = args.in[16];
    F.fw_gate = args.in[17]; F.fw_up = args.in[18]; F.fw_down = args.in[19]; F.router = args.in[20]; F.mw_gate = args.in[21]; F.mw_up = args.in[22]; F.mw_down = args.in[23];
    volatile LAS unsigned* MISC = (volatile LAS unsigned*)(F.lds + MISC_OFF);
    if (F.tid < 64) MISC[F.tid] = 0u;
    __syncthreads();
    const int lo = args.ph_lo, hi = args.ph_hi;
    XcdBarrier bar; bar.bar = WSP(unsigned, WS_CTL) + CW_BAR; bar.x = 0; bar.st = nullptr;
    if (hi - lo > 1) bar = xcd_barrier_post(WSP(unsigned, WS_CTL) + CW_BAR, MISC + 8);

    if (IN(0)) { p_prep(F); } SEAM(0);
    if (IN(1)) { p_h0(F); } SEAM(1);
    layer_front<0>(F, bar, lo, hi);
    layer_front<1>(F, bar, lo, hi);
    for (int s = 0; s < 5; ++s) {
        if (IN(17 + 2 * s)) {
            pg8::MoeOrder<true> S; moe_tiles(F, S.pre, S.cnt);
            S.T0 = 64 * s; S.nrt = min(S.pre[NE] - S.T0, 64); S.nN = 2 * FF / 256; S.G = F.G; S.c = (int)blockIdx.x; S.K = D;
            S.A = (const char*)WSP(bf16, WS_ACT); S.Bt = (const char*)WSP(bf16, WS_MGU); S.bstride = (size_t)2 * FF * D * 2; S.list = WSP(int, WS_LIST);
            pg8::EpiSwiGLU E{WSP(bf16, WS_HIDS), FF};
            pg8::gemm_phase(F.lds, D, S, E);
        } SEAM(17 + 2 * s);
        if (IN(18 + 2 * s)) {
            pg8::MoeOrder<false> S; moe_tiles(F, S.pre, S.cnt);
            S.T0 = 64 * s; S.nrt = min(S.pre[NE] - S.T0, 64); S.nN = D / 256; S.G = F.G; S.c = (int)blockIdx.x; S.K = FF;
            S.A = (const char*)WSP(bf16, WS_HIDS); S.Bt = (const char*)WSP(bf16, WS_MD); S.bstride = (size_t)FF * D * 2; S.list = WSP(int, WS_LIST);
            pg8::EpiMoeDown E{WSP(bf16, WS_Y), WSP(int, WS_LIST), WSP(float, WS_LGATE)};
            pg8::gemm_phase(F.lds, FF, S, E);
        } SEAM(18 + 2 * s);
    }
    if (IN(27)) { p_final(F); }
#undef IN
#undef SEAM
}

extern "C" void kernel_launch(void* const* d_in, const int* in_sizes, int n_in, void* d_out, int out_size, void* d_ws, size_t ws_size, hipStream_t stream) {
    static int grid = 0;
    if (grid == 0) {
        if (n_in != 24 || out_size != NL * D || ws_size < WS_END) { fprintf(stderr, "kernel_launch: unexpected shapes (n_in %d, out %d, ws %zu < %zu); nothing launched\n", n_in, out_size, ws_size, (size_t)WS_END); grid = -1; return; }
        int dev = 0, cus = 0, per_cu = 0;
        if (hipGetDevice(&dev) != hipSuccess || hipDeviceGetAttribute(&cus, hipDeviceAttributeMultiprocessorCount, dev) != hipSuccess) { grid = -1; return; }
        if (hipFuncSetAttribute((const void*)hybrid_fwd, hipFuncAttributeMaxDynamicSharedMemorySize, LDS_BYTES) != hipSuccess) { fprintf(stderr, "kernel_launch: hipFuncSetAttribute failed\n"); grid = -1; return; }
        if (hipOccupancyMaxActiveBlocksPerMultiprocessor(&per_cu, (const void*)hybrid_fwd, NTHR, LDS_BYTES) != hipSuccess || per_cu < 1) { fprintf(stderr, "kernel_launch: occupancy query says %d\n", per_cu); }
        (void)hipGetLastError();
        grid = cus;
    }
    if (grid < 0) return;
    if (hipMemsetAsync((char*)d_ws + WS_CTL, 0, CTL_ZERO_BYTES, stream) != hipSuccess) return;
    Args a{};
    for (int i = 0; i < 24; ++i) a.in[i] = (const float*)d_in[i];
    a.out = (float*)d_out; a.ws = (unsigned char*)d_ws;
#if MK_N_LAUNCHES == 1
    a.ph_lo = 0; a.ph_hi = NPHASE;
    hipLaunchKernelGGL(hybrid_fwd, dim3(grid), dim3(NTHR), LDS_BYTES, stream, a);
#else
    for (int p = 0; p < NPHASE; ++p) { a.ph_lo = p; a.ph_hi = p + 1; hipLaunchKernelGGL(hybrid_fwd, dim3(grid), dim3(NTHR), LDS_BYTES, stream, a); }
#endif
}
```

```cpp
#include <hip/hip_runtime.h>
#include <cstdio>
#include <cstdint>
#define MK_N_LAUNCHES 1
__device__ __forceinline__ int opq(int v) { asm volatile("" : "+v"(v)); return v; }
namespace pg8 {
#define PG8_LAS __attribute__((address_space(3)))
typedef unsigned short bf16_t;
typedef short bf16x8 __attribute__((ext_vector_type(8)));
typedef float f32x4 __attribute__((ext_vector_type(4)));
typedef float f32x2 __attribute__((ext_vector_type(2)));
typedef unsigned u32x4 __attribute__((ext_vector_type(4)));
constexpr int BM = 256, BK = 64, HALF = 128, HTB = HALF * BK * 2  , STAGE_BYTES = 8 * HTB, NXCD = 8, WGM = 8;

__host__ __device__ __forceinline__ int lds_byte(int r, int c) { const int st = (r >> 4) * 2 + (c >> 5), rr = r & 15, cc = c & 31, ob = rr * 64 + cc * 2; return st * 1024 + (ob ^ (((ob >> 9) & 1) << 5)); }
__host__ __device__ __forceinline__ void stage_rc(int b, int& R, int& C) { const int st = b / 1024, sb = b % 1024, swz = sb ^ (((sb >> 9) & 1) << 5); R = (st >> 1) * 16 + swz / 64; C = (st & 1) * 32 + (swz % 64) / 2; }
__host__ __device__ __forceinline__ int perm32(int rho) { const int n = rho >> 4, i = rho & 15; return 8 * (i >> 2) + 4 * n + (i & 3); }

struct Unit { int pm, pn, e, rt, cnt; const char* ab; const char* bb; };

__device__ __forceinline__ bool tile_order(int i, int G, int c, int nM, int nN, int& pm, int& pn) {
    const int nwg = nM * nN; const long L = (long)i * G + c; if (L >= nwg) return false;
    int wgid = (int)L; { const int q = nwg / NXCD, r = nwg % NXCD, xcd = wgid % NXCD, off = wgid / NXCD; wgid = (xcd < r ? xcd * (q + 1) : r * (q + 1) + (xcd - r) * q) + off; }
    const int nig = WGM * nN, gid = wgid / nig, fm = gid * WGM, gsz = (nM - fm) < WGM ? (nM - fm) : WGM;
    pm = fm + ((wgid % nig) % gsz); pn = (wgid % nig) / gsz; return true;
}
struct StaticOrder {
    static constexpr bool GATHER = false;
    int nM, nN, G, c, K; const char* A; const char* Bt;
    __device__ __forceinline__ void init(const void* A_, const void* Bt_, int M, int N, int K_, int G_, int c_) { A = (const char*)A_; Bt = (const char*)Bt_; nM = M / BM; nN = N / BM; K = K_; G = G_; c = c_; }
    __device__ __forceinline__ bool next(int i, Unit& u) const {
        int pm, pn; if (!tile_order(i, G, c, nM, nN, pm, pn)) return false;
        u.pm = pm; u.pn = pn; u.e = 0; u.rt = pm; u.cnt = 1 << 30; u.ab = A + (size_t)pm * BM * K * 2; u.bb = Bt + (size_t)pn * BM * K * 2; return true;
    }
    __device__ __forceinline__ void aoff(const Unit&, const int (&R)[2], const int (&C)[2], unsigned (&va)[2][2]) const {
#pragma unroll
        for (int h = 0; h < 2; ++h)
#pragma unroll
            for (int i = 0; i < 2; ++i) va[h][i] = (unsigned)((R[i] + HALF * h) * K + C[i]) * 2u;
    }
};

__device__ __forceinline__ unsigned cvt_pk_bf16(float lo, float hi) { unsigned r; asm volatile("v_cvt_pk_bf16_f32 %0, %1, %2" : "=v"(r) : "v"(lo), "v"(hi)); return r; }

template <class Epi, class Sched>
__device__ __forceinline__ void gemm_phase(PG8_LAS unsigned char* lds, const int K, const Sched& S, const Epi& E) {
    const int tid = opq((int)threadIdx.x), wid = __builtin_amdgcn_readfirstlane(tid >> 6), lane = tid & 63, wr = wid >> 2, wc = wid & 3, fr = lane & 15, fq = lane >> 4;
    const int nt = K / BK;
    int R[2], C[2]; unsigned voffB[2];
#pragma unroll
    for (int i = 0; i < 2; ++i) { stage_rc(tid * 16 + i * 8192, R[i], C[i]); const int Rb = Epi::PERM ? ((R[i] & ~31) + perm32(R[i] & 31)) : R[i]; voffB[i] = (unsigned)(Rb * K + C[i]) * 2u; }
    const size_t kstep = (size_t)(BK * 2);
    const size_t hstep = (size_t)HALF * K * 2;
    const unsigned ldsw = (unsigned)wid * 1024u;
    const int aoff = lds_byte(wr * 64 + fr, fq * 8), boff = lds_byte(wc * 32 + fr, fq * 8);
#define PG8_SA(b, h) (((b) * 2 + (h)) * HTB)
#define PG8_SB(b, h) ((4 + (b) * 2 + (h)) * HTB)
#define PG8_STAGE(bufoff, gbase, voff) do { _Pragma("unroll") for (int _i = 0; _i < 2; ++_i) \
        __builtin_amdgcn_global_load_lds((const unsigned*)((const char*)(gbase) + (voff)[_i]), (PG8_LAS unsigned*)(lds + (bufoff) + ldsw + _i * 8192), 16, 0, 0); } while (0)
#define PG8_LDA(dst, b, h) do { _Pragma("unroll") for (int m = 0; m < 4; ++m) _Pragma("unroll") for (int k = 0; k < 2; ++k) dst[m][k] = *(const PG8_LAS bf16x8*)(lds + PG8_SA(b, h) + aoff + m * 2048 + k * 1024); } while (0)
#define PG8_LDB(dst, b, h) do { _Pragma("unroll") for (int n = 0; n < 2; ++n) _Pragma("unroll") for (int k = 0; k < 2; ++k) dst[n][k] = *(const PG8_LAS bf16x8*)(lds + PG8_SB(b, h) + boff + n * 2048 + k * 1024); } while (0)
#define PG8_MMA(ai, bj, At, Bt) do { __builtin_amdgcn_s_setprio(1); _Pragma("unroll") for (int m = 0; m < 4; ++m) _Pragma("unroll") for (int n = 0; n < 2; ++n) _Pragma("unroll") for (int k = 0; k < 2; ++k) \
        acc[ai][bj][m][n] = __builtin_amdgcn_mfma_f32_16x16x32_bf16(Bt[n][k], At[m][k], acc[ai][bj][m][n], 0, 0, 0); __builtin_amdgcn_s_setprio(0); } while (0)
#define PG8_WAIT_V(n) asm volatile("s_waitcnt vmcnt(" #n ")" ::: "memory")
#define PG8_WAIT_L(n) asm volatile("s_waitcnt lgkmcnt(" #n ")" ::: "memory")
#define PG8_BAR __builtin_amdgcn_s_barrier()
#define PG8_SCHED __builtin_amdgcn_sched_barrier(0)
    Unit cur, nxt; int ui = 0;
    if (!S.next(0, cur)) return;
    unsigned va[2][2], nva[2][2];
    S.aoff(cur, R, C, va);
    f32x4 acc[2][2][4][2];
#pragma unroll
    for (int a = 0; a < 2; ++a)
#pragma unroll
        for (int b = 0; b < 2; ++b)
#pragma unroll
            for (int m = 0; m < 4; ++m)
#pragma unroll
                for (int n = 0; n < 2; ++n) acc[a][b][m][n] = (f32x4){0.f, 0.f, 0.f, 0.f};
    bf16x8 At[4][2], B0[2][2], B1[2][2];
    const char* cA = cur.ab; const char* cB = cur.bb;
    PG8_STAGE(PG8_SB(0, 0), cB, voffB); PG8_STAGE(PG8_SB(0, 1), cB + hstep, voffB); PG8_STAGE(PG8_SA(0, 0), cA, va[0]); PG8_STAGE(PG8_SA(0, 1), cA, va[1]);
    if (wr == 1) PG8_BAR;
    PG8_WAIT_V(2); PG8_BAR;
    PG8_STAGE(PG8_SB(1, 0), cB + kstep, voffB); PG8_STAGE(PG8_SA(1, 0), cA + kstep, va[0]); PG8_STAGE(PG8_SB(1, 1), cB + hstep + kstep, voffB);
    PG8_WAIT_V(6); PG8_BAR;
    for (;;) {
        const bool has_next = S.next(ui + 1, nxt);
        const char* nA = has_next ? nxt.ab : cA; const char* nB = has_next ? nxt.bb : cB;
        if constexpr (Sched::GATHER) {
            if (has_next) S.aoff(nxt, R, C, nva);
            else {
#pragma unroll
                for (int h = 0; h < 2; ++h)
#pragma unroll
                    for (int i = 0; i < 2; ++i) nva[h][i] = va[h][i]; } }
        for (int t = 0; t < nt; t += 2) {
            const bool last = (t == nt - 2);
            const char* a1 = cA + (size_t)(t + 1) * kstep;
            const char* a2 = last ? nA : cA + (size_t)(t + 2) * kstep; const char* b2 = last ? nB : cB + (size_t)(t + 2) * kstep;
            const char* a3 = a2 + kstep; const char* b3 = b2 + kstep;
            unsigned x0[2], x1[2];
#pragma unroll
            for (int i = 0; i < 2; ++i) { if constexpr (Sched::GATHER) { x0[i] = last ? nva[0][i] : va[0][i]; x1[i] = last ? nva[1][i] : va[1][i]; } else { x0[i] = va[0][i]; x1[i] = va[1][i]; } }
            PG8_LDB(B0, 0, 0); PG8_LDB(B1, 0, 1); PG8_SCHED; PG8_LDA(At, 0, 0); PG8_STAGE(PG8_SA(1, 1), a1, va[1]);
            PG8_WAIT_V(8); PG8_WAIT_L(0); PG8_BAR; PG8_MMA(0, 0, At, B0); PG8_MMA(0, 1, At, B1); PG8_BAR; PG8_SCHED;
            PG8_LDA(At, 0, 1); PG8_STAGE(PG8_SB(0, 0), b2, voffB); PG8_STAGE(PG8_SB(0, 1), b2 + hstep, voffB); PG8_STAGE(PG8_SA(0, 0), a2, x0);
            PG8_WAIT_V(8); PG8_WAIT_L(0); PG8_BAR; PG8_MMA(1, 0, At, B0); PG8_MMA(1, 1, At, B1); PG8_BAR; PG8_SCHED;
            PG8_LDB(B0, 1, 0); PG8_LDB(B1, 1, 1); PG8_SCHED; PG8_LDA(At, 1, 0); PG8_STAGE(PG8_SA(0, 1), a2, x1);
            PG8_WAIT_V(8); PG8_WAIT_L(0); PG8_BAR; PG8_MMA(0, 0, At, B0); PG8_MMA(0, 1, At, B1); PG8_BAR; PG8_SCHED;
            PG8_LDA(At, 1, 1); PG8_STAGE(PG8_SB(1, 0), b3, voffB); PG8_STAGE(PG8_SB(1, 1), b3 + hstep, voffB); PG8_STAGE(PG8_SA(1, 0), a3, x0);
            PG8_WAIT_V(8); PG8_WAIT_L(0); PG8_BAR; PG8_MMA(1, 0, At, B0); PG8_MMA(1, 1, At, B1); PG8_BAR; PG8_SCHED;
        }
        if (wr == 0) PG8_BAR;
        E(acc, cur, wr, wc, fr, fq);
        if (!has_next) break;
#pragma unroll
        for (int a = 0; a < 2; ++a)
#pragma unroll
            for (int b = 0; b < 2; ++b)
#pragma unroll
                for (int m = 0; m < 4; ++m)
#pragma unroll
                    for (int n = 0; n < 2; ++n) acc[a][b][m][n] = (f32x4){0.f, 0.f, 0.f, 0.f};
        cur = nxt; cA = nA; cB = nB; ++ui;
        if constexpr (Sched::GATHER) {
#pragma unroll
            for (int h = 0; h < 2; ++h)
#pragma unroll
                for (int i = 0; i < 2; ++i) va[h][i] = nva[h][i]; }
        if (wr == 1) PG8_BAR;
    }
    PG8_WAIT_V(0);
    PG8_BAR;
#undef PG8_SA
#undef PG8_SB
#undef PG8_STAGE
#undef PG8_LDA
#undef PG8_LDB
#undef PG8_MMA
#undef PG8_WAIT_V
#undef PG8_WAIT_L
#undef PG8_BAR
#undef PG8_SCHED
}
}
constexpr int D = 1024, NB = 8, SEQ = 4096, CTXL = 256, NL = NB * SEQ, NC = NB * CTXL, MT = NL + NC;
constexpr int INW = 1792, FF = 2816, NE = 8;
constexpr int C_Q = 0, C_K = 512, C_V = 640, C_U = 768, C_RQ = 1024, C_RK = 1152, C_RV = 1280, C_RG = 1536;
constexpr int NCHK = 34;
constexpr float LN_EPS = 1e-5f, LOG2E = 1.4426950408889634f;
constexpr float QSCALE = 0.125f * LOG2E;
constexpr float RSCALE = 0.17677669529663687f;
constexpr float ALPHA = 1.4142135623730951f;
constexpr int LCAP = 32768;

namespace pg8 {
__device__ __forceinline__ void store8(bf16_t* p, f32x4 v0, f32x4 v1) {
    u32x4 w; w.x = cvt_pk_bf16(v0[0], v0[1]); w.y = cvt_pk_bf16(v0[2], v0[3]); w.z = cvt_pk_bf16(v1[0], v1[1]); w.w = cvt_pk_bf16(v1[2], v1[3]); *(u32x4*)p = w;
}
struct EpiBf16 {
    static constexpr bool PERM = true;
    bf16_t* O; int ldc;
    __device__ __forceinline__ void operator()(const f32x4 (&acc)[2][2][4][2], const Unit& u, int wr, int wc, int fr, int fq) const {
        const int row0 = u.pm * BM + wr * 64 + fr, col0 = u.pn * BM + wc * 32 + 8 * fq;
#pragma unroll
        for (int ai = 0; ai < 2; ++ai)
#pragma unroll
            for (int m = 0; m < 4; ++m) { bf16_t* rowp = O + (size_t)(row0 + ai * HALF + m * 16) * ldc + col0;
#pragma unroll
                for (int bj = 0; bj < 2; ++bj) store8(rowp + bj * HALF, acc[ai][bj][m][0], acc[ai][bj][m][1]); }
    }
};
struct EpiInProj {
    static constexpr bool PERM = true;
    bf16_t* O; const float* rc; const float* rs;
    __device__ __forceinline__ void operator()(const f32x4 (&acc)[2][2][4][2], const Unit& u, int wr, int wc, int fr, int fq) const {
        const int row0 = u.pm * BM + wr * 64 + fr; const bool lat = u.pm < (NL / BM);
#pragma unroll
        for (int bj = 0; bj < 2; ++bj) {
            const int seg = 2 * u.pn + bj;
            const bool rope = lat && seg <= 4; const float sc = seg <= 3 ? QSCALE : (seg == 9 ? RSCALE : 1.0f);
#pragma unroll
            for (int ai = 0; ai < 2; ++ai)
#pragma unroll
                for (int m = 0; m < 4; ++m) { const int row = row0 + ai * HALF + m * 16;
                    f32x4 v0 = acc[ai][bj][m][0], v1 = acc[ai][bj][m][1];
                    if (rope) { const int t = row & (SEQ - 1); const int pos = (wc & 1) ? (t & 63) : (t >> 6);
                        const f32x4 c4 = *(const f32x4*)(rc + pos * 16 + 4 * fq), s4 = *(const f32x4*)(rs + pos * 16 + 4 * fq);
                        const f32x4 o0 = v0 * c4 - v1 * s4, o1 = v0 * s4 + v1 * c4; v0 = o0; v1 = o1; }
                    v0 = v0 * sc; v1 = v1 * sc;
                    store8(O + (size_t)row * INW + seg * HALF + wc * 32 + 8 * fq, v0, v1); }
        }
    }
};
struct EpiSwiGLU {
    static constexpr bool PERM = true;
    bf16_t* H; int ldh;
    __device__ __forceinline__ void operator()(const f32x4 (&acc)[2][2][4][2], const Unit& u, int wr, int wc, int fr, int fq) const {
        const int row0 = u.pm * BM + wr * 64 + fr, col0 = u.pn * HALF + wc * 32 + 8 * fq;
#pragma unroll
        for (int ai = 0; ai < 2; ++ai)
#pragma unroll
            for (int m = 0; m < 4; ++m) { f32x4 h[2];
#pragma unroll
                for (int n = 0; n < 2; ++n) { const f32x4 g = acc[ai][0][m][n], up = acc[ai][1][m][n];
#pragma unroll
                    for (int i = 0; i < 4; ++i) h[n][i] = g[i] * __builtin_amdgcn_rcpf(1.0f + __builtin_amdgcn_exp2f(-LOG2E * g[i])) * up[i]; }
                store8(H + (size_t)(row0 + ai * HALF + m * 16) * ldh + col0, h[0], h[1]); }
    }
};
struct EpiMoeDown {
    static constexpr bool PERM = true;
    bf16_t* Y; const int* list; const float* lgate;
    __device__ __forceinline__ void operator()(const f32x4 (&acc)[2][2][4][2], const Unit& u, int wr, int wc, int fr, int fq) const {
        const int col0 = u.pn * BM + wc * 32 + 8 * fq;
#pragma unroll
        for (int ai = 0; ai < 2; ++ai)
#pragma unroll
            for (int m = 0; m < 4; ++m) { const int pos = u.rt * BM + ai * HALF + wr * 64 + m * 16 + fr;
                if (pos < u.cnt) { const int ent = list[u.e * LCAP + pos]; const float g = lgate[u.e * LCAP + pos];
                    bf16_t* rowp = Y + ((size_t)(ent & 1) * NL + (size_t)(ent >> 1)) * D + col0;
#pragma unroll
                    for (int bj = 0; bj < 2; ++bj) store8(rowp + bj * HALF, acc[ai][bj][m][0] * g, acc[ai][bj][m][1] * g); } }
    }
};
template <bool GATHER_> struct MoeOrder {
    static constexpr bool GATHER = GATHER_;
    int nrt, nN, G, c, K, T0; int pre[NE + 1]; int cnt[NE];
    const char* A; const char* Bt; size_t bstride; const int* list;
    __device__ __forceinline__ bool next(int i, Unit& u) const {
        int pm, pn; if (nrt <= 0 || !tile_order(i, G, c, nrt, nN, pm, pn)) return false;
        const int T = T0 + pm; int e = 0;
#pragma unroll
        for (int j = 1; j < NE; ++j) e += (T >= pre[j]) ? 1 : 0;
        int p0 = pre[0], ce = cnt[0];
#pragma unroll
        for (int j = 1; j < NE; ++j) { p0 = (e == j) ? pre[j] : p0; ce = (e == j) ? cnt[j] : ce; }
        u.pm = pm; u.pn = pn; u.e = e; u.rt = T - p0; u.cnt = ce;
        u.ab = GATHER ? A : A + (size_t)pm * BM * K * 2; u.bb = Bt + (size_t)e * bstride + (size_t)pn * BM * K * 2; return true;
    }
    __device__ __forceinline__ void aoff(const Unit& u, const int (&R)[2], const int (&C)[2], unsigned (&va)[2][2]) const {
#pragma unroll
        for (int h = 0; h < 2; ++h)
#pragma unroll
            for (int i = 0; i < 2; ++i) {
                if (GATHER) { const int pos = u.rt * BM + R[i] + HALF * h; const int tok = pos < u.cnt ? (list[u.e * LCAP + pos] >> 1) : 0; va[h][i] = (unsigned)(tok * K + C[i]) * 2u; }
                else va[h][i] = (unsigned)((R[i] + HALF * h) * K + C[i]) * 2u; }
    }
};
}
constexpr size_t MiB = 1u << 20;
constexpr size_t WS_CTL = 0, CTL_ZERO_BYTES = 1 * MiB;
constexpr size_t WS_MOD = 1 * MiB;
constexpr size_t WS_ROPE = 1 * MiB + 512 * 1024;
constexpr size_t WS_LIST = 2 * MiB, WS_LGATE = 3 * MiB;
constexpr size_t WS_KVS = 8 * MiB;
constexpr size_t WS_XC = 26 * MiB;
constexpr size_t WS_WIN = 34 * MiB, WS_WOUT = 41 * MiB, WS_FGU = 45 * MiB, WS_FD = 56 * MiB, WS_MGU = 62 * MiB, WS_MD = 150 * MiB;
constexpr size_t WS_ACT = 194 * MiB;
constexpr size_t WS_PROJ = 262 * MiB, WS_MIX = 381 * MiB;
constexpr size_t WS_HID = 262 * MiB;
constexpr size_t WS_Y = 262 * MiB, WS_HIDS = 390 * MiB;
constexpr size_t WS_END = 478 * MiB;
static_assert(WS_WIN + (size_t)2 * INW * D * 2 <= WS_WOUT && WS_FGU + (size_t)2 * FF * D * 2 <= WS_FD && WS_FD + (size_t)FF * D * 2 <= WS_MGU && WS_MGU + (size_t)NE * 2 * FF * D * 2 <= WS_MD && WS_MD + (size_t)NE * FF * D * 2 <= WS_ACT, "weights map");
static_assert(WS_ACT + (size_t)MT * D * 2 <= WS_PROJ && WS_PROJ + (size_t)MT * INW * 2 <= WS_MIX && WS_MIX + (size_t)MT * D * 2 <= WS_END && WS_HID + (size_t)MT * FF * 2 <= WS_END, "act map");
static_assert(WS_Y + (size_t)2 * NL * D * 2 <= WS_HIDS && WS_HIDS + (size_t)64 * 256 * FF * 2 <= WS_END && WS_KVS + (size_t)2 * 32 * NCHK * 2048 * 4 <= WS_XC, "moe map");
constexpr int CW_TMO = 0;
constexpr int CW_GCNT = 1024;
constexpr int CW_BAR = 4096;

constexpr int RING_BYTES = 131072;
constexpr int SCR_BYTES = 155648;
constexpr int MISC_OFF = SCR_BYTES;
constexpr int LDS_BYTES = SCR_BYTES + 256;

#define GAS __attribute__((address_space(1)))
#define LAS __attribute__((address_space(3)))
typedef unsigned short bf16;
typedef unsigned v4u __attribute__((ext_vector_type(4)));
typedef unsigned v2u __attribute__((ext_vector_type(2)));
typedef float f32x4 __attribute__((ext_vector_type(4)));
typedef __bf16 bf16x2_t __attribute__((ext_vector_type(2)));
typedef float f32x2_t __attribute__((ext_vector_type(2)));
#define RLX_AGENT __ATOMIC_RELAXED, __HIP_MEMORY_SCOPE_AGENT
__device__ __forceinline__ unsigned pk2(float lo, float hi) { f32x2_t v = {lo, hi}; bf16x2_t b = __builtin_convertvector(v, bf16x2_t); return __builtin_bit_cast(unsigned, b); }
__device__ __forceinline__ float bflo(unsigned w) { return __uint_as_float(w << 16); }
__device__ __forceinline__ float bfhi(unsigned w) { return __uint_as_float(w & 0xffff0000u); }
__device__ __forceinline__ float dot2bf(unsigned a, unsigned b, float c) { return __builtin_amdgcn_fdot2_f32_bf16(__builtin_bit_cast(bf16x2_t, a), __builtin_bit_cast(bf16x2_t, b), c, false); }
__device__ __forceinline__ float wave_sum(float v) {
#pragma unroll
    for (int o = 1; o < 64; o <<= 1) v += __shfl_xor(v, o);
    return v;
}

#define XB_TMO      128
#define XB_XCNT(j)  (256  + 64 * (j))
#define XB_XSUB(j)  (1280 + 64 * (j))
#define XB_XGEN(j)  (2304 + 64 * (j))
#define XB_TOP      3328
#define XB_TOPGEN   3392
#define XCD_BAR_WORDS 3456
#define XB_SPIN_CAP (1u << 18)
__device__ __forceinline__ unsigned xb_ld(unsigned* p)              { return __hip_atomic_load(p, __ATOMIC_RELAXED, __HIP_MEMORY_SCOPE_AGENT); }
__device__ __forceinline__ unsigned xb_add(unsigned* p, unsigned v) { return __hip_atomic_fetch_add(p, v, __ATOMIC_RELAXED, __HIP_MEMORY_SCOPE_AGENT); }
__device__ __forceinline__ unsigned xb_xcc_id() { return (unsigned)__builtin_amdgcn_s_getreg((3 << 11) | 20) & 0xFu; }
#define XB_SPIN(cond, bar) do { unsigned _sp = 0; while (cond) { __builtin_amdgcn_s_sleep(1); \
    if ((++_sp & 255u) == 0u) { if (xb_ld(&(bar)[XB_TMO])) break; if (_sp > XB_SPIN_CAP) { atomicAdd(&(bar)[XB_TMO], 1u); break; } } } } while (0)
struct XcdBarrier { unsigned* bar; unsigned x; volatile LAS unsigned* st; };
__device__ __forceinline__ XcdBarrier xcd_barrier_post(unsigned* bar, volatile LAS unsigned* st) {
    XcdBarrier b; b.bar = bar; b.x = xb_xcc_id(); b.st = st;
    if (threadIdx.x == 0) (void)xb_add(&bar[XB_XCNT(b.x)], 1u);
    return b;
}
__device__ __forceinline__ void xcd_barrier_complete(unsigned* bar, unsigned x, unsigned& nloc, unsigned& nx) {
    const unsigned G = gridDim.x * gridDim.y * gridDim.z;
    unsigned sum, cnt, mine, sp = 0u;
    for (;;) {
        sum = 0u; cnt = 0u; mine = 0u;
#pragma unroll
        for (unsigned j = 0; j < 16; ++j) { const unsigned c = xb_ld(&bar[XB_XCNT(j)]); sum += c; cnt += (c > 0u) ? 1u : 0u; mine = (j == x) ? c : mine; }
        if (sum == G) break;
        __builtin_amdgcn_s_sleep(1);
        if ((++sp & 255u) == 0u) { if (xb_ld(&bar[XB_TMO])) break; if (sp > XB_SPIN_CAP) { atomicAdd(&bar[XB_TMO], 1u); break; } }
    }
    nloc = mine > 0u ? mine : 1u; nx = cnt > 0u ? cnt : 1u;
}
__device__ __forceinline__ void xcd_barrier(const XcdBarrier& b) {
    asm volatile("s_waitcnt vmcnt(0)" ::: "memory");
    __syncthreads();
    if (threadIdx.x == 0) {
        unsigned* bar = b.bar;
        __builtin_amdgcn_s_waitcnt(0);
        unsigned nloc = b.st[0], nx = b.st[1];
        if (nloc == 0u) { xcd_barrier_complete(bar, b.x, nloc, nx); b.st[0] = nloc; b.st[1] = nx; }
        const unsigned old = xb_add(&bar[XB_XSUB(b.x)], 1u);
        const unsigned gen = old / nloc;
        if (old + 1u == (gen + 1u) * nloc) {
            __builtin_amdgcn_fence(__ATOMIC_RELEASE, "agent");
            asm volatile("s_waitcnt vmcnt(0)" ::: "memory");
            const unsigned og = xb_add(&bar[XB_TOP], 1u);
            const unsigned tg = og / nx;
            if (og + 1u == (tg + 1u) * nx) xb_add(&bar[XB_TOPGEN], 1u);
            else XB_SPIN(xb_ld(&bar[XB_TOPGEN]) == tg, bar);
            __builtin_amdgcn_fence(__ATOMIC_ACQUIRE, "agent");
            xb_add(&bar[XB_XGEN(b.x)], 1u);
            asm volatile("s_waitcnt vmcnt(0)" ::: "memory");
        } else {
            XB_SPIN(xb_ld(&bar[XB_XGEN(b.x)]) == gen, bar);
            __builtin_amdgcn_fence(__ATOMIC_ACQUIRE, "agent");
            asm volatile("s_waitcnt vmcnt(0)" ::: "memory");
        }
    }
    __syncthreads();
}

constexpr int NWAVES = 8, NTHR = 512;
struct Frame {
    LAS unsigned char* lds;
    int tid, lane, wave, vcu, G;
    unsigned char* ws; float* out;
    const float *x, *c, *ctx, *c_ctx, *w_mod, *b_mod, *w_in, *sink, *pool_w, *pool_scale, *lgf, *lgb, *w_out, *ln1_g, *ln1_b, *ln2_g, *ln2_b;
    const float *fw_gate, *fw_up, *fw_down, *router, *mw_gate, *mw_up, *mw_down;
};
#define WSP(T, off) ((T*)(F.ws + (off)))

template <class RowMap>
__device__ __forceinline__ void transpose_item(const float* W, int K, int N, bf16* WT, const RowMap& rowmap, LAS float* scr, int item, int lane) {
    const int nblk = N / 32, kb = item / nblk, nb = item % nblk, k0 = 64 * kb, n0 = 32 * nb;
#pragma unroll 8
    for (int i = 0; i < 32; ++i) { const int kk = 2 * i + (lane >> 5); scr[kk * 33 + (lane & 31)] = W[(size_t)(k0 + kk) * N + n0 + (lane & 31)]; }
    asm volatile("s_waitcnt lgkmcnt(0)" ::: "memory");
    const int c = lane & 7;
#pragma unroll
    for (int j = 0; j < 4; ++j) { const int n = (lane >> 3) + 8 * j; const LAS float* s = scr + (8 * c) * 33 + n;
        v4u o; o.x = pk2(s[0 * 33], s[1 * 33]); o.y = pk2(s[2 * 33], s[3 * 33]); o.z = pk2(s[4 * 33], s[5 * 33]); o.w = pk2(s[6 * 33], s[7 * 33]);
        *(GAS v4u*)(WT + (size_t)rowmap(n0 + n) * K + k0 + 8 * c) = o; }
    asm volatile("s_waitcnt lgkmcnt(0)" ::: "memory");
}
struct MapId { __device__ __forceinline__ int operator()(int n) const { return n; } };
struct MapInProj {
    __device__ __forceinline__ int operator()(int n) const { if (n >= C_V) return n; const int dd = n & 31, j = dd & 15, x2 = dd >> 4; return (n & ~31) + 8 * (j >> 2) + 4 * x2 + (j & 3); } };
struct MapGU { int up; __device__ __forceinline__ int operator()(int n) const { return 256 * (n >> 7) + 128 * up + (n & 127); } };

__device__ __forceinline__ void p_prep(Frame& F) {
    const int tid = opq(F.tid), lane = tid & 63, wave = F.wave;
    LAS float* sv = (LAS float*)F.lds;
    LAS float* red = sv + 1024 * 12;
    bool have_sv = false;
    for (int un = blockIdx.x; un < 2 * 96; un += F.G) {
        if (!have_sv) {
            for (int idx = tid; idx < 9 * 1024; idx += NTHR) { const int r = idx >> 10, k = idx & 1023; const float v = r < 8 ? F.c[r * 1024 + k] : F.c_ctx[k]; sv[k * 12 + r] = v / (1.0f + __expf(-v)); }
            have_sv = true; __syncthreads();
        }
        const int layer = un / 96, cc = un % 96, col = cc * 64 + lane;
        float acc[9];
#pragma unroll
        for (int r = 0; r < 9; ++r) acc[r] = 0.f;
        const float* wp = F.w_mod + ((size_t)layer * 1024 + wave * 128) * 6144 + col;
#pragma unroll 8
        for (int kk = 0; kk < 128; ++kk) { const float wv = wp[(size_t)kk * 6144]; const LAS float* s = sv + (wave * 128 + kk) * 12;
            const f32x4 s0 = *(const LAS f32x4*)s, s1 = *(const LAS f32x4*)(s + 4); const float s8 = s[8];
            acc[0] += s0[0] * wv; acc[1] += s0[1] * wv; acc[2] += s0[2] * wv; acc[3] += s0[3] * wv; acc[4] += s1[0] * wv; acc[5] += s1[1] * wv; acc[6] += s1[2] * wv; acc[7] += s1[3] * wv; acc[8] += s8 * wv; }
#pragma unroll
        for (int r = 0; r < 9; ++r) red[(wave * 9 + r) * 64 + lane] = acc[r];
        __syncthreads();
        for (int idx = tid; idx < 9 * 64; idx += NTHR) { const int r = idx >> 6, ln = idx & 63; float s = F.b_mod[layer * 6144 + cc * 64 + ln];
#pragma unroll
            for (int w = 0; w < 8; ++w) s += red[(w * 9 + r) * 64 + ln];
            WSP(float, WS_MOD)[(size_t)(layer * 9 + r) * 6144 + cc * 64 + ln] = s; }
        __syncthreads();
    }
    if (blockIdx.x == F.G - 1) { for (int idx = tid; idx < 1024; idx += NTHR) { const int pos = idx >> 4, j = idx & 15; const float inv = powf(10000.0f, -(float)j / 16.0f); const float ang = (float)pos * inv;
            WSP(float, WS_ROPE)[idx] = cosf(ang); WSP(float, WS_ROPE)[1024 + idx] = sinf(ang); } }
    __syncthreads();
    LAS float* scr = (LAS float*)(F.lds + wave * 16384);
    const int gw = F.vcu * NWAVES + wave, NGW = F.G * NWAVES;
    constexpr int I_IN = (D / 64) * (INW / 32), I_OUT = (D / 64) * (D / 32), I_GU = (D / 64) * (FF / 32), I_DN = (FF / 64) * (D / 32);
    constexpr int NITEMS = 2 * (I_IN + I_OUT) + (1 + NE) * (2 * I_GU + I_DN);
    for (int it = gw; it < NITEMS; it += NGW) {
        int r = it;
        if (r < 2 * I_IN) { const int l = r / I_IN; transpose_item(F.w_in + (size_t)l * D * INW, D, INW, WSP(bf16, WS_WIN) + (size_t)l * INW * D, MapInProj{}, scr, r % I_IN, lane); continue; } r -= 2 * I_IN;
        if (r < 2 * I_OUT) { const int l = r / I_OUT; transpose_item(F.w_out + (size_t)l * D * D, D, D, WSP(bf16, WS_WOUT) + (size_t)l * D * D, MapId{}, scr, r % I_OUT, lane); continue; } r -= 2 * I_OUT;
        const int per = 2 * I_GU + I_DN, m = r / per; r %= per;
        const float* wg = m == 0 ? F.fw_gate : F.mw_gate + (size_t)(m - 1) * D * FF; const float* wu = m == 0 ? F.fw_up : F.mw_up + (size_t)(m - 1) * D * FF; const float* wd = m == 0 ? F.fw_down : F.mw_down + (size_t)(m - 1) * FF * D;
        bf16* gu = m == 0 ? WSP(bf16, WS_FGU) : WSP(bf16, WS_MGU) + (size_t)(m - 1) * 2 * FF * D; bf16* dn = m == 0 ? WSP(bf16, WS_FD) : WSP(bf16, WS_MD) + (size_t)(m - 1) * FF * D;
        if (r < I_GU) { transpose_item(wg, D, FF, gu, MapGU{0}, scr, r, lane); continue; } r -= I_GU;
        if (r < I_GU) { transpose_item(wu, D, FF, gu, MapGU{1}, scr, r, lane); continue; } r -= I_GU;
        transpose_item(wd, FF, D, dn, MapId{}, scr, r, lane);
    }
}

__device__ __forceinline__ void row_load_f32(const float* p, int lane, f32x4 (&v)[4]) {
#pragma unroll
    for (int j = 0; j < 4; ++j) v[j] = *(const f32x4*)(p + 4 * lane + 256 * j);
}
__device__ __forceinline__ void row_load_bf16(const bf16* p, int lane, f32x4 (&v)[4]) {
#pragma unroll
    for (int j = 0; j < 4; ++j) { const v2u w = *(const v2u*)(p + 4 * lane + 256 * j); v[j] = (f32x4){bflo(w.x), bfhi(w.x), bflo(w.y), bfhi(w.y)}; }
}
__device__ __forceinline__ void row_store_bf16(bf16* p, int lane, const f32x4 (&v)[4]) {
#pragma unroll
    for (int j = 0; j < 4; ++j) { v2u w; w.x = pk2(v[j][0], v[j][1]); w.y = pk2(v[j][2], v[j][3]); *(v2u*)(p + 4 * lane + 256 * j) = w; }
}
__device__ __forceinline__ void row_store_f32(float* p, int lane, const f32x4 (&v)[4]) {
#pragma unroll
    for (int j = 0; j < 4; ++j) *(f32x4*)(p + 4 * lane + 256 * j) = v[j];
}
__device__ __forceinline__ void row_ln(f32x4 (&v)[4], const float* g, const float* b, int lane) {
    float s = 0.f;
#pragma unroll
    for (int j = 0; j < 4; ++j) s += (v[j][0] + v[j][1]) + (v[j][2] + v[j][3]);
    const float mean = wave_sum(s) * (1.0f / D); float q = 0.f;
#pragma unroll
    for (int j = 0; j < 4; ++j) { v[j] = v[j] - mean; q += (v[j][0] * v[j][0] + v[j][1] * v[j][1]) + (v[j][2] * v[j][2] + v[j][3] * v[j][3]); }
    const float rstd = 1.0f / sqrtf(wave_sum(q) * (1.0f / D) + LN_EPS);
#pragma unroll
    for (int j = 0; j < 4; ++j) { const f32x4 gg = *(const f32x4*)(g + 4 * lane + 256 * j), bb = *(const f32x4*)(b + 4 * lane + 256 * j); v[j] = v[j] * rstd * gg + bb; }
}
__device__ __forceinline__ const float* modp(Frame& F, int layer, int mr, int part) { return WSP(float, WS_MOD) + (size_t)(layer * 9 + mr) * 6144 + part * 1024; }
__device__ __forceinline__ void row_modulate(f32x4 (&v)[4], const float* sh, const float* sc, int lane) {
#pragma unroll
    for (int j = 0; j < 4; ++j) { const f32x4 a = *(const f32x4*)(sc + 4 * lane + 256 * j), b = *(const f32x4*)(sh + 4 * lane + 256 * j); v[j] = v[j] * (1.0f + a) + b; }
}
__device__ __forceinline__ void p_h0(Frame& F) {
    const int gw = F.vcu * NWAVES + F.wave, NGW = F.G * NWAVES, lane = opq(F.lane);
    for (int r = gw; r < MT; r += NGW) { const int mr = r < NL ? (r >> 12) : 8; const float* xr = r < NL ? F.x + (size_t)r * D : F.ctx + (size_t)(r - NL) * D;
        f32x4 v[4]; row_load_f32(xr, lane, v); row_modulate(v, modp(F, 0, mr, 0), modp(F, 0, mr, 1), lane); row_store_bf16(WSP(bf16, WS_ACT) + (size_t)r * D, lane, v); }
}
__device__ __forceinline__ void p_ln1(Frame& F, int layer) {
    const int lane = opq(F.lane);
    if (layer == 0) {
        const int gw = F.vcu * NWAVES + F.wave, NGW = F.G * NWAVES;
        for (int r = gw; r < MT; r += NGW) { const int mr = r < NL ? (r >> 12) : 8; const float* xr = r < NL ? F.x + (size_t)r * D : F.ctx + (size_t)(r - NL) * D;
            float* xo = r < NL ? F.out + (size_t)r * D : WSP(float, WS_XC) + (size_t)(r - NL) * D; bf16* ar = WSP(bf16, WS_ACT) + (size_t)r * D;
            f32x4 v[4], y[4]; row_load_f32(xr, lane, v); row_load_bf16(ar, lane, y); const float* g1 = modp(F, 0, mr, 2);
#pragma unroll
            for (int j = 0; j < 4; ++j) v[j] = ALPHA * v[j] + *(const f32x4*)(g1 + 4 * lane + 256 * j) * y[j];
            row_ln(v, F.ln1_g, F.ln1_b, lane); row_store_f32(xo, lane, v);
            row_modulate(v, modp(F, 0, mr, 3), modp(F, 0, mr, 4), lane); row_store_bf16(ar, lane, v); }
        return;
    }
    LAS int* lcnt = (LAS int*)F.lds; LAS int* lbase = lcnt + 8; LAS int* rinfo = lcnt + 16;
    float rt[16][8];
#pragma unroll
    for (int j = 0; j < 4; ++j)
#pragma unroll
        for (int q = 0; q < 4; ++q) { const float* rp = F.router + (size_t)(4 * lane + 256 * j + q) * 8; const f32x4 a = *(const f32x4*)rp, b = *(const f32x4*)(rp + 4);
            rt[j * 4 + q][0] = a[0]; rt[j * 4 + q][1] = a[1]; rt[j * 4 + q][2] = a[2]; rt[j * 4 + q][3] = a[3]; rt[j * 4 + q][4] = b[0]; rt[j * 4 + q][5] = b[1]; rt[j * 4 + q][6] = b[2]; rt[j * 4 + q][7] = b[3]; }
    for (int rb = blockIdx.x; rb < NL / 128; rb += F.G) {
        if (F.tid < 8) lcnt[F.tid] = 0;
        __syncthreads();
        for (int i = 0; i < 16; ++i) { const int rl = F.wave * 16 + i, r = rb * 128 + rl, mr = r >> 12;
            float* xo = F.out + (size_t)r * D; bf16* ar = WSP(bf16, WS_ACT) + (size_t)r * D;
            f32x4 v[4], y[4]; row_load_f32(xo, lane, v); row_load_bf16(ar, lane, y); const float* g1 = modp(F, 1, mr, 2);
#pragma unroll
            for (int j = 0; j < 4; ++j) v[j] = ALPHA * v[j] + *(const f32x4*)(g1 + 4 * lane + 256 * j) * y[j];
            row_ln(v, F.ln1_g + D, F.ln1_b + D, lane); row_store_f32(xo, lane, v);
            row_modulate(v, modp(F, 1, mr, 3), modp(F, 1, mr, 4), lane); row_store_bf16(ar, lane, v);
            float lg[8];
#pragma unroll
            for (int e = 0; e < 8; ++e) { float s = 0.f;
#pragma unroll
                for (int j = 0; j < 4; ++j)
#pragma unroll
                    for (int q = 0; q < 4; ++q) s += v[j][q] * rt[j * 4 + q][e];
                lg[e] = wave_sum(s); }
            int i1 = 0; float v1 = lg[0];
#pragma unroll
            for (int e = 1; e < 8; ++e) if (lg[e] > v1) { v1 = lg[e]; i1 = e; }
            int i2 = -1; float v2 = -3.0e38f;
#pragma unroll
            for (int e = 0; e < 8; ++e) if (e != i1 && lg[e] > v2) { v2 = lg[e]; i2 = e; }
            const float ex = __expf(v2 - v1), w1 = 1.0f / (1.0f + ex), w2 = ex / (1.0f + ex);
            if (lane == 0) { const int p1 = __hip_atomic_fetch_add(lcnt + i1, 1, __ATOMIC_RELAXED, __HIP_MEMORY_SCOPE_WORKGROUP), p2 = __hip_atomic_fetch_add(lcnt + i2, 1, __ATOMIC_RELAXED, __HIP_MEMORY_SCOPE_WORKGROUP);
                LAS int* ri = rinfo + rl * 6; ri[0] = i1; ri[1] = p1; ri[2] = __float_as_int(w1); ri[3] = i2; ri[4] = p2; ri[5] = __float_as_int(w2); }
        }
        __syncthreads();
        if (F.tid < 8) lbase[F.tid] = (int)__hip_atomic_fetch_add((unsigned*)(WSP(unsigned, WS_CTL) + CW_GCNT + 64 * F.tid), (unsigned)lcnt[F.tid], RLX_AGENT);
        __syncthreads();
        if (F.tid < 256) { const int rl = F.tid >> 1, s = F.tid & 1; const LAS int* ri = rinfo + rl * 6 + 3 * s; const int e = ri[0], pos = lbase[e] + ri[1];
            WSP(int, WS_LIST)[e * LCAP + pos] = ((rb * 128 + rl) << 1) | s; WSP(float, WS_LGATE)[e * LCAP + pos] = __int_as_float(ri[2]); }
        __syncthreads();
    }
}
__device__ __forceinline__ void p_ln2_l0(Frame& F) {
    const int lane = opq(F.lane), gw = F.vcu * NWAVES + F.wave, NGW = F.G * NWAVES;
    for (int r = gw; r < MT; r += NGW) { const int mr = r < NL ? (r >> 12) : 8;
        float* xo = r < NL ? F.out + (size_t)r * D : WSP(float, WS_XC) + (size_t)(r - NL) * D; bf16* ar = WSP(bf16, WS_ACT) + (size_t)r * D;
        f32x4 v[4], y[4]; row_load_f32(xo, lane, v); row_load_bf16(ar, lane, y); const float* g2 = modp(F, 0, mr, 5);
#pragma unroll
        for (int j = 0; j < 4; ++j) v[j] = ALPHA * v[j] + *(const f32x4*)(g2 + 4 * lane + 256 * j) * y[j];
        row_ln(v, F.ln2_g, F.ln2_b, lane); row_store_f32(xo, lane, v);
        row_modulate(v, modp(F, 1, mr, 0), modp(F, 1, mr, 1), lane); row_store_bf16(ar, lane, v); }
}
__device__ __forceinline__ void p_final(Frame& F) {
    const int lane = opq(F.lane), gw = F.vcu * NWAVES + F.wave, NGW = F.G * NWAVES;
    for (int r = gw; r < NL; r += NGW) { const int mr = r >> 12; float* xo = F.out + (size_t)r * D;
        f32x4 v[4], y0[4], y1[4]; row_load_f32(xo, lane, v); row_load_bf16(WSP(bf16, WS_Y) + (size_t)r * D, lane, y0); row_load_bf16(WSP(bf16, WS_Y) + (size_t)(NL + r) * D, lane, y1); const float* g2 = modp(F, 1, mr, 5);
#pragma unroll
        for (int j = 0; j < 4; ++j) v[j] = ALPHA * v[j] + *(const f32x4*)(g2 + 4 * lane + 256 * j) * (y0[j] + y1[j]);
        row_ln(v, F.ln2_g + D, F.ln2_b + D, lane);
#if defined(ATTN_CHECK) || defined(MIX_CHECK)
        if ((__hip_atomic_load(WSP(unsigned, WS_CTL) + 8, RLX_AGENT) | __hip_atomic_load(WSP(unsigned, WS_CTL) + 9, RLX_AGENT) * CHK_POOL | __hip_atomic_load(WSP(unsigned, WS_CTL) + 10, RLX_AGENT) * CHK_KV | __hip_atomic_load(WSP(unsigned, WS_CTL) + 11, RLX_AGENT) * CHK_RET) != 0u) { const float qn = __builtin_nanf("");
#pragma unroll
            for (int j = 0; j < 4; ++j) v[j] = (f32x4){qn, qn, qn, qn}; }
#endif
        row_store_f32(xo, lane, v); }
}

__device__ __forceinline__ int chunk_row0(int b, int cid) { return cid < 2 ? NL + b * CTXL + cid * 128 : b * SEQ + (cid - 2) * 128; }
namespace att {
using bf16x8 = __attribute__((ext_vector_type(8))) short;
using s16x4 = __attribute__((ext_vector_type(4))) short;
using f32x16 = __attribute__((ext_vector_type(16))) float;
using u32x4 = __attribute__((ext_vector_type(4))) unsigned;
typedef short v4i16_t __attribute__((ext_vector_type(4)));
typedef __attribute__((address_space(3))) const char* lds_cptr;
constexpr int SLOTB = 8192, LDS_K = 0, LDS_V = 2 * SLOTB, LDS_WS = 4 * SLOTB, LDS_OST = LDS_WS + 8 * 256, LDS_TOTAL = LDS_OST + 8 * 4096;
constexpr float THR = 8.0f, NEGBIG = -1.0e30f;
__device__ __forceinline__ int crow(int r, int hi) { return (r & 3) + 8 * (r >> 2) + 4 * hi; }
__device__ __forceinline__ void glds16(const void* gsrc, unsigned lds_dst) { unsigned keep;
    asm volatile("s_mov_b32 %0, m0\n\ts_mov_b32 m0, %2\n\ts_nop 0\n\tglobal_load_lds_dwordx4 %1, off\n\ts_mov_b32 m0, %0" : "=&s"(keep) : "v"(gsrc), "s"(lds_dst) : "memory"); }
__device__ __forceinline__ s16x4 vtr(lds_cptr p) { return __builtin_bit_cast(s16x4, __builtin_amdgcn_ds_read_tr16_b64_v4i16((__attribute__((address_space(3))) v4i16_t*)p)); }
__device__ __forceinline__ unsigned cvtpk(float lo, float hi) { f32x2_t v = {lo, hi}; bf16x2_t b = __builtin_convertvector(v, bf16x2_t); return __builtin_bit_cast(unsigned, b); }

__device__ __forceinline__ void attn_unit(Frame& F, int layer, int b, int qb, int kvh, bool isctx) {
    const int tid = opq(F.tid), lane = tid & 63, r32 = lane & 31, hi = lane >> 5; const int wid = __builtin_amdgcn_readfirstlane(tid >> 6);
    const int g = wid >> 1, qh = wid & 1, head = kvh * 4 + g;
    const bf16* P = WSP(bf16, WS_PROJ);
    const int qrow0 = (isctx ? NL + b * CTXL : b * SEQ) + qb * 128 + qh * 64;
    const int tlo = isctx ? 0 : (qb == 0 ? 2 : 0), thi = isctx ? 0 : (qb == SEQ / 128 - 1 ? 4 : 6), nloc = thi - tlo, ntiles = nloc + 4;
    const lds_cptr shm = (lds_cptr)F.lds; const unsigned lds0 = (unsigned)(uintptr_t)F.lds;
    LAS float* wsf = (LAS float*)(F.lds + LDS_WS) + wid * 64;
    bf16x8 qr[2][4];
#pragma unroll
    for (int rb = 0; rb < 2; ++rb)
#pragma unroll
        for (int d0 = 0; d0 < 4; ++d0) qr[rb][d0] = *(const bf16x8*)(P + (size_t)(qrow0 + 32 * rb + r32) * INW + head * 64 + d0 * 16 + hi * 8);
    float m[2], l[2]; f32x16 o[2][2];
    { const float s0 = F.sink[layer * 8 + head] * LOG2E;
#pragma unroll
      for (int rb = 0; rb < 2; ++rb) { m[rb] = s0; l[rb] = hi == 0 ? 1.0f : 0.0f; o[rb][0] = f32x16{}; o[rb][1] = f32x16{}; } }
    auto tile_row = [&](int i) -> int { return i < nloc ? b * SEQ + qb * 128 - 128 + 64 * (tlo + i) : NL + b * CTXL + 64 * (i - nloc); };
    auto dma = [&](int i) { const int kr = tile_row(i); const unsigned slot = (unsigned)(i & 1) * SLOTB;
        glds16(P + (size_t)(kr + lane) * INW + C_K + kvh * 64 + wid * 8, (unsigned)__builtin_amdgcn_readfirstlane(lds0 + LDS_K + slot + wid * 1024));
        glds16(P + (size_t)(kr + 16 * (wid & 3) + (lane >> 2)) * INW + C_V + kvh * 64 + (wid >> 2) * 32 + (lane & 3) * 8, (unsigned)__builtin_amdgcn_readfirstlane(lds0 + LDS_V + slot + wid * 1024)); };
    dma(0);
    for (int i = 0; i < ntiles; ++i) {
        if (i + 1 < ntiles) { dma(i + 1); asm volatile("s_waitcnt vmcnt(2)\n\ts_barrier" ::: "memory"); }
        else asm volatile("s_waitcnt vmcnt(0)\n\ts_barrier" ::: "memory");
        const lds_cptr kp = shm + LDS_K + (i & 1) * SLOTB + hi * 1024 + r32 * 16;
        const lds_cptr vp = shm + LDS_V + (i & 1) * SLOTB + ((lane >> 4) & 1) * 32 + (lane & 3) * 8 + (4 * hi + ((lane & 15) >> 2)) * 64;
        const bool local = i < nloc; const int c = local ? 128 - 64 * (tlo + i) : 0;
#pragma unroll
        for (int rb = 0; rb < 2; ++rb) {
            const int q0 = qh * 64 + rb * 32;
            bool partial = false;
            if (local) { const int dlo = q0 - 63 + c, dhi = q0 + 31 + c; if (dlo > 128 || dhi < -128) continue; partial = !(dlo >= -128 && dhi <= 128); }
            f32x16 p0, p1; { const float nm = -m[rb];
#pragma unroll
                for (int r = 0; r < 16; ++r) { p0[r] = nm; p1[r] = nm; } }
#pragma unroll
            for (int d0 = 0; d0 < 4; ++d0) { const bf16x8 k0 = *(const __attribute__((address_space(3))) bf16x8*)(kp + d0 * 2048), k1 = *(const __attribute__((address_space(3))) bf16x8*)(kp + d0 * 2048 + 512);
                p0 = __builtin_amdgcn_mfma_f32_32x32x16_bf16(k0, qr[rb][d0], p0, 0, 0, 0); p1 = __builtin_amdgcn_mfma_f32_32x32x16_bf16(k1, qr[rb][d0], p1, 0, 0, 0); }
            if (partial) { const int qq = q0 + r32 + c;
#pragma unroll
                for (int r = 0; r < 16; ++r) { const int dl = qq - crow(r, hi); if (dl > 128 || dl < -128) p0[r] = NEGBIG; if (dl - 32 > 128 || dl - 32 < -128) p1[r] = NEGBIG; } }
            float rm = fmaxf(p0[0], p1[0]);
#pragma unroll
            for (int r = 1; r < 16; ++r) rm = fmaxf(rm, fmaxf(p0[r], p1[r]));
            { auto rr = __builtin_amdgcn_permlane32_swap(__float_as_uint(rm), __float_as_uint(rm), false, false); rm = fmaxf(__uint_as_float(rr[0]), __uint_as_float(rr[1])); }
            if (__any(rm > THR)) {
                const float dl = fmaxf(rm, 0.f); m[rb] += dl;
#pragma unroll
                for (int r = 0; r < 16; ++r) { p0[r] -= dl; p1[r] -= dl; }
                const float f = __builtin_amdgcn_exp2f(-dl); l[rb] *= f; if (hi == 0) wsf[r32] = f;
                asm volatile("s_waitcnt lgkmcnt(0)" ::: "memory");
#pragma unroll
                for (int r = 0; r < 16; ++r) { const float fr = wsf[crow(r, hi)]; o[rb][0][r] *= fr; o[rb][1][r] *= fr; }
            }
            float sacc = 0.f;
#pragma unroll
            for (int r = 0; r < 16; ++r) { p0[r] = __builtin_amdgcn_exp2f(p0[r]); p1[r] = __builtin_amdgcn_exp2f(p1[r]); sacc += p0[r] + p1[r]; }
            l[rb] += sacc;
            u32x4 pw[4];
#pragma unroll
            for (int k = 0; k < 4; ++k) { pw[0][k] = cvtpk(p0[2 * k], p0[2 * k + 1]); pw[1][k] = cvtpk(p0[8 + 2 * k], p0[9 + 2 * k]); pw[2][k] = cvtpk(p1[2 * k], p1[2 * k + 1]); pw[3][k] = cvtpk(p1[8 + 2 * k], p1[9 + 2 * k]); }
#pragma unroll
            for (int d0 = 0; d0 < 2; ++d0) {
#pragma unroll
                for (int ks = 0; ks < 4; ++ks) { const s16x4 lo = vtr(vp + d0 * 4096 + ks * 1024), hh = vtr(vp + d0 * 4096 + ks * 1024 + 512);
                    const bf16x8 vf = (bf16x8){lo[0], lo[1], lo[2], lo[3], hh[0], hh[1], hh[2], hh[3]};
                    o[rb][d0] = __builtin_amdgcn_mfma_f32_32x32x16_bf16(__builtin_bit_cast(bf16x8, pw[ks]), vf, o[rb][d0], 0, 0, 0); } }
        }
        asm volatile("s_waitcnt lgkmcnt(0)\n\ts_barrier" ::: "memory");
    }
    LAS bf16* stg = (LAS bf16*)(F.lds + LDS_OST) + wid * 2048;
#pragma unroll
    for (int rb = 0; rb < 2; ++rb) {
        float lt = l[rb]; { auto rr = __builtin_amdgcn_permlane32_swap(__float_as_uint(lt), __float_as_uint(lt), false, false); lt = __uint_as_float(rr[0]) + __uint_as_float(rr[1]); }
        if (hi == 0) wsf[r32] = 1.0f / lt;
        asm volatile("s_waitcnt lgkmcnt(0)" ::: "memory");
#pragma unroll
        for (int r = 0; r < 16; ++r) { const float rl = wsf[crow(r, hi)]; const int orow = crow(r, hi);
            stg[orow * 64 + r32] = (bf16)(pk2(o[rb][0][r] * rl, 0.f) & 0xffffu); stg[orow * 64 + 32 + r32] = (bf16)(pk2(o[rb][1][r] * rl, 0.f) & 0xffffu); }
        asm volatile("s_waitcnt lgkmcnt(0)" ::: "memory");
        bf16* Ow = WSP(bf16, WS_MIX) + (size_t)(qrow0 + 32 * rb) * D + head * 64;
#pragma unroll
        for (int k = 0; k < 4; ++k) { const int row = k * 8 + (lane >> 3), ch = lane & 7; const v4u v = *(const LAS v4u*)(stg + row * 64 + ch * 8); *(v4u*)(Ow + (size_t)row * D + ch * 8) = v; }
        asm volatile("s_waitcnt lgkmcnt(0)" ::: "memory");
    }
}
}
__device__ __forceinline__ void p_attn(Frame& F, int layer) {
    const int vcu = (blockIdx.x % 8) * (F.G / 8) + blockIdx.x / 8;
    for (int u = vcu * 2; u < 512; u += 2 * F.G) { att::attn_unit(F, layer, u >> 6, (u >> 1) & 31, u & 1, false); att::attn_unit(F, layer, (u + 1) >> 6, ((u + 1) >> 1) & 31, (u + 1) & 1, false); }
    if (layer == 0) for (int v = blockIdx.x; v < 32; v += F.G) att::attn_unit(F, layer, v >> 2, (v >> 1) & 1, v & 1, true);
}
namespace mixb {
using att::bf16x8; using att::s16x4; using att::f32x16; using att::u32x4; using att::lds_cptr; using att::vtr; using att::crow; using att::cvtpk;
__device__ __forceinline__ bf16x8 tr_pair(lds_cptr p, int second_off) { const s16x4 lo = vtr(p), hh = vtr(p + second_off); return (bf16x8){lo[0], lo[1], lo[2], lo[3], hh[0], hh[1], hh[2], hh[3]}; }
__device__ __forceinline__ void unpack8(const v4u w, float (&f)[8]) { f[0] = bflo(w.x); f[1] = bfhi(w.x); f[2] = bflo(w.y); f[3] = bfhi(w.y); f[4] = bflo(w.z); f[5] = bfhi(w.z); f[6] = bflo(w.w); f[7] = bfhi(w.w); }
__device__ __forceinline__ v4u pack8(const float (&f)[8]) { v4u w; w.x = pk2(f[0], f[1]); w.y = pk2(f[2], f[3]); w.z = pk2(f[4], f[5]); w.w = pk2(f[6], f[7]); return w; }
__device__ __forceinline__ float half_sum(float v) {
#pragma unroll
    for (int o = 1; o < 32; o <<= 1) v += __shfl_xor(v, o);
    return v;
}
__device__ __forceinline__ void kv_unit(Frame& F, int layer, int b, int cid, int hp) {
    const int tid = opq(F.tid), lane = tid & 63, r32 = lane & 31, hi = lane >> 5; const int wid = __builtin_amdgcn_readfirstlane(tid >> 6);
    const bf16* P = WSP(bf16, WS_PROJ); const int row0 = chunk_row0(b, cid);
    __syncthreads();
#pragma unroll
    for (int it = 0; it < 2; ++it) { const int idx = tid + it * NTHR, hs = idx >> 9, t = (idx >> 2) & 127, c = idx & 3, h = 2 * hp + hs;
        const v4u w = *(const v4u*)(P + (size_t)(row0 + t) * INW + C_RK + h * 32 + c * 8); float f[8], a[8], bb[8]; unpack8(w, f);
        const float wf = __expf(F.lgf[layer * 4 + h] * (float)(127 - t)), wb = __expf(F.lgb[layer * 4 + h] * (float)t);
#pragma unroll
        for (int j = 0; j < 8; ++j) { a[j] = f[j] * wf; bb[j] = f[j] * wb; }
        LAS unsigned char* d = F.lds + hs * 32768 + t * 64 + c * 16; *(LAS v4u*)d = pack8(a); *(LAS v4u*)(d + 8192) = pack8(bb); }
#pragma unroll
    for (int it = 0; it < 4; ++it) { const int idx = tid + it * NTHR, hs = idx >> 10, t = (idx >> 3) & 127, c = idx & 7, h = 2 * hp + hs;
        *(LAS v4u*)(F.lds + hs * 32768 + 16384 + (c >> 2) * 8192 + t * 64 + (c & 3) * 16) = *(const v4u*)(P + (size_t)(row0 + t) * INW + C_RV + h * 64 + c * 8); }
    __syncthreads();
    const int hs = wid >> 2, h = 2 * hp + hs, dir = (wid >> 1) & 1, eh = wid & 1;
    const int natoff = (8 * hi + ((lane & 15) >> 2)) * 64 + ((lane >> 4) & 1) * 32 + (lane & 3) * 8;
    const lds_cptr ab = (lds_cptr)F.lds + hs * 32768 + dir * 8192 + natoff, bb = (lds_cptr)F.lds + hs * 32768 + 16384 + eh * 8192 + natoff;
    f32x16 acc = f32x16{};
#pragma unroll
    for (int ks = 0; ks < 8; ++ks) acc = __builtin_amdgcn_mfma_f32_32x32x16_bf16(tr_pair(ab + ks * 1024, 256), tr_pair(bb + ks * 1024, 256), acc, 0, 0, 0);
    float* dst = WSP(float, WS_KVS) + ((size_t)((dir * 8 + b) * 4 + h) * NCHK + cid) * 2048 + 32 * eh + r32;
#pragma unroll
    for (int r = 0; r < 16; ++r) dst[crow(r, hi) * 64] = acc[r];
}
__device__ __forceinline__ void ret_unit(Frame& F, int layer, int b, int cid, int hp) {
    const int tid = opq(F.tid), lane = tid & 63, r32 = lane & 31, hi = lane >> 5; const int wid = __builtin_amdgcn_readfirstlane(tid >> 6);
    const bf16* P = WSP(bf16, WS_PROJ); const int row0 = chunk_row0(b, cid);
    constexpr int HB = 40960;
    __syncthreads();
#pragma unroll
    for (int it = 0; it < 2; ++it) { const int idx = tid + it * NTHR, hs = idx >> 9, t = (idx >> 2) & 127, c = idx & 3, h = 2 * hp + hs;
        const v4u w = *(const v4u*)(P + (size_t)(row0 + t) * INW + C_RK + h * 32 + c * 8); float f[8], a[8], bb[8]; unpack8(w, f);
        const float sf = __expf(-F.lgf[layer * 4 + h] * (float)t), sb = __expf(F.lgb[layer * 4 + h] * (float)t);
#pragma unroll
        for (int j = 0; j < 8; ++j) { a[j] = f[j] * sf; bb[j] = f[j] * sb; }
        LAS unsigned char* d = F.lds + hs * HB + c * 2048 + t * 16; *(LAS v4u*)d = pack8(a); *(LAS v4u*)(d + 8192) = pack8(bb); }
#pragma unroll
    for (int it = 0; it < 4; ++it) { const int idx = tid + it * NTHR, hs = idx >> 10, t = (idx >> 3) & 127, c = idx & 7, h = 2 * hp + hs;
        *(LAS v4u*)(F.lds + hs * HB + 16384 + (c >> 2) * 8192 + t * 64 + (c & 3) * 16) = *(const v4u*)(P + (size_t)(row0 + t) * INW + C_RV + h * 64 + c * 8); }
#pragma unroll
    for (int it = 0; it < 4; ++it) { const int idx = tid + it * NTHR, hs = idx >> 10, dir = (idx >> 9) & 1, d = (idx >> 4) & 31, e4 = idx & 15, h = 2 * hp + hs;
        const f32x4 v = *(const f32x4*)(WSP(float, WS_KVS) + ((size_t)((dir * 8 + b) * 4 + h) * NCHK + cid) * 2048 + d * 64 + e4 * 4);
        const float fac = dir ? __expf(F.lgb[layer * 4 + h] * 128.0f) : __expf(F.lgf[layer * 4 + h]);
        v2u w; w.x = pk2(v[0] * fac, v[1] * fac); w.y = pk2(v[2] * fac, v[3] * fac);
        *(LAS v2u*)(F.lds + hs * HB + 32768 + dir * 4096 + (e4 >> 3) * 2048 + d * 64 + (e4 & 7) * 8) = w; }
    __syncthreads();
    const int hs = wid >> 2, h = 2 * hp + hs, qb = wid & 3, n = 32 * qb + r32;
    const lds_cptr hb = (lds_cptr)F.lds + hs * HB;
    bf16x8 qf[2], qbk[2];
    { const float sf = __expf(F.lgf[layer * 4 + h] * (float)n), sb = __expf(-F.lgb[layer * 4 + h] * (float)n);
#pragma unroll
      for (int ks = 0; ks < 2; ++ks) { const v4u w = *(const v4u*)(P + (size_t)(row0 + n) * INW + C_RQ + h * 32 + 16 * ks + 8 * hi); float f[8], a[8], bb[8]; unpack8(w, f);
#pragma unroll
          for (int j = 0; j < 8; ++j) { a[j] = f[j] * sf; bb[j] = f[j] * sb; }
          qf[ks] = __builtin_bit_cast(bf16x8, pack8(a)); qbk[ks] = __builtin_bit_cast(bf16x8, pack8(bb)); } }
    const int qoff = ((lane & 15) >> 2) * 64 + ((lane >> 4) & 1) * 32 + (lane & 3) * 8;
    const int natoff = 8 * hi * 64 + qoff, permoff = 4 * hi * 64 + qoff;
    f32x16 o[2]; o[0] = f32x16{}; o[1] = f32x16{};
#pragma unroll
    for (int eh = 0; eh < 2; ++eh)
#pragma unroll
        for (int ks = 0; ks < 2; ++ks) {
            o[eh] = __builtin_amdgcn_mfma_f32_32x32x16_bf16(qf[ks], tr_pair(hb + 32768 + eh * 2048 + ks * 1024 + natoff, 256), o[eh], 0, 0, 0);
            o[eh] = __builtin_amdgcn_mfma_f32_32x32x16_bf16(qbk[ks], tr_pair(hb + 36864 + eh * 2048 + ks * 1024 + natoff, 256), o[eh], 0, 0, 0); }
#pragma unroll
    for (int kb = 0; kb < 4; ++kb) {
        f32x16 x = f32x16{};
        if (kb <= qb) { f32x16 xf = f32x16{};
#pragma unroll
            for (int ks = 0; ks < 2; ++ks) xf = __builtin_amdgcn_mfma_f32_32x32x16_bf16(*(const __attribute__((address_space(3))) bf16x8*)(hb + (2 * ks + hi) * 2048 + (32 * kb + r32) * 16), qf[ks], xf, 0, 0, 0);
            if (kb == qb) {
#pragma unroll
                for (int r = 0; r < 16; ++r) xf[r] = crow(r, hi) <= r32 ? xf[r] : 0.f; }
            x = xf; }
        if (kb >= qb) { f32x16 xb = f32x16{};
#pragma unroll
            for (int ks = 0; ks < 2; ++ks) xb = __builtin_amdgcn_mfma_f32_32x32x16_bf16(*(const __attribute__((address_space(3))) bf16x8*)(hb + 8192 + (2 * ks + hi) * 2048 + (32 * kb + r32) * 16), qbk[ks], xb, 0, 0, 0);
            if (kb == qb) {
#pragma unroll
                for (int r = 0; r < 16; ++r) xb[r] = crow(r, hi) >= r32 ? xb[r] : 0.f; }
            x = x + xb; }
        u32x4 pw[2];
#pragma unroll
        for (int k = 0; k < 4; ++k) { pw[0][k] = cvtpk(x[2 * k], x[2 * k + 1]); pw[1][k] = cvtpk(x[8 + 2 * k], x[9 + 2 * k]); }
#pragma unroll
        for (int eh = 0; eh < 2; ++eh)
#pragma unroll
            for (int k2 = 0; k2 < 2; ++k2) o[eh] = __builtin_amdgcn_mfma_f32_32x32x16_bf16(__builtin_bit_cast(bf16x8, pw[k2]), tr_pair(hb + 16384 + eh * 8192 + (32 * kb + 16 * k2) * 64 + permoff, 512), o[eh], 0, 0, 0);
    }
    LAS float* stg = (LAS float*)(F.lds + 2 * HB) + wid * 2048;
#pragma unroll
    for (int r = 0; r < 16; ++r) { const float mean = half_sum(o[0][r] + o[1][r]) * (1.0f / 64.0f); const float d0 = o[0][r] - mean, d1 = o[1][r] - mean;
        const float rstd = 1.0f / sqrtf(half_sum(d0 * d0 + d1 * d1) * (1.0f / 64.0f) + LN_EPS);
        stg[crow(r, hi) * 64 + r32] = d0 * rstd; stg[crow(r, hi) * 64 + 32 + r32] = d1 * rstd; }
    asm volatile("s_waitcnt lgkmcnt(0)" ::: "memory");
#pragma unroll
    for (int k = 0; k < 4; ++k) { const int row = k * 8 + (lane >> 3), ch = lane & 7; const size_t grow = (size_t)(row0 + 32 * qb + row);
        const f32x4 v0 = *(const LAS f32x4*)(stg + row * 64 + ch * 8), v1 = *(const LAS f32x4*)(stg + row * 64 + ch * 8 + 4);
        float rg[8], y[8]; unpack8(*(const v4u*)(P + grow * INW + C_RG + h * 64 + ch * 8), rg);
#pragma unroll
        for (int j = 0; j < 8; ++j) y[j] = rg[j] * __builtin_amdgcn_rcpf(1.0f + __builtin_amdgcn_exp2f(-LOG2E * rg[j])) * (j < 4 ? v0[j] : v1[j - 4]);
        *(v4u*)(WSP(bf16, WS_MIX) + grow * D + 768 + h * 64 + ch * 8) = pack8(y); }
}
__device__ __forceinline__ void pool_unit(Frame& F, int layer, int s, int blk) {
    const int tid = opq(F.tid), lane = tid & 63, r32 = lane & 31, hi = lane >> 5; const int wid = __builtin_amdgcn_readfirstlane(tid >> 6);
    const bool isctx = s >= 8; const int b = s & 7, len = isctx ? CTXL : SEQ, row0 = isctx ? NL + b * CTXL : b * SEQ, t0 = blk * 128;
    const bf16* P = WSP(bf16, WS_PROJ);
    constexpr int UST = 528, PWB = 144 * UST, PST = 144;
    __syncthreads();
#pragma unroll
    for (int it = 0; it < 9; ++it) { const int idx = tid + it * NTHR, rr = idx >> 5, c = idx & 31, t = t0 - 8 + rr; v4u w = (v4u){0u, 0u, 0u, 0u};
        if (t >= 0 && t < len) w = *(const v4u*)(P + (size_t)(row0 + t) * INW + C_U + c * 8);
        *(LAS v4u*)(F.lds + rr * UST + c * 16) = w; }
    for (int idx = tid; idx < 16384; idx += NTHR) { const int g = idx >> 12, c = (idx >> 6) & 63, d = idx & 63;
        *(LAS bf16*)(F.lds + PWB + (g * 64 + d) * PST + c * 2) = (bf16)(pk2(F.pool_w[(size_t)layer * 16384 + idx], 0.f) & 0xffffu); }
    __syncthreads();
    const int rbk = wid & 3, ch = wid >> 2, t = 32 * rbk + r32, tt = t0 + t;
    const lds_cptr ub = (lds_cptr)F.lds + (t + 8) * UST + hi * 16;
    bf16* dstrow = WSP(bf16, WS_MIX) + (size_t)(row0 + tt) * D + 512 + 32 * ch + 4 * hi;
#pragma unroll
    for (int g = 0; g < 4; ++g) { const int hw = 1 << g; const float inv = 1.0f / (float)(min(tt + hw, len) - max(tt - hw, 0));
        f32x16 acc = f32x16{};
#pragma unroll
        for (int ks = 0; ks < 4; ++ks) { const lds_cptr up = ub + g * 128 + ks * 32; float sum[8], own[8];
#pragma unroll
            for (int j = 0; j < 8; ++j) sum[j] = 0.f;
#pragma unroll
            for (int dt = -hw; dt < hw; ++dt) { float f[8]; unpack8(*(const __attribute__((address_space(3))) v4u*)(up + dt * UST), f);
#pragma unroll
                for (int j = 0; j < 8; ++j) sum[j] += f[j]; }
            unpack8(*(const __attribute__((address_space(3))) v4u*)up, own);
#pragma unroll
            for (int j = 0; j < 8; ++j) sum[j] = sum[j] * inv - own[j];
            const bf16x8 df = __builtin_bit_cast(bf16x8, pack8(sum));
            const bf16x8 wf = *(const __attribute__((address_space(3))) bf16x8*)((lds_cptr)F.lds + PWB + (g * 64 + 32 * ch + r32) * PST + (16 * ks + 8 * hi) * 2);
            acc = __builtin_amdgcn_mfma_f32_32x32x16_bf16(wf, df, acc, 0, 0, 0); }
        const float* ps = F.pool_scale + layer * 256 + g * 64 + 32 * ch + 4 * hi;
#pragma unroll
        for (int rq = 0; rq < 4; ++rq) { const f32x4 sc = *(const f32x4*)(ps + 8 * rq); v2u w; w.x = pk2(acc[4 * rq] * sc[0], acc[4 * rq + 1] * sc[1]); w.y = pk2(acc[4 * rq + 2] * sc[2], acc[4 * rq + 3] * sc[3]);
            *(v2u*)(dstrow + g * 64 + 8 * rq) = w; }
    }
}
}
__device__ __forceinline__ void p_mix(Frame& F, int layer) {
    p_attn(F, layer);
    const int n_pool = 256 + (layer == 0 ? 16 : 0);
    for (int u = blockIdx.x; u < n_pool; u += F.G) { if (u < 256) mixb::pool_unit(F, layer, u >> 5, u & 31); else mixb::pool_unit(F, layer, 8 + ((u - 256) >> 1), (u - 256) & 1); }
    for (int u = blockIdx.x; u < 8 * NCHK * 2; u += F.G) mixb::kv_unit(F, layer, u / (NCHK * 2), (u >> 1) % NCHK, u & 1);
    __syncthreads();
}
__device__ __forceinline__ void p_ret(Frame& F, int layer) {
    for (int u = blockIdx.x; u < 8 * NCHK * 2; u += F.G) { const int cid = (u >> 1) % NCHK; if (layer == 1 && cid < 2) continue; mixb::ret_unit(F, layer, u / (NCHK * 2), cid, u & 1); }
    __syncthreads();
}
#if defined(MIX_CHECK)
__device__ __forceinline__ void chk(Frame& F, float a, float ref, float abs_t, float rel_t, int word) { const float d = fabsf(a - ref); if (!(d <= abs_t + rel_t * fabsf(ref))) atomicOr(WSP(unsigned, WS_CTL) + word, 1u); }
#endif
__device__ __forceinline__ void attn_naive_unit(Frame& F, int layer, int b, int qb, int kvh, bool isctx) {
    const int tid = opq(F.tid), qq = tid & 127, g = tid >> 7, head = kvh * 4 + g;
    const bf16* P = WSP(bf16, WS_PROJ);
    const int qrow = isctx ? NL + b * CTXL + qb * 128 + qq : b * SEQ + qb * 128 + qq;
    LAS unsigned* kt = (LAS unsigned*)F.lds;
    LAS unsigned* vt = kt + 64 * 32;
    unsigned q[32];
#pragma unroll
    for (int i = 0; i < 8; ++i) { const v4u w = *(const v4u*)(P + (size_t)qrow * INW + head * 64 + i * 8); q[4 * i] = w.x; q[4 * i + 1] = w.y; q[4 * i + 2] = w.z; q[4 * i + 3] = w.w; }
    float m = F.sink[layer * 8 + head] * LOG2E, l = 1.0f, o[64];
#pragma unroll
    for (int d = 0; d < 64; ++d) o[d] = 0.f;
    const int qpos = qb * 128 + qq;
    for (int tile = isctx ? 6 : 0; tile < 10; ++tile) {
        int krow0, kpos0 = 0; const bool local = tile < 6;
        if (local) { kpos0 = qb * 128 - 128 + 64 * tile; if (kpos0 < 0 || kpos0 >= SEQ) continue; krow0 = b * SEQ + kpos0; }
        else krow0 = NL + b * CTXL + 64 * (tile - 6);
        __syncthreads();
        { const int r = tid >> 3, ch = tid & 7; const bf16* src = P + (size_t)(krow0 + r) * INW + kvh * 64 + ch * 8;
          *(LAS v4u*)(kt + r * 32 + ch * 4) = *(const v4u*)(src + C_K); *(LAS v4u*)(vt + r * 32 + ch * 4) = *(const v4u*)(src + C_V); }
        __syncthreads();
        for (int j = 0; j < 64; ++j) {
            float s = 0.f;
#pragma unroll
            for (int i = 0; i < 32; ++i) s = dot2bf(q[i], kt[j * 32 + i], s);
            const int dlt = qpos - (kpos0 + j); const bool valid = !local || (dlt <= 128 && dlt >= -128);
            if (valid) {
                if (s > m) { const float f = __builtin_amdgcn_exp2f(m - s); l *= f;
#pragma unroll
                    for (int d = 0; d < 64; ++d) o[d] *= f;
                    m = s; }
                const float p = __builtin_amdgcn_exp2f(s - m); l += p;
#pragma unroll
                for (int i = 0; i < 32; ++i) { const unsigned w = vt[j * 32 + i]; o[2 * i] += p * bflo(w); o[2 * i + 1] += p * bfhi(w); }
            }
        }
    }
    const float rl = 1.0f / l;
    bf16* dst = WSP(bf16, WS_MIX) + (size_t)qrow * D + head * 64;
#if defined(ATTN_CHECK)
    { bool bad = false;
#pragma unroll
      for (int i = 0; i < 8; ++i) { const v4u w = *(const v4u*)(dst + 8 * i); const float r8[8] = {bflo(w.x), bfhi(w.x), bflo(w.y), bfhi(w.y), bflo(w.z), bfhi(w.z), bflo(w.w), bfhi(w.w)};
#pragma unroll
          for (int k = 0; k < 8; ++k) { const float a = o[8 * i + k] * rl, d = fabsf(a - r8[k]); if (!(d <= ATTN_CHECK_ABS + ATTN_CHECK_REL * fabsf(a))) bad = true; } }
      if (bad) atomicOr(WSP(unsigned, WS_CTL) + 8, 1u); }
#endif
#pragma unroll
    for (int i = 0; i < 8; ++i) { v4u w; w.x = pk2(o[8 * i] * rl, o[8 * i + 1] * rl); w.y = pk2(o[8 * i + 2] * rl, o[8 * i + 3] * rl); w.z = pk2(o[8 * i + 4] * rl, o[8 * i + 5] * rl); w.w = pk2(o[8 * i + 6] * rl, o[8 * i + 7] * rl); *(v4u*)(dst + 8 * i) = w; }
    __syncthreads();
}
__device__ __forceinline__ void pool_naive_unit(Frame& F, int layer, int s, int blk) {
    const int tid = opq(F.tid); const bool isctx = s >= 8; const int b = s & 7, len = isctx ? CTXL : SEQ, row0 = isctx ? NL + b * CTXL : b * SEQ, t0 = blk * 128;
    const bf16* P = WSP(bf16, WS_PROJ);
    LAS float* ub = (LAS float*)F.lds;
    LAS float* pwb = ub + 144 * 64;
    LAS float* db = pwb + 64 * 64;
    for (int g = 0; g < 4; ++g) { const int hw = 1 << g;
        __syncthreads();
        for (int idx = tid; idx < 144 * 8; idx += NTHR) { const int rr = idx >> 3, ch = idx & 7, t = t0 - 8 + rr; v4u w = (v4u){0u, 0u, 0u, 0u};
            if (t >= 0 && t < len) w = *(const v4u*)(P + (size_t)(row0 + t) * INW + C_U + g * 64 + ch * 8);
            LAS float* d = ub + rr * 64 + ch * 8; d[0] = bflo(w.x); d[1] = bfhi(w.x); d[2] = bflo(w.y); d[3] = bfhi(w.y); d[4] = bflo(w.z); d[5] = bfhi(w.z); d[6] = bflo(w.w); d[7] = bfhi(w.w); }
        for (int idx = tid; idx < 4096; idx += NTHR) pwb[idx] = F.pool_w[(size_t)(layer * 4 + g) * 4096 + idx];
        __syncthreads();
        for (int idx = tid; idx < 8192; idx += NTHR) { const int t = idx >> 6, c = idx & 63, tt = t0 + t; const int lo = max(tt - hw, 0), hi = min(tt + hw, len); float sum = 0.f;
            for (int p = lo; p < hi; ++p) sum += ub[(p - t0 + 8) * 64 + c];
            db[t * 65 + c] = sum / (float)(hi - lo) - ub[(t + 8) * 64 + c]; }
        __syncthreads();
        const int t = tid & 127, dq = tid >> 7; float acc[16];
#pragma unroll
        for (int i = 0; i < 16; ++i) acc[i] = 0.f;
        for (int c = 0; c < 64; ++c) { const float xv = db[t * 65 + c];
#pragma unroll
            for (int i = 0; i < 16; ++i) acc[i] += xv * pwb[c * 64 + dq * 16 + i]; }
        const float* ps = F.pool_scale + layer * 256 + g * 64 + dq * 16;
        bf16* dst = WSP(bf16, WS_MIX) + (size_t)(row0 + t0 + t) * D + 512 + g * 64 + dq * 16;
#if defined(MIX_CHECK)
#pragma unroll
        for (int i = 0; i < 2; ++i) { const v4u w = *(const v4u*)(dst + 8 * i); const float r8[8] = {bflo(w.x), bfhi(w.x), bflo(w.y), bfhi(w.y), bflo(w.z), bfhi(w.z), bflo(w.w), bfhi(w.w)};
#pragma unroll
            for (int k = 0; k < 8; ++k) chk(F, r8[k], acc[8 * i + k] * ps[8 * i + k], 0.02f, 0.03f, 9); }
#endif
#pragma unroll
        for (int i = 0; i < 2; ++i) { v4u w; w.x = pk2(acc[8 * i] * ps[8 * i], acc[8 * i + 1] * ps[8 * i + 1]); w.y = pk2(acc[8 * i + 2] * ps[8 * i + 2], acc[8 * i + 3] * ps[8 * i + 3]);
            w.z = pk2(acc[8 * i + 4] * ps[8 * i + 4], acc[8 * i + 5] * ps[8 * i + 5]); w.w = pk2(acc[8 * i + 6] * ps[8 * i + 6], acc[8 * i + 7] * ps[8 * i + 7]); *(v4u*)(dst + 8 * i) = w; }
    }
    __syncthreads();
}
__device__ __forceinline__ void kv_naive_unit(Frame& F, int layer, int b, int h, int cid) {
    const int tid = opq(F.tid); const bf16* P = WSP(bf16, WS_PROJ); const int row0 = chunk_row0(b, cid);
    LAS float* kf = (LAS float*)F.lds;
    LAS float* vf = kf + 128 * 32;
    LAS float* wf = vf + 128 * 64;
    const float lgf = F.lgf[layer * 4 + h], lgb = F.lgb[layer * 4 + h];
    __syncthreads();
    { const int r = tid >> 2, ch = tid & 3; const v4u w = *(const v4u*)(P + (size_t)(row0 + r) * INW + C_RK + h * 32 + ch * 8); LAS float* d = kf + r * 32 + ch * 8;
      d[0] = bflo(w.x); d[1] = bfhi(w.x); d[2] = bflo(w.y); d[3] = bfhi(w.y); d[4] = bflo(w.z); d[5] = bfhi(w.z); d[6] = bflo(w.w); d[7] = bfhi(w.w); }
    for (int idx = tid; idx < 1024; idx += NTHR) { const int r = idx >> 3, ch = idx & 7; const v4u w = *(const v4u*)(P + (size_t)(row0 + r) * INW + C_RV + h * 64 + ch * 8); LAS float* d = vf + r * 64 + ch * 8;
      d[0] = bflo(w.x); d[1] = bfhi(w.x); d[2] = bflo(w.y); d[3] = bfhi(w.y); d[4] = bflo(w.z); d[5] = bfhi(w.z); d[6] = bflo(w.w); d[7] = bfhi(w.w); }
    if (tid < 128) { wf[tid] = __expf(lgf * (float)(127 - tid)); wf[128 + tid] = __expf(lgb * (float)tid); }
    __syncthreads();
    const int i = tid >> 4, e0 = (tid & 15) * 4; f32x4 af = (f32x4){0.f, 0.f, 0.f, 0.f}, ab = af;
    for (int m = 0; m < 128; ++m) { const float kk = kf[m * 32 + i]; const f32x4 vv = *(const LAS f32x4*)(vf + m * 64 + e0); af += (kk * wf[m]) * vv; ab += (kk * wf[128 + m]) * vv; }
    float* dst = WSP(float, WS_KVS) + ((size_t)(b * 4 + h) * NCHK + cid) * 2048 + i * 64 + e0;
#if defined(MIX_CHECK)
    { const f32x4 cf = *(const f32x4*)dst, cb = *(const f32x4*)(dst + (size_t)32 * NCHK * 2048);
#pragma unroll
      for (int k = 0; k < 4; ++k) { chk(F, cf[k], af[k], 0.05f, 0.03f, 10); chk(F, cb[k], ab[k], 0.05f, 0.03f, 10); } }
#endif
    *(f32x4*)dst = af; *(f32x4*)(dst + (size_t)32 * NCHK * 2048) = ab;
    __syncthreads();
}
__device__ __forceinline__ void p_scan(Frame& F, int layer) {
    for (int gid = blockIdx.x * NTHR + opq(F.tid); gid < 2 * 32 * 2048; gid += F.G * NTHR) {
        const int dir = gid >> 16, bh = (gid >> 11) & 31, e = gid & 2047; const float lg = (dir ? F.lgb : F.lgf)[layer * 4 + (bh & 3)]; const float G = __expf(lg * 128.0f);
        float* base = WSP(float, WS_KVS) + ((size_t)(dir * 32 + bh) * NCHK) * 2048 + e;
        float kv[NCHK];
#pragma unroll
        for (int c = 0; c < NCHK; ++c) kv[c] = base[(size_t)c * 2048];
        float S = 0.f;
        if (dir == 0) {
#pragma unroll
            for (int c = 0; c < NCHK; ++c) { base[(size_t)c * 2048] = S; S = G * S + kv[c]; }
        } else {
            base[2048] = S; S = G * S + kv[1]; base[0] = S; S = G * S + kv[0];
#pragma unroll
            for (int c = NCHK - 1; c >= 2; --c) { base[(size_t)c * 2048] = S; S = G * S + kv[c]; }
        }
    }
}
__device__ __forceinline__ void ret_naive_unit(Frame& F, int layer, int b, int h, int cid) {
    const int tid = opq(F.tid); const bf16* P = WSP(bf16, WS_PROJ); const int row0 = chunk_row0(b, cid);
    LAS float* kf = (LAS float*)F.lds;
    LAS float* qf = kf + 128 * 33;
    LAS float* vf = qf + 128 * 33;
    LAS float* Am = vf + 128 * 64;
    LAS float* Sf = Am + 128 * 129;
    LAS float* red = Sf + 2 * 2048;
    const float lgf = F.lgf[layer * 4 + h], lgb = F.lgb[layer * 4 + h];
    __syncthreads();
    { const int r = tid >> 2, ch = tid & 3; const v4u w = *(const v4u*)(P + (size_t)(row0 + r) * INW + C_RK + h * 32 + ch * 8); LAS float* d = kf + r * 33 + ch * 8;
      d[0] = bflo(w.x); d[1] = bfhi(w.x); d[2] = bflo(w.y); d[3] = bfhi(w.y); d[4] = bflo(w.z); d[5] = bfhi(w.z); d[6] = bflo(w.w); d[7] = bfhi(w.w); }
    { const int r = tid >> 2, ch = tid & 3; const v4u w = *(const v4u*)(P + (size_t)(row0 + r) * INW + C_RQ + h * 32 + ch * 8); LAS float* d = qf + r * 33 + ch * 8;
      d[0] = bflo(w.x); d[1] = bfhi(w.x); d[2] = bflo(w.y); d[3] = bfhi(w.y); d[4] = bflo(w.z); d[5] = bfhi(w.z); d[6] = bflo(w.w); d[7] = bfhi(w.w); }
    for (int idx = tid; idx < 1024; idx += NTHR) { const int r = idx >> 3, ch = idx & 7; const v4u w = *(const v4u*)(P + (size_t)(row0 + r) * INW + C_RV + h * 64 + ch * 8); LAS float* d = vf + r * 64 + ch * 8;
      d[0] = bflo(w.x); d[1] = bfhi(w.x); d[2] = bflo(w.y); d[3] = bfhi(w.y); d[4] = bflo(w.z); d[5] = bfhi(w.z); d[6] = bflo(w.w); d[7] = bfhi(w.w); }
    { const float* sp = WSP(float, WS_KVS) + ((size_t)(b * 4 + h) * NCHK + cid) * 2048;
      for (int idx = tid; idx < 2048; idx += NTHR) { Sf[idx] = sp[idx]; Sf[2048 + idx] = sp[(size_t)32 * NCHK * 2048 + idx]; } }
    const int n = tid & 127, qt = tid >> 7;
    __syncthreads();
#pragma unroll 1
    for (int mm = 0; mm < 32; ++mm) { const int m = qt * 32 + mm; float s = 0.f;
#pragma unroll 8
        for (int d = 0; d < 32; ++d) s += qf[n * 33 + d] * kf[m * 33 + d];
        const float w = m < n ? __expf(lgf * (float)(n - m)) : (m > n ? __expf(lgb * (float)(m - n)) : 2.0f);
        Am[n * 129 + m] = s * w; }
    __syncthreads();
    float o[16];
#pragma unroll
    for (int i = 0; i < 16; ++i) o[i] = 0.f;
#pragma unroll 2
    for (int m = 0; m < 128; ++m) { const float a = Am[n * 129 + m];
#pragma unroll
        for (int i = 0; i < 4; ++i) { const f32x4 vv = *(const LAS f32x4*)(vf + m * 64 + qt * 16 + 4 * i); o[4 * i] += a * vv[0]; o[4 * i + 1] += a * vv[1]; o[4 * i + 2] += a * vv[2]; o[4 * i + 3] += a * vv[3]; } }
    const float cf = __expf(lgf * (float)(n + 1)), cb = __expf(lgb * (float)(128 - n));
#pragma unroll 2
    for (int d = 0; d < 32; ++d) { const float qv = qf[n * 33 + d]; const float q1 = qv * cf, q2 = qv * cb;
#pragma unroll
        for (int i = 0; i < 4; ++i) { const f32x4 sf = *(const LAS f32x4*)(Sf + d * 64 + qt * 16 + 4 * i), sb = *(const LAS f32x4*)(Sf + 2048 + d * 64 + qt * 16 + 4 * i);
            o[4 * i] += q1 * sf[0] + q2 * sb[0]; o[4 * i + 1] += q1 * sf[1] + q2 * sb[1]; o[4 * i + 2] += q1 * sf[2] + q2 * sb[2]; o[4 * i + 3] += q1 * sf[3] + q2 * sb[3]; } }
    float s = 0.f;
#pragma unroll
    for (int i = 0; i < 16; ++i) s += o[i];
    red[n * 4 + qt] = s;
    __syncthreads();
    const float mean = (red[n * 4] + red[n * 4 + 1] + red[n * 4 + 2] + red[n * 4 + 3]) * (1.0f / 64.0f);
    __syncthreads();
    float qd = 0.f;
#pragma unroll
    for (int i = 0; i < 16; ++i) { o[i] -= mean; qd += o[i] * o[i]; }
    red[n * 4 + qt] = qd;
    __syncthreads();
    const float rstd = 1.0f / sqrtf((red[n * 4] + red[n * 4 + 1] + red[n * 4 + 2] + red[n * 4 + 3]) * (1.0f / 64.0f) + LN_EPS);
    const bf16* rgp = P + (size_t)(row0 + n) * INW + C_RG + h * 64 + qt * 16; bf16* dst = WSP(bf16, WS_MIX) + (size_t)(row0 + n) * D + 768 + h * 64 + qt * 16;
#pragma unroll
    for (int i = 0; i < 2; ++i) { const v4u w = *(const v4u*)(rgp + 8 * i); const float r8[8] = {bflo(w.x), bfhi(w.x), bflo(w.y), bfhi(w.y), bflo(w.z), bfhi(w.z), bflo(w.w), bfhi(w.w)}; float y8[8];
#pragma unroll
        for (int k = 0; k < 8; ++k) y8[k] = r8[k] / (1.0f + __expf(-r8[k])) * (o[8 * i + k] * rstd);
#if defined(MIX_CHECK)
        { const v4u cw = *(const v4u*)(dst + 8 * i); const float c8[8] = {bflo(cw.x), bfhi(cw.x), bflo(cw.y), bfhi(cw.y), bflo(cw.z), bfhi(cw.z), bflo(cw.w), bfhi(cw.w)};
#pragma unroll
          for (int k = 0; k < 8; ++k) chk(F, c8[k], y8[k], 0.03f, 0.04f, 11); }
#endif
        v4u ow; ow.x = pk2(y8[0], y8[1]); ow.y = pk2(y8[2], y8[3]); ow.z = pk2(y8[4], y8[5]); ow.w = pk2(y8[6], y8[7]); *(v4u*)(dst + 8 * i) = ow; }
    __syncthreads();
}
__device__ __forceinline__ void p_mix_naive(Frame& F, int layer, const XcdBarrier& bar) {
#if defined(MIX_CHECK)
    p_mix(F, layer); xcd_barrier(bar);
#endif
#if defined(ATTN_CHECK)
    p_attn(F, layer); xcd_barrier(bar);
#endif
#if defined(ATTN_NAIVE) || defined(ATTN_CHECK)
    const int n_att = 512 + (layer == 0 ? 32 : 0);
    for (int u = blockIdx.x; u < n_att; u += F.G) {
        if (u < 512) attn_naive_unit(F, layer, u >> 6, (u >> 1) & 31, u & 1, false);
        else { const int v = u - 512; attn_naive_unit(F, layer, v >> 2, (v >> 1) & 1, v & 1, true); }
    }
#elif !defined(MIX_CHECK)
    p_attn(F, layer);
#endif
    const int n_pool = 256 + (layer == 0 ? 16 : 0);
    for (int u = blockIdx.x; u < n_pool; u += F.G) { if (u < 256) pool_naive_unit(F, layer, u >> 5, u & 31); else pool_naive_unit(F, layer, 8 + ((u - 256) >> 1), (u - 256) & 1); }
    for (int u = blockIdx.x; u < 32 * NCHK; u += F.G) kv_naive_unit(F, layer, u / (4 * NCHK), (u / NCHK) & 3, u % NCHK);
}
__device__ __forceinline__ void p_ret_naive(Frame& F, int layer, const XcdBarrier& bar) {
#if defined(MIX_CHECK)
    p_ret(F, layer); xcd_barrier(bar);
#endif
    for (int u = blockIdx.x; u < 32 * NCHK; u += F.G) { const int cid = u % NCHK; if (layer == 1 && cid < 2) continue; ret_naive_unit(F, layer, u / (4 * NCHK), (u / NCHK) & 3, cid); }
}
#ifndef MK_N_LAUNCHES
#define MK_N_LAUNCHES 1
#endif
constexpr int NPHASE = 28;
struct Args { const float* in[24]; float* out; unsigned char* ws; int ph_lo, ph_hi; };

__device__ __forceinline__ void moe_tiles(Frame& F, int (&pre)[NE + 1], int (&cnt)[NE]) {
    int acc = 0;
#pragma unroll
    for (int e = 0; e < NE; ++e) { const int c = __builtin_amdgcn_readfirstlane((int)__hip_atomic_load(WSP(unsigned, WS_CTL) + CW_GCNT + 64 * e, RLX_AGENT)); cnt[e] = c; pre[e] = acc; acc += (c + 255) >> 8; }
    pre[NE] = acc;
}

#define IN(k) (lo <= (k) && (k) < hi)
#define SEAM(k) do { if (IN(k) && IN((k) + 1)) xcd_barrier(bar); } while (0)
template <int layer> __device__ __forceinline__ void layer_front(Frame& F, const XcdBarrier& bar, const int lo, const int hi) {
        const int pb = 2 + 9 * layer;
        if (IN(pb)) {
            pg8::StaticOrder S; S.init(WSP(bf16, WS_ACT), WSP(bf16, WS_WIN) + (size_t)layer * INW * D, MT, INW, D, F.G, (int)blockIdx.x);
            pg8::EpiInProj E{WSP(bf16, WS_PROJ), WSP(float, WS_ROPE), WSP(float, WS_ROPE) + 1024};
            pg8::gemm_phase(F.lds, D, S, E);
        } SEAM(pb);
#if defined(MIX_NAIVE) || defined(MIX_CHECK) || defined(ATTN_CHECK) || defined(ATTN_NAIVE)
        if (IN(pb + 1)) { p_mix_naive(F, layer, bar); } SEAM(pb + 1);
#else
        if (IN(pb + 1)) { p_mix(F, layer); } SEAM(pb + 1);
#endif
        if (IN(pb + 2)) { p_scan(F, layer); } SEAM(pb + 2);
#if defined(MIX_NAIVE) || defined(MIX_CHECK) || defined(ATTN_CHECK) || defined(ATTN_NAIVE)
        if (IN(pb + 3)) { p_ret_naive(F, layer, bar); } SEAM(pb + 3);
#else
        if (IN(pb + 3)) { p_ret(F, layer); } SEAM(pb + 3);
#endif
        if (IN(pb + 4)) {
            pg8::StaticOrder S; S.init(WSP(bf16, WS_MIX), WSP(bf16, WS_WOUT) + (size_t)layer * D * D, layer == 0 ? MT : NL, D, D, F.G, (int)blockIdx.x);
            pg8::EpiBf16 E{WSP(bf16, WS_ACT), D};
            pg8::gemm_phase(F.lds, D, S, E);
        } SEAM(pb + 4);
        if (IN(pb + 5)) { p_ln1(F, layer); } SEAM(pb + 5);
        if constexpr (layer == 0) {
        if (IN(8)) {
            pg8::StaticOrder S; S.init(WSP(bf16, WS_ACT), WSP(bf16, WS_FGU), MT, 2 * FF, D, F.G, (int)blockIdx.x);
            pg8::EpiSwiGLU E{WSP(bf16, WS_HID), FF};
            pg8::gemm_phase(F.lds, D, S, E);
        } SEAM(8);
        if (IN(9)) {
            pg8::StaticOrder S; S.init(WSP(bf16, WS_HID), WSP(bf16, WS_FD), MT, D, FF, F.G, (int)blockIdx.x);
            pg8::EpiBf16 E{WSP(bf16, WS_ACT), D};
            pg8::gemm_phase(F.lds, FF, S, E);
        } SEAM(9);
        if (IN(10)) { p_ln2_l0(F); } SEAM(10);
        }
}

__global__ void __launch_bounds__(NTHR, 2) hybrid_fwd(Args args) {
    extern __shared__ __attribute__((aligned(16))) unsigned char lds_raw[];
    Frame F;
    F.lds = (LAS unsigned char*)lds_raw;
    F.tid = threadIdx.x; F.lane = F.tid & 63; F.wave = __builtin_amdgcn_readfirstlane(F.tid >> 6);
    F.G = gridDim.x; { const int bx = blockIdx.x; F.vcu = (F.G % 8 == 0) ? (bx % 8) * (F.G / 8) + bx / 8 : bx; }
    F.ws = args.ws; F.out = args.out;
    F.x = args.in[0]; F.c = args.in[1]; F.ctx = args.in[2]; F.c_ctx = args.in[3]; F.w_mod = args.in[4]; F.b_mod = args.in[5]; F.w_in = args.in[6]; F.sink = args.in[7];
    F.pool_w = args.in[8]; F.pool_scale = args.in[9]; F.lgf = args.in[10]; F.lgb = args.in[11]; F.w_out = args.in[12]; F.ln1_g = args.in[13]; F.ln1_b = args.in[14]; F.ln2_g = args.in[15]; F.ln2_b = args.in[16];
    F.fw_gate = args.in[17]; F.fw_up = args.in[18]; F.fw_down = args.in[19]; F.router = args.in[20]; F.mw_gate = args.in[21]; F.mw_up = args.in[22]; F.mw_down = args.in[23];
    volatile LAS unsigned* MISC = (volatile LAS unsigned*)(F.lds + MISC_OFF);
    if (F.tid < 64) MISC[F.tid] = 0u;
    __syncthreads();
    const int lo = args.ph_lo, hi = args.ph_hi;
    XcdBarrier bar; bar.bar = WSP(unsigned, WS_CTL) + CW_BAR; bar.x = 0; bar.st = nullptr;
    if (hi - lo > 1) bar = xcd_barrier_post(WSP(unsigned, WS_CTL) + CW_BAR, MISC + 8);

    if (IN(0)) { p_prep(F); } SEAM(0);
    if (IN(1)) { p_h0(F); } SEAM(1);
    layer_front<0>(F, bar, lo, hi);
    layer_front<1>(F, bar, lo, hi);
    for (int s = 0; s < 5; ++s) {
        if (IN(17 + 2 * s)) {
            pg8::MoeOrder<true> S; moe_tiles(F, S.pre, S.cnt);
            S.T0 = 64 * s; S.nrt = min(S.pre[NE] - S.T0, 64); S.nN = 2 * FF / 256; S.G = F.G; S.c = (int)blockIdx.x; S.K = D;
            S.A = (const char*)WSP(bf16, WS_ACT); S.Bt = (const char*)WSP(bf16, WS_MGU); S.bstride = (size_t)2 * FF * D * 2; S.list = WSP(int, WS_LIST);
            pg8::EpiSwiGLU E{WSP(bf16, WS_HIDS), FF};
            pg8::gemm_phase(F.lds, D, S, E);
        } SEAM(17 + 2 * s);
        if (IN(18 + 2 * s)) {
            pg8::MoeOrder<false> S; moe_tiles(F, S.pre, S.cnt);
            S.T0 = 64 * s; S.nrt = min(S.pre[NE] - S.T0, 64); S.nN = D / 256; S.G = F.G; S.c = (int)blockIdx.x; S.K = FF;
            S.A = (const char*)WSP(bf16, WS_HIDS); S.Bt = (const char*)WSP(bf16, WS_MD); S.bstride = (size_t)FF * D * 2; S.list = WSP(int, WS_LIST);
            pg8::EpiMoeDown E{WSP(bf16, WS_Y), WSP(int, WS_LIST), WSP(float, WS_LGATE)};
            pg8::gemm_phase(F.lds, FF, S, E);
        } SEAM(18 + 2 * s);
    }
    if (IN(27)) { p_final(F); }
#undef IN
#undef SEAM
}

extern "C" void kernel_launch(void* const* d_in, const int* in_sizes, int n_in, void* d_out, int out_size, void* d_ws, size_t ws_size, hipStream_t stream) {
    static int grid = 0;
    if (grid == 0) {
        if (n_in != 24 || out_size != NL * D || ws_size < WS_END) { fprintf(stderr, "kernel_launch: unexpected shapes (n_in %d, out %d, ws %zu < %zu); nothing launched\n", n_in, out_size, ws_size, (size_t)WS_END); grid = -1; return; }
        int dev = 0, cus = 0, per_cu = 0;
        if (hipGetDevice(&dev) != hipSuccess || hipDeviceGetAttribute(&cus, hipDeviceAttributeMultiprocessorCount, dev) != hipSuccess) { grid = -1; return; }
        if (hipFuncSetAttribute((const void*)hybrid_fwd, hipFuncAttributeMaxDynamicSharedMemorySize, LDS_BYTES) != hipSuccess) { fprintf(stderr, "kernel_launch: hipFuncSetAttribute failed\n"); grid = -1; return; }
        if (hipOccupancyMaxActiveBlocksPerMultiprocessor(&per_cu, (const void*)hybrid_fwd, NTHR, LDS_BYTES) != hipSuccess || per_cu < 1) { fprintf(stderr, "kernel_launch: occupancy query says %d\n", per_cu); }
        (void)hipGetLastError();
        grid = cus;
    }
    if (grid < 0) return;
    if (hipMemsetAsync((char*)d_ws + WS_CTL, 0, CTL_ZERO_BYTES, stream) != hipSuccess) return;
    Args a{};
    for (int i = 0; i < 24; ++i) a.in[i] = (const float*)d_in[i];
    a.out = (float*)d_out; a.ws = (unsigned char*)d_ws;
#if MK_N_LAUNCHES == 1
    a.ph_lo = 0; a.ph_hi = NPHASE;
    hipLaunchKernelGGL(hybrid_fwd, dim3(grid), dim3(NTHR), LDS_BYTES, stream, a);
#else
    for (int p = 0; p < NPHASE; ++p) { a.ph_lo = p; a.ph_hi = p + 1; hipLaunchKernelGGL(hybrid_fwd, dim3(grid), dim3(NTHR), LDS_BYTES, stream, a); }
#endif
}
```

```cpp
#include <hip/hip_runtime.h>
#include <cstdio>
#include <cstdint>
#define MK_N_LAUNCHES 1
__device__ __forceinline__ int opq(int v) { asm volatile("" : "+v"(v)); return v; }
namespace pg8 {
#define PG8_LAS __attribute__((address_space(3)))
typedef unsigned short bf16_t;
typedef short bf16x8 __attribute__((ext_vector_type(8)));
typedef float f32x4 __attribute__((ext_vector_type(4)));
typedef float f32x2 __attribute__((ext_vector_type(2)));
typedef unsigned u32x4 __attribute__((ext_vector_type(4)));
constexpr int BM = 256, BK = 64, HALF = 128, HTB = HALF * BK * 2  , STAGE_BYTES = 8 * HTB, NXCD = 8, WGM = 8;

__host__ __device__ __forceinline__ int lds_byte(int r, int c) { const int st = (r >> 4) * 2 + (c >> 5), rr = r & 15, cc = c & 31, ob = rr * 64 + cc * 2; return st * 1024 + (ob ^ (((ob >> 9) & 1) << 5)); }
__host__ __device__ __forceinline__ void stage_rc(int b, int& R, int& C) { const int st = b / 1024, sb = b % 1024, swz = sb ^ (((sb >> 9) & 1) << 5); R = (st >> 1) * 16 + swz / 64; C = (st & 1) * 32 + (swz % 64) / 2; }
__host__ __device__ __forceinline__ int perm32(int rho) { const int n = rho >> 4, i = rho & 15; return 8 * (i >> 2) + 4 * n + (i & 3); }

struct Unit { int pm, pn, e, rt, cnt; const char* ab; const char* bb; };

__device__ __forceinline__ bool tile_order(int i, int G, int c, int nM, int nN, int& pm, int& pn) {
    const int nwg = nM * nN; const long L = (long)i * G + c; if (L >= nwg) return false;
    int wgid = (int)L; { const int q = nwg / NXCD, r = nwg % NXCD, xcd = wgid % NXCD, off = wgid / NXCD; wgid = (xcd < r ? xcd * (q + 1) : r * (q + 1) + (xcd - r) * q) + off; }
    const int nig = WGM * nN, gid = wgid / nig, fm = gid * WGM, gsz = (nM - fm) < WGM ? (nM - fm) : WGM;
    pm = fm + ((wgid % nig) % gsz); pn = (wgid % nig) / gsz; return true;
}
struct StaticOrder {
    static constexpr bool GATHER = false;
    int nM, nN, G, c, KB; const char* A; const char* Bt;
    __device__ __forceinline__ void init(const void* A_, const void* Bt_, int M, int N, int KB_, int G_, int c_) { A = (const char*)A_; Bt = (const char*)Bt_; nM = M / BM; nN = N / BM; KB = KB_; G = G_; c = c_; }
    __device__ __forceinline__ bool next(int i, Unit& u) const {
        int pm, pn; if (!tile_order(i, G, c, nM, nN, pm, pn)) return false;
        u.pm = pm; u.pn = pn; u.e = 0; u.rt = pm; u.cnt = 1 << 30; u.ab = A + (size_t)pm * BM * KB; u.bb = Bt + (size_t)pn * BM * KB; return true;
    }
    __device__ __forceinline__ void aoff(const Unit&, int tid, unsigned (&va)[2][2]) const {
#pragma unroll
        for (int i = 0; i < 2; ++i) { int R, C; stage_rc(tid * 16 + i * 8192, R, C);
#pragma unroll
            for (int h = 0; h < 2; ++h) va[h][i] = (unsigned)((R + HALF * h) * KB + C * 2); }
    }
};

typedef int v8i32 __attribute__((ext_vector_type(8)));
typedef int v4i32 __attribute__((ext_vector_type(4)));
__device__ __forceinline__ v8i32 cat8(bf16x8 a, bf16x8 b) { const v4i32 x = __builtin_bit_cast(v4i32, a), y = __builtin_bit_cast(v4i32, b); return (v8i32){x[0], x[1], x[2], x[3], y[0], y[1], y[2], y[3]}; }
__device__ __forceinline__ void glds16s(unsigned voff, const void* sbase, unsigned lds_dst) { unsigned keep;
    asm volatile("s_mov_b32 %0, m0\n\ts_mov_b32 m0, %3\n\ts_nop 0\n\tglobal_load_lds_dwordx4 %1, %2\n\ts_mov_b32 m0, %0" : "=&s"(keep) : "v"(voff), "s"(sbase), "s"(lds_dst) : "memory"); }
__device__ __forceinline__ unsigned cvt_pk_bf16(float lo, float hi) { unsigned r; asm volatile("v_cvt_pk_bf16_f32 %0, %1, %2" : "=v"(r) : "v"(lo), "v"(hi)); return r; }

template <bool FP8, class Epi, class Sched>
__device__ __forceinline__ void gemm_phase(PG8_LAS unsigned char* lds, const int KB, const Sched& S, const Epi& E) {
    const int tid = opq((int)threadIdx.x), wid = __builtin_amdgcn_readfirstlane(tid >> 6), lane = tid & 63, wr = wid >> 2, wc = wid & 3, fr = lane & 15, fq = lane >> 4;
    const int nt = KB / 128;
    unsigned voffB[2];
#pragma unroll
    for (int i = 0; i < 2; ++i) { int R, C; stage_rc(tid * 16 + i * 8192, R, C); const int Rb = Epi::PERM ? ((R & ~31) + perm32(R & 31)) : R; voffB[i] = (unsigned)(Rb * KB + C * 2); }
    const size_t kstep = (size_t)(BK * 2);
    const size_t hstep = (size_t)HALF * KB;
    const unsigned ldsw = (unsigned)wid * 1024u;
    const int aoff = lds_byte(wr * 64 + fr, fq * 8), boff = lds_byte(wc * 32 + fr, fq * 8);
    const unsigned lds0 = (unsigned)(uintptr_t)lds;
#define PG8_SA(b, h) (((b) * 2 + (h)) * HTB)
#define PG8_SB(b, h) ((4 + (b) * 2 + (h)) * HTB)
#define PG8_STAGE(bufoff, gbase, voff) do { _Pragma("unroll") for (int _i = 0; _i < 2; ++_i) glds16s((voff)[_i], (const void*)(gbase), lds0 + (unsigned)(bufoff) + ldsw + (unsigned)(_i * 8192)); } while (0)
#define PG8_LD8(p) __builtin_shufflevector(*(const PG8_LAS v4i32*)(p), *(const PG8_LAS v4i32*)((p) + 1024), 0, 1, 2, 3, 4, 5, 6, 7)
#define PG8_LDA(dst, b, h) do { _Pragma("unroll") for (int m = 0; m < 4; ++m) dst[m] = PG8_LD8(lds + PG8_SA(b, h) + aoff + m * 2048); } while (0)
#define PG8_LDB(dst, b, h) do { _Pragma("unroll") for (int n = 0; n < 2; ++n) dst[n] = PG8_LD8(lds + PG8_SB(b, h) + boff + n * 2048); } while (0)
#define PG8_LO(v) __builtin_bit_cast(bf16x8, __builtin_shufflevector(v, v, 0, 1, 2, 3))
#define PG8_HI(v) __builtin_bit_cast(bf16x8, __builtin_shufflevector(v, v, 4, 5, 6, 7))
#define PG8_MMA(ai, bj, At, Bt) do { __builtin_amdgcn_s_setprio(1); _Pragma("unroll") for (int m = 0; m < 4; ++m) _Pragma("unroll") for (int n = 0; n < 2; ++n) { \
        if constexpr (FP8) acc[ai][bj][m][n] = __builtin_amdgcn_mfma_scale_f32_16x16x128_f8f6f4(Bt[n], At[m], acc[ai][bj][m][n], 0, 0, 0, 0, 0, 0); \
        else { acc[ai][bj][m][n] = __builtin_amdgcn_mfma_f32_16x16x32_bf16(PG8_LO(Bt[n]), PG8_LO(At[m]), acc[ai][bj][m][n], 0, 0, 0); \
               acc[ai][bj][m][n] = __builtin_amdgcn_mfma_f32_16x16x32_bf16(PG8_HI(Bt[n]), PG8_HI(At[m]), acc[ai][bj][m][n], 0, 0, 0); } } \
        __builtin_amdgcn_s_setprio(0); } while (0)
#define PG8_WAIT_V(n) asm volatile("s_waitcnt vmcnt(" #n ")" ::: "memory")
#define PG8_WAIT_L(n) asm volatile("s_waitcnt lgkmcnt(" #n ")" ::: "memory")
#define PG8_BAR __builtin_amdgcn_s_barrier()
#define PG8_SCHED __builtin_amdgcn_sched_barrier(0)
    Unit cur, nxt; int ui = 0;
    if (!S.next(0, cur)) return;
    unsigned va[2][2];
    PG8_LAS u32x4* stash = (PG8_LAS u32x4*)(lds + STAGE_BYTES) + tid;
    S.aoff(cur, tid, va);
    f32x4 acc[2][2][4][2];
#pragma unroll
    for (int a = 0; a < 2; ++a)
#pragma unroll
        for (int b = 0; b < 2; ++b)
#pragma unroll
            for (int m = 0; m < 4; ++m)
#pragma unroll
                for (int n = 0; n < 2; ++n) acc[a][b][m][n] = (f32x4){0.f, 0.f, 0.f, 0.f};
    v8i32 At[4], B0[2], B1[2];
    const char* cA = cur.ab; const char* cB = cur.bb;
    PG8_STAGE(PG8_SB(0, 0), cB, voffB); PG8_STAGE(PG8_SB(0, 1), cB + hstep, voffB); PG8_STAGE(PG8_SA(0, 0), cA, va[0]); PG8_STAGE(PG8_SA(0, 1), cA, va[1]);
    if (wr == 1) PG8_BAR;
    PG8_WAIT_V(2); PG8_BAR;
    PG8_STAGE(PG8_SB(1, 0), cB + kstep, voffB); PG8_STAGE(PG8_SA(1, 0), cA + kstep, va[0]); PG8_STAGE(PG8_SB(1, 1), cB + hstep + kstep, voffB);
    PG8_WAIT_V(6); PG8_BAR;
    for (;;) {
        const bool has_next = S.next(ui + 1, nxt);
        const char* nA = has_next ? nxt.ab : cA; const char* nB = has_next ? nxt.bb : cB;
        if constexpr (Sched::GATHER) {
            unsigned t4[2][2];
            if (has_next) S.aoff(nxt, opq((int)threadIdx.x), t4);
            else {
#pragma unroll
                for (int h = 0; h < 2; ++h)
#pragma unroll
                    for (int i = 0; i < 2; ++i) t4[h][i] = va[h][i]; }
            *stash = (u32x4){t4[0][0], t4[0][1], t4[1][0], t4[1][1]}; }
#pragma unroll 1
        for (int t = 0; t < nt; t += 2) {
            const bool last = (t == nt - 2);
            const char* a1 = cA + (size_t)(t + 1) * kstep;
            const char* a2 = last ? nA : cA + (size_t)(t + 2) * kstep; const char* b2 = last ? nB : cB + (size_t)(t + 2) * kstep;
            const char* a3 = a2 + kstep; const char* b3 = b2 + kstep;
            unsigned x0[2], x1[2];
#pragma unroll
            for (int i = 0; i < 2; ++i) { x0[i] = va[0][i]; x1[i] = va[1][i]; }
            if constexpr (Sched::GATHER) { if (last) { const u32x4 s4 = *stash; x0[0] = s4.x; x0[1] = s4.y; x1[0] = s4.z; x1[1] = s4.w; } }
            PG8_LDB(B0, 0, 0); PG8_LDB(B1, 0, 1); PG8_SCHED; PG8_LDA(At, 0, 0); PG8_STAGE(PG8_SA(1, 1), a1, va[1]);
            PG8_WAIT_V(8); PG8_WAIT_L(0); PG8_BAR; PG8_MMA(0, 0, At, B0); PG8_MMA(0, 1, At, B1); PG8_BAR; PG8_SCHED;
            PG8_LDA(At, 0, 1); PG8_STAGE(PG8_SB(0, 0), b2, voffB); PG8_STAGE(PG8_SB(0, 1), b2 + hstep, voffB); PG8_STAGE(PG8_SA(0, 0), a2, x0);
            PG8_WAIT_V(8); PG8_WAIT_L(0); PG8_BAR; PG8_MMA(1, 0, At, B0); PG8_MMA(1, 1, At, B1); PG8_BAR; PG8_SCHED;
            PG8_LDB(B0, 1, 0); PG8_LDB(B1, 1, 1); PG8_SCHED; PG8_LDA(At, 1, 0); PG8_STAGE(PG8_SA(0, 1), a2, x1);
            PG8_WAIT_V(8); PG8_WAIT_L(0); PG8_BAR; PG8_MMA(0, 0, At, B0); PG8_MMA(0, 1, At, B1); PG8_BAR; PG8_SCHED;
            PG8_LDA(At, 1, 1); PG8_STAGE(PG8_SB(1, 0), b3, voffB); PG8_STAGE(PG8_SB(1, 1), b3 + hstep, voffB); PG8_STAGE(PG8_SA(1, 0), a3, x0);
            PG8_WAIT_V(8); PG8_WAIT_L(0); PG8_BAR; PG8_MMA(1, 0, At, B0); PG8_MMA(1, 1, At, B1); PG8_BAR; PG8_SCHED;
        }
        if (wr == 0) PG8_BAR;
        { const int l2 = opq((int)threadIdx.x) & 63; E(acc, cur, wr, wc, l2 & 15, l2 >> 4); }
        if (!has_next) break;
#pragma unroll
        for (int a = 0; a < 2; ++a)
#pragma unroll
            for (int b = 0; b < 2; ++b)
#pragma unroll
                for (int m = 0; m < 4; ++m)
#pragma unroll
                    for (int n = 0; n < 2; ++n) acc[a][b][m][n] = (f32x4){0.f, 0.f, 0.f, 0.f};
        cur = nxt; cA = nA; cB = nB; ++ui;
        if constexpr (Sched::GATHER) { const u32x4 s4 = *stash; va[0][0] = s4.x; va[0][1] = s4.y; va[1][0] = s4.z; va[1][1] = s4.w; }
        if (wr == 1) PG8_BAR;
    }
    PG8_WAIT_V(0);
    PG8_BAR;
#undef PG8_SA
#undef PG8_SB
#undef PG8_STAGE
#undef PG8_LDA
#undef PG8_LDB
#undef PG8_LD8
#undef PG8_LO
#undef PG8_HI
#undef PG8_MMA
#undef PG8_WAIT_V
#undef PG8_WAIT_L
#undef PG8_BAR
#undef PG8_SCHED
}
}
constexpr int D = 1024, NB = 8, SEQ = 4096, CTXL = 256, NL = NB * SEQ, NC = NB * CTXL, MT = NL + NC;
constexpr int INW = 1792, FF = 2816, NE = 8;
constexpr int C_Q = 0, C_K = 512, C_V = 640, C_U = 768, C_RQ = 1024, C_RK = 1152, C_RV = 1280, C_RG = 1536;
constexpr int NCHK = 34;
constexpr float LN_EPS = 1e-5f, LOG2E = 1.4426950408889634f;
constexpr float QSCALE = 0.125f * LOG2E;
constexpr float RSCALE = 0.17677669529663687f;
constexpr float ALPHA = 1.4142135623730951f;
constexpr int LCAP = 32768;

namespace pg8 {
__device__ __forceinline__ void store8(bf16_t* p, f32x4 v0, f32x4 v1) {
    u32x4 w; w.x = cvt_pk_bf16(v0[0], v0[1]); w.y = cvt_pk_bf16(v0[2], v0[3]); w.z = cvt_pk_bf16(v1[0], v1[1]); w.w = cvt_pk_bf16(v1[2], v1[3]); *(u32x4*)p = w;
}
struct EpiBf16 {
    static constexpr bool PERM = true;
    bf16_t* O; int ldc;
    __device__ __forceinline__ void operator()(const f32x4 (&acc)[2][2][4][2], const Unit& u, int wr, int wc, int fr, int fq) const {
        const int row0 = u.pm * BM + wr * 64 + fr, col0 = u.pn * BM + wc * 32 + 8 * fq;
#pragma unroll
        for (int ai = 0; ai < 2; ++ai)
#pragma unroll
            for (int m = 0; m < 4; ++m) { bf16_t* rowp = O + (size_t)(row0 + ai * HALF + m * 16) * ldc + col0;
#pragma unroll
                for (int bj = 0; bj < 2; ++bj) store8(rowp + bj * HALF, acc[ai][bj][m][0], acc[ai][bj][m][1]); }
    }
};
struct EpiInProj {
    static constexpr bool PERM = true;
    bf16_t* O; const float* rc; const float* rs;
    __device__ __forceinline__ void operator()(const f32x4 (&acc)[2][2][4][2], const Unit& u, int wr, int wc, int fr, int fq) const {
        const int row0 = u.pm * BM + wr * 64 + fr; const bool lat = u.pm < (NL / BM);
#pragma unroll
        for (int bj = 0; bj < 2; ++bj) {
            const int seg = 2 * u.pn + bj;
            const bool rope = lat && seg <= 4; const float sc = seg <= 3 ? QSCALE : (seg == 9 ? RSCALE : 1.0f);
#pragma unroll
            for (int ai = 0; ai < 2; ++ai)
#pragma unroll
                for (int m = 0; m < 4; ++m) { const int row = row0 + ai * HALF + m * 16;
                    f32x4 v0 = acc[ai][bj][m][0], v1 = acc[ai][bj][m][1];
                    if (rope) { const int t = row & (SEQ - 1); const int pos = (wc & 1) ? (t & 63) : (t >> 6);
                        const f32x4 c4 = *(const f32x4*)(rc + pos * 16 + 4 * fq), s4 = *(const f32x4*)(rs + pos * 16 + 4 * fq);
                        const f32x4 o0 = v0 * c4 - v1 * s4, o1 = v0 * s4 + v1 * c4; v0 = o0; v1 = o1; }
                    v0 = v0 * sc; v1 = v1 * sc;
                    store8(O + (size_t)row * INW + seg * HALF + wc * 32 + 8 * fq, v0, v1); }
        }
    }
};
struct EpiSwiGLU {
    static constexpr bool PERM = true;
    bf16_t* H; int ldh;
    __device__ __forceinline__ void operator()(const f32x4 (&acc)[2][2][4][2], const Unit& u, int wr, int wc, int fr, int fq) const {
        const int row0 = u.pm * BM + wr * 64 + fr, col0 = u.pn * HALF + wc * 32 + 8 * fq;
#pragma unroll
        for (int ai = 0; ai < 2; ++ai)
#pragma unroll
            for (int m = 0; m < 4; ++m) { f32x4 h[2];
#pragma unroll
                for (int n = 0; n < 2; ++n) { const f32x4 g = acc[ai][0][m][n], up = acc[ai][1][m][n];
#pragma unroll
                    for (int i = 0; i < 4; ++i) h[n][i] = g[i] * __builtin_amdgcn_rcpf(1.0f + __builtin_amdgcn_exp2f(-LOG2E * g[i])) * up[i]; }
                store8(H + (size_t)(row0 + ai * HALF + m * 16) * ldh + col0, h[0], h[1]); }
    }
};
__device__ __forceinline__ unsigned pk4_fp8(float a, float b, float c, float d) {
    a = __builtin_amdgcn_fmed3f(a, -448.f, 448.f); b = __builtin_amdgcn_fmed3f(b, -448.f, 448.f); c = __builtin_amdgcn_fmed3f(c, -448.f, 448.f); d = __builtin_amdgcn_fmed3f(d, -448.f, 448.f);
    int w = __builtin_amdgcn_cvt_pk_fp8_f32(a, b, 0, false); w = __builtin_amdgcn_cvt_pk_fp8_f32(c, d, w, true); return (unsigned)w; }
struct EpiSwiGLU8 {
    static constexpr bool PERM = true;
    unsigned char* H; int ldh; float in_scale, out_scale;
    __device__ __forceinline__ void operator()(const f32x4 (&acc)[2][2][4][2], const Unit& u, int wr, int wc, int fr, int fq) const {
        const int row0 = u.pm * BM + wr * 64 + fr, col0 = u.pn * HALF + wc * 32 + 8 * fq;
#pragma unroll
        for (int ai = 0; ai < 2; ++ai)
#pragma unroll
            for (int m = 0; m < 4; ++m) { f32x4 h[2];
#pragma unroll
                for (int n = 0; n < 2; ++n) { const f32x4 g = acc[ai][0][m][n] * in_scale, up = acc[ai][1][m][n] * (in_scale * out_scale);
#pragma unroll
                    for (int i = 0; i < 4; ++i) h[n][i] = g[i] * __builtin_amdgcn_rcpf(1.0f + __builtin_amdgcn_exp2f(-LOG2E * g[i])) * up[i]; }
                typedef unsigned u32x2 __attribute__((ext_vector_type(2))); u32x2 w; w.x = pk4_fp8(h[0][0], h[0][1], h[0][2], h[0][3]); w.y = pk4_fp8(h[1][0], h[1][1], h[1][2], h[1][3]);
                *(u32x2*)(H + (size_t)(row0 + ai * HALF + m * 16) * ldh + col0) = w; }
    }
};
struct EpiMoeDown {
    static constexpr bool PERM = true;
    bf16_t* Y; const int* list; const float* lgate; float scale;
    __device__ __forceinline__ void operator()(const f32x4 (&acc)[2][2][4][2], const Unit& u, int wr, int wc, int fr, int fq) const {
        const int col0 = u.pn * BM + wc * 32 + 8 * fq;
#pragma unroll
        for (int ai = 0; ai < 2; ++ai)
#pragma unroll
            for (int m = 0; m < 4; ++m) { const int pos = u.rt * BM + ai * HALF + wr * 64 + m * 16 + fr;
                if (pos < u.cnt) { const int ent = list[u.e * LCAP + pos]; const float g = lgate[u.e * LCAP + pos] * scale;
                    bf16_t* rowp = Y + ((size_t)(ent & 1) * NL + (size_t)(ent >> 1)) * D + col0;
#pragma unroll
                    for (int bj = 0; bj < 2; ++bj) store8(rowp + bj * HALF, acc[ai][bj][m][0] * g, acc[ai][bj][m][1] * g); } }
    }
};
template <bool GATHER_> struct MoeOrder {
    static constexpr bool GATHER = GATHER_;
    int nrt, nN, G, c, KB, T0; const PG8_LAS int* tbl;
    const char* A; const char* Bt; size_t bstride; const int* list;
    __device__ __forceinline__ bool next(int i, Unit& u) const {
        int pm, pn; if (nrt <= 0 || !tile_order(i, G, c, nrt, nN, pm, pn)) return false;
        const int T = T0 + pm; int e = 0;
#pragma unroll
        for (int j = 1; j < NE; ++j) e += (T >= tbl[j]) ? 1 : 0;
        e = __builtin_amdgcn_readfirstlane(e);
        u.pm = pm; u.pn = pn; u.e = e; u.rt = T - __builtin_amdgcn_readfirstlane(tbl[e]); u.cnt = __builtin_amdgcn_readfirstlane(tbl[NE + 1 + e]);
        u.ab = GATHER ? A : A + (size_t)pm * BM * KB; u.bb = Bt + (size_t)e * bstride + (size_t)pn * BM * KB; return true;
    }
    __device__ __forceinline__ void aoff(const Unit& u, int tid, unsigned (&va)[2][2]) const {
#pragma unroll
        for (int i = 0; i < 2; ++i) { int R, C; stage_rc(tid * 16 + i * 8192, R, C);
#pragma unroll
            for (int h = 0; h < 2; ++h) {
                if (GATHER) { const int pos = u.rt * BM + R + HALF * h; const int tok = pos < u.cnt ? (list[u.e * LCAP + pos] >> 1) : 0; va[h][i] = (unsigned)(tok * KB + C * 2); }
                else va[h][i] = (unsigned)((R + HALF * h) * KB + C * 2); } }
    }
};
}
constexpr size_t MiB = 1u << 20;
constexpr size_t WS_CTL = 0, CTL_ZERO_BYTES = 1 * MiB;
constexpr size_t WS_MOD = 1 * MiB;
constexpr size_t WS_ROPE = 1 * MiB + 512 * 1024;
constexpr size_t WS_LIST = 2 * MiB, WS_LGATE = 3 * MiB;
constexpr size_t WS_KVS = 8 * MiB;
constexpr size_t WS_XC = 26 * MiB;
constexpr size_t WS_WIN = 34 * MiB, WS_WOUT = 41 * MiB, WS_FGU = 45 * MiB, WS_FD = 56 * MiB;
constexpr size_t WS_MGU8 = 62 * MiB, WS_MD8 = 106 * MiB, WS_T8 = 128 * MiB;
constexpr size_t WS_ACT = 194 * MiB;
constexpr size_t WS_PROJ = 262 * MiB, WS_MIX = 381 * MiB;
constexpr size_t WS_HID = 262 * MiB;
constexpr size_t WS_Y = 160 * MiB, WS_HID8 = 288 * MiB;
constexpr size_t WS_END = 470 * MiB;
static_assert(WS_WIN + (size_t)2 * INW * D * 2 <= WS_WOUT && WS_FGU + (size_t)2 * FF * D * 2 <= WS_FD && WS_FD + (size_t)FF * D * 2 <= WS_MGU8 && WS_MGU8 + (size_t)NE * 2 * FF * D <= WS_MD8 && WS_MD8 + (size_t)NE * FF * D <= WS_T8 && WS_T8 + (size_t)NL * D <= WS_Y, "weights map");
static_assert(WS_ACT + (size_t)MT * D * 2 <= WS_PROJ && WS_PROJ + (size_t)MT * INW * 2 <= WS_MIX && WS_MIX + (size_t)MT * D * 2 <= WS_END && WS_HID + (size_t)MT * FF * 2 <= WS_END, "act map");
static_assert(WS_Y + (size_t)2 * NL * D * 2 <= WS_HID8 && WS_HID8 + (size_t)264 * 256 * FF <= WS_END && WS_KVS + (size_t)2 * 32 * NCHK * 2048 * 4 <= WS_XC, "moe map");
constexpr int CW_TMO = 0;
constexpr int CW_GCNT = 1024;
constexpr int CW_BAR = 4096;

constexpr int RING_BYTES = 131072;
constexpr int SCR_BYTES = 155648;
constexpr int MISC_OFF = SCR_BYTES;
constexpr int LDS_BYTES = SCR_BYTES + 256;

#define GAS __attribute__((address_space(1)))
#define LAS __attribute__((address_space(3)))
typedef unsigned short bf16;
typedef unsigned v4u __attribute__((ext_vector_type(4)));
typedef unsigned v2u __attribute__((ext_vector_type(2)));
typedef float f32x4 __attribute__((ext_vector_type(4)));
typedef __bf16 bf16x2_t __attribute__((ext_vector_type(2)));
typedef float f32x2_t __attribute__((ext_vector_type(2)));
#define RLX_AGENT __ATOMIC_RELAXED, __HIP_MEMORY_SCOPE_AGENT
__device__ __forceinline__ unsigned pk2(float lo, float hi) { f32x2_t v = {lo, hi}; bf16x2_t b = __builtin_convertvector(v, bf16x2_t); return __builtin_bit_cast(unsigned, b); }
__device__ __forceinline__ float bflo(unsigned w) { return __uint_as_float(w << 16); }
__device__ __forceinline__ float bfhi(unsigned w) { return __uint_as_float(w & 0xffff0000u); }
__device__ __forceinline__ float dot2bf(unsigned a, unsigned b, float c) { return __builtin_amdgcn_fdot2_f32_bf16(__builtin_bit_cast(bf16x2_t, a), __builtin_bit_cast(bf16x2_t, b), c, false); }
__device__ __forceinline__ float wave_sum(float v) {
#pragma unroll
    for (int o = 1; o < 64; o <<= 1) v += __shfl_xor(v, o);
    return v;
}

#define XB_TMO      128
#define XB_XCNT(j)  (256  + 64 * (j))
#define XB_XSUB(j)  (1280 + 64 * (j))
#define XB_XGEN(j)  (2304 + 64 * (j))
#define XB_TOP      3328
#define XB_TOPGEN   3392
#define XCD_BAR_WORDS 3456
#define XB_SPIN_CAP (1u << 18)
__device__ __forceinline__ unsigned xb_ld(unsigned* p)              { return __hip_atomic_load(p, __ATOMIC_RELAXED, __HIP_MEMORY_SCOPE_AGENT); }
__device__ __forceinline__ unsigned xb_add(unsigned* p, unsigned v) { return __hip_atomic_fetch_add(p, v, __ATOMIC_RELAXED, __HIP_MEMORY_SCOPE_AGENT); }
__device__ __forceinline__ unsigned xb_xcc_id() { return (unsigned)__builtin_amdgcn_s_getreg((3 << 11) | 20) & 0xFu; }
#define XB_SPIN(cond, bar) do { unsigned _sp = 0; while (cond) { __builtin_amdgcn_s_sleep(1); \
    if ((++_sp & 255u) == 0u) { if (xb_ld(&(bar)[XB_TMO])) break; if (_sp > XB_SPIN_CAP) { atomicAdd(&(bar)[XB_TMO], 1u); break; } } } } while (0)
struct XcdBarrier { unsigned* bar; unsigned x; volatile LAS unsigned* st; };
__device__ __forceinline__ XcdBarrier xcd_barrier_post(unsigned* bar, volatile LAS unsigned* st) {
    XcdBarrier b; b.bar = bar; b.x = xb_xcc_id(); b.st = st;
    if (threadIdx.x == 0) (void)xb_add(&bar[XB_XCNT(b.x)], 1u);
    return b;
}
__device__ __forceinline__ void xcd_barrier_complete(unsigned* bar, unsigned x, unsigned& nloc, unsigned& nx) {
    const unsigned G = gridDim.x * gridDim.y * gridDim.z;
    unsigned sum, cnt, mine, sp = 0u;
    for (;;) {
        sum = 0u; cnt = 0u; mine = 0u;
#pragma unroll
        for (unsigned j = 0; j < 16; ++j) { const unsigned c = xb_ld(&bar[XB_XCNT(j)]); sum += c; cnt += (c > 0u) ? 1u : 0u; mine = (j == x) ? c : mine; }
        if (sum == G) break;
        __builtin_amdgcn_s_sleep(1);
        if ((++sp & 255u) == 0u) { if (xb_ld(&bar[XB_TMO])) break; if (sp > XB_SPIN_CAP) { atomicAdd(&bar[XB_TMO], 1u); break; } }
    }
    nloc = mine > 0u ? mine : 1u; nx = cnt > 0u ? cnt : 1u;
}
__device__ __forceinline__ void xcd_barrier(const XcdBarrier& b) {
    asm volatile("s_waitcnt vmcnt(0)" ::: "memory");
    __syncthreads();
    if (threadIdx.x == 0) {
        unsigned* bar = b.bar;
        __builtin_amdgcn_s_waitcnt(0);
        unsigned nloc = b.st[0], nx = b.st[1];
        if (nloc == 0u) { xcd_barrier_complete(bar, b.x, nloc, nx); b.st[0] = nloc; b.st[1] = nx; }
        const unsigned old = xb_add(&bar[XB_XSUB(b.x)], 1u);
        const unsigned gen = old / nloc;
        if (old + 1u == (gen + 1u) * nloc) {
            __builtin_amdgcn_fence(__ATOMIC_RELEASE, "agent");
            asm volatile("s_waitcnt vmcnt(0)" ::: "memory");
            const unsigned og = xb_add(&bar[XB_TOP], 1u);
            const unsigned tg = og / nx;
            if (og + 1u == (tg + 1u) * nx) xb_add(&bar[XB_TOPGEN], 1u);
            else XB_SPIN(xb_ld(&bar[XB_TOPGEN]) == tg, bar);
            __builtin_amdgcn_fence(__ATOMIC_ACQUIRE, "agent");
            xb_add(&bar[XB_XGEN(b.x)], 1u);
            asm volatile("s_waitcnt vmcnt(0)" ::: "memory");
        } else {
            XB_SPIN(xb_ld(&bar[XB_XGEN(b.x)]) == gen, bar);
            __builtin_amdgcn_fence(__ATOMIC_ACQUIRE, "agent");
            asm volatile("s_waitcnt vmcnt(0)" ::: "memory");
        }
    }
    __syncthreads();
}

constexpr int NWAVES = 8, NTHR = 512;
struct Frame {
    LAS unsigned char* lds;
    int wave, vcu, G;
    unsigned char* ws; float* out;
    const float *x, *c, *ctx, *c_ctx, *w_mod, *b_mod, *w_in, *sink, *pool_w, *pool_scale, *lgf, *lgb, *w_out, *ln1_g, *ln1_b, *ln2_g, *ln2_b;
    const float *fw_gate, *fw_up, *fw_down, *router, *mw_gate, *mw_up, *mw_down;
};
#define WSP(T, off) ((T*)(F.ws + (off)))

template <class RowMap>
__device__ __forceinline__ void transpose_item(const float* W, int K, int N, bf16* WT, const RowMap& rowmap, LAS float* scr, int item, int lane) {
    const int nblk = N / 32, kb = item / nblk, nb = item % nblk, k0 = 64 * kb, n0 = 32 * nb;
#pragma unroll 8
    for (int i = 0; i < 32; ++i) { const int kk = 2 * i + (lane >> 5); scr[kk * 33 + (lane & 31)] = W[(size_t)(k0 + kk) * N + n0 + (lane & 31)]; }
    asm volatile("s_waitcnt lgkmcnt(0)" ::: "memory");
    const int c = lane & 7;
#pragma unroll
    for (int j = 0; j < 4; ++j) { const int n = (lane >> 3) + 8 * j; const LAS float* s = scr + (8 * c) * 33 + n;
        v4u o; o.x = pk2(s[0 * 33], s[1 * 33]); o.y = pk2(s[2 * 33], s[3 * 33]); o.z = pk2(s[4 * 33], s[5 * 33]); o.w = pk2(s[6 * 33], s[7 * 33]);
        *(GAS v4u*)(WT + (size_t)rowmap(n0 + n) * K + k0 + 8 * c) = o; }
    asm volatile("s_waitcnt lgkmcnt(0)" ::: "memory");
}
__device__ __forceinline__ unsigned pk4_fp8s(float a, float b, float c, float d, float s) { return pg8::pk4_fp8(a * s, b * s, c * s, d * s); }
template <class RowMap>
__device__ __forceinline__ void transpose_item8(const float* W, int K, int N, unsigned char* WT, const RowMap& rowmap, float scale, LAS float* scr, int item, int lane) {
    const int nblk = N / 32, kb = item / nblk, nb = item % nblk, k0 = 64 * kb, n0 = 32 * nb;
#pragma unroll 8
    for (int i = 0; i < 32; ++i) { const int kk = 2 * i + (lane >> 5); scr[kk * 33 + (lane & 31)] = W[(size_t)(k0 + kk) * N + n0 + (lane & 31)]; }
    asm volatile("s_waitcnt lgkmcnt(0)" ::: "memory");
    const int c = lane & 7;
#pragma unroll
    for (int j = 0; j < 4; ++j) { const int n = (lane >> 3) + 8 * j; const LAS float* s = scr + (8 * c) * 33 + n;
        v2u o; o.x = pk4_fp8s(s[0 * 33], s[1 * 33], s[2 * 33], s[3 * 33], scale); o.y = pk4_fp8s(s[4 * 33], s[5 * 33], s[6 * 33], s[7 * 33], scale);
        *(GAS v2u*)(WT + (size_t)rowmap(n0 + n) * K + k0 + 8 * c) = o; }
    asm volatile("s_waitcnt lgkmcnt(0)" ::: "memory");
}
struct MapId { __device__ __forceinline__ int operator()(int n) const { return n; } };
struct MapInProj {
    __device__ __forceinline__ int operator()(int n) const { if (n >= C_V) return n; const int dd = n & 31, j = dd & 15, x2 = dd >> 4; return (n & ~31) + 8 * (j >> 2) + 4 * x2 + (j & 3); } };
struct MapGU { int up; __device__ __forceinline__ int operator()(int n) const { return 256 * (n >> 7) + 128 * up + (n & 127); } };

__device__ __forceinline__ void p_prep(Frame& F) {
    const int tid = opq((int)threadIdx.x), lane = tid & 63, wave = F.wave;
    LAS float* sv = (LAS float*)F.lds;
    LAS float* red = sv + 1024 * 12;
    bool have_sv = false;
    for (int un = blockIdx.x; un < 2 * 96; un += F.G) {
        if (!have_sv) {
            for (int idx = tid; idx < 9 * 1024; idx += NTHR) { const int r = idx >> 10, k = idx & 1023; const float v = r < 8 ? F.c[r * 1024 + k] : F.c_ctx[k]; sv[k * 12 + r] = v / (1.0f + __expf(-v)); }
            have_sv = true; __syncthreads();
        }
        const int layer = un / 96, cc = un % 96, col = cc * 64 + lane;
        float acc[9];
#pragma unroll
        for (int r = 0; r < 9; ++r) acc[r] = 0.f;
        const float* wp = F.w_mod + ((size_t)layer * 1024 + wave * 128) * 6144 + col;
#pragma unroll 8
        for (int kk = 0; kk < 128; ++kk) { const float wv = wp[(size_t)kk * 6144]; const LAS float* s = sv + (wave * 128 + kk) * 12;
            const f32x4 s0 = *(const LAS f32x4*)s, s1 = *(const LAS f32x4*)(s + 4); const float s8 = s[8];
            acc[0] += s0[0] * wv; acc[1] += s0[1] * wv; acc[2] += s0[2] * wv; acc[3] += s0[3] * wv; acc[4] += s1[0] * wv; acc[5] += s1[1] * wv; acc[6] += s1[2] * wv; acc[7] += s1[3] * wv; acc[8] += s8 * wv; }
#pragma unroll
        for (int r = 0; r < 9; ++r) red[(wave * 9 + r) * 64 + lane] = acc[r];
        __syncthreads();
        for (int idx = tid; idx < 9 * 64; idx += NTHR) { const int r = idx >> 6, ln = idx & 63; float s = F.b_mod[layer * 6144 + cc * 64 + ln];
#pragma unroll
            for (int w = 0; w < 8; ++w) s += red[(w * 9 + r) * 64 + ln];
            WSP(float, WS_MOD)[(size_t)(layer * 9 + r) * 6144 + cc * 64 + ln] = s; }
        __syncthreads();
    }
    if (blockIdx.x == F.G - 1) { for (int idx = tid; idx < 1024; idx += NTHR) { const int pos = idx >> 4, j = idx & 15; const float inv = powf(10000.0f, -(float)j / 16.0f); const float ang = (float)pos * inv;
            WSP(float, WS_ROPE)[idx] = cosf(ang); WSP(float, WS_ROPE)[1024 + idx] = sinf(ang); } }
    __syncthreads();
    LAS float* scr = (LAS float*)(F.lds + wave * 16384);
    const int gw = F.vcu * NWAVES + wave, NGW = F.G * NWAVES;
    constexpr int I_IN = (D / 64) * (INW / 32), I_OUT = (D / 64) * (D / 32), I_GU = (D / 64) * (FF / 32), I_DN = (FF / 64) * (D / 32);
    constexpr int NITEMS = 2 * (I_IN + I_OUT) + (1 + NE) * (2 * I_GU + I_DN);
    for (int it = gw; it < NITEMS; it += NGW) {
        int r = it;
        if (r < 2 * I_IN) { const int l = r / I_IN; transpose_item(F.w_in + (size_t)l * D * INW, D, INW, WSP(bf16, WS_WIN) + (size_t)l * INW * D, MapInProj{}, scr, r % I_IN, lane); continue; } r -= 2 * I_IN;
        if (r < 2 * I_OUT) { const int l = r / I_OUT; transpose_item(F.w_out + (size_t)l * D * D, D, D, WSP(bf16, WS_WOUT) + (size_t)l * D * D, MapId{}, scr, r % I_OUT, lane); continue; } r -= 2 * I_OUT;
        const int per = 2 * I_GU + I_DN, m = r / per; r %= per;
        if (m == 0) {
            if (r < I_GU) { transpose_item(F.fw_gate, D, FF, WSP(bf16, WS_FGU), MapGU{0}, scr, r, lane); continue; } r -= I_GU;
            if (r < I_GU) { transpose_item(F.fw_up, D, FF, WSP(bf16, WS_FGU), MapGU{1}, scr, r, lane); continue; } r -= I_GU;
            transpose_item(F.fw_down, FF, D, WSP(bf16, WS_FD), MapId{}, scr, r, lane);
        } else {
            unsigned char* gu = WSP(unsigned char, WS_MGU8) + (size_t)(m - 1) * 2 * FF * D; unsigned char* dn = WSP(unsigned char, WS_MD8) + (size_t)(m - 1) * FF * D;
            if (r < I_GU) { transpose_item8(F.mw_gate + (size_t)(m - 1) * D * FF, D, FF, gu, MapGU{0}, 32.0f, scr, r, lane); continue; } r -= I_GU;
            if (r < I_GU) { transpose_item8(F.mw_up + (size_t)(m - 1) * D * FF, D, FF, gu, MapGU{1}, 32.0f, scr, r, lane); continue; } r -= I_GU;
            transpose_item8(F.mw_down + (size_t)(m - 1) * FF * D, FF, D, dn, MapId{}, 128.0f, scr, r, lane);
        }
    }
}

__device__ __forceinline__ void row_load_f32(const float* p, int lane, f32x4 (&v)[4]) {
#pragma unroll
    for (int j = 0; j < 4; ++j) v[j] = *(const f32x4*)(p + 4 * lane + 256 * j);
}
__device__ __forceinline__ void row_load_bf16(const bf16* p, int lane, f32x4 (&v)[4]) {
#pragma unroll
    for (int j = 0; j < 4; ++j) { const v2u w = *(const v2u*)(p + 4 * lane + 256 * j); v[j] = (f32x4){bflo(w.x), bfhi(w.x), bflo(w.y), bfhi(w.y)}; }
}
__device__ __forceinline__ void row_store_bf16(bf16* p, int lane, const f32x4 (&v)[4]) {
#pragma unroll
    for (int j = 0; j < 4; ++j) { v2u w; w.x = pk2(v[j][0], v[j][1]); w.y = pk2(v[j][2], v[j][3]); *(v2u*)(p + 4 * lane + 256 * j) = w; }
}
__device__ __forceinline__ void row_store_f32(float* p, int lane, const f32x4 (&v)[4]) {
#pragma unroll
    for (int j = 0; j < 4; ++j) *(f32x4*)(p + 4 * lane + 256 * j) = v[j];
}
__device__ __forceinline__ void row_ln(f32x4 (&v)[4], const float* g, const float* b, int lane) {
    float s = 0.f;
#pragma unroll
    for (int j = 0; j < 4; ++j) s += (v[j][0] + v[j][1]) + (v[j][2] + v[j][3]);
    const float mean = wave_sum(s) * (1.0f / D); float q = 0.f;
#pragma unroll
    for (int j = 0; j < 4; ++j) { v[j] = v[j] - mean; q += (v[j][0] * v[j][0] + v[j][1] * v[j][1]) + (v[j][2] * v[j][2] + v[j][3] * v[j][3]); }
    const float rstd = 1.0f / sqrtf(wave_sum(q) * (1.0f / D) + LN_EPS);
#pragma unroll
    for (int j = 0; j < 4; ++j) { const f32x4 gg = *(const f32x4*)(g + 4 * lane + 256 * j), bb = *(const f32x4*)(b + 4 * lane + 256 * j); v[j] = v[j] * rstd * gg + bb; }
}
__device__ __forceinline__ const float* modp(Frame& F, int layer, int mr, int part) { return WSP(float, WS_MOD) + (size_t)(layer * 9 + mr) * 6144 + part * 1024; }
__device__ __forceinline__ void row_modulate(f32x4 (&v)[4], const float* sh, const float* sc, int lane) {
#pragma unroll
    for (int j = 0; j < 4; ++j) { const f32x4 a = *(const f32x4*)(sc + 4 * lane + 256 * j), b = *(const f32x4*)(sh + 4 * lane + 256 * j); v[j] = v[j] * (1.0f + a) + b; }
}
__device__ __forceinline__ void p_h0(Frame& F) {
    const int gw = F.vcu * NWAVES + F.wave, NGW = F.G * NWAVES, lane = (opq((int)threadIdx.x) & 63);
    for (int r = gw; r < MT; r += NGW) { const int mr = r < NL ? (r >> 12) : 8; const float* xr = r < NL ? F.x + (size_t)r * D : F.ctx + (size_t)(r - NL) * D;
        f32x4 v[4]; row_load_f32(xr, lane, v); row_modulate(v, modp(F, 0, mr, 0), modp(F, 0, mr, 1), lane); row_store_bf16(WSP(bf16, WS_ACT) + (size_t)r * D, lane, v); }
}
__device__ __forceinline__ void p_ln1(Frame& F, int layer) {
    const int lane = (opq((int)threadIdx.x) & 63);
    if (layer == 0) {
        const int gw = F.vcu * NWAVES + F.wave, NGW = F.G * NWAVES;
        for (int r = gw; r < MT; r += NGW) { const int mr = r < NL ? (r >> 12) : 8; const float* xr = r < NL ? F.x + (size_t)r * D : F.ctx + (size_t)(r - NL) * D;
            float* xo = r < NL ? F.out + (size_t)r * D : WSP(float, WS_XC) + (size_t)(r - NL) * D; bf16* ar = WSP(bf16, WS_ACT) + (size_t)r * D;
            f32x4 v[4], y[4]; row_load_f32(xr, lane, v); row_load_bf16(ar, lane, y); const float* g1 = modp(F, 0, mr, 2);
#pragma unroll
            for (int j = 0; j < 4; ++j) v[j] = ALPHA * v[j] + *(const f32x4*)(g1 + 4 * lane + 256 * j) * y[j];
            row_ln(v, F.ln1_g, F.ln1_b, lane); row_store_f32(xo, lane, v);
            row_modulate(v, modp(F, 0, mr, 3), modp(F, 0, mr, 4), lane); row_store_bf16(ar, lane, v); }
        return;
    }
    LAS int* lcnt = (LAS int*)F.lds; LAS int* lbase = lcnt + 8; LAS int* rinfo = lcnt + 16;
    float rt[16][8];
#pragma unroll
    for (int j = 0; j < 4; ++j)
#pragma unroll
        for (int q = 0; q < 4; ++q) { const float* rp = F.router + (size_t)(4 * lane + 256 * j + q) * 8; const f32x4 a = *(const f32x4*)rp, b = *(const f32x4*)(rp + 4);
            rt[j * 4 + q][0] = a[0]; rt[j * 4 + q][1] = a[1]; rt[j * 4 + q][2] = a[2]; rt[j * 4 + q][3] = a[3]; rt[j * 4 + q][4] = b[0]; rt[j * 4 + q][5] = b[1]; rt[j * 4 + q][6] = b[2]; rt[j * 4 + q][7] = b[3]; }
    for (int rb = blockIdx.x; rb < NL / 128; rb += F.G) {
        if ((int)threadIdx.x < 8) lcnt[threadIdx.x] = 0;
        __syncthreads();
        for (int i = 0; i < 16; ++i) { const int rl = F.wave * 16 + i, r = rb * 128 + rl, mr = r >> 12;
            float* xo = F.out + (size_t)r * D; bf16* ar = WSP(bf16, WS_ACT) + (size_t)r * D;
            f32x4 v[4], y[4]; row_load_f32(xo, lane, v); row_load_bf16(ar, lane, y); const float* g1 = modp(F, 1, mr, 2);
#pragma unroll
            for (int j = 0; j < 4; ++j) v[j] = ALPHA * v[j] + *(const f32x4*)(g1 + 4 * lane + 256 * j) * y[j];
            row_ln(v, F.ln1_g + D, F.ln1_b + D, lane); row_store_f32(xo, lane, v);
            row_modulate(v, modp(F, 1, mr, 3), modp(F, 1, mr, 4), lane);
            { unsigned char* t8 = WSP(unsigned char, WS_T8) + (size_t)r * D;
#pragma unroll
              for (int j = 0; j < 4; ++j) *(unsigned*)(t8 + 4 * lane + 256 * j) = pk4_fp8s(v[j][0], v[j][1], v[j][2], v[j][3], 4.0f); }
            float lg[8];
#pragma unroll
            for (int e = 0; e < 8; ++e) { float s = 0.f;
#pragma unroll
                for (int j = 0; j < 4; ++j)
#pragma unroll
                    for (int q = 0; q < 4; ++q) s += v[j][q] * rt[j * 4 + q][e];
                lg[e] = wave_sum(s); }
            int i1 = 0; float v1 = lg[0];
#pragma unroll
            for (int e = 1; e < 8; ++e) if (lg[e] > v1) { v1 = lg[e]; i1 = e; }
            int i2 = -1; float v2 = -3.0e38f;
#pragma unroll
            for (int e = 0; e < 8; ++e) if (e != i1 && lg[e] > v2) { v2 = lg[e]; i2 = e; }
            const float ex = __expf(v2 - v1), w1 = 1.0f / (1.0f + ex), w2 = ex / (1.0f + ex);
            if (lane == 0) { const int p1 = __hip_atomic_fetch_add(lcnt + i1, 1, __ATOMIC_RELAXED, __HIP_MEMORY_SCOPE_WORKGROUP), p2 = __hip_atomic_fetch_add(lcnt + i2, 1, __ATOMIC_RELAXED, __HIP_MEMORY_SCOPE_WORKGROUP);
                LAS int* ri = rinfo + rl * 6; ri[0] = i1; ri[1] = p1; ri[2] = __float_as_int(w1); ri[3] = i2; ri[4] = p2; ri[5] = __float_as_int(w2); }
        }
        __syncthreads();
        if ((int)threadIdx.x < 8) lbase[threadIdx.x] = (int)__hip_atomic_fetch_add((unsigned*)(WSP(unsigned, WS_CTL) + CW_GCNT + 64 * threadIdx.x), (unsigned)lcnt[threadIdx.x], RLX_AGENT);
        __syncthreads();
        if ((int)threadIdx.x < 256) { const int rl = (int)threadIdx.x >> 1, s = (int)threadIdx.x & 1; const LAS int* ri = rinfo + rl * 6 + 3 * s; const int e = ri[0], pos = lbase[e] + ri[1];
            WSP(int, WS_LIST)[e * LCAP + pos] = ((rb * 128 + rl) << 1) | s; WSP(float, WS_LGATE)[e * LCAP + pos] = __int_as_float(ri[2]); }
        __syncthreads();
    }
}
__device__ __forceinline__ void p_ln2_l0(Frame& F) {
    const int lane = (opq((int)threadIdx.x) & 63), gw = F.vcu * NWAVES + F.wave, NGW = F.G * NWAVES;
    for (int r = gw; r < MT; r += NGW) { const int mr = r < NL ? (r >> 12) : 8;
        float* xo = r < NL ? F.out + (size_t)r * D : WSP(float, WS_XC) + (size_t)(r - NL) * D; bf16* ar = WSP(bf16, WS_ACT) + (size_t)r * D;
        f32x4 v[4], y[4]; row_load_f32(xo, lane, v); row_load_bf16(ar, lane, y); const float* g2 = modp(F, 0, mr, 5);
#pragma unroll
        for (int j = 0; j < 4; ++j) v[j] = ALPHA * v[j] + *(const f32x4*)(g2 + 4 * lane + 256 * j) * y[j];
        row_ln(v, F.ln2_g, F.ln2_b, lane); row_store_f32(xo, lane, v);
        row_modulate(v, modp(F, 1, mr, 0), modp(F, 1, mr, 1), lane); row_store_bf16(ar, lane, v); }
}
__device__ __forceinline__ void p_final(Frame& F) {
    const int lane = (opq((int)threadIdx.x) & 63), gw = F.vcu * NWAVES + F.wave, NGW = F.G * NWAVES;
    for (int r = gw; r < NL; r += NGW) { const int mr = r >> 12; float* xo = F.out + (size_t)r * D;
        f32x4 v[4], y0[4], y1[4]; row_load_f32(xo, lane, v); row_load_bf16(WSP(bf16, WS_Y) + (size_t)r * D, lane, y0); row_load_bf16(WSP(bf16, WS_Y) + (size_t)(NL + r) * D, lane, y1); const float* g2 = modp(F, 1, mr, 5);
#pragma unroll
        for (int j = 0; j < 4; ++j) v[j] = ALPHA * v[j] + *(const f32x4*)(g2 + 4 * lane + 256 * j) * (y0[j] + y1[j]);
        row_ln(v, F.ln2_g + D, F.ln2_b + D, lane);
#if defined(ATTN_CHECK) || defined(MIX_CHECK)
        if ((__hip_atomic_load(WSP(unsigned, WS_CTL) + 8, RLX_AGENT) | __hip_atomic_load(WSP(unsigned, WS_CTL) + 9, RLX_AGENT) * CHK_POOL | __hip_atomic_load(WSP(unsigned, WS_CTL) + 10, RLX_AGENT) * CHK_KV | __hip_atomic_load(WSP(unsigned, WS_CTL) + 11, RLX_AGENT) * CHK_RET) != 0u) { const float qn = 0.0f;
#pragma unroll
            for (int j = 0; j < 4; ++j) v[j] = (f32x4){qn, qn, qn, qn}; }
#endif
        row_store_f32(xo, lane, v); }
}

__device__ __forceinline__ int chunk_row0(int b, int cid) { return cid < 2 ? NL + b * CTXL + cid * 128 : b * SEQ + (cid - 2) * 128; }
namespace att {
using bf16x8 = __attribute__((ext_vector_type(8))) short;
using s16x4 = __attribute__((ext_vector_type(4))) short;
using f32x16 = __attribute__((ext_vector_type(16))) float;
using u32x4 = __attribute__((ext_vector_type(4))) unsigned;
typedef short v4i16_t __attribute__((ext_vector_type(4)));
typedef __attribute__((address_space(3))) const char* lds_cptr;
constexpr int SLOTB = 8192, LDS_K = 0, LDS_V = 2 * SLOTB, LDS_WS = 4 * SLOTB, LDS_OST = LDS_WS + 8 * 256, LDS_TOTAL = LDS_OST + 8 * 4096;
constexpr float THR = 8.0f, NEGBIG = -1.0e30f;
__device__ __forceinline__ int crow(int r, int hi) { return (r & 3) + 8 * (r >> 2) + 4 * hi; }
__device__ __forceinline__ void glds16(const void* gsrc, unsigned lds_dst) { unsigned keep;
    asm volatile("s_mov_b32 %0, m0\n\ts_mov_b32 m0, %2\n\ts_nop 0\n\tglobal_load_lds_dwordx4 %1, off\n\ts_mov_b32 m0, %0" : "=&s"(keep) : "v"(gsrc), "s"(lds_dst) : "memory"); }
__device__ __forceinline__ s16x4 vtr(lds_cptr p) { return __builtin_bit_cast(s16x4, __builtin_amdgcn_ds_read_tr16_b64_v4i16((__attribute__((address_space(3))) v4i16_t*)p)); }
__device__ __forceinline__ unsigned cvtpk(float lo, float hi) { f32x2_t v = {lo, hi}; bf16x2_t b = __builtin_convertvector(v, bf16x2_t); return __builtin_bit_cast(unsigned, b); }

__device__ __forceinline__ void attn_unit(Frame& F, int layer, int b, int qb, int kvh, bool isctx) {
    const int tid = opq((int)threadIdx.x), lane = tid & 63, r32 = lane & 31, hi = lane >> 5; const int wid = __builtin_amdgcn_readfirstlane(tid >> 6);
    const int g = wid >> 1, qh = wid & 1, head = kvh * 4 + g;
    const bf16* P = WSP(bf16, WS_PROJ);
    const int qrow0 = (isctx ? NL + b * CTXL : b * SEQ) + qb * 128 + qh * 64;
    const int tlo = isctx ? 0 : (qb == 0 ? 2 : 0), thi = isctx ? 0 : (qb == SEQ / 128 - 1 ? 4 : 6), nloc = thi - tlo, ntiles = nloc + 4;
    const lds_cptr shm = (lds_cptr)F.lds; const unsigned lds0 = (unsigned)(uintptr_t)F.lds;
    LAS float* wsf = (LAS float*)(F.lds + LDS_WS) + wid * 64;
    bf16x8 qr[2][4];
#pragma unroll
    for (int rb = 0; rb < 2; ++rb)
#pragma unroll
        for (int d0 = 0; d0 < 4; ++d0) qr[rb][d0] = *(const bf16x8*)(P + (size_t)(qrow0 + 32 * rb + r32) * INW + head * 64 + d0 * 16 + hi * 8);
    float m[2], l[2]; f32x16 o[2][2];
    { const float s0 = F.sink[layer * 8 + head] * LOG2E;
#pragma unroll
      for (int rb = 0; rb < 2; ++rb) { m[rb] = s0; l[rb] = hi == 0 ? 1.0f : 0.0f; o[rb][0] = f32x16{}; o[rb][1] = f32x16{}; } }
    auto tile_row = [&](int i) -> int { return i < nloc ? b * SEQ + qb * 128 - 128 + 64 * (tlo + i) : NL + b * CTXL + 64 * (i - nloc); };
    auto dma = [&](int i) { const int kr = tile_row(i); const unsigned slot = (unsigned)(i & 1) * SLOTB;
        glds16(P + (size_t)(kr + lane) * INW + C_K + kvh * 64 + wid * 8, (unsigned)__builtin_amdgcn_readfirstlane(lds0 + LDS_K + slot + wid * 1024));
        glds16(P + (size_t)(kr + 16 * (wid & 3) + (lane >> 2)) * INW + C_V + kvh * 64 + (wid >> 2) * 32 + (lane & 3) * 8, (unsigned)__builtin_amdgcn_readfirstlane(lds0 + LDS_V + slot + wid * 1024)); };
    dma(0);
    for (int i = 0; i < ntiles; ++i) {
        if (i + 1 < ntiles) { dma(i + 1); asm volatile("s_waitcnt vmcnt(2)\n\ts_barrier" ::: "memory"); }
        else asm volatile("s_waitcnt vmcnt(0)\n\ts_barrier" ::: "memory");
        const lds_cptr kp = shm + LDS_K + (i & 1) * SLOTB + hi * 1024 + r32 * 16;
        const lds_cptr vp = shm + LDS_V + (i & 1) * SLOTB + ((lane >> 4) & 1) * 32 + (lane & 3) * 8 + (4 * hi + ((lane & 15) >> 2)) * 64;
        const bool local = i < nloc; const int c = local ? 128 - 64 * (tlo + i) : 0;
#pragma unroll
        for (int rb = 0; rb < 2; ++rb) {
            const int q0 = qh * 64 + rb * 32;
            bool partial = false;
            if (local) { const int dlo = q0 - 63 + c, dhi = q0 + 31 + c; if (dlo > 128 || dhi < -128) continue; partial = !(dlo >= -128 && dhi <= 128); }
            f32x16 p0, p1; { const float nm = -m[rb];
#pragma unroll
                for (int r = 0; r < 16; ++r) { p0[r] = nm; p1[r] = nm; } }
#pragma unroll
            for (int d0 = 0; d0 < 4; ++d0) { const bf16x8 k0 = *(const __attribute__((address_space(3))) bf16x8*)(kp + d0 * 2048), k1 = *(const __attribute__((address_space(3))) bf16x8*)(kp + d0 * 2048 + 512);
                p0 = __builtin_amdgcn_mfma_f32_32x32x16_bf16(k0, qr[rb][d0], p0, 0, 0, 0); p1 = __builtin_amdgcn_mfma_f32_32x32x16_bf16(k1, qr[rb][d0], p1, 0, 0, 0); }
            if (partial) { const int qq = q0 + r32 + c;
#pragma unroll
                for (int r = 0; r < 16; ++r) { const int dl = qq - crow(r, hi); if (dl > 128 || dl < -128) p0[r] = NEGBIG; if (dl - 32 > 128 || dl - 32 < -128) p1[r] = NEGBIG; } }
            float rm = fmaxf(p0[0], p1[0]);
#pragma unroll
            for (int r = 1; r < 16; ++r) rm = fmaxf(rm, fmaxf(p0[r], p1[r]));
            { auto rr = __builtin_amdgcn_permlane32_swap(__float_as_uint(rm), __float_as_uint(rm), false, false); rm = fmaxf(__uint_as_float(rr[0]), __uint_as_float(rr[1])); }
            if (__any(rm > THR)) {
                const float dl = fmaxf(rm, 0.f); m[rb] += dl;
#pragma unroll
                for (int r = 0; r < 16; ++r) { p0[r] -= dl; p1[r] -= dl; }
                const float f = __builtin_amdgcn_exp2f(-dl); l[rb] *= f; if (hi == 0) wsf[r32] = f;
                asm volatile("s_waitcnt lgkmcnt(0)" ::: "memory");
#pragma unroll
                for (int r = 0; r < 16; ++r) { const float fr = wsf[crow(r, hi)]; o[rb][0][r] *= fr; o[rb][1][r] *= fr; }
            }
            float sacc = 0.f;
#pragma unroll
            for (int r = 0; r < 16; ++r) { p0[r] = __builtin_amdgcn_exp2f(p0[r]); p1[r] = __builtin_amdgcn_exp2f(p1[r]); sacc += p0[r] + p1[r]; }
            l[rb] += sacc;
            u32x4 pw[4];
#pragma unroll
            for (int k = 0; k < 4; ++k) { pw[0][k] = cvtpk(p0[2 * k], p0[2 * k + 1]); pw[1][k] = cvtpk(p0[8 + 2 * k], p0[9 + 2 * k]); pw[2][k] = cvtpk(p1[2 * k], p1[2 * k + 1]); pw[3][k] = cvtpk(p1[8 + 2 * k], p1[9 + 2 * k]); }
#pragma unroll
            for (int d0 = 0; d0 < 2; ++d0) {
#pragma unroll
                for (int ks = 0; ks < 4; ++ks) { const s16x4 lo = vtr(vp + d0 * 4096 + ks * 1024), hh = vtr(vp + d0 * 4096 + ks * 1024 + 512);
                    const bf16x8 vf = (bf16x8){lo[0], lo[1], lo[2], lo[3], hh[0], hh[1], hh[2], hh[3]};
                    o[rb][d0] = __builtin_amdgcn_mfma_f32_32x32x16_bf16(__builtin_bit_cast(bf16x8, pw[ks]), vf, o[rb][d0], 0, 0, 0); } }
        }
        asm volatile("s_waitcnt lgkmcnt(0)\n\ts_barrier" ::: "memory");
    }
    LAS bf16* stg = (LAS bf16*)(F.lds + LDS_OST) + wid * 2048;
#pragma unroll
    for (int rb = 0; rb < 2; ++rb) {
        float lt = l[rb]; { auto rr = __builtin_amdgcn_permlane32_swap(__float_as_uint(lt), __float_as_uint(lt), false, false); lt = __uint_as_float(rr[0]) + __uint_as_float(rr[1]); }
        if (hi == 0) wsf[r32] = 1.0f / lt;
        asm volatile("s_waitcnt lgkmcnt(0)" ::: "memory");
#pragma unroll
        for (int r = 0; r < 16; ++r) { const float rl = wsf[crow(r, hi)]; const int orow = crow(r, hi);
            stg[orow * 64 + r32] = (bf16)(pk2(o[rb][0][r] * rl, 0.f) & 0xffffu); stg[orow * 64 + 32 + r32] = (bf16)(pk2(o[rb][1][r] * rl, 0.f) & 0xffffu); }
        asm volatile("s_waitcnt lgkmcnt(0)" ::: "memory");
        bf16* Ow = WSP(bf16, WS_MIX) + (size_t)(qrow0 + 32 * rb) * D + head * 64;
#pragma unroll
        for (int k = 0; k < 4; ++k) { const int row = k * 8 + (lane >> 3), ch = lane & 7; const v4u v = *(const LAS v4u*)(stg + row * 64 + ch * 8); *(v4u*)(Ow + (size_t)row * D + ch * 8) = v; }
        asm volatile("s_waitcnt lgkmcnt(0)" ::: "memory");
    }
}
}
__device__ __forceinline__ void p_attn(Frame& F, int layer) {
    const int vcu = (blockIdx.x % 8) * (F.G / 8) + blockIdx.x / 8;
    for (int u = vcu * 2; u < 512; u += 2 * F.G) { att::attn_unit(F, layer, u >> 6, (u >> 1) & 31, u & 1, false); att::attn_unit(F, layer, (u + 1) >> 6, ((u + 1) >> 1) & 31, (u + 1) & 1, false); }
    if (layer == 0) for (int v = blockIdx.x; v < 32; v += F.G) att::attn_unit(F, layer, v >> 2, (v >> 1) & 1, v & 1, true);
}
namespace mixb {
using att::bf16x8; using att::s16x4; using att::f32x16; using att::u32x4; using att::lds_cptr; using att::vtr; using att::crow; using att::cvtpk;
__device__ __forceinline__ bf16x8 tr_pair(lds_cptr p, int second_off) { const s16x4 lo = vtr(p), hh = vtr(p + second_off); return (bf16x8){lo[0], lo[1], lo[2], lo[3], hh[0], hh[1], hh[2], hh[3]}; }
__device__ __forceinline__ void unpack8(const v4u w, float (&f)[8]) { f[0] = bflo(w.x); f[1] = bfhi(w.x); f[2] = bflo(w.y); f[3] = bfhi(w.y); f[4] = bflo(w.z); f[5] = bfhi(w.z); f[6] = bflo(w.w); f[7] = bfhi(w.w); }
__device__ __forceinline__ v4u pack8(const float (&f)[8]) { v4u w; w.x = pk2(f[0], f[1]); w.y = pk2(f[2], f[3]); w.z = pk2(f[4], f[5]); w.w = pk2(f[6], f[7]); return w; }
__device__ __forceinline__ float half_sum(float v) {
#pragma unroll
    for (int o = 1; o < 32; o <<= 1) v += __shfl_xor(v, o);
    return v;
}
__device__ __forceinline__ void kv_unit(Frame& F, int layer, int b, int cid, int hp) {
    const int tid = opq((int)threadIdx.x), lane = tid & 63, r32 = lane & 31, hi = lane >> 5; const int wid = __builtin_amdgcn_readfirstlane(tid >> 6);
    const bf16* P = WSP(bf16, WS_PROJ); const int row0 = chunk_row0(b, cid);
    __syncthreads();
#pragma unroll
    for (int it = 0; it < 2; ++it) { const int idx = tid + it * NTHR, hs = idx >> 9, t = (idx >> 2) & 127, c = idx & 3, h = 2 * hp + hs;
        const v4u w = *(const v4u*)(P + (size_t)(row0 + t) * INW + C_RK + h * 32 + c * 8); float f[8], a[8], bb[8]; unpack8(w, f);
        const float wf = __expf(F.lgf[layer * 4 + h] * (float)(127 - t)), wb = __expf(F.lgb[layer * 4 + h] * (float)t);
#pragma unroll
        for (int j = 0; j < 8; ++j) { a[j] = f[j] * wf; bb[j] = f[j] * wb; }
        LAS unsigned char* d = F.lds + hs * 32768 + t * 64 + c * 16; *(LAS v4u*)d = pack8(a); *(LAS v4u*)(d + 8192) = pack8(bb); }
#pragma unroll
    for (int it = 0; it < 4; ++it) { const int idx = tid + it * NTHR, hs = idx >> 10, t = (idx >> 3) & 127, c = idx & 7, h = 2 * hp + hs;
        *(LAS v4u*)(F.lds + hs * 32768 + 16384 + (c >> 2) * 8192 + t * 64 + (c & 3) * 16) = *(const v4u*)(P + (size_t)(row0 + t) * INW + C_RV + h * 64 + c * 8); }
    __syncthreads();
    const int hs = wid >> 2, h = 2 * hp + hs, dir = (wid >> 1) & 1, eh = wid & 1;
    const int natoff = (8 * hi + ((lane & 15) >> 2)) * 64 + ((lane >> 4) & 1) * 32 + (lane & 3) * 8;
    const lds_cptr ab = (lds_cptr)F.lds + hs * 32768 + dir * 8192 + natoff, bb = (lds_cptr)F.lds + hs * 32768 + 16384 + eh * 8192 + natoff;
    f32x16 acc = f32x16{};
#pragma unroll
    for (int ks = 0; ks < 8; ++ks) acc = __builtin_amdgcn_mfma_f32_32x32x16_bf16(tr_pair(ab + ks * 1024, 256), tr_pair(bb + ks * 1024, 256), acc, 0, 0, 0);
    float* dst = WSP(float, WS_KVS) + ((size_t)((dir * 8 + b) * 4 + h) * NCHK + cid) * 2048 + 32 * eh + r32;
#pragma unroll
    for (int r = 0; r < 16; ++r) dst[crow(r, hi) * 64] = acc[r];
}
__device__ __forceinline__ void ret_unit(Frame& F, int layer, int b, int cid, int hp) {
    const int tid = opq((int)threadIdx.x), lane = tid & 63, r32 = lane & 31, hi = lane >> 5; const int wid = __builtin_amdgcn_readfirstlane(tid >> 6);
    const bf16* P = WSP(bf16, WS_PROJ); const int row0 = chunk_row0(b, cid);
    constexpr int HB = 40960;
    __syncthreads();
#pragma unroll
    for (int it = 0; it < 2; ++it) { const int idx = tid + it * NTHR, hs = idx >> 9, t = (idx >> 2) & 127, c = idx & 3, h = 2 * hp + hs;
        const v4u w = *(const v4u*)(P + (size_t)(row0 + t) * INW + C_RK + h * 32 + c * 8); float f[8], a[8], bb[8]; unpack8(w, f);
        const float sf = __expf(-F.lgf[layer * 4 + h] * (float)t), sb = __expf(F.lgb[layer * 4 + h] * (float)t);
#pragma unroll
        for (int j = 0; j < 8; ++j) { a[j] = f[j] * sf; bb[j] = f[j] * sb; }
        LAS unsigned char* d = F.lds + hs * HB + c * 2048 + t * 16; *(LAS v4u*)d = pack8(a); *(LAS v4u*)(d + 8192) = pack8(bb); }
#pragma unroll
    for (int it = 0; it < 4; ++it) { const int idx = tid + it * NTHR, hs = idx >> 10, t = (idx >> 3) & 127, c = idx & 7, h = 2 * hp + hs;
        *(LAS v4u*)(F.lds + hs * HB + 16384 + (c >> 2) * 8192 + t * 64 + (c & 3) * 16) = *(const v4u*)(P + (size_t)(row0 + t) * INW + C_RV + h * 64 + c * 8); }
#pragma unroll
    for (int it = 0; it < 4; ++it) { const int idx = tid + it * NTHR, hs = idx >> 10, dir = (idx >> 9) & 1, d = (idx >> 4) & 31, e4 = idx & 15, h = 2 * hp + hs;
        const f32x4 v = *(const f32x4*)(WSP(float, WS_KVS) + ((size_t)((dir * 8 + b) * 4 + h) * NCHK + cid) * 2048 + d * 64 + e4 * 4);
        const float fac = dir ? __expf(F.lgb[layer * 4 + h] * 128.0f) : __expf(F.lgf[layer * 4 + h]);
        v2u w; w.x = pk2(v[0] * fac, v[1] * fac); w.y = pk2(v[2] * fac, v[3] * fac);
        *(LAS v2u*)(F.lds + hs * HB + 32768 + dir * 4096 + (e4 >> 3) * 2048 + d * 64 + (e4 & 7) * 8) = w; }
    __syncthreads();
    const int hs = wid >> 2, h = 2 * hp + hs, qb = wid & 3, n = 32 * qb + r32;
    const lds_cptr hb = (lds_cptr)F.lds + hs * HB;
    bf16x8 qf[2], qbk[2];
    { const float sf = __expf(F.lgf[layer * 4 + h] * (float)n), sb = __expf(-F.lgb[layer * 4 + h] * (float)n);
#pragma unroll
      for (int ks = 0; ks < 2; ++ks) { const v4u w = *(const v4u*)(P + (size_t)(row0 + n) * INW + C_RQ + h * 32 + 16 * ks + 8 * hi); float f[8], a[8], bb[8]; unpack8(w, f);
#pragma unroll
          for (int j = 0; j < 8; ++j) { a[j] = f[j] * sf; bb[j] = f[j] * sb; }
          qf[ks] = __builtin_bit_cast(bf16x8, pack8(a)); qbk[ks] = __builtin_bit_cast(bf16x8, pack8(bb)); } }
    const int qoff = ((lane & 15) >> 2) * 64 + ((lane >> 4) & 1) * 32 + (lane & 3) * 8;
    const int natoff = 8 * hi * 64 + qoff, permoff = 4 * hi * 64 + qoff;
    f32x16 o[2]; o[0] = f32x16{}; o[1] = f32x16{};
#pragma unroll
    for (int eh = 0; eh < 2; ++eh)
#pragma unroll
        for (int ks = 0; ks < 2; ++ks) {
            o[eh] = __builtin_amdgcn_mfma_f32_32x32x16_bf16(qf[ks], tr_pair(hb + 32768 + eh * 2048 + ks * 1024 + natoff, 256), o[eh], 0, 0, 0);
            o[eh] = __builtin_amdgcn_mfma_f32_32x32x16_bf16(qbk[ks], tr_pair(hb + 36864 + eh * 2048 + ks * 1024 + natoff, 256), o[eh], 0, 0, 0); }
#pragma unroll
    for (int kb = 0; kb < 4; ++kb) {
        f32x16 x = f32x16{};
        if (kb <= qb) { f32x16 xf = f32x16{};
#pragma unroll
            for (int ks = 0; ks < 2; ++ks) xf = __builtin_amdgcn_mfma_f32_32x32x16_bf16(*(const __attribute__((address_space(3))) bf16x8*)(hb + (2 * ks + hi) * 2048 + (32 * kb + r32) * 16), qf[ks], xf, 0, 0, 0);
            if (kb == qb) {
#pragma unroll
                for (int r = 0; r < 16; ++r) xf[r] = crow(r, hi) <= r32 ? xf[r] : 0.f; }
            x = xf; }
        if (kb >= qb) { f32x16 xb = f32x16{};
#pragma unroll
            for (int ks = 0; ks < 2; ++ks) xb = __builtin_amdgcn_mfma_f32_32x32x16_bf16(*(const __attribute__((address_space(3))) bf16x8*)(hb + 8192 + (2 * ks + hi) * 2048 + (32 * kb + r32) * 16), qbk[ks], xb, 0, 0, 0);
            if (kb == qb) {
#pragma unroll
                for (int r = 0; r < 16; ++r) xb[r] = crow(r, hi) >= r32 ? xb[r] : 0.f; }
            x = x + xb; }
        u32x4 pw[2];
#pragma unroll
        for (int k = 0; k < 4; ++k) { pw[0][k] = cvtpk(x[2 * k], x[2 * k + 1]); pw[1][k] = cvtpk(x[8 + 2 * k], x[9 + 2 * k]); }
#pragma unroll
        for (int eh = 0; eh < 2; ++eh)
#pragma unroll
            for (int k2 = 0; k2 < 2; ++k2) o[eh] = __builtin_amdgcn_mfma_f32_32x32x16_bf16(__builtin_bit_cast(bf16x8, pw[k2]), tr_pair(hb + 16384 + eh * 8192 + (32 * kb + 16 * k2) * 64 + permoff, 512), o[eh], 0, 0, 0);
    }
    LAS float* stg = (LAS float*)(F.lds + 2 * HB) + wid * 2048;
#pragma unroll
    for (int r = 0; r < 16; ++r) { const float mean = half_sum(o[0][r] + o[1][r]) * (1.0f / 64.0f); const float d0 = o[0][r] - mean, d1 = o[1][r] - mean;
        const float rstd = 1.0f / sqrtf(half_sum(d0 * d0 + d1 * d1) * (1.0f / 64.0f) + LN_EPS);
        stg[crow(r, hi) * 64 + r32] = d0 * rstd; stg[crow(r, hi) * 64 + 32 + r32] = d1 * rstd; }
    asm volatile("s_waitcnt lgkmcnt(0)" ::: "memory");
#pragma unroll
    for (int k = 0; k < 4; ++k) { const int row = k * 8 + (lane >> 3), ch = lane & 7; const size_t grow = (size_t)(row0 + 32 * qb + row);
        const f32x4 v0 = *(const LAS f32x4*)(stg + row * 64 + ch * 8), v1 = *(const LAS f32x4*)(stg + row * 64 + ch * 8 + 4);
        float rg[8], y[8]; unpack8(*(const v4u*)(P + grow * INW + C_RG + h * 64 + ch * 8), rg);
#pragma unroll
        for (int j = 0; j < 8; ++j) y[j] = rg[j] * __builtin_amdgcn_rcpf(1.0f + __builtin_amdgcn_exp2f(-LOG2E * rg[j])) * (j < 4 ? v0[j] : v1[j - 4]);
        *(v4u*)(WSP(bf16, WS_MIX) + grow * D + 768 + h * 64 + ch * 8) = pack8(y); }
}
__device__ __forceinline__ void pool_unit(Frame& F, int layer, int s, int blk) {
    const int tid = opq((int)threadIdx.x), lane = tid & 63, r32 = lane & 31, hi = lane >> 5; const int wid = __builtin_amdgcn_readfirstlane(tid >> 6);
    const bool isctx = s >= 8; const int b = s & 7, len = isctx ? CTXL : SEQ, row0 = isctx ? NL + b * CTXL : b * SEQ, t0 = blk * 128;
    const bf16* P = WSP(bf16, WS_PROJ);
    constexpr int UST = 528, PWB = 144 * UST, PST = 144;
    __syncthreads();
#pragma unroll
    for (int it = 0; it < 9; ++it) { const int idx = tid + it * NTHR, rr = idx >> 5, c = idx & 31, t = t0 - 8 + rr; v4u w = (v4u){0u, 0u, 0u, 0u};
        if (t >= 0 && t < len) w = *(const v4u*)(P + (size_t)(row0 + t) * INW + C_U + c * 8);
        *(LAS v4u*)(F.lds + rr * UST + c * 16) = w; }
    for (int idx = tid; idx < 16384; idx += NTHR) { const int g = idx >> 12, c = (idx >> 6) & 63, d = idx & 63;
        *(LAS bf16*)(F.lds + PWB + (g * 64 + d) * PST + c * 2) = (bf16)(pk2(F.pool_w[(size_t)layer * 16384 + idx], 0.f) & 0xffffu); }
    __syncthreads();
    const int rbk = wid & 3, ch = wid >> 2, t = 32 * rbk + r32, tt = t0 + t;
    const lds_cptr ub = (lds_cptr)F.lds + (t + 8) * UST + hi * 16;
    bf16* dstrow = WSP(bf16, WS_MIX) + (size_t)(row0 + tt) * D + 512 + 32 * ch + 4 * hi;
#pragma unroll
    for (int g = 0; g < 4; ++g) { const int hw = 1 << g; const float inv = 1.0f / (float)(min(tt + hw, len) - max(tt - hw, 0));
        f32x16 acc = f32x16{};
#pragma unroll
        for (int ks = 0; ks < 4; ++ks) { const lds_cptr up = ub + g * 128 + ks * 32; float sum[8], own[8];
#pragma unroll
            for (int j = 0; j < 8; ++j) sum[j] = 0.f;
#pragma unroll
            for (int dt = -hw; dt < hw; ++dt) { float f[8]; unpack8(*(const __attribute__((address_space(3))) v4u*)(up + dt * UST), f);
#pragma unroll
                for (int j = 0; j < 8; ++j) sum[j] += f[j]; }
            unpack8(*(const __attribute__((address_space(3))) v4u*)up, own);
#pragma unroll
            for (int j = 0; j < 8; ++j) sum[j] = sum[j] * inv - own[j];
            const bf16x8 df = __builtin_bit_cast(bf16x8, pack8(sum));
            const bf16x8 wf = *(const __attribute__((address_space(3))) bf16x8*)((lds_cptr)F.lds + PWB + (g * 64 + 32 * ch + r32) * PST + (16 * ks + 8 * hi) * 2);
            acc = __builtin_amdgcn_mfma_f32_32x32x16_bf16(wf, df, acc, 0, 0, 0); }
        const float* ps = F.pool_scale + layer * 256 + g * 64 + 32 * ch + 4 * hi;
#pragma unroll
        for (int rq = 0; rq < 4; ++rq) { const f32x4 sc = *(const f32x4*)(ps + 8 * rq); v2u w; w.x = pk2(acc[4 * rq] * sc[0], acc[4 * rq + 1] * sc[1]); w.y = pk2(acc[4 * rq + 2] * sc[2], acc[4 * rq + 3] * sc[3]);
            *(v2u*)(dstrow + g * 64 + 8 * rq) = w; }
    }
}
}
__device__ __forceinline__ void p_mix(Frame& F, int layer) {
    p_attn(F, layer);
    const int n_pool = 256 + (layer == 0 ? 16 : 0);
    for (int u = blockIdx.x; u < n_pool; u += F.G) { if (u < 256) mixb::pool_unit(F, layer, u >> 5, u & 31); else mixb::pool_unit(F, layer, 8 + ((u - 256) >> 1), (u - 256) & 1); }
    for (int u = blockIdx.x; u < 8 * NCHK * 2; u += F.G) mixb::kv_unit(F, layer, u / (NCHK * 2), (u >> 1) % NCHK, u & 1);
    __syncthreads();
}
__device__ __forceinline__ void p_ret(Frame& F, int layer) {
    for (int u = blockIdx.x; u < 8 * NCHK * 2; u += F.G) { const int cid = (u >> 1) % NCHK; if (layer == 1 && cid < 2) continue; mixb::ret_unit(F, layer, u / (NCHK * 2), cid, u & 1); }
    __syncthreads();
}
#if defined(MIX_CHECK)
__device__ __forceinline__ void chk(Frame& F, float a, float ref, float abs_t, float rel_t, int word) { const float d = fabsf(a - ref); if (!(d <= abs_t + rel_t * fabsf(ref))) atomicOr(WSP(unsigned, WS_CTL) + word, 1u); }
#endif
__device__ __forceinline__ void attn_naive_unit(Frame& F, int layer, int b, int qb, int kvh, bool isctx) {
    const int tid = opq((int)threadIdx.x), qq = tid & 127, g = tid >> 7, head = kvh * 4 + g;
    const bf16* P = WSP(bf16, WS_PROJ);
    const int qrow = isctx ? NL + b * CTXL + qb * 128 + qq : b * SEQ + qb * 128 + qq;
    LAS unsigned* kt = (LAS unsigned*)F.lds;
    LAS unsigned* vt = kt + 64 * 32;
    unsigned q[32];
#pragma unroll
    for (int i = 0; i < 8; ++i) { const v4u w = *(const v4u*)(P + (size_t)qrow * INW + head * 64 + i * 8); q[4 * i] = w.x; q[4 * i + 1] = w.y; q[4 * i + 2] = w.z; q[4 * i + 3] = w.w; }
    float m = F.sink[layer * 8 + head] * LOG2E, l = 1.0f, o[64];
#pragma unroll
    for (int d = 0; d < 64; ++d) o[d] = 0.f;
    const int qpos = qb * 128 + qq;
    for (int tile = isctx ? 6 : 0; tile < 10; ++tile) {
        int krow0, kpos0 = 0; const bool local = tile < 6;
        if (local) { kpos0 = qb * 128 - 128 + 64 * tile; if (kpos0 < 0 || kpos0 >= SEQ) continue; krow0 = b * SEQ + kpos0; }
        else krow0 = NL + b * CTXL + 64 * (tile - 6);
        __syncthreads();
        { const int r = tid >> 3, ch = tid & 7; const bf16* src = P + (size_t)(krow0 + r) * INW + kvh * 64 + ch * 8;
          *(LAS v4u*)(kt + r * 32 + ch * 4) = *(const v4u*)(src + C_K); *(LAS v4u*)(vt + r * 32 + ch * 4) = *(const v4u*)(src + C_V); }
        __syncthreads();
        for (int j = 0; j < 64; ++j) {
            float s = 0.f;
#pragma unroll
            for (int i = 0; i < 32; ++i) s = dot2bf(q[i], kt[j * 32 + i], s);
            const int dlt = qpos - (kpos0 + j); const bool valid = !local || (dlt <= 128 && dlt >= -128);
            if (valid) {
                if (s > m) { const float f = __builtin_amdgcn_exp2f(m - s); l *= f;
#pragma unroll
                    for (int d = 0; d < 64; ++d) o[d] *= f;
                    m = s; }
                const float p = __builtin_amdgcn_exp2f(s - m); l += p;
#pragma unroll
                for (int i = 0; i < 32; ++i) { const unsigned w = vt[j * 32 + i]; o[2 * i] += p * bflo(w); o[2 * i + 1] += p * bfhi(w); }
            }
        }
    }
    const float rl = 1.0f / l;
    bf16* dst = WSP(bf16, WS_MIX) + (size_t)qrow * D + head * 64;
#if defined(ATTN_CHECK)
    { bool bad = false;
#pragma unroll
      for (int i = 0; i < 8; ++i) { const v4u w = *(const v4u*)(dst + 8 * i); const float r8[8] = {bflo(w.x), bfhi(w.x), bflo(w.y), bfhi(w.y), bflo(w.z), bfhi(w.z), bflo(w.w), bfhi(w.w)};
#pragma unroll
          for (int k = 0; k < 8; ++k) { const float a = o[8 * i + k] * rl, d = fabsf(a - r8[k]); if (!(d <= ATTN_CHECK_ABS + ATTN_CHECK_REL * fabsf(a))) bad = true; } }
      if (bad) atomicOr(WSP(unsigned, WS_CTL) + 8, 1u); }
#endif
#pragma unroll
    for (int i = 0; i < 8; ++i) { v4u w; w.x = pk2(o[8 * i] * rl, o[8 * i + 1] * rl); w.y = pk2(o[8 * i + 2] * rl, o[8 * i + 3] * rl); w.z = pk2(o[8 * i + 4] * rl, o[8 * i + 5] * rl); w.w = pk2(o[8 * i + 6] * rl, o[8 * i + 7] * rl); *(v4u*)(dst + 8 * i) = w; }
    __syncthreads();
}
__device__ __forceinline__ void pool_naive_unit(Frame& F, int layer, int s, int blk) {
    const int tid = opq((int)threadIdx.x); const bool isctx = s >= 8; const int b = s & 7, len = isctx ? CTXL : SEQ, row0 = isctx ? NL + b * CTXL : b * SEQ, t0 = blk * 128;
    const bf16* P = WSP(bf16, WS_PROJ);
    LAS float* ub = (LAS float*)F.lds;
    LAS float* pwb = ub + 144 * 64;
    LAS float* db = pwb + 64 * 64;
    for (int g = 0; g < 4; ++g) { const int hw = 1 << g;
        __syncthreads();
        for (int idx = tid; idx < 144 * 8; idx += NTHR) { const int rr = idx >> 3, ch = idx & 7, t = t0 - 8 + rr; v4u w = (v4u){0u, 0u, 0u, 0u};
            if (t >= 0 && t < len) w = *(const v4u*)(P + (size_t)(row0 + t) * INW + C_U + g * 64 + ch * 8);
            LAS float* d = ub + rr * 64 + ch * 8; d[0] = bflo(w.x); d[1] = bfhi(w.x); d[2] = bflo(w.y); d[3] = bfhi(w.y); d[4] = bflo(w.z); d[5] = bfhi(w.z); d[6] = bflo(w.w); d[7] = bfhi(w.w); }
        for (int idx = tid; idx < 4096; idx += NTHR) pwb[idx] = F.pool_w[(size_t)(layer * 4 + g) * 4096 + idx];
        __syncthreads();
        for (int idx = tid; idx < 8192; idx += NTHR) { const int t = idx >> 6, c = idx & 63, tt = t0 + t; const int lo = max(tt - hw, 0), hi = min(tt + hw, len); float sum = 0.f;
            for (int p = lo; p < hi; ++p) sum += ub[(p - t0 + 8) * 64 + c];
            db[t * 65 + c] = sum / (float)(hi - lo) - ub[(t + 8) * 64 + c]; }
        __syncthreads();
        const int t = tid & 127, dq = tid >> 7; float acc[16];
#pragma unroll
        for (int i = 0; i < 16; ++i) acc[i] = 0.f;
        for (int c = 0; c < 64; ++c) { const float xv = db[t * 65 + c];
#pragma unroll
            for (int i = 0; i < 16; ++i) acc[i] += xv * pwb[c * 64 + dq * 16 + i]; }
        const float* ps = F.pool_scale + layer * 256 + g * 64 + dq * 16;
        bf16* dst = WSP(bf16, WS_MIX) + (size_t)(row0 + t0 + t) * D + 512 + g * 64 + dq * 16;
#if defined(MIX_CHECK)
#pragma unroll
        for (int i = 0; i < 2; ++i) { const v4u w = *(const v4u*)(dst + 8 * i); const float r8[8] = {bflo(w.x), bfhi(w.x), bflo(w.y), bfhi(w.y), bflo(w.z), bfhi(w.z), bflo(w.w), bfhi(w.w)};
#pragma unroll
            for (int k = 0; k < 8; ++k) chk(F, r8[k], acc[8 * i + k] * ps[8 * i + k], 0.02f, 0.03f, 9); }
#endif
#pragma unroll
        for (int i = 0; i < 2; ++i) { v4u w; w.x = pk2(acc[8 * i] * ps[8 * i], acc[8 * i + 1] * ps[8 * i + 1]); w.y = pk2(acc[8 * i + 2] * ps[8 * i + 2], acc[8 * i + 3] * ps[8 * i + 3]);
            w.z = pk2(acc[8 * i + 4] * ps[8 * i + 4], acc[8 * i + 5] * ps[8 * i + 5]); w.w = pk2(acc[8 * i + 6] * ps[8 * i + 6], acc[8 * i + 7] * ps[8 * i + 7]); *(v4u*)(dst + 8 * i) = w; }
    }
    __syncthreads();
}
__device__ __forceinline__ void kv_naive_unit(Frame& F, int layer, int b, int h, int cid) {
    const int tid = opq((int)threadIdx.x); const bf16* P = WSP(bf16, WS_PROJ); const int row0 = chunk_row0(b, cid);
    LAS float* kf = (LAS float*)F.lds;
    LAS float* vf = kf + 128 * 32;
    LAS float* wf = vf + 128 * 64;
    const float lgf = F.lgf[layer * 4 + h], lgb = F.lgb[layer * 4 + h];
    __syncthreads();
    { const int r = tid >> 2, ch = tid & 3; const v4u w = *(const v4u*)(P + (size_t)(row0 + r) * INW + C_RK + h * 32 + ch * 8); LAS float* d = kf + r * 32 + ch * 8;
      d[0] = bflo(w.x); d[1] = bfhi(w.x); d[2] = bflo(w.y); d[3] = bfhi(w.y); d[4] = bflo(w.z); d[5] = bfhi(w.z); d[6] = bflo(w.w); d[7] = bfhi(w.w); }
    for (int idx = tid; idx < 1024; idx += NTHR) { const int r = idx >> 3, ch = idx & 7; const v4u w = *(const v4u*)(P + (size_t)(row0 + r) * INW + C_RV + h * 64 + ch * 8); LAS float* d = vf + r * 64 + ch * 8;
      d[0] = bflo(w.x); d[1] = bfhi(w.x); d[2] = bflo(w.y); d[3] = bfhi(w.y); d[4] = bflo(w.z); d[5] = bfhi(w.z); d[6] = bflo(w.w); d[7] = bfhi(w.w); }
    if (tid < 128) { wf[tid] = __expf(lgf * (float)(127 - tid)); wf[128 + tid] = __expf(lgb * (float)tid); }
    __syncthreads();
    const int i = tid >> 4, e0 = (tid & 15) * 4; f32x4 af = (f32x4){0.f, 0.f, 0.f, 0.f}, ab = af;
    for (int m = 0; m < 128; ++m) { const float kk = kf[m * 32 + i]; const f32x4 vv = *(const LAS f32x4*)(vf + m * 64 + e0); af += (kk * wf[m]) * vv; ab += (kk * wf[128 + m]) * vv; }
    float* dst = WSP(float, WS_KVS) + ((size_t)(b * 4 + h) * NCHK + cid) * 2048 + i * 64 + e0;
#if defined(MIX_CHECK)
    { const f32x4 cf = *(const f32x4*)dst, cb = *(const f32x4*)(dst + (size_t)32 * NCHK * 2048);
#pragma unroll
      for (int k = 0; k < 4; ++k) { chk(F, cf[k], af[k], 0.05f, 0.03f, 10); chk(F, cb[k], ab[k], 0.05f, 0.03f, 10); } }
#endif
    *(f32x4*)dst = af; *(f32x4*)(dst + (size_t)32 * NCHK * 2048) = ab;
    __syncthreads();
}
__device__ __forceinline__ void p_scan(Frame& F, int layer) {
    for (int gid = blockIdx.x * NTHR + opq((int)threadIdx.x); gid < 2 * 32 * 2048; gid += F.G * NTHR) {
        const int dir = gid >> 16, bh = (gid >> 11) & 31, e = gid & 2047; const float lg = (dir ? F.lgb : F.lgf)[layer * 4 + (bh & 3)]; const float G = __expf(lg * 128.0f);
        float* base = WSP(float, WS_KVS) + ((size_t)(dir * 32 + bh) * NCHK) * 2048 + e;
        float kv[NCHK];
#pragma unroll
        for (int c = 0; c < NCHK; ++c) kv[c] = base[(size_t)c * 2048];
        float S = 0.f;
        if (dir == 0) {
#pragma unroll
            for (int c = 0; c < NCHK; ++c) { base[(size_t)c * 2048] = S; S = G * S + kv[c]; }
        } else {
            base[2048] = S; S = G * S + kv[1]; base[0] = S; S = G * S + kv[0];
#pragma unroll
            for (int c = NCHK - 1; c >= 2; --c) { base[(size_t)c * 2048] = S; S = G * S + kv[c]; }
        }
    }
}
__device__ __forceinline__ void ret_naive_unit(Frame& F, int layer, int b, int h, int cid) {
    const int tid = opq((int)threadIdx.x); const bf16* P = WSP(bf16, WS_PROJ); const int row0 = chunk_row0(b, cid);
    LAS float* kf = (LAS float*)F.lds;
    LAS float* qf = kf + 128 * 33;
    LAS float* vf = qf + 128 * 33;
    LAS float* Am = vf + 128 * 64;
    LAS float* Sf = Am + 128 * 129;
    LAS float* red = Sf + 2 * 2048;
    const float lgf = F.lgf[layer * 4 + h], lgb = F.lgb[layer * 4 + h];
    __syncthreads();
    { const int r = tid >> 2, ch = tid & 3; const v4u w = *(const v4u*)(P + (size_t)(row0 + r) * INW + C_RK + h * 32 + ch * 8); LAS float* d = kf + r * 33 + ch * 8;
      d[0] = bflo(w.x); d[1] = bfhi(w.x); d[2] = bflo(w.y); d[3] = bfhi(w.y); d[4] = bflo(w.z); d[5] = bfhi(w.z); d[6] = bflo(w.w); d[7] = bfhi(w.w); }
    { const int r = tid >> 2, ch = tid & 3; const v4u w = *(const v4u*)(P + (size_t)(row0 + r) * INW + C_RQ + h * 32 + ch * 8); LAS float* d = qf + r * 33 + ch * 8;
      d[0] = bflo(w.x); d[1] = bfhi(w.x); d[2] = bflo(w.y); d[3] = bfhi(w.y); d[4] = bflo(w.z); d[5] = bfhi(w.z); d[6] = bflo(w.w); d[7] = bfhi(w.w); }
    for (int idx = tid; idx < 1024; idx += NTHR) { const int r = idx >> 3, ch = idx & 7; const v4u w = *(const v4u*)(P + (size_t)(row0 + r) * INW + C_RV + h * 64 + ch * 8); LAS float* d = vf + r * 64 + ch * 8;
      d[0] = bflo(w.x); d[1] = bfhi(w.x); d[2] = bflo(w.y); d[3] = bfhi(w.y); d[4] = bflo(w.z); d[5] = bfhi(w.z); d[6] = bflo(w.w); d[7] = bfhi(w.w); }
    { const float* sp = WSP(float, WS_KVS) + ((size_t)(b * 4 + h) * NCHK + cid) * 2048;
      for (int idx = tid; idx < 2048; idx += NTHR) { Sf[idx] = sp[idx]; Sf[2048 + idx] = sp[(size_t)32 * NCHK * 2048 + idx]; } }
    const int n = tid & 127, qt = tid >> 7;
    __syncthreads();
#pragma unroll 1
    for (int mm = 0; mm < 32; ++mm) { const int m = qt * 32 + mm; float s = 0.f;
#pragma unroll 8
        for (int d = 0; d < 32; ++d) s += qf[n * 33 + d] * kf[m * 33 + d];
        const float w = m < n ? __expf(lgf * (float)(n - m)) : (m > n ? __expf(lgb * (float)(m - n)) : 2.0f);
        Am[n * 129 + m] = s * w; }
    __syncthreads();
    float o[16];
#pragma unroll
    for (int i = 0; i < 16; ++i) o[i] = 0.f;
#pragma unroll 2
    for (int m = 0; m < 128; ++m) { const float a = Am[n * 129 + m];
#pragma unroll
        for (int i = 0; i < 4; ++i) { const f32x4 vv = *(const LAS f32x4*)(vf + m * 64 + qt * 16 + 4 * i); o[4 * i] += a * vv[0]; o[4 * i + 1] += a * vv[1]; o[4 * i + 2] += a * vv[2]; o[4 * i + 3] += a * vv[3]; } }
    const float cf = __expf(lgf * (float)(n + 1)), cb = __expf(lgb * (float)(128 - n));
#pragma unroll 2
    for (int d = 0; d < 32; ++d) { const float qv = qf[n * 33 + d]; const float q1 = qv * cf, q2 = qv * cb;
#pragma unroll
        for (int i = 0; i < 4; ++i) { const f32x4 sf = *(const LAS f32x4*)(Sf + d * 64 + qt * 16 + 4 * i), sb = *(const LAS f32x4*)(Sf + 2048 + d * 64 + qt * 16 + 4 * i);
            o[4 * i] += q1 * sf[0] + q2 * sb[0]; o[4 * i + 1] += q1 * sf[1] + q2 * sb[1]; o[4 * i + 2] += q1 * sf[2] + q2 * sb[2]; o[4 * i + 3] += q1 * sf[3] + q2 * sb[3]; } }
    float s = 0.f;
#pragma unroll
    for (int i = 0; i < 16; ++i) s += o[i];
    red[n * 4 + qt] = s;
    __syncthreads();
    const float mean = (red[n * 4] + red[n * 4 + 1] + red[n * 4 + 2] + red[n * 4 + 3]) * (1.0f / 64.0f);
    __syncthreads();
    float qd = 0.f;
#pragma unroll
    for (int i = 0; i < 16; ++i) { o[i] -= mean; qd += o[i] * o[i]; }
    red[n * 4 + qt] = qd;
    __syncthreads();
    const float rstd = 1.0f / sqrtf((red[n * 4] + red[n * 4 + 1] + red[n * 4 + 2] + red[n * 4 + 3]) * (1.0f / 64.0f) + LN_EPS);
    const bf16* rgp = P + (size_t)(row0 + n) * INW + C_RG + h * 64 + qt * 16; bf16* dst = WSP(bf16, WS_MIX) + (size_t)(row0 + n) * D + 768 + h * 64 + qt * 16;
#pragma unroll
    for (int i = 0; i < 2; ++i) { const v4u w = *(const v4u*)(rgp + 8 * i); const float r8[8] = {bflo(w.x), bfhi(w.x), bflo(w.y), bfhi(w.y), bflo(w.z), bfhi(w.z), bflo(w.w), bfhi(w.w)}; float y8[8];
#pragma unroll
        for (int k = 0; k < 8; ++k) y8[k] = r8[k] / (1.0f + __expf(-r8[k])) * (o[8 * i + k] * rstd);
#if defined(MIX_CHECK)
        { const v4u cw = *(const v4u*)(dst + 8 * i); const float c8[8] = {bflo(cw.x), bfhi(cw.x), bflo(cw.y), bfhi(cw.y), bflo(cw.z), bfhi(cw.z), bflo(cw.w), bfhi(cw.w)};
#pragma unroll
          for (int k = 0; k < 8; ++k) chk(F, c8[k], y8[k], 0.03f, 0.04f, 11); }
#endif
        v4u ow; ow.x = pk2(y8[0], y8[1]); ow.y = pk2(y8[2], y8[3]); ow.z = pk2(y8[4], y8[5]); ow.w = pk2(y8[6], y8[7]); *(v4u*)(dst + 8 * i) = ow; }
    __syncthreads();
}
__device__ __forceinline__ void p_mix_naive(Frame& F, int layer, const XcdBarrier& bar) {
#if defined(MIX_CHECK)
    p_mix(F, layer); xcd_barrier(bar);
#endif
#if defined(ATTN_CHECK)
    p_attn(F, layer); xcd_barrier(bar);
#endif
#if defined(ATTN_NAIVE) || defined(ATTN_CHECK)
    const int n_att = 512 + (layer == 0 ? 32 : 0);
    for (int u = blockIdx.x; u < n_att; u += F.G) {
        if (u < 512) attn_naive_unit(F, layer, u >> 6, (u >> 1) & 31, u & 1, false);
        else { const int v = u - 512; attn_naive_unit(F, layer, v >> 2, (v >> 1) & 1, v & 1, true); }
    }
#elif !defined(MIX_CHECK)
    p_attn(F, layer);
#endif
    const int n_pool = 256 + (layer == 0 ? 16 : 0);
    for (int u = blockIdx.x; u < n_pool; u += F.G) { if (u < 256) pool_naive_unit(F, layer, u >> 5, u & 31); else pool_naive_unit(F, layer, 8 + ((u - 256) >> 1), (u - 256) & 1); }
    for (int u = blockIdx.x; u < 32 * NCHK; u += F.G) kv_naive_unit(F, layer, u / (4 * NCHK), (u / NCHK) & 3, u % NCHK);
}
__device__ __forceinline__ void p_ret_naive(Frame& F, int layer, const XcdBarrier& bar) {
#if defined(MIX_CHECK)
    p_ret(F, layer); xcd_barrier(bar);
#endif
    for (int u = blockIdx.x; u < 32 * NCHK; u += F.G) { const int cid = u % NCHK; if (layer == 1 && cid < 2) continue; ret_naive_unit(F, layer, u / (4 * NCHK), (u / NCHK) & 3, cid); }
}
#ifndef MK_N_LAUNCHES
#define MK_N_LAUNCHES 1
#endif
constexpr int NPHASE = 20;
struct Args { const float* in[24]; float* out; unsigned char* ws; int ph_lo, ph_hi; };

__device__ __forceinline__ int moe_tiles(Frame& F, volatile LAS unsigned* MISC) {
    __syncthreads();
    if (threadIdx.x == 0) { int acc = 0;
        for (int e = 0; e < NE; ++e) { const int c = (int)__hip_atomic_load(WSP(unsigned, WS_CTL) + CW_GCNT + 64 * e, RLX_AGENT); MISC[16 + NE + 1 + e] = (unsigned)c; MISC[16 + e] = (unsigned)acc; acc += (c + 255) >> 8; }
        MISC[16 + NE] = (unsigned)acc; }
    __syncthreads();
    return __builtin_amdgcn_readfirstlane((int)MISC[16 + NE]);
}

#define IN(k) (lo <= (k) && (k) < hi)
#define SEAM(k) do { if (IN(k) && IN((k) + 1)) xcd_barrier(bar); } while (0)
template <int layer> __device__ __forceinline__ void layer_front(Frame& F, const XcdBarrier& bar, const int lo, const int hi) {
        const int pb = 2 + 9 * layer;
        if (IN(pb)) {
            pg8::StaticOrder S; S.init(WSP(bf16, WS_ACT), WSP(bf16, WS_WIN) + (size_t)layer * INW * D, MT, INW, 2 * D, F.G, (int)blockIdx.x);
            pg8::EpiInProj E{WSP(bf16, WS_PROJ), WSP(float, WS_ROPE), WSP(float, WS_ROPE) + 1024};
            pg8::gemm_phase<false>(F.lds, 2 * D, S, E);
        } SEAM(pb);
#if defined(MIX_NAIVE) || defined(MIX_CHECK) || defined(ATTN_CHECK) || defined(ATTN_NAIVE)
        if (IN(pb + 1)) { p_mix_naive(F, layer, bar); } SEAM(pb + 1);
#else
        if (IN(pb + 1)) { p_mix(F, layer); } SEAM(pb + 1);
#endif
        if (IN(pb + 2)) { p_scan(F, layer); } SEAM(pb + 2);
#if defined(MIX_NAIVE) || defined(MIX_CHECK) || defined(ATTN_CHECK) || defined(ATTN_NAIVE)
        if (IN(pb + 3)) { p_ret_naive(F, layer, bar); } SEAM(pb + 3);
#else
        if (IN(pb + 3)) { p_ret(F, layer); } SEAM(pb + 3);
#endif
        if (IN(pb + 4)) {
            pg8::StaticOrder S; S.init(WSP(bf16, WS_MIX), WSP(bf16, WS_WOUT) + (size_t)layer * D * D, layer == 0 ? MT : NL, D, 2 * D, F.G, (int)blockIdx.x);
            pg8::EpiBf16 E{WSP(bf16, WS_ACT), D};
            pg8::gemm_phase<false>(F.lds, 2 * D, S, E);
        } SEAM(pb + 4);
        if (IN(pb + 5)) { p_ln1(F, layer); } SEAM(pb + 5);
        if constexpr (layer == 0) {
        if (IN(8)) {
            pg8::StaticOrder S; S.init(WSP(bf16, WS_ACT), WSP(bf16, WS_FGU), MT, 2 * FF, 2 * D, F.G, (int)blockIdx.x);
            pg8::EpiSwiGLU E{WSP(bf16, WS_HID), FF};
            pg8::gemm_phase<false>(F.lds, 2 * D, S, E);
        } SEAM(8);
        if (IN(9)) {
            pg8::StaticOrder S; S.init(WSP(bf16, WS_HID), WSP(bf16, WS_FD), MT, D, 2 * FF, F.G, (int)blockIdx.x);
            pg8::EpiBf16 E{WSP(bf16, WS_ACT), D};
            pg8::gemm_phase<false>(F.lds, 2 * FF, S, E);
        } SEAM(9);
        if (IN(10)) { p_ln2_l0(F); } SEAM(10);
        }
}

__global__ void __launch_bounds__(NTHR, 2) hybrid_fwd(Args args) {
    extern __shared__ __attribute__((aligned(16))) unsigned char lds_raw[];
    Frame F;
    F.lds = (LAS unsigned char*)lds_raw;
    F.wave = __builtin_amdgcn_readfirstlane((int)threadIdx.x >> 6);
    F.G = gridDim.x; { const int bx = blockIdx.x; F.vcu = (F.G % 8 == 0) ? (bx % 8) * (F.G / 8) + bx / 8 : bx; }
    F.ws = args.ws; F.out = args.out;
    F.x = args.in[0]; F.c = args.in[1]; F.ctx = args.in[2]; F.c_ctx = args.in[3]; F.w_mod = args.in[4]; F.b_mod = args.in[5]; F.w_in = args.in[6]; F.sink = args.in[7];
    F.pool_w = args.in[8]; F.pool_scale = args.in[9]; F.lgf = args.in[10]; F.lgb = args.in[11]; F.w_out = args.in[12]; F.ln1_g = args.in[13]; F.ln1_b = args.in[14]; F.ln2_g = args.in[15]; F.ln2_b = args.in[16];
    F.fw_gate = args.in[17]; F.fw_up = args.in[18]; F.fw_down = args.in[19]; F.router = args.in[20]; F.mw_gate = args.in[21]; F.mw_up = args.in[22]; F.mw_down = args.in[23];
    volatile LAS unsigned* MISC = (volatile LAS unsigned*)(F.lds + MISC_OFF);
    if (threadIdx.x < 64) MISC[threadIdx.x] = 0u;
    __syncthreads();
    const int lo = args.ph_lo, hi = args.ph_hi;
    XcdBarrier bar; bar.bar = WSP(unsigned, WS_CTL) + CW_BAR; bar.x = 0; bar.st = nullptr;
    if (hi - lo > 1) bar = xcd_barrier_post(WSP(unsigned, WS_CTL) + CW_BAR, MISC + 8);

    if (IN(0)) { p_prep(F); } SEAM(0);
    if (IN(1)) { p_h0(F); } SEAM(1);
    layer_front<0>(F, bar, lo, hi);
    layer_front<1>(F, bar, lo, hi);
    if (IN(17)) {
        pg8::MoeOrder<true> S; S.nrt = moe_tiles(F, MISC); S.tbl = (const LAS int*)(MISC + 16);
        S.T0 = 0; S.nN = 2 * FF / 256; S.G = F.G; S.c = (int)blockIdx.x; S.KB = D;
        S.A = (const char*)WSP(unsigned char, WS_T8); S.Bt = (const char*)WSP(unsigned char, WS_MGU8); S.bstride = (size_t)2 * FF * D; S.list = WSP(int, WS_LIST);
        pg8::EpiSwiGLU8 E{WSP(unsigned char, WS_HID8), FF, 1.0f / 128.0f, 4.0f};
        pg8::gemm_phase<true>(F.lds, D, S, E);
    } SEAM(17);
    if (IN(18)) {
        pg8::MoeOrder<false> S; S.nrt = moe_tiles(F, MISC); S.tbl = (const LAS int*)(MISC + 16);
        S.T0 = 0; S.nN = D / 256; S.G = F.G; S.c = (int)blockIdx.x; S.KB = FF;
        S.A = (const char*)WSP(unsigned char, WS_HID8); S.Bt = (const char*)WSP(unsigned char, WS_MD8); S.bstride = (size_t)FF * D; S.list = WSP(int, WS_LIST);
        pg8::EpiMoeDown E{WSP(bf16, WS_Y), WSP(int, WS_LIST), WSP(float, WS_LGATE), 1.0f / 512.0f};
        pg8::gemm_phase<true>(F.lds, FF, S, E);
    } SEAM(18);
    if (IN(19)) { p_final(F); }
#undef IN
#undef SEAM
}

extern "C" void kernel_launch(void* const* d_in, const int* in_sizes, int n_in, void* d_out, int out_size, void* d_ws, size_t ws_size, hipStream_t stream) {
    static int grid = 0;
    if (grid == 0) {
        if (n_in != 24 || out_size != NL * D || ws_size < WS_END) { fprintf(stderr, "kernel_launch: unexpected shapes (n_in %d, out %d, ws %zu < %zu); nothing launched\n", n_in, out_size, ws_size, (size_t)WS_END); grid = -1; return; }
        int dev = 0, cus = 0, per_cu = 0;
        if (hipGetDevice(&dev) != hipSuccess || hipDeviceGetAttribute(&cus, hipDeviceAttributeMultiprocessorCount, dev) != hipSuccess) { grid = -1; return; }
        if (hipFuncSetAttribute((const void*)hybrid_fwd, hipFuncAttributeMaxDynamicSharedMemorySize, LDS_BYTES) != hipSuccess) { fprintf(stderr, "kernel_launch: hipFuncSetAttribute failed\n"); grid = -1; return; }
        if (hipOccupancyMaxActiveBlocksPerMultiprocessor(&per_cu, (const void*)hybrid_fwd, NTHR, LDS_BYTES) != hipSuccess || per_cu < 1) { fprintf(stderr, "kernel_launch: occupancy query says %d\n", per_cu); }
        (void)hipGetLastError();
        grid = cus;
    }
    if (grid < 0) return;
    if (hipMemsetAsync((char*)d_ws + WS_CTL, 0, CTL_ZERO_BYTES, stream) != hipSuccess) return;
    Args a{};
    for (int i = 0; i < 24; ++i) a.in[i] = (const float*)d_in[i];
    a.out = (float*)d_out; a.ws = (unsigned char*)d_ws;
#if MK_N_LAUNCHES == 1
    a.ph_lo = 0; a.ph_hi = NPHASE;
    hipLaunchKernelGGL(hybrid_fwd, dim3(grid), dim3(NTHR), LDS_BYTES, stream, a);
#else
    for (int p = 0; p < NPHASE; ++p) { a.ph_lo = p; a.ph_hi = p + 1; hipLaunchKernelGGL(hybrid_fwd, dim3(grid), dim3(NTHR), LDS_BYTES, stream, a); }
#endif
}
```

```cpp
#include <hip/hip_runtime.h>
#include <cstdio>
#include <cstdint>
#define MK_N_LAUNCHES 1
#ifndef INQ
#define INQ 1
#endif
#ifndef MOEQ
#define MOEQ 0
#endif
#ifndef BGCONV
#define BGCONV 1
#endif
#ifndef RES16
#define RES16 1
#endif
#ifndef FUSE_LN
#define FUSE_LN 0
#endif
#ifndef MOE_SK
#define MOE_SK 0
#endif
#ifndef FFD_SK
#define FFD_SK 0
#endif
#ifndef OUT_SK
#define OUT_SK 0
#endif
#ifndef REV_MASK
#define REV_MASK 15
#endif
#ifndef ATTN_LATE
#define ATTN_LATE 0
#endif
#ifndef TAILQ
#define TAILQ 7
#endif
#ifndef CONV_SPREAD
#define CONV_SPREAD 0
#endif
#ifndef HID_FP8
#define HID_FP8 1
#endif
#ifndef RESADD
#define RESADD 0
#endif
#ifndef WGM_SET
#define WGM_SET 16
#endif
#ifndef FFN0_FP8
#define FFN0_FP8 0
#endif
#ifndef REP_MASK
#define REP_MASK 0
#endif
#if ((REP_MASK) >> 0) & 1
#define REPEAT_0 _Pragma("unroll 1") for (int rep_ = 0; rep_ < 2; ++rep_)
#define REPSYNC_0 __syncthreads();
#else
#define REPEAT_0
#define REPSYNC_0
#endif
#if ((REP_MASK) >> 1) & 1
#define REPEAT_1 _Pragma("unroll 1") for (int rep_ = 0; rep_ < 2; ++rep_)
#define REPSYNC_1 __syncthreads();
#else
#define REPEAT_1
#define REPSYNC_1
#endif
#if ((REP_MASK) >> 2) & 1
#define REPEAT_2 _Pragma("unroll 1") for (int rep_ = 0; rep_ < 2; ++rep_)
#define REPSYNC_2 __syncthreads();
#else
#define REPEAT_2
#define REPSYNC_2
#endif
#if ((REP_MASK) >> 3) & 1
#define REPEAT_3 _Pragma("unroll 1") for (int rep_ = 0; rep_ < 2; ++rep_)
#define REPSYNC_3 __syncthreads();
#else
#define REPEAT_3
#define REPSYNC_3
#endif
#if ((REP_MASK) >> 4) & 1
#define REPEAT_4 _Pragma("unroll 1") for (int rep_ = 0; rep_ < 2; ++rep_)
#define REPSYNC_4 __syncthreads();
#else
#define REPEAT_4
#define REPSYNC_4
#endif
#if ((REP_MASK) >> 5) & 1
#define REPEAT_5 _Pragma("unroll 1") for (int rep_ = 0; rep_ < 2; ++rep_)
#define REPSYNC_5 __syncthreads();
#else
#define REPEAT_5
#define REPSYNC_5
#endif
#if ((REP_MASK) >> 6) & 1
#define REPEAT_6 _Pragma("unroll 1") for (int rep_ = 0; rep_ < 2; ++rep_)
#define REPSYNC_6 __syncthreads();
#else
#define REPEAT_6
#define REPSYNC_6
#endif
#if ((REP_MASK) >> 7) & 1
#define REPEAT_7 _Pragma("unroll 1") for (int rep_ = 0; rep_ < 2; ++rep_)
#define REPSYNC_7 __syncthreads();
#else
#define REPEAT_7
#define REPSYNC_7
#endif
#if ((REP_MASK) >> 8) & 1
#define REPEAT_8 _Pragma("unroll 1") for (int rep_ = 0; rep_ < 2; ++rep_)
#define REPSYNC_8 __syncthreads();
#else
#define REPEAT_8
#define REPSYNC_8
#endif
#if ((REP_MASK) >> 9) & 1
#define REPEAT_9 _Pragma("unroll 1") for (int rep_ = 0; rep_ < 2; ++rep_)
#define REPSYNC_9 __syncthreads();
#else
#define REPEAT_9
#define REPSYNC_9
#endif
#if ((REP_MASK) >> 10) & 1
#define REPEAT_10 _Pragma("unroll 1") for (int rep_ = 0; rep_ < 2; ++rep_)
#define REPSYNC_10 __syncthreads();
#else
#define REPEAT_10
#define REPSYNC_10
#endif
#if ((REP_MASK) >> 11) & 1
#define REPEAT_11 _Pragma("unroll 1") for (int rep_ = 0; rep_ < 2; ++rep_)
#define REPSYNC_11 __syncthreads();
#else
#define REPEAT_11
#define REPSYNC_11
#endif
#if ((REP_MASK) >> 12) & 1
#define REPEAT_12 _Pragma("unroll 1") for (int rep_ = 0; rep_ < 2; ++rep_)
#define REPSYNC_12 __syncthreads();
#else
#define REPEAT_12
#define REPSYNC_12
#endif
#if ((REP_MASK) >> 13) & 1
#define REPEAT_13 _Pragma("unroll 1") for (int rep_ = 0; rep_ < 2; ++rep_)
#define REPSYNC_13 __syncthreads();
#else
#define REPEAT_13 if (false)
#define REPSYNC_13
#endif
#if ((REP_MASK) >> 14) & 1
#define REPEAT_14 _Pragma("unroll 1") for (int rep_ = 0; rep_ < 2; ++rep_)
#define REPSYNC_14 __syncthreads();
#else
#define REPEAT_14
#define REPSYNC_14
#endif
#if ((REP_MASK) >> 15) & 1
#define REPEAT_15 _Pragma("unroll 1") for (int rep_ = 0; rep_ < 2; ++rep_)
#define REPSYNC_15 __syncthreads();
#else
#define REPEAT_15
#define REPSYNC_15
#endif
#if ((REP_MASK) >> 16) & 1
#define REPEAT_16 _Pragma("unroll 1") for (int rep_ = 0; rep_ < 2; ++rep_)
#define REPSYNC_16 __syncthreads();
#else
#define REPEAT_16
#define REPSYNC_16
#endif
#if ((REP_MASK) >> 17) & 1
#define REPEAT_17 _Pragma("unroll 1") for (int rep_ = 0; rep_ < 2; ++rep_)
#define REPSYNC_17 __syncthreads();
#else
#define REPEAT_17
#define REPSYNC_17
#endif
#if ((REP_MASK) >> 18) & 1
#define REPEAT_18 _Pragma("unroll 1") for (int rep_ = 0; rep_ < 2; ++rep_)
#define REPSYNC_18 __syncthreads();
#else
#define REPEAT_18
#define REPSYNC_18
#endif
#if ((REP_MASK) >> 19) & 1
#define REPEAT_19 _Pragma("unroll 1") for (int rep_ = 0; rep_ < 2; ++rep_)
#define REPSYNC_19 __syncthreads();
#else
#define REPEAT_19
#define REPSYNC_19
#endif
#define REPEAT(bit) REPEAT_##bit
#define REPSYNC(bit) REPSYNC_##bit
__device__ __forceinline__ int opq(int v) { asm volatile("" : "+v"(v)); return v; }
namespace pg8 {
#define PG8_LAS __attribute__((address_space(3)))
typedef unsigned short bf16_t;
typedef short bf16x8 __attribute__((ext_vector_type(8)));
typedef float f32x4 __attribute__((ext_vector_type(4)));
typedef float f32x2 __attribute__((ext_vector_type(2)));
typedef unsigned u32x4 __attribute__((ext_vector_type(4)));
constexpr int BM = 256, BK = 64, HALF = 128, HTB = HALF * BK * 2  , STAGE_BYTES = 8 * HTB, NXCD = 8, WGM = WGM_SET;

__host__ __device__ __forceinline__ int lds_byte(int r, int c) { const int st = (r >> 4) * 2 + (c >> 5), rr = r & 15, cc = c & 31, ob = rr * 64 + cc * 2; return st * 1024 + (ob ^ (((ob >> 9) & 1) << 5)); }
__host__ __device__ __forceinline__ void stage_rc(int b, int& R, int& C) { const int st = b / 1024, sb = b % 1024, swz = sb ^ (((sb >> 9) & 1) << 5); R = (st >> 1) * 16 + swz / 64; C = (st & 1) * 32 + (swz % 64) / 2; }
__host__ __device__ __forceinline__ int perm32(int rho) { const int n = rho >> 4, i = rho & 15; return 8 * (i >> 2) + 4 * n + (i & 3); }

struct Unit { int pm, pn, e, rt, cnt; const char* ab; const char* bb; int nt, part, slot; };

__device__ __forceinline__ void tile_from_L(int L, int nM, int nN, int& pm, int& pn) {
    const int nwg = nM * nN;
    int wgid = L; { const int q = nwg / NXCD, r = nwg % NXCD, xcd = wgid % NXCD, off = wgid / NXCD; wgid = (xcd < r ? xcd * (q + 1) : r * (q + 1) + (xcd - r) * q) + off; }
    const int nig = WGM * nN, gid = wgid / nig, fm = gid * WGM, gsz = (nM - fm) < WGM ? (nM - fm) : WGM;
    pm = fm + ((wgid % nig) % gsz); pn = (wgid % nig) / gsz;
}
__device__ __forceinline__ bool tile_order(int i, int G, int c, int nM, int nN, int& pm, int& pn, bool rev = false) {
    const int nwg = nM * nN; const long L = (long)i * G + c; if (L >= nwg) return false;
    int wgid = (int)L; { const int q = nwg / NXCD, r = nwg % NXCD, xcd = wgid % NXCD; int off = wgid / NXCD; if (rev) off = q + (xcd < r ? 1 : 0) - 1 - off;
        wgid = (xcd < r ? xcd * (q + 1) : r * (q + 1) + (xcd - r) * q) + off; }
    const int nig = WGM * nN, gid = wgid / nig, fm = gid * WGM, gsz = (nM - fm) < WGM ? (nM - fm) : WGM;
    pm = fm + ((wgid % nig) % gsz); pn = (wgid % nig) / gsz; return true;
}
struct StreamK {
    int on, x, W, F, P, a, b, c; float* slots; unsigned* flags; unsigned tag;
    __device__ __forceinline__ void init(int n, int ntile, int G, int c_, float* slots_, unsigned* flags_, unsigned tag_) {
        c = c_; slots = slots_; flags = flags_; tag = tag_; on = 0; P = ntile >> 1; x = c_ & 7; W = G >> 3; F = 0; a = 0; b = 0;
        if ((G & 7) == 0 && (ntile & 1) == 0) { const int k = c_ >> 3, nx = (n - x + 7) >> 3;
            if (nx >= W) { on = 1; F = nx / W - 1; const int T = (nx - F * W) * P; a = (k * T) / W; b = ((k + 1) * T) / W; } }
    }
    __device__ __forceinline__ bool next(int i, int n, int G, int& L, int& p0, int& np, int& part) const {
        if (!on || i < F) { L = i * G + c; p0 = 0; np = P; part = 0; return L < n; }
        const int q = a / P + (i - F); const int s = a > q * P ? a : q * P, e = b < (q + 1) * P ? b : (q + 1) * P;
        if (s >= e) return false;
        L = (F * W + q) * 8 + x; p0 = s - q * P; np = e - s; part = p0 > 0 ? 1 : (np < P ? 2 : 0); return true;
    }
};
struct TailPlan { int F = 1 << 30, rem = 0, x = 0, W = 1;
    __device__ __forceinline__ void init(int n, int G, int c, bool enable) { F = 1 << 30; rem = 0; x = c & 7; W = G >> 3;
        if (enable && (G & 7) == 0 && W > 0) { const int nx = (n - x + 7) >> 3, f = nx / W, r = nx - f * W; if (r > 0 && r <= 8 && f > 0) { F = f; rem = r; } } }
    __device__ __forceinline__ bool quarter(int j, int c, int& cq, int& ai, int& bj) const { const int v = (c >> 3) + W * j, q = v >> 2; if (q >= rem) return false; cq = q * 8 + x; ai = (v >> 1) & 1; bj = v & 1; return true; }
};
template <bool SK_> struct StaticOrderT {
    static constexpr bool GATHER = false, SK = SK_;
    int nM, nN, G, c, KB; const char* A; const char* Bt;
    bool rev = false;
    StreamK sk; TailPlan tail;
    __device__ __forceinline__ void init(const void* A_, const void* Bt_, int M, int N, int KB_, int G_, int c_, bool tail_ = false) { A = (const char*)A_; Bt = (const char*)Bt_; nM = M / BM; nN = N / BM; KB = KB_; G = G_; c = c_; tail.init(nM * nN, G_, c_, tail_); }
    __device__ __forceinline__ bool tail_next(int j, Unit& u, int& ai, int& bj) const {
        int cq, pm, pn; if (!tail.quarter(j, c, cq, ai, bj) || !tile_order(tail.F, G, cq, nM, nN, pm, pn, rev)) return false;
        u.pm = pm; u.pn = pn; u.e = 0; u.rt = pm; u.cnt = 1 << 30; u.ab = A + (size_t)pm * BM * KB; u.bb = Bt + (size_t)pn * BM * KB; return true;
    }
    __device__ __forceinline__ bool next(int i, Unit& u) const {
        int pm, pn; if (i >= tail.F) return false;
        if constexpr (SK) { int L, p0, np, part; if (!sk.next(i, nM * nN, G, L, p0, np, part)) return false;
            tile_from_L(L, nM, nN, pm, pn);
            u.pm = pm; u.pn = pn; u.e = 0; u.rt = pm; u.cnt = 1 << 30; u.ab = A + (size_t)pm * BM * KB + (size_t)p0 * 256; u.bb = Bt + (size_t)pn * BM * KB + (size_t)p0 * 256;
            u.nt = 2 * np; u.part = part; u.slot = part == 2 ? c + 8 : c; return true; }
        else { if (!tile_order(i, G, c, nM, nN, pm, pn, rev)) return false;
            u.pm = pm; u.pn = pn; u.e = 0; u.rt = pm; u.cnt = 1 << 30; u.ab = A + (size_t)pm * BM * KB; u.bb = Bt + (size_t)pn * BM * KB; return true; }
    }
    __device__ __forceinline__ void aoff(const Unit&, int tid, unsigned (&va)[2][2]) const {
#pragma unroll
        for (int i = 0; i < 2; ++i) { int R, C; stage_rc(tid * 16 + i * 8192, R, C);
#pragma unroll
            for (int h = 0; h < 2; ++h) va[h][i] = (unsigned)((R + HALF * h) * KB + C * 2); }
    }
};
typedef StaticOrderT<false> StaticOrder;

typedef int v8i32 __attribute__((ext_vector_type(8)));
typedef int v4i32 __attribute__((ext_vector_type(4)));
__device__ __forceinline__ v8i32 cat8(bf16x8 a, bf16x8 b) { const v4i32 x = __builtin_bit_cast(v4i32, a), y = __builtin_bit_cast(v4i32, b); return (v8i32){x[0], x[1], x[2], x[3], y[0], y[1], y[2], y[3]}; }
__device__ __forceinline__ void glds16s(unsigned voff, const void* sbase, unsigned lds_dst) { unsigned keep;
    asm volatile("s_mov_b32 %0, m0\n\ts_mov_b32 m0, %3\n\ts_nop 0\n\tglobal_load_lds_dwordx4 %1, %2\n\ts_mov_b32 m0, %0" : "=&s"(keep) : "v"(voff), "s"(sbase), "s"(lds_dst) : "memory"); }
__device__ __forceinline__ unsigned cvt_pk_bf16(float lo, float hi) { unsigned r; asm volatile("v_cvt_pk_bf16_f32 %0, %1, %2" : "=v"(r) : "v"(lo), "v"(hi)); return r; }

template <int MODE  , class Epi, class Sched>
__device__ __forceinline__ void gemm_phase(PG8_LAS unsigned char* lds, const int KB, const Sched& S, const Epi& E) {
    const int tid = opq((int)threadIdx.x), wid = __builtin_amdgcn_readfirstlane(tid >> 6), lane = tid & 63, wr = wid >> 2, wc = wid & 3, fr = lane & 15, fq = lane >> 4;
    const int nt = KB / 128;
    unsigned voffB[2];
#pragma unroll
    for (int i = 0; i < 2; ++i) { int R, C; stage_rc(tid * 16 + i * 8192, R, C); const int Rb = Epi::PERM ? ((R & ~31) + perm32(R & 31)) : R; voffB[i] = (unsigned)(Rb * KB + C * 2); }
    const size_t kstep = (size_t)(BK * 2);
    const size_t hstep = (size_t)HALF * KB;
    const unsigned ldsw = (unsigned)wid * 1024u;
    const int aoff = lds_byte(wr * 64 + fr, fq * 8), boff = lds_byte(wc * 32 + fr, fq * 8);
    const unsigned lds0 = (unsigned)(uintptr_t)lds;
#define PG8_SA(b, h) (((b) * 2 + (h)) * HTB)
#define PG8_SB(b, h) ((4 + (b) * 2 + (h)) * HTB)
#define PG8_STAGE(bufoff, gbase, voff) do { _Pragma("unroll") for (int _i = 0; _i < 2; ++_i) glds16s((voff)[_i], (const void*)(gbase), lds0 + (unsigned)(bufoff) + ldsw + (unsigned)(_i * 8192)); } while (0)
#define PG8_LD8(p) __builtin_shufflevector(*(const PG8_LAS v4i32*)(p), *(const PG8_LAS v4i32*)((p) + 1024), 0, 1, 2, 3, 4, 5, 6, 7)
#define PG8_LDA(dst, b, h) do { _Pragma("unroll") for (int m = 0; m < 4; ++m) dst[m] = PG8_LD8(lds + PG8_SA(b, h) + aoff + m * 2048); } while (0)
#define PG8_LDB(dst, b, h) do { _Pragma("unroll") for (int n = 0; n < 2; ++n) dst[n] = PG8_LD8(lds + PG8_SB(b, h) + boff + n * 2048); } while (0)
#define PG8_LO(v) __builtin_bit_cast(bf16x8, __builtin_shufflevector(v, v, 0, 1, 2, 3))
#define PG8_HI(v) __builtin_bit_cast(bf16x8, __builtin_shufflevector(v, v, 4, 5, 6, 7))
#define PG8_MMA(ai, bj, At, Bt) do { __builtin_amdgcn_s_setprio(1); _Pragma("unroll") for (int m = 0; m < 4; ++m) _Pragma("unroll") for (int n = 0; n < 2; ++n) { \
        if constexpr (MODE == 1) acc[ai][bj][m][n] = __builtin_amdgcn_mfma_scale_f32_16x16x128_f8f6f4(Bt[n], At[m], acc[ai][bj][m][n], 0, 0, 0, 0, 0, 0); \
        else if constexpr (MODE == 2) { v4i32 c_ = __builtin_bit_cast(v4i32, acc[ai][bj][m][n]); \
               c_ = __builtin_amdgcn_mfma_i32_16x16x64_i8(__builtin_shufflevector(Bt[n], Bt[n], 0, 1, 2, 3), __builtin_shufflevector(At[m], At[m], 0, 1, 2, 3), c_, 0, 0, 0); \
               c_ = __builtin_amdgcn_mfma_i32_16x16x64_i8(__builtin_shufflevector(Bt[n], Bt[n], 4, 5, 6, 7), __builtin_shufflevector(At[m], At[m], 4, 5, 6, 7), c_, 0, 0, 0); \
               acc[ai][bj][m][n] = __builtin_bit_cast(f32x4, c_); } \
        else { acc[ai][bj][m][n] = __builtin_amdgcn_mfma_f32_16x16x32_bf16(PG8_LO(Bt[n]), PG8_LO(At[m]), acc[ai][bj][m][n], 0, 0, 0); \
               acc[ai][bj][m][n] = __builtin_amdgcn_mfma_f32_16x16x32_bf16(PG8_HI(Bt[n]), PG8_HI(At[m]), acc[ai][bj][m][n], 0, 0, 0); } } \
        __builtin_amdgcn_s_setprio(0); } while (0)
#define PG8_WAIT_V(n) asm volatile("s_waitcnt vmcnt(" #n ")" ::: "memory")
#define PG8_WAIT_L(n) asm volatile("s_waitcnt lgkmcnt(" #n ")" ::: "memory")
#define PG8_BAR __builtin_amdgcn_s_barrier()
#define PG8_SCHED __builtin_amdgcn_sched_barrier(0)
    Unit cur, nxt; int ui = 0;
    if (!S.next(0, cur)) return;
    unsigned va[2][2];
    S.aoff(cur, tid, va);
    f32x4 acc[2][2][4][2];
#define PG8_ACC_INIT(U) do { \
    bool ld_ = false; if constexpr (Sched::SK) ld_ = (U).part == 2; \
    if (ld_) { const int t2 = opq((int)threadIdx.x); const char* sb = (const char*)S.sk.slots + (size_t)(U).slot * (size_t)(BM * BM * 4); const unsigned vo = (unsigned)t2 * 16u; unsigned* fl = S.sk.flags + (U).slot * 16; \
        if (t2 == 0) { unsigned sp_ = 0; while (__hip_atomic_load(fl, __ATOMIC_RELAXED, __HIP_MEMORY_SCOPE_AGENT) != S.sk.tag) { __builtin_amdgcn_s_sleep(1); if (++sp_ > (1u << 24)) break; } \
            } \
        PG8_BAR; \
        _Pragma("unroll") for (int a = 0; a < 2; ++a) _Pragma("unroll") for (int b = 0; b < 2; ++b) _Pragma("unroll") for (int m = 0; m < 4; ++m) _Pragma("unroll") for (int n = 0; n < 2; ++n) \
            asm volatile("global_load_dwordx4 %0, %1, %2 sc1" : "=v"(acc[a][b][m][n]) : "v"(vo), "s"(sb + (((a * 2 + b) * 4 + m) * 2 + n) * 8192) : "memory");        \
        asm volatile("s_waitcnt vmcnt(0)" ::: "memory"); \
    } else { \
        _Pragma("unroll") for (int a = 0; a < 2; ++a) _Pragma("unroll") for (int b = 0; b < 2; ++b) _Pragma("unroll") for (int m = 0; m < 4; ++m) _Pragma("unroll") for (int n = 0; n < 2; ++n) acc[a][b][m][n] = (f32x4){0.f, 0.f, 0.f, 0.f}; \
    } } while (0)
    PG8_ACC_INIT(cur);
    v8i32 At[4], B0[2], B1[2];
    const char* cA = cur.ab; const char* cB = cur.bb;
    PG8_STAGE(PG8_SB(0, 0), cB, voffB); PG8_STAGE(PG8_SB(0, 1), cB + hstep, voffB); PG8_STAGE(PG8_SA(0, 0), cA, va[0]); PG8_STAGE(PG8_SA(0, 1), cA, va[1]);
    if (wr == 1) PG8_BAR;
    PG8_WAIT_V(2); PG8_BAR;
    PG8_STAGE(PG8_SB(1, 0), cB + kstep, voffB); PG8_STAGE(PG8_SA(1, 0), cA + kstep, va[0]); PG8_STAGE(PG8_SB(1, 1), cB + hstep + kstep, voffB);
    PG8_WAIT_V(6); PG8_BAR;
    for (;;) {
        const bool has_next = S.next(ui + 1, nxt);
        const char* nA = has_next ? nxt.ab : cA; const char* nB = has_next ? nxt.bb : cB;
        if constexpr (Sched::GATHER) {
            if (has_next && wid == 0) glds16s((unsigned)lane * 16u, S.list_src(nxt), lds0 + (unsigned)STAGE_BYTES + (unsigned)(((ui + 1) & 1) * 1024)); }
        int ntu = nt; if constexpr (Sched::SK) ntu = cur.nt;
#pragma unroll 1
        for (int t = 0; t < ntu; t += 2) {
            const bool last = (t == ntu - 2);
            const char* a1 = cA + (size_t)(t + 1) * kstep;
            const char* a2 = last ? nA : cA + (size_t)(t + 2) * kstep; const char* b2 = last ? nB : cB + (size_t)(t + 2) * kstep;
            const char* a3 = a2 + kstep; const char* b3 = b2 + kstep;
            PG8_LDB(B0, 0, 0); PG8_LDB(B1, 0, 1); PG8_SCHED; PG8_LDA(At, 0, 0); PG8_STAGE(PG8_SA(1, 1), a1, va[1]);
            if constexpr (Sched::GATHER) { if (last && has_next) S.aoff_lds(nxt, opq((int)threadIdx.x), (const PG8_LAS int*)(lds + STAGE_BYTES + ((ui + 1) & 1) * 1024), va); }
            PG8_WAIT_V(8); PG8_WAIT_L(0); PG8_BAR; PG8_MMA(0, 0, At, B0); PG8_MMA(0, 1, At, B1); PG8_BAR; PG8_SCHED;
            PG8_LDA(At, 0, 1); PG8_STAGE(PG8_SB(0, 0), b2, voffB); PG8_STAGE(PG8_SB(0, 1), b2 + hstep, voffB); PG8_STAGE(PG8_SA(0, 0), a2, va[0]);
            PG8_WAIT_V(8); PG8_WAIT_L(0); PG8_BAR; PG8_MMA(1, 0, At, B0); PG8_MMA(1, 1, At, B1); PG8_BAR; PG8_SCHED;
            PG8_LDB(B0, 1, 0); PG8_LDB(B1, 1, 1); PG8_SCHED; PG8_LDA(At, 1, 0); PG8_STAGE(PG8_SA(0, 1), a2, va[1]);
            PG8_WAIT_V(8); PG8_WAIT_L(0); PG8_BAR; PG8_MMA(0, 0, At, B0); PG8_MMA(0, 1, At, B1); PG8_BAR; PG8_SCHED;
            PG8_LDA(At, 1, 1); PG8_STAGE(PG8_SB(1, 0), b3, voffB); PG8_STAGE(PG8_SB(1, 1), b3 + hstep, voffB); PG8_STAGE(PG8_SA(1, 0), a3, va[0]);
            PG8_WAIT_V(8); PG8_WAIT_L(0); PG8_BAR; PG8_MMA(1, 0, At, B0); PG8_MMA(1, 1, At, B1); PG8_BAR; PG8_SCHED;
        }
        if (wr == 0) PG8_BAR;
        if constexpr (Sched::SK) {
            if (cur.part == 1) { const int t2 = opq((int)threadIdx.x); const char* sb = (const char*)S.sk.slots + (size_t)cur.slot * (size_t)(BM * BM * 4); const unsigned vo = (unsigned)t2 * 16u; unsigned* fl = S.sk.flags + cur.slot * 16;
                {
#pragma unroll
                    for (int a = 0; a < 2; ++a)
#pragma unroll
                        for (int b = 0; b < 2; ++b)
#pragma unroll
                            for (int m = 0; m < 4; ++m)
#pragma unroll
                                for (int n = 0; n < 2; ++n) asm volatile("global_store_dwordx4 %0, %1, %2 sc1" :: "v"(vo), "v"(acc[a][b][m][n]), "s"(sb + (((a * 2 + b) * 4 + m) * 2 + n) * 8192) : "memory");
                    PG8_WAIT_V(0); PG8_BAR;
                    if (t2 == 0) __hip_atomic_store(fl, S.sk.tag, __ATOMIC_RELAXED, __HIP_MEMORY_SCOPE_AGENT);
                }
            }
        }
        if constexpr (!Epi::AFTER_DRAIN) { if (!Sched::SK || cur.part != 1) { const int l2 = opq((int)threadIdx.x) & 63; E(acc, cur, wr, wc, l2 & 15, l2 >> 4); } }
        if (!has_next) break;
        PG8_ACC_INIT(nxt);
        cur = nxt; cA = nA; cB = nB; ++ui;
        if (wr == 1) PG8_BAR;
    }
    PG8_WAIT_V(0);
    PG8_BAR;
    if constexpr (Epi::AFTER_DRAIN) { const int l2 = opq((int)threadIdx.x) & 63; E.fused(acc, cur, wr, wc, l2 & 15, l2 >> 4, lds, wid, l2); }
#undef PG8_ACC_INIT
#undef PG8_SA
#undef PG8_SB
#undef PG8_STAGE
#undef PG8_LDA
#undef PG8_LDB
#undef PG8_LD8
#undef PG8_LO
#undef PG8_HI
#undef PG8_MMA
#undef PG8_WAIT_V
#undef PG8_WAIT_L
#undef PG8_BAR
#undef PG8_SCHED
}
template <int MODE, class Epi, class Sched>
__device__ __forceinline__ void gemm_tail(PG8_LAS unsigned char* lds, const int KB, const Sched& S, const Epi& E) {
    static_assert(MODE == 0 || MODE == 1, "bf16 or fp8");
    const int tid = opq((int)threadIdx.x), wid = __builtin_amdgcn_readfirstlane(tid >> 6), lane = tid & 63, wr = wid >> 2, wc = wid & 3, fr = lane & 15, fq = lane >> 4;
    const int nt = KB / 128;
    unsigned voffB[2];
#pragma unroll
    for (int i = 0; i < 2; ++i) { int R, C; stage_rc(tid * 16 + i * 8192, R, C); const int Rb = Epi::PERM ? ((R & ~31) + perm32(R & 31)) : R; voffB[i] = (unsigned)(Rb * KB + C * 2); }
    const unsigned ldsw = (unsigned)wid * 1024u, lds0 = (unsigned)(uintptr_t)lds;
    const int aoff = lds_byte(wr * 64 + fr, fq * 8), boff = lds_byte(wc * 32 + fr, fq * 8);
    for (int j = 0;; ++j) {
        Unit u; int ai, bj; if (!S.tail_next(j, u, ai, bj)) break;
        unsigned va[2][2]; S.aoff(u, tid, va);
        const unsigned va0 = ai ? va[1][0] : va[0][0], va1 = ai ? va[1][1] : va[0][1];
        const char* cA = u.ab; const char* cB = u.bb + (size_t)bj * HALF * KB;
        f32x4 acc[4][2];
#pragma unroll
        for (int m = 0; m < 4; ++m)
#pragma unroll
            for (int n = 0; n < 2; ++n) acc[m][n] = (f32x4){0.f, 0.f, 0.f, 0.f};
#define PG8T_STAGE(t, b) do { const unsigned d_ = lds0 + (unsigned)((b) * 2 * HTB) + ldsw; const char* a_ = cA + (size_t)(t) * 128; const char* b_ = cB + (size_t)(t) * 128; \
        glds16s(va0, a_, d_); glds16s(va1, a_, d_ + 8192u); glds16s(voffB[0], b_, d_ + (unsigned)HTB); glds16s(voffB[1], b_, d_ + (unsigned)HTB + 8192u); } while (0)
        PG8T_STAGE(0, 0);
#pragma unroll 1
        for (int t = 0; t < nt; ++t) { const int b = t & 1;
            if (t + 1 < nt) { PG8T_STAGE(t + 1, b ^ 1); asm volatile("s_waitcnt vmcnt(4)" ::: "memory"); } else asm volatile("s_waitcnt vmcnt(0)" ::: "memory");
            __builtin_amdgcn_s_barrier();
            v8i32 At[4], Bt[2];
            const PG8_LAS unsigned char* ab_ = lds + b * 2 * HTB + aoff; const PG8_LAS unsigned char* bb_ = lds + b * 2 * HTB + HTB + boff;
#pragma unroll
            for (int m = 0; m < 4; ++m) At[m] = __builtin_shufflevector(*(const PG8_LAS v4i32*)(ab_ + m * 2048), *(const PG8_LAS v4i32*)(ab_ + m * 2048 + 1024), 0, 1, 2, 3, 4, 5, 6, 7);
#pragma unroll
            for (int n = 0; n < 2; ++n) Bt[n] = __builtin_shufflevector(*(const PG8_LAS v4i32*)(bb_ + n * 2048), *(const PG8_LAS v4i32*)(bb_ + n * 2048 + 1024), 0, 1, 2, 3, 4, 5, 6, 7);
#pragma unroll
            for (int m = 0; m < 4; ++m)
#pragma unroll
                for (int n = 0; n < 2; ++n) {
                    if constexpr (MODE == 1) acc[m][n] = __builtin_amdgcn_mfma_scale_f32_16x16x128_f8f6f4(Bt[n], At[m], acc[m][n], 0, 0, 0, 0, 0, 0);
                    else { acc[m][n] = __builtin_amdgcn_mfma_f32_16x16x32_bf16(__builtin_bit_cast(bf16x8, __builtin_shufflevector(Bt[n], Bt[n], 0, 1, 2, 3)), __builtin_bit_cast(bf16x8, __builtin_shufflevector(At[m], At[m], 0, 1, 2, 3)), acc[m][n], 0, 0, 0);
                           acc[m][n] = __builtin_amdgcn_mfma_f32_16x16x32_bf16(__builtin_bit_cast(bf16x8, __builtin_shufflevector(Bt[n], Bt[n], 4, 5, 6, 7)), __builtin_bit_cast(bf16x8, __builtin_shufflevector(At[m], At[m], 4, 5, 6, 7)), acc[m][n], 0, 0, 0); } }
            asm volatile("s_waitcnt lgkmcnt(0)" ::: "memory");
            __builtin_amdgcn_s_barrier();
        }
#undef PG8T_STAGE
        { const int l2 = opq((int)threadIdx.x) & 63; E.quarter(acc, u, ai, bj, wr, wc, l2 & 15, l2 >> 4); }
    }
    asm volatile("s_waitcnt vmcnt(0)" ::: "memory");
    __builtin_amdgcn_s_barrier();
}
}
constexpr int D = 1024, NB = 8, SEQ = 4096, CTXL = 256, NL = NB * SEQ, NC = NB * CTXL, MT = NL + NC;
constexpr int INW = 1792, FF = 2816, NE = 8;
constexpr int C_Q = 0, C_K = 512, C_V = 640, C_U = 768, C_RQ = 1024, C_RK = 1152, C_RV = 1280, C_RG = 1536;
constexpr int NCHK = 34;
constexpr float LN_EPS = 1e-5f, LOG2E = 1.4426950408889634f;
constexpr float QSCALE = 0.125f * LOG2E;
constexpr float RSCALE = 0.17677669529663687f;
constexpr float ALPHA = 1.4142135623730951f;
constexpr int LCAP = 32768;

namespace pg8 {
__device__ __forceinline__ void store8(bf16_t* p, f32x4 v0, f32x4 v1) {
    u32x4 w; w.x = cvt_pk_bf16(v0[0], v0[1]); w.y = cvt_pk_bf16(v0[2], v0[3]); w.z = cvt_pk_bf16(v1[0], v1[1]); w.w = cvt_pk_bf16(v1[2], v1[3]); *(u32x4*)p = w;
}
typedef float f32x2_t __attribute__((ext_vector_type(2)));
struct EpiBf16 {
    static constexpr bool PERM = true, AFTER_DRAIN = false;
    bf16_t* O; int ldc; float scale;
    __device__ __forceinline__ void operator()(const f32x4 (&acc)[2][2][4][2], const Unit& u, int wr, int wc, int fr, int fq) const {
        const int row0 = u.pm * BM + wr * 64 + fr, col0 = u.pn * BM + wc * 32 + 8 * fq;
#pragma unroll
        for (int ai = 0; ai < 2; ++ai)
#pragma unroll
            for (int m = 0; m < 4; ++m) { bf16_t* rowp = O + (size_t)(row0 + ai * HALF + m * 16) * ldc + col0;
#pragma unroll
                for (int bj = 0; bj < 2; ++bj) store8(rowp + bj * HALF, acc[ai][bj][m][0] * scale, acc[ai][bj][m][1] * scale); }
    }
    __device__ __forceinline__ void quarter(const f32x4 (&a)[4][2], const Unit& u, int ai, int bj, int wr, int wc, int fr, int fq) const {
        const int row0 = u.pm * BM + ai * HALF + wr * 64 + fr, col0 = u.pn * BM + bj * HALF + wc * 32 + 8 * fq;
#pragma unroll
        for (int m = 0; m < 4; ++m) store8(O + (size_t)(row0 + m * 16) * ldc + col0, a[m][0] * scale, a[m][1] * scale);
    }
};
template <bool XF32> struct EpiRes {
    static constexpr bool PERM = true, AFTER_DRAIN = false;
    unsigned char* ws; float scale; size_t o_out, o_x16, o_g;
    __device__ __forceinline__ const float* grow(const Unit& u, int col) const { const int mr = u.pm < (NL / BM) ? (u.pm * BM) >> 12 : 8; return (const float*)(ws + o_g) + (size_t)mr * 6144 + col; }
    __device__ __forceinline__ void one(int row, int col, f32x4 a0, f32x4 a1, f32x4 g0, f32x4 g1, f32x4 x0, f32x4 x1) const { store8((bf16_t*)(ws + o_out) + (size_t)row * D + col, x0 * ALPHA + g0 * a0, x1 * ALPHA + g1 * a1); }
    __device__ __forceinline__ const float* xbase(const Unit& u) const {
        const float* const* ka = (const float* const*)__builtin_amdgcn_kernarg_segment_ptr(); return u.pm < (NL / BM) ? ka[0] : ka[2] - (size_t)NL * D; }
    __device__ __forceinline__ void ldx(const float* xb, int row, int col, f32x4& x0, f32x4& x1) const {
        if constexpr (XF32) { const float* p = xb + (size_t)row * D + col; x0 = *(const f32x4*)p; x1 = *(const f32x4*)(p + 4); }
        else { const u32x4 w = *(const u32x4*)((const bf16_t*)(ws + o_x16) + (size_t)row * D + col);
            x0 = (f32x4){__uint_as_float(w.x << 16), __uint_as_float(w.x & 0xffff0000u), __uint_as_float(w.y << 16), __uint_as_float(w.y & 0xffff0000u)};
            x1 = (f32x4){__uint_as_float(w.z << 16), __uint_as_float(w.z & 0xffff0000u), __uint_as_float(w.w << 16), __uint_as_float(w.w & 0xffff0000u)}; }
    }
    __device__ __forceinline__ void operator()(const f32x4 (&acc)[2][2][4][2], const Unit& u, int wr, int wc, int fr, int fq) const {
        const int row0 = u.pm * BM + wr * 64 + fr, col0 = u.pn * BM + wc * 32 + 8 * fq; const float* g = grow(u, col0); const float* xb = XF32 ? xbase(u) : nullptr;
        f32x4 gv[2][2];
#pragma unroll
        for (int bj = 0; bj < 2; ++bj)
#pragma unroll
            for (int n = 0; n < 2; ++n) gv[bj][n] = *(const f32x4*)(g + bj * HALF + 4 * n) * scale;
#pragma unroll
        for (int ai = 0; ai < 2; ++ai) { f32x4 xa[4][2][2];
#pragma unroll
            for (int m = 0; m < 4; ++m)
#pragma unroll
                for (int bj = 0; bj < 2; ++bj) ldx(xb, row0 + ai * HALF + m * 16, col0 + bj * HALF, xa[m][bj][0], xa[m][bj][1]);
#pragma unroll
            for (int m = 0; m < 4; ++m)
#pragma unroll
                for (int bj = 0; bj < 2; ++bj) one(row0 + ai * HALF + m * 16, col0 + bj * HALF, acc[ai][bj][m][0], acc[ai][bj][m][1], gv[bj][0], gv[bj][1], xa[m][bj][0], xa[m][bj][1]); }
    }
    __device__ __forceinline__ void quarter(const f32x4 (&a)[4][2], const Unit& u, int ai, int bj, int wr, int wc, int fr, int fq) const {
        const int row0 = u.pm * BM + ai * HALF + wr * 64 + fr, col0 = u.pn * BM + bj * HALF + wc * 32 + 8 * fq; const float* g = grow(u, col0);
        const f32x4 g0 = *(const f32x4*)g * scale, g1 = *(const f32x4*)(g + 4) * scale; f32x4 xa[4][2]; const float* xb = XF32 ? xbase(u) : nullptr;
#pragma unroll
        for (int m = 0; m < 4; ++m) ldx(xb, row0 + m * 16, col0, xa[m][0], xa[m][1]);
#pragma unroll
        for (int m = 0; m < 4; ++m) one(row0 + m * 16, col0, a[m][0], a[m][1], g0, g1, xa[m][0], xa[m][1]);
    }
};
template <bool Q  > struct EpiInProj {
    static constexpr bool PERM = true, AFTER_DRAIN = false;
    bf16_t* O; const PG8_LAS float* rope;
    const float* sa; const float* sw;
    __device__ __forceinline__ void operator()(const f32x4 (&acc)[2][2][4][2], const Unit& u, int wr, int wc, int fr, int fq) const {
        const int row0 = u.pm * BM + wr * 64 + fr; const bool lat = u.pm < (NL / BM);
        float rs8[2][4];
        f32x4 cw[2][2];
        if constexpr (Q) {
#pragma unroll
            for (int ai = 0; ai < 2; ++ai)
#pragma unroll
                for (int m = 0; m < 4; ++m) rs8[ai][m] = sa[row0 + ai * HALF + m * 16];
#pragma unroll
            for (int bj = 0; bj < 2; ++bj)
#pragma unroll
                for (int n = 0; n < 2; ++n) cw[bj][n] = *(const f32x4*)(sw + (2 * u.pn + bj) * HALF + wc * 32 + 8 * fq + 4 * n) * (1.0f / 127.0f);
        }
#pragma unroll
        for (int bj = 0; bj < 2; ++bj) {
            const int seg = 2 * u.pn + bj;
            const bool rope_on = lat && seg <= 4; const float sc = seg <= 3 ? QSCALE : (seg == 9 ? RSCALE : 1.0f);
#pragma unroll
            for (int ai = 0; ai < 2; ++ai)
#pragma unroll
                for (int m = 0; m < 4; ++m) { const int row = row0 + ai * HALF + m * 16;
                    f32x4 v0 = acc[ai][bj][m][0], v1 = acc[ai][bj][m][1];
                    if constexpr (Q) { const float s = rs8[ai][m]; const v4i32 i0 = __builtin_bit_cast(v4i32, v0), i1 = __builtin_bit_cast(v4i32, v1);
                        v0 = (f32x4){(float)i0[0], (float)i0[1], (float)i0[2], (float)i0[3]} * (cw[bj][0] * s); v1 = (f32x4){(float)i1[0], (float)i1[1], (float)i1[2], (float)i1[3]} * (cw[bj][1] * s); }
                    if (rope_on) { const int t = row & (SEQ - 1); const int pos = (wc & 1) ? (t & 63) : (t >> 6);
                        const f32x4 c4 = *(const PG8_LAS f32x4*)(rope + pos * 16 + 4 * fq), s4 = *(const PG8_LAS f32x4*)(rope + 1024 + pos * 16 + 4 * fq);
                        const f32x4 o0 = v0 * c4 - v1 * s4, o1 = v0 * s4 + v1 * c4; v0 = o0; v1 = o1; }
                    v0 = v0 * sc; v1 = v1 * sc;
                    store8(O + (size_t)row * INW + seg * HALF + wc * 32 + 8 * fq, v0, v1); }
        }
    }
};
struct EpiSwiGLU {
    static constexpr bool PERM = true, AFTER_DRAIN = false;
    bf16_t* H; int ldh;
    __device__ __forceinline__ void operator()(const f32x4 (&acc)[2][2][4][2], const Unit& u, int wr, int wc, int fr, int fq) const {
        const int row0 = u.pm * BM + wr * 64 + fr, col0 = u.pn * HALF + wc * 32 + 8 * fq;
#pragma unroll
        for (int ai = 0; ai < 2; ++ai)
#pragma unroll
            for (int m = 0; m < 4; ++m) { f32x4 h[2];
#pragma unroll
                for (int n = 0; n < 2; ++n) { const f32x4 g = acc[ai][0][m][n], up = acc[ai][1][m][n];
#pragma unroll
                    for (int i = 0; i < 4; ++i) h[n][i] = g[i] * __builtin_amdgcn_rcpf(1.0f + __builtin_amdgcn_exp2f(-LOG2E * g[i])) * up[i]; }
                store8(H + (size_t)(row0 + ai * HALF + m * 16) * ldh + col0, h[0], h[1]); }
    }
};
__device__ __forceinline__ unsigned pk4_fp8(float a, float b, float c, float d) {
    a = __builtin_amdgcn_fmed3f(a, -448.f, 448.f); b = __builtin_amdgcn_fmed3f(b, -448.f, 448.f); c = __builtin_amdgcn_fmed3f(c, -448.f, 448.f); d = __builtin_amdgcn_fmed3f(d, -448.f, 448.f);
    int w = __builtin_amdgcn_cvt_pk_fp8_f32(a, b, 0, false); w = __builtin_amdgcn_cvt_pk_fp8_f32(c, d, w, true); return (unsigned)w; }
struct EpiSwiGLU8 {
    static constexpr bool PERM = true, AFTER_DRAIN = false;
    unsigned char* H; int ldh; float in_scale, out_scale;
    __device__ __forceinline__ void operator()(const f32x4 (&acc)[2][2][4][2], const Unit& u, int wr, int wc, int fr, int fq) const {
        const int row0 = u.pm * BM + wr * 64 + fr, col0 = u.pn * HALF + wc * 32 + 8 * fq;
        const float k1 = -LOG2E * in_scale, invC = 1.0f / (in_scale * in_scale * out_scale);
#pragma unroll
        for (int ai = 0; ai < 2; ++ai)
#pragma unroll
            for (int m = 0; m < 4; ++m) { f32x4 h[2];
#pragma unroll
                for (int n = 0; n < 2; ++n) { const f32x4 G = acc[ai][0][m][n], U = acc[ai][1][m][n];
#pragma unroll
                    for (int p = 0; p < 2; ++p) { const f32x2_t g2 = {G[2 * p], G[2 * p + 1]}, u2 = {U[2 * p], U[2 * p + 1]}; const f32x2_t mm = g2 * k1;
                        const f32x2_t e = {__builtin_amdgcn_exp2f(mm.x), __builtin_amdgcn_exp2f(mm.y)}; const f32x2_t d = __builtin_elementwise_fma(e, (f32x2_t){invC, invC}, (f32x2_t){invC, invC});
                        const f32x2_t r = {__builtin_amdgcn_rcpf(d.x), __builtin_amdgcn_rcpf(d.y)}; const f32x2_t hh = (g2 * u2) * r; h[n][2 * p] = hh.x; h[n][2 * p + 1] = hh.y; } }
                typedef unsigned u32x2 __attribute__((ext_vector_type(2))); u32x2 w; w.x = pk4_fp8(h[0][0], h[0][1], h[0][2], h[0][3]); w.y = pk4_fp8(h[1][0], h[1][1], h[1][2], h[1][3]);
                *(u32x2*)(H + (size_t)(row0 + ai * HALF + m * 16) * ldh + col0) = w; }
    }
};
template <bool OUT8, bool GATH> struct EpiSwiGLUq {
    static constexpr bool PERM = true, AFTER_DRAIN = false;
    void* H; int ldh; const float* st; const float* sw; const int* list; float out_scale;
    __device__ __forceinline__ void operator()(const f32x4 (&acc)[2][2][4][2], const Unit& u, int wr, int wc, int fr, int fq) const {
        const int row0 = u.pm * BM + wr * 64 + fr, col0 = u.pn * HALF + wc * 32 + 8 * fq;
        const float* swp = sw + (size_t)u.e * 2 * FF + u.pn * BM + wc * 32 + 8 * fq;
        f32x4 sg[2], su[2];
#pragma unroll
        for (int n = 0; n < 2; ++n) { sg[n] = *(const f32x4*)(swp + 4 * n) * (1.0f / 127.0f); su[n] = *(const f32x4*)(swp + HALF + 4 * n) * (out_scale / 127.0f); }
        f32x4 cg[2], sgu[2];
#pragma unroll
        for (int n = 0; n < 2; ++n) { cg[n] = sg[n] * -LOG2E; sgu[n] = sg[n] * su[n]; }
        float sa8[2][4];
#pragma unroll
        for (int ai = 0; ai < 2; ++ai)
#pragma unroll
            for (int m = 0; m < 4; ++m) { const int rl = ai * HALF + wr * 64 + m * 16 + fr;
                if constexpr (GATH) { const int pos = u.rt * BM + rl; sa8[ai][m] = pos < u.cnt ? st[list[u.e * LCAP + pos] >> 1] : 0.f; } else sa8[ai][m] = st[u.pm * BM + rl]; }
#pragma unroll
        for (int ai = 0; ai < 2; ++ai)
#pragma unroll
            for (int m = 0; m < 4; ++m) { const float sa = sa8[ai][m], isa2 = __builtin_amdgcn_rcpf(sa * sa);
                f32x4 h[2];
#pragma unroll
                for (int n = 0; n < 2; ++n) { const v4i32 gi = __builtin_bit_cast(v4i32, acc[ai][0][m][n]), ui = __builtin_bit_cast(v4i32, acc[ai][1][m][n]);
#pragma unroll
                    for (int p = 0; p < 2; ++p) { const f32x2_t g2 = {(float)gi[2 * p], (float)gi[2 * p + 1]}, u2 = {(float)ui[2 * p], (float)ui[2 * p + 1]};
                        const f32x2_t mm = (g2 * (f32x2_t){cg[n][2 * p], cg[n][2 * p + 1]}) * sa;
                        const f32x2_t e = {__builtin_amdgcn_exp2f(mm.x), __builtin_amdgcn_exp2f(mm.y)}; const f32x2_t d = __builtin_elementwise_fma(e, (f32x2_t){isa2, isa2}, (f32x2_t){isa2, isa2});
                        const f32x2_t r = {__builtin_amdgcn_rcpf(d.x), __builtin_amdgcn_rcpf(d.y)}; const f32x2_t hh = ((g2 * u2) * (f32x2_t){sgu[n][2 * p], sgu[n][2 * p + 1]}) * r; h[n][2 * p] = hh.x; h[n][2 * p + 1] = hh.y; } }
                if constexpr (OUT8) { typedef unsigned u32x2 __attribute__((ext_vector_type(2))); u32x2 w; w.x = pk4_fp8(h[0][0], h[0][1], h[0][2], h[0][3]); w.y = pk4_fp8(h[1][0], h[1][1], h[1][2], h[1][3]);
                    *(u32x2*)((unsigned char*)H + (size_t)(row0 + ai * HALF + m * 16) * ldh + col0) = w; }
                else store8((bf16_t*)H + (size_t)(row0 + ai * HALF + m * 16) * ldh + col0, h[0], h[1]); }
    }
};
struct EpiMoeDown {
    static constexpr bool PERM = true, AFTER_DRAIN = false;
    bf16_t* Y; const int* list; const float* lgate; float scale;
    __device__ __forceinline__ void operator()(const f32x4 (&acc)[2][2][4][2], const Unit& u, int wr, int wc, int fr, int fq) const {
        const int col0 = u.pn * BM + wc * 32 + 8 * fq;
#pragma unroll
        for (int ai = 0; ai < 2; ++ai)
#pragma unroll
            for (int m = 0; m < 4; ++m) { const int pos = u.rt * BM + ai * HALF + wr * 64 + m * 16 + fr;
                if (pos < u.cnt) { const int ent = list[u.e * LCAP + pos]; const float g = lgate[u.e * LCAP + pos] * scale;
                    bf16_t* rowp = Y + ((size_t)(ent & 1) * NL + (size_t)(ent >> 1)) * D + col0;
#pragma unroll
                    for (int bj = 0; bj < 2; ++bj) store8(rowp + bj * HALF, acc[ai][bj][m][0] * g, acc[ai][bj][m][1] * g); } }
    }
    __device__ __forceinline__ void quarter(const f32x4 (&a)[4][2], const Unit& u, int ai, int bj, int wr, int wc, int fr, int fq) const {
        const int col0 = u.pn * BM + bj * HALF + wc * 32 + 8 * fq;
#pragma unroll
        for (int m = 0; m < 4; ++m) { const int pos = u.rt * BM + ai * HALF + wr * 64 + m * 16 + fr;
            if (pos < u.cnt) { const int ent = list[u.e * LCAP + pos]; const float g = lgate[u.e * LCAP + pos] * scale;
                store8(Y + ((size_t)(ent & 1) * NL + (size_t)(ent >> 1)) * D + col0, a[m][0] * g, a[m][1] * g); } }
    }
};
template <bool GATHER_, bool SK_ = false> struct MoeOrder {
    static constexpr bool GATHER = GATHER_, SK = SK_;
    int nrt, nN, G, c, KB, T0; const PG8_LAS int* tbl;
    const char* A; const char* Bt; size_t bstride; const int* list;
    bool rev = false;
    StreamK sk; TailPlan tail;
#if ((REP_MASK) >> 13) & 2
    int i0 = 0, i1 = 1 << 30;
#endif
    __device__ __forceinline__ void fill(Unit& u, int pm, int pn, int p0) const {
        const int T = T0 + pm; int e = 0;
#pragma unroll
        for (int j = 1; j < NE; ++j) e += (T >= tbl[j]) ? 1 : 0;
        e = __builtin_amdgcn_readfirstlane(e);
        u.pm = pm; u.pn = pn; u.e = e; u.rt = T - __builtin_amdgcn_readfirstlane(tbl[e]); u.cnt = __builtin_amdgcn_readfirstlane(tbl[NE + 1 + e]);
        u.ab = GATHER ? A : A + (size_t)pm * BM * KB + (size_t)p0 * 256; u.bb = Bt + (size_t)e * bstride + (size_t)pn * BM * KB + (size_t)p0 * 256;
    }
    __device__ __forceinline__ bool tail_next(int j, Unit& u, int& ai, int& bj) const {
        int cq, pm, pn; if (nrt <= 0 || !tail.quarter(j, c, cq, ai, bj) || !tile_order(tail.F, G, cq, nrt, nN, pm, pn, rev)) return false;
        fill(u, pm, pn, 0); return true;
    }
    __device__ __forceinline__ bool next(int i, Unit& u) const {
        int pm, pn, p0 = 0; if (i >= tail.F) return false;
#if ((REP_MASK) >> 13) & 2
        i += i0; if (i >= i1) return false;
#endif
        if constexpr (SK) { int L, np, part; if (nrt <= 0 || !sk.next(i, nrt * nN, G, L, p0, np, part)) return false;
            tile_from_L(L, nrt, nN, pm, pn); u.nt = 2 * np; u.part = part; u.slot = part == 2 ? c + 8 : c; }
        else { if (nrt <= 0 || !tile_order(i, G, c, nrt, nN, pm, pn, rev)) return false; }
        fill(u, pm, pn, p0); return true;
    }
    __device__ __forceinline__ const void* list_src(const Unit& u) const { return (const void*)(list + (size_t)u.e * LCAP + (size_t)u.rt * BM); }
    __device__ __forceinline__ void aoff_lds(const Unit& u, int tid, const PG8_LAS int* slot, unsigned (&va)[2][2]) const {
#pragma unroll
        for (int i = 0; i < 2; ++i) { int R, C; stage_rc(tid * 16 + i * 8192, R, C);
#pragma unroll
            for (int h = 0; h < 2; ++h) { const int rl = R + HALF * h; const int ent = slot[rl]; const int tok = (u.rt * BM + rl) < u.cnt ? (ent >> 1) : 0; va[h][i] = (unsigned)(tok * KB + C * 2); } }
    }
    __device__ __forceinline__ void aoff(const Unit& u, int tid, unsigned (&va)[2][2]) const {
#pragma unroll
        for (int i = 0; i < 2; ++i) { int R, C; stage_rc(tid * 16 + i * 8192, R, C);
#pragma unroll
            for (int h = 0; h < 2; ++h) {
                if (GATHER) { const int pos = u.rt * BM + R + HALF * h; const int tok = pos < u.cnt ? (list[u.e * LCAP + pos] >> 1) : 0; va[h][i] = (unsigned)(tok * KB + C * 2); }
                else va[h][i] = (unsigned)((R + HALF * h) * KB + C * 2); } }
    }
};
}
namespace pg8 {
struct PanelStats {
    unsigned* xbuf;
    unsigned* cnt;
    unsigned* tmo;
    float eps; unsigned code;
    __device__ __forceinline__ bool run(const f32x4 (&v)[2][2][4][2], const Unit& u, int wr, int wc, int fr, int fq, PG8_LAS unsigned char* lds, int wid, int lane) const {
        typedef float f32x2v __attribute__((ext_vector_type(2)));
        PG8_LAS f32x2v* P = (PG8_LAS f32x2v*)lds;
        PG8_LAS f32x2v* S = (PG8_LAS f32x2v*)(lds + 8192);
        PG8_LAS unsigned* flag = (PG8_LAS unsigned*)(lds + 8192 + 2048);
#pragma unroll
        for (int ai = 0; ai < 2; ++ai)
#pragma unroll
            for (int m = 0; m < 4; ++m) {
                float s = 0.f;
#pragma unroll
                for (int bj = 0; bj < 2; ++bj)
#pragma unroll
                    for (int n = 0; n < 2; ++n) { const f32x4 x = v[ai][bj][m][n]; s += (x[0] + x[1]) + (x[2] + x[3]); }
                s += __shfl_xor(s, 16); s += __shfl_xor(s, 32);
                const float mw = s * (1.0f / 64.0f); float q = 0.f;
#pragma unroll
                for (int bj = 0; bj < 2; ++bj)
#pragma unroll
                    for (int n = 0; n < 2; ++n) { const f32x4 d = v[ai][bj][m][n] - mw; q += (d[0] * d[0] + d[1] * d[1]) + (d[2] * d[2] + d[3] * d[3]); }
                q += __shfl_xor(q, 16); q += __shfl_xor(q, 32);
                if (fq == 0) P[(ai * HALF + wr * 64 + m * 16 + fr) * 4 + wc] = (f32x2v){mw, q};
            }
        asm volatile("s_waitcnt lgkmcnt(0)" ::: "memory"); __builtin_amdgcn_s_barrier(); asm volatile("" ::: "memory");
        const int row = wid * 32 + (lane & 31);
        if (lane < 32) {
            const f32x2v a = P[row * 4 + 0], b = P[row * 4 + 1], c = P[row * 4 + 2], d = P[row * 4 + 3];
            const float mt = (a.x + b.x + c.x + d.x) * 0.25f;
            const float da = a.x - mt, db = b.x - mt, dc = c.x - mt, dd = d.x - mt;
            const float m2 = (a.y + b.y) + (c.y + d.y) + 64.0f * ((da * da + db * db) + (dc * dc + dd * dd));
            unsigned long long* slot = (unsigned long long*)xbuf + ((size_t)(u.pm * BM + row) * 4 + u.pn);
            __hip_atomic_store(slot, ((unsigned long long)__float_as_uint(m2) << 32) | __float_as_uint(mt), __ATOMIC_RELAXED, __HIP_MEMORY_SCOPE_AGENT);
        }
        asm volatile("s_waitcnt vmcnt(0)" ::: "memory");
        if (lane == 0) __hip_atomic_fetch_add(cnt + 64 * u.pm, 1u, __ATOMIC_RELAXED, __HIP_MEMORY_SCOPE_AGENT);
        if (wid == 0) {
            bool dead = false; const unsigned long long t0 = __builtin_amdgcn_s_memrealtime(); const unsigned want = 32u;
            for (;;) {
                if ((unsigned)__builtin_amdgcn_readfirstlane(__hip_atomic_load(cnt + 64 * u.pm, __ATOMIC_RELAXED, __HIP_MEMORY_SCOPE_AGENT)) >= want) break;
                if (__builtin_amdgcn_s_memrealtime() - t0 > 2000000ull) {
                    if (lane == 0) { unsigned expect = 0u; __hip_atomic_compare_exchange_strong(tmo + 1, &expect, code | (unsigned)(u.pm & 0xff), __ATOMIC_RELAXED, __ATOMIC_RELAXED, __HIP_MEMORY_SCOPE_AGENT);
                                     __hip_atomic_store(tmo, 1u, __ATOMIC_RELAXED, __HIP_MEMORY_SCOPE_AGENT); }
                    dead = true; break; }
                __builtin_amdgcn_s_sleep(2);
            }
            __builtin_amdgcn_fence(__ATOMIC_ACQUIRE, "agent");
            if (lane == 0) flag[0] = dead ? 1u : 0u;
        }
        asm volatile("s_waitcnt vmcnt(0) lgkmcnt(0)" ::: "memory"); __builtin_amdgcn_s_barrier(); asm volatile("" ::: "memory");
        const bool bad = flag[0] != 0u;
        if (lane < 32) {
            const unsigned long long* slot = (const unsigned long long*)xbuf + (size_t)(u.pm * BM + row) * 4; float mt[4], m2[4]; float ms = 0.f;
#pragma unroll
            for (int t = 0; t < 4; ++t) { const unsigned long long w = __hip_atomic_load(slot + t, __ATOMIC_RELAXED, __HIP_MEMORY_SCOPE_AGENT); mt[t] = __uint_as_float((unsigned)w); m2[t] = __uint_as_float((unsigned)(w >> 32)); ms += mt[t]; }
            const float mean = ms * 0.25f; float q = 0.f;
#pragma unroll
            for (int t = 0; t < 4; ++t) { const float dm = mt[t] - mean; q += m2[t] + 256.0f * dm * dm; }
            S[row] = (f32x2v){mean, 1.0f / sqrtf(q * (1.0f / 1024.0f) + eps)};
        }
        asm volatile("s_waitcnt lgkmcnt(0)" ::: "memory"); __builtin_amdgcn_s_barrier(); asm volatile("" ::: "memory");
        return bad;
    }
};
template <bool OUT8, bool ROUTE> struct EpiLN {
    static constexpr bool PERM = true, AFTER_DRAIN = true;
    const float* xin_lat; const float* xin_ctx; float* xo_lat; float* xo_ctx;
    const float* mod_g; const float* mod_sh; const float* mod_sc;
    const float* gam; const float* bet;
    bf16_t* tout; unsigned char* t8; float* plog; const float* router;
    PanelStats st;
    __device__ __forceinline__ void fused(f32x4 (&acc)[2][2][4][2], const Unit& u, int wr, int wc, int fr, int fq, PG8_LAS unsigned char* lds, int wid, int lane) const {
        typedef float f32x2v __attribute__((ext_vector_type(2)));
        const bool lat = u.pm < (1 << 7); const int mr = lat ? (u.pm >> 4) : 8;
        const float* xin = lat ? xin_lat : xin_ctx - (size_t)(1 << 15) * 1024; float* xo = lat ? xo_lat : xo_ctx - (size_t)(1 << 15) * 1024;
        const int col0 = u.pn * BM + wc * 32 + 8 * fq; const int row0 = u.pm * BM + wr * 64 + fr;
        PG8_LAS float* Rl = (PG8_LAS float*)(lds + 16384);
        PG8_LAS float* PLs = (PG8_LAS float*)(lds + 24576);
        if constexpr (ROUTE) { const int t = threadIdx.x; ((PG8_LAS f32x4*)Rl)[t] = ((const f32x4*)(router + (size_t)u.pn * BM * 8))[t]; ((PG8_LAS f32x4*)PLs)[t] = (f32x4){0.f, 0.f, 0.f, 0.f}; }
        { f32x4 gv[2][2];
#pragma unroll
          for (int bj = 0; bj < 2; ++bj)
#pragma unroll
              for (int n = 0; n < 2; ++n) gv[bj][n] = *(const f32x4*)(mod_g + (size_t)mr * 6144 + col0 + bj * HALF + 4 * n);
#pragma unroll
          for (int ai = 0; ai < 2; ++ai)
#pragma unroll
              for (int m = 0; m < 4; ++m) { const float* xr = xin + (size_t)(row0 + ai * HALF + m * 16) * 1024 + col0;
#pragma unroll
                  for (int bj = 0; bj < 2; ++bj)
#pragma unroll
                      for (int n = 0; n < 2; ++n) acc[ai][bj][m][n] = 1.4142135623730951f * *(const f32x4*)(xr + bj * HALF + 4 * n) + gv[bj][n] * acc[ai][bj][m][n];
                  asm volatile("" : "+v"(acc[ai][0][m][0]), "+v"(acc[ai][0][m][1]), "+v"(acc[ai][1][m][0]), "+v"(acc[ai][1][m][1]));
                  if (m & 1) asm volatile("" ::: "memory"); } }
        st.run(acc, u, wr, wc, fr, fq, lds, wid, lane);
        const PG8_LAS f32x2v* S = (const PG8_LAS f32x2v*)(lds + 8192);
#pragma unroll
        for (int bj = 0; bj < 2; ++bj) {
            f32x4 ga[2], be[2], sc[2], sh[2];
#pragma unroll
            for (int n = 0; n < 2; ++n) { const int c = col0 + bj * HALF + 4 * n; ga[n] = *(const f32x4*)(gam + c); be[n] = *(const f32x4*)(bet + c); sc[n] = *(const f32x4*)(mod_sc + (size_t)mr * 6144 + c) + 1.0f; sh[n] = *(const f32x4*)(mod_sh + (size_t)mr * 6144 + c); }
#pragma unroll
            for (int ai = 0; ai < 2; ++ai)
#pragma unroll
                for (int m = 0; m < 4; ++m) { const int r = ai * HALF + wr * 64 + m * 16 + fr; const f32x2v sr = S[r]; const size_t off = (size_t)(u.pm * BM + r) * 1024 + col0 + bj * HALF;
                    f32x4 t[2];
#pragma unroll
                    for (int n = 0; n < 2; ++n) { const f32x4 x1 = (acc[ai][bj][m][n] - sr.x) * sr.y * ga[n] + be[n]; *(f32x4*)(xo + off + 4 * n) = x1; t[n] = x1 * sc[n] + sh[n]; if constexpr (ROUTE) acc[ai][bj][m][n] = t[n]; }
                    if constexpr (OUT8) { typedef unsigned u32x2 __attribute__((ext_vector_type(2))); u32x2 w; w.x = pk4_fp8(t[0][0] * 4.0f, t[0][1] * 4.0f, t[0][2] * 4.0f, t[0][3] * 4.0f); w.y = pk4_fp8(t[1][0] * 4.0f, t[1][1] * 4.0f, t[1][2] * 4.0f, t[1][3] * 4.0f); *(u32x2*)(t8 + off) = w; }
                    else store8(tout + off, t[0], t[1]);
                    if (m & 1) asm volatile("" ::: "memory"); }
        }
        if constexpr (ROUTE) {
#pragma unroll
            for (int ai = 0; ai < 2; ++ai)
#pragma unroll
                for (int m = 0; m < 4; ++m) { float pl[8];
#pragma unroll
                    for (int e = 0; e < 8; ++e) pl[e] = 0.f;
#pragma unroll
                    for (int bj = 0; bj < 2; ++bj)
#pragma unroll
                        for (int n = 0; n < 2; ++n)
#pragma unroll
                            for (int i = 0; i < 4; ++i) { const PG8_LAS float* rr = Rl + (wc * 32 + 8 * fq + bj * HALF + 4 * n + i) * 8; const f32x4 r0 = *(const PG8_LAS f32x4*)rr, r1 = *(const PG8_LAS f32x4*)(rr + 4); const float tv = acc[ai][bj][m][n][i];
                                pl[0] += tv * r0[0]; pl[1] += tv * r0[1]; pl[2] += tv * r0[2]; pl[3] += tv * r0[3]; pl[4] += tv * r1[0]; pl[5] += tv * r1[1]; pl[6] += tv * r1[2]; pl[7] += tv * r1[3]; }
#pragma unroll
                    for (int e = 0; e < 8; ++e) { pl[e] += __shfl_xor(pl[e], 16); pl[e] += __shfl_xor(pl[e], 32); }
                    if (fq == 0) { PG8_LAS float* d = PLs + (ai * HALF + wr * 64 + m * 16 + fr) * 8;
#pragma unroll
                        for (int e = 0; e < 8; ++e) __hip_atomic_fetch_add(d + e, pl[e], __ATOMIC_RELAXED, __HIP_MEMORY_SCOPE_WORKGROUP); } }
            asm volatile("s_waitcnt lgkmcnt(0)" ::: "memory"); __builtin_amdgcn_s_barrier(); asm volatile("" ::: "memory");
            { const int t = threadIdx.x; ((f32x4*)(plog + ((size_t)u.pn * (1 << 15) + (size_t)u.pm * BM) * 8))[t] = ((const PG8_LAS f32x4*)PLs)[t]; }
        }
    }
};
struct SliceOrder {
    static constexpr bool GATHER = false, SK = false;
    int base, total, v, KB; const char* A; const char* Bt;
    __device__ __forceinline__ bool next(int i, Unit& u) const {
        const int L = base + v; if (i != 0 || L >= total) return false;
        u.pm = L >> 2; u.pn = L & 3; u.e = 0; u.rt = u.pm; u.cnt = 1 << 30; u.ab = A + (size_t)u.pm * BM * KB; u.bb = Bt + (size_t)u.pn * BM * KB; return true;
    }
    __device__ __forceinline__ void aoff(const Unit&, int tid, unsigned (&va)[2][2]) const {
#pragma unroll
        for (int i = 0; i < 2; ++i) { int R, C; stage_rc(tid * 16 + i * 8192, R, C);
#pragma unroll
            for (int h = 0; h < 2; ++h) va[h][i] = (unsigned)((R + HALF * h) * KB + C * 2); }
    }
};
}
constexpr size_t MiB = 1u << 20;
constexpr size_t WS_CTL = 0, CTL_ZERO_BYTES = 1 * MiB;
constexpr size_t WS_MOD = 1 * MiB;
constexpr size_t WS_ROPE = 1 * MiB + 512 * 1024;
constexpr size_t WS_ST = 1 * MiB + 768 * 1024;
constexpr size_t WS_SH = 4 * MiB;
constexpr int CM_WIN = 9 * 2 * FF;
constexpr size_t WS_T8L0 = 451 * MiB;
constexpr size_t WS_LIST = 2 * MiB, WS_LGATE = 3 * MiB;
constexpr size_t WS_KVS = 8 * MiB;
constexpr size_t WS_XC = 26 * MiB;
constexpr size_t WS_WIN = 34 * MiB, WS_WOUT = 41 * MiB, WS_FGU = 45 * MiB, WS_FD = 56 * MiB;
constexpr size_t WS_MGU8 = 62 * MiB, WS_MD8 = 106 * MiB;
#if RES16
constexpr size_t WS_X16 = 128 * MiB;
constexpr size_t WS_ACT = 196 * MiB;
constexpr size_t WS_PROJ = 264 * MiB, WS_MIX = 383 * MiB;
constexpr size_t WS_HID = 264 * MiB;
constexpr size_t WS_T8 = 8 * MiB;
constexpr size_t WS_Y = 196 * MiB, WS_HID8 = 324 * MiB;
constexpr size_t WS_END = 506 * MiB;
static_assert(!FFN0_FP8, "RES16 places T8 over layer-0 data");
static_assert(WS_T8L0 + (size_t)MT * D <= WS_END && WS_MIX + (size_t)MT * D * 2 <= WS_T8L0, "T8L0");
static_assert(WS_MD8 + (size_t)NE * FF * D <= WS_X16 && WS_X16 + (size_t)MT * D * 2 <= WS_ACT && WS_T8 + (size_t)NL * D <= WS_MGU8, "map");
#else
constexpr size_t WS_T8 = 128 * MiB;
constexpr size_t WS_ACT = 194 * MiB;
constexpr size_t WS_PROJ = 262 * MiB, WS_MIX = 381 * MiB;
constexpr size_t WS_HID = 262 * MiB;
constexpr size_t WS_Y = 160 * MiB, WS_HID8 = 288 * MiB;
constexpr size_t WS_END = 470 * MiB;
static_assert(WS_MD8 + (size_t)NE * FF * D <= WS_T8 && WS_T8 + (size_t)MT * D <= WS_ACT, "map");
#endif
static_assert(WS_WIN + (size_t)2 * INW * D * 2 <= WS_WOUT && WS_FGU + (size_t)2 * FF * D * 2 <= WS_FD && WS_FD + (size_t)FF * D * 2 <= WS_MGU8 && WS_MGU8 + (size_t)NE * 2 * FF * D <= WS_MD8, "weights map");
static_assert(WS_ACT + (size_t)MT * D * 2 <= WS_PROJ && WS_PROJ + (size_t)MT * INW * 2 <= WS_MIX && WS_MIX + (size_t)MT * D * 2 <= WS_END && WS_HID + (size_t)MT * FF * 2 <= WS_END, "act map");
static_assert(WS_Y + (size_t)2 * NL * D * 2 <= WS_HID8 && WS_HID8 + (size_t)264 * 256 * FF <= WS_END && WS_KVS + (size_t)2 * 32 * NCHK * 2048 * 4 <= WS_XC, "moe map");
constexpr int CW_TMO = 0;
constexpr int CW_GCNT = 1024;
constexpr int CW_BGQ = 2048;
constexpr int CW_CMAX = 65536;
constexpr int CW_BAR = 4096;
constexpr int CW_SK = 200000;
constexpr int CW_SEAM = 16384, SEAM_BANK = 136 * 64;
constexpr size_t WS_XB = 4 * MiB, XB_BANK = (size_t)MT * 4 * 8;
constexpr size_t WS_PLOG = WS_KVS;

constexpr int RING_BYTES = 131072;
constexpr int SCR_BYTES = 155648;
constexpr int ROPE_LDS = 139264;
constexpr int MISC_OFF = SCR_BYTES;
constexpr int LDS_BYTES = SCR_BYTES + 256;

#define GAS __attribute__((address_space(1)))
#define LAS __attribute__((address_space(3)))
typedef unsigned short bf16;
typedef unsigned v4u __attribute__((ext_vector_type(4)));
typedef unsigned v2u __attribute__((ext_vector_type(2)));
typedef float f32x4 __attribute__((ext_vector_type(4)));
typedef __bf16 bf16x2_t __attribute__((ext_vector_type(2)));
typedef float f32x2_t __attribute__((ext_vector_type(2)));
#define RLX_AGENT __ATOMIC_RELAXED, __HIP_MEMORY_SCOPE_AGENT
__device__ __forceinline__ unsigned pk2(float lo, float hi) { f32x2_t v = {lo, hi}; bf16x2_t b = __builtin_convertvector(v, bf16x2_t); return __builtin_bit_cast(unsigned, b); }
__device__ __forceinline__ float bflo(unsigned w) { return __uint_as_float(w << 16); }
__device__ __forceinline__ float bfhi(unsigned w) { return __uint_as_float(w & 0xffff0000u); }
__device__ __forceinline__ float dot2bf(unsigned a, unsigned b, float c) { return __builtin_amdgcn_fdot2_f32_bf16(__builtin_bit_cast(bf16x2_t, a), __builtin_bit_cast(bf16x2_t, b), c, false); }
template <int CTRL, int ROWMASK> __device__ __forceinline__ float dpp_f(float v) { return __int_as_float(__builtin_amdgcn_update_dpp(0, __float_as_int(v), CTRL, ROWMASK, 0xF, false)); }
__device__ __forceinline__ float wave_sum(float v) {
    v += dpp_f<0xB1, 0xF>(v); v += dpp_f<0x4E, 0xF>(v); v += dpp_f<0x141, 0xF>(v); v += dpp_f<0x140, 0xF>(v);
    v += dpp_f<0x142, 0xA>(v); v += dpp_f<0x143, 0xC>(v);
    return __int_as_float(__builtin_amdgcn_readlane(__float_as_int(v), 63));
}
__device__ __forceinline__ float wave_max_abs(float v) {
    v = fmaxf(v, dpp_f<0xB1, 0xF>(v)); v = fmaxf(v, dpp_f<0x4E, 0xF>(v)); v = fmaxf(v, dpp_f<0x141, 0xF>(v)); v = fmaxf(v, dpp_f<0x140, 0xF>(v));
    v = fmaxf(v, dpp_f<0x142, 0xA>(v)); v = fmaxf(v, dpp_f<0x143, 0xC>(v));
    return __int_as_float(__builtin_amdgcn_readlane(__float_as_int(v), 63));
}

#define XB_TMO      128
#define XB_XCNT(j)  (256  + 64 * (j))
#define XB_XSUB(j)  (1280 + 64 * (j))
#define XB_XGEN(j)  (2304 + 64 * (j))
#define XB_TOP      3328
#define XB_TOPGEN   3392
#define XCD_BAR_WORDS 3456
#define XB_SPIN_CAP (1u << 18)
__device__ __forceinline__ unsigned xb_ld(unsigned* p)              { return __hip_atomic_load(p, __ATOMIC_RELAXED, __HIP_MEMORY_SCOPE_AGENT); }
__device__ __forceinline__ unsigned xb_add(unsigned* p, unsigned v) { return __hip_atomic_fetch_add(p, v, __ATOMIC_RELAXED, __HIP_MEMORY_SCOPE_AGENT); }
__device__ __forceinline__ unsigned xb_xcc_id() { return (unsigned)__builtin_amdgcn_s_getreg((3 << 11) | 20) & 0xFu; }
#define XB_SPIN(cond, bar) do { unsigned _sp = 0; while (cond) { __builtin_amdgcn_s_sleep(1); \
    if ((++_sp & 255u) == 0u) { if (xb_ld(&(bar)[XB_TMO])) break; if (_sp > XB_SPIN_CAP) { atomicAdd(&(bar)[XB_TMO], 1u); break; } } } } while (0)
struct XcdBarrier { unsigned* bar; unsigned x; volatile LAS unsigned* st; };
__device__ __forceinline__ XcdBarrier xcd_barrier_post(unsigned* bar, volatile LAS unsigned* st) {
    XcdBarrier b; b.bar = bar; b.x = xb_xcc_id(); b.st = st;
    if (threadIdx.x == 0) (void)xb_add(&bar[XB_XCNT(b.x)], 1u);
    return b;
}
__device__ __forceinline__ void xcd_barrier_complete(unsigned* bar, unsigned x, unsigned& nloc, unsigned& nx) {
    const unsigned G = gridDim.x * gridDim.y * gridDim.z;
    unsigned sum, cnt, mine, sp = 0u;
    for (;;) {
        sum = 0u; cnt = 0u; mine = 0u;
#pragma unroll
        for (unsigned j = 0; j < 16; ++j) { const unsigned c = xb_ld(&bar[XB_XCNT(j)]); sum += c; cnt += (c > 0u) ? 1u : 0u; mine = (j == x) ? c : mine; }
        if (sum == G) break;
        __builtin_amdgcn_s_sleep(1);
        if ((++sp & 255u) == 0u) { if (xb_ld(&bar[XB_TMO])) break; if (sp > XB_SPIN_CAP) { atomicAdd(&bar[XB_TMO], 1u); break; } }
    }
    nloc = mine > 0u ? mine : 1u; nx = cnt > 0u ? cnt : 1u;
}
__device__ __forceinline__ void xcd_barrier(const XcdBarrier& b) {
    asm volatile("s_waitcnt vmcnt(0)" ::: "memory");
    __syncthreads();
    if (threadIdx.x == 0) {
        unsigned* bar = b.bar;
        __builtin_amdgcn_s_waitcnt(0);
        unsigned nloc = b.st[0], nx = b.st[1];
        if (nloc == 0u) { xcd_barrier_complete(bar, b.x, nloc, nx); b.st[0] = nloc; b.st[1] = nx; }
        const unsigned old = xb_add(&bar[XB_XSUB(b.x)], 1u);
        const unsigned gen = old / nloc;
        if (old + 1u == (gen + 1u) * nloc) {
            __builtin_amdgcn_fence(__ATOMIC_RELEASE, "agent");
            asm volatile("s_waitcnt vmcnt(0)" ::: "memory");
            const unsigned og = xb_add(&bar[XB_TOP], 1u);
            const unsigned tg = og / nx;
            if (og + 1u == (tg + 1u) * nx) xb_add(&bar[XB_TOPGEN], 1u);
            else XB_SPIN(xb_ld(&bar[XB_TOPGEN]) == tg, bar);
            __builtin_amdgcn_fence(__ATOMIC_ACQUIRE, "agent");
            xb_add(&bar[XB_XGEN(b.x)], 1u);
            asm volatile("s_waitcnt vmcnt(0)" ::: "memory");
        } else {
            XB_SPIN(xb_ld(&bar[XB_XGEN(b.x)]) == gen, bar);
            __builtin_amdgcn_fence(__ATOMIC_ACQUIRE, "agent");
            asm volatile("s_waitcnt vmcnt(0)" ::: "memory");
        }
    }
    __syncthreads();
}

constexpr int NWAVES = 8, NTHR = 512;
struct Frame {
    LAS unsigned char* lds;
    int wave, vcu, G;
    unsigned char* ws; float* out;
    const float *x, *c, *ctx, *c_ctx, *w_mod, *b_mod, *w_in, *sink, *pool_w, *pool_scale, *lgf, *lgb, *w_out, *ln1_g, *ln1_b, *ln2_g, *ln2_b;
    const float *fw_gate, *fw_up, *fw_down, *router, *mw_gate, *mw_up, *mw_down;
};
#define WSP(T, off) ((T*)(F.ws + (off)))

__device__ __forceinline__ void tile_to_lds(const float* W, int N, int k0, int n0, LAS float* scr, int lane) {
    const int rr = lane >> 3, c4 = (lane & 7) * 4; f32x4 v[8];
#pragma unroll
    for (int i = 0; i < 8; ++i) v[i] = *(const f32x4*)(W + (size_t)(k0 + 8 * i + rr) * N + n0 + c4);
#pragma unroll
    for (int i = 0; i < 8; ++i) { LAS float* d = scr + (8 * i + rr) * 33 + c4; d[0] = v[i][0]; d[1] = v[i][1]; d[2] = v[i][2]; d[3] = v[i][3]; }
    asm volatile("s_waitcnt lgkmcnt(0)" ::: "memory");
}
template <class RowMap>
__device__ __forceinline__ void transpose_item(const float* W, int K, int N, bf16* WT, const RowMap& rowmap, LAS float* scr, int item, int lane) {
    const int nblk = N / 32, kb = item / nblk, nb = item % nblk, k0 = 64 * kb, n0 = 32 * nb;
    tile_to_lds(W, N, k0, n0, scr, lane);
    const int c = lane & 7;
#pragma unroll
    for (int j = 0; j < 4; ++j) { const int n = (lane >> 3) + 8 * j; const LAS float* s = scr + (8 * c) * 33 + n;
        v4u o; o.x = pk2(s[0 * 33], s[1 * 33]); o.y = pk2(s[2 * 33], s[3 * 33]); o.z = pk2(s[4 * 33], s[5 * 33]); o.w = pk2(s[6 * 33], s[7 * 33]);
        *(GAS v4u*)(WT + (size_t)rowmap(n0 + n) * K + k0 + 8 * c) = o; }
    asm volatile("s_waitcnt lgkmcnt(0)" ::: "memory");
}
__device__ __forceinline__ unsigned pk4_fp8s(float a, float b, float c, float d, float s) { return pg8::pk4_fp8(a * s, b * s, c * s, d * s); }
template <class RowMap>
__device__ __forceinline__ void transpose_item8(const float* W, int K, int N, unsigned char* WT, const RowMap& rowmap, float scale, LAS float* scr, int item, int lane) {
    const int nblk = N / 32, kb = item / nblk, nb = item % nblk, k0 = 64 * kb, n0 = 32 * nb;
    tile_to_lds(W, N, k0, n0, scr, lane);
    const int c = lane & 7;
#pragma unroll
    for (int j = 0; j < 4; ++j) { const int n = (lane >> 3) + 8 * j; const LAS float* s = scr + (8 * c) * 33 + n;
        v2u o; o.x = pk4_fp8s(s[0 * 33], s[1 * 33], s[2 * 33], s[3 * 33], scale); o.y = pk4_fp8s(s[4 * 33], s[5 * 33], s[6 * 33], s[7 * 33], scale);
        *(GAS v2u*)(WT + (size_t)rowmap(n0 + n) * K + k0 + 8 * c) = o; }
    asm volatile("s_waitcnt lgkmcnt(0)" ::: "memory");
}
template <class RowMap>
__device__ __forceinline__ void colmax_item(const float* W, int N, unsigned* cmax, const RowMap& rowmap, int item, int lane) {
    const int nblk = N / 32, kb = item / nblk, nb = item % nblk, k0 = 64 * kb, n0 = 32 * nb;
    const int rr = lane >> 3, c4 = (lane & 7) * 4; f32x4 v[8];
#pragma unroll
    for (int i = 0; i < 8; ++i) v[i] = *(const f32x4*)(W + (size_t)(k0 + 8 * i + rr) * N + n0 + c4);
    float mx[4];
#pragma unroll
    for (int q = 0; q < 4; ++q) { float m = fabsf(v[0][q]);
#pragma unroll
        for (int i = 1; i < 8; ++i) m = fmaxf(m, fabsf(v[i][q]));
        m = fmaxf(m, __shfl_xor(m, 8)); m = fmaxf(m, __shfl_xor(m, 16)); m = fmaxf(m, __shfl_xor(m, 32)); mx[q] = m; }
    if (lane < 8) {
#pragma unroll
        for (int q = 0; q < 4; ++q) atomicMax(cmax + rowmap(n0 + c4 + q), __float_as_uint(mx[q])); }
}
__device__ __forceinline__ unsigned pk4_i8(float a, float b, float c, float d, float inv) {
    const int q0 = (int)__builtin_rintf(a * inv), q1 = (int)__builtin_rintf(b * inv), q2 = (int)__builtin_rintf(c * inv), q3 = (int)__builtin_rintf(d * inv);
    return (unsigned)(q0 & 255) | ((unsigned)(q1 & 255) << 8) | ((unsigned)(q2 & 255) << 16) | ((unsigned)(q3 & 255) << 24);
}
template <class RowMap>
__device__ __forceinline__ void transpose_item_q(const float* W, int K, int N, unsigned char* WT, const RowMap& rowmap, const unsigned* cmax, LAS float* scr, int item, int lane) {
    const int nblk = N / 32, kb = item / nblk, nb = item % nblk, k0 = 64 * kb, n0 = 32 * nb;
    tile_to_lds(W, N, k0, n0, scr, lane);
    const int c = lane & 7;
#pragma unroll
    for (int j = 0; j < 4; ++j) { const int n = (lane >> 3) + 8 * j; const LAS float* s = scr + (8 * c) * 33 + n; const int row = rowmap(n0 + n);
        const float mx = __uint_as_float(cmax[row]); const float inv = mx > 0.f ? 127.0f / mx : 0.f;
        v2u o; o.x = pk4_i8(s[0 * 33], s[1 * 33], s[2 * 33], s[3 * 33], inv); o.y = pk4_i8(s[4 * 33], s[5 * 33], s[6 * 33], s[7 * 33], inv);
        *(GAS v2u*)(WT + (size_t)row * K + k0 + 8 * c) = o; }
    asm volatile("s_waitcnt lgkmcnt(0)" ::: "memory");
}
struct MapId { __device__ __forceinline__ int operator()(int n) const { return n; } };
struct MapInProj {
    __device__ __forceinline__ int operator()(int n) const { if (n >= C_V) return n; const int dd = n & 31, j = dd & 15, x2 = dd >> 4; return (n & ~31) + 8 * (j >> 2) + 4 * x2 + (j & 3); } };
struct MapGU { int up; __device__ __forceinline__ int operator()(int n) const { return 256 * (n >> 7) + 128 * up + (n & 127); } };

__device__ __forceinline__ void p_prep(Frame& F) {
    const int tid = opq((int)threadIdx.x), lane = tid & 63, wave = F.wave;
    LAS float* sv = (LAS float*)F.lds;
    LAS float* red = sv + 1024 * 12;
    bool have_sv = false;
    for (int un = blockIdx.x; un < 2 * 96; un += F.G) {
        if (!have_sv) {
            for (int idx = tid; idx < 9 * 1024; idx += NTHR) { const int r = idx >> 10, k = idx & 1023; const float v = r < 8 ? F.c[r * 1024 + k] : F.c_ctx[k]; sv[k * 12 + r] = v / (1.0f + __expf(-v)); }
            have_sv = true; __syncthreads();
        }
        const int layer = un / 96, cc = un % 96, col = cc * 64 + lane;
        float acc[9];
#pragma unroll
        for (int r = 0; r < 9; ++r) acc[r] = 0.f;
        const float* wp = F.w_mod + ((size_t)layer * 1024 + wave * 128) * 6144 + col;
#pragma unroll 8
        for (int kk = 0; kk < 128; ++kk) { const float wv = wp[(size_t)kk * 6144]; const LAS float* s = sv + (wave * 128 + kk) * 12;
            const f32x4 s0 = *(const LAS f32x4*)s, s1 = *(const LAS f32x4*)(s + 4); const float s8 = s[8];
            acc[0] += s0[0] * wv; acc[1] += s0[1] * wv; acc[2] += s0[2] * wv; acc[3] += s0[3] * wv; acc[4] += s1[0] * wv; acc[5] += s1[1] * wv; acc[6] += s1[2] * wv; acc[7] += s1[3] * wv; acc[8] += s8 * wv; }
#pragma unroll
        for (int r = 0; r < 9; ++r) red[(wave * 9 + r) * 64 + lane] = acc[r];
        __syncthreads();
        for (int idx = tid; idx < 9 * 64; idx += NTHR) { const int r = idx >> 6, ln = idx & 63; float s = F.b_mod[layer * 6144 + cc * 64 + ln];
#pragma unroll
            for (int w = 0; w < 8; ++w) s += red[(w * 9 + r) * 64 + ln];
            WSP(float, WS_MOD)[(size_t)(layer * 9 + r) * 6144 + cc * 64 + ln] = s; }
        __syncthreads();
    }
    if (blockIdx.x == F.G - 1) { for (int idx = tid; idx < 1024; idx += NTHR) { const int pos = idx >> 4, j = idx & 15; const float inv = powf(10000.0f, -(float)j / 16.0f); const float ang = (float)pos * inv;
            WSP(float, WS_ROPE)[idx] = cosf(ang); WSP(float, WS_ROPE)[1024 + idx] = sinf(ang); } }
    __syncthreads();
    LAS float* scr = (LAS float*)(F.lds + wave * 16384);
    const int gw = F.vcu * NWAVES + wave, NGW = F.G * NWAVES;
    constexpr int I_IN = (D / 64) * (INW / 32), I_OUT = (D / 64) * (D / 32), I_GU = (D / 64) * (FF / 32), I_DN = (FF / 64) * (D / 32);
    constexpr int N_CVT = 2 * (I_IN + I_OUT) + I_DN, N_MAX = (MOEQ ? 1 + NE : 1) * 2 * I_GU;
    unsigned* cmax = WSP(unsigned, WS_CTL) + CW_CMAX;
    for (int it = gw; it < N_CVT + N_MAX; it += NGW) {
        int r = it;
#if INQ
        if (r < 2 * I_IN) { const int l = r / I_IN; colmax_item(F.w_in + (size_t)l * D * INW, INW, cmax + CM_WIN + l * INW, MapInProj{}, r % I_IN, lane); continue; } r -= 2 * I_IN;
#else
        if (r < 2 * I_IN) { const int l = r / I_IN; transpose_item(F.w_in + (size_t)l * D * INW, D, INW, WSP(bf16, WS_WIN) + (size_t)l * INW * D, MapInProj{}, scr, r % I_IN, lane); continue; } r -= 2 * I_IN;
#endif
        if (r < 2 * I_OUT) { const int l = r / I_OUT; transpose_item(F.w_out + (size_t)l * D * D, D, D, WSP(bf16, WS_WOUT) + (size_t)l * D * D, MapId{}, scr, r % I_OUT, lane); continue; } r -= 2 * I_OUT;
#if HID_FP8
        if (r < I_DN) { transpose_item8(F.fw_down, FF, D, WSP(unsigned char, WS_FD), MapId{}, 128.0f, scr, r, lane); continue; } r -= I_DN;
#else
        if (r < I_DN) { transpose_item(F.fw_down, FF, D, WSP(bf16, WS_FD), MapId{}, scr, r, lane); continue; } r -= I_DN;
#endif
        const int m = r / (2 * I_GU), up = (r / I_GU) & 1, item = r % I_GU;
        const float* w = m == 0 ? (up ? F.fw_up : F.fw_gate) : (up ? F.mw_up : F.mw_gate) + (size_t)(m - 1) * D * FF;
        colmax_item(w, FF, cmax + m * 2 * FF, MapGU{up}, item, lane);
    }
}
__device__ __forceinline__ void quant_dense_gu(Frame& F) {
    const int lane = opq((int)threadIdx.x) & 63; LAS float* scr = (LAS float*)(F.lds + F.wave * 16384);
    constexpr int I_GU = (D / 64) * (FF / 32);
    constexpr int I_IN = (D / 64) * (INW / 32);
    for (int it = F.vcu * NWAVES + F.wave; it < 2 * I_GU + (INQ ? 2 * I_IN : 0); it += F.G * NWAVES) {
        if (it < 2 * I_GU) { const int up = it / I_GU; transpose_item_q(up ? F.fw_up : F.fw_gate, D, FF, WSP(unsigned char, WS_FGU), MapGU{up}, WSP(unsigned, WS_CTL) + CW_CMAX, scr, it % I_GU, lane); }
        else { const int r = it - 2 * I_GU, l = r / I_IN; transpose_item_q(F.w_in + (size_t)l * D * INW, D, INW, WSP(unsigned char, WS_WIN) + (size_t)l * INW * D, MapInProj{}, WSP(unsigned, WS_CTL) + CW_CMAX + CM_WIN + l * INW, scr, r % I_IN, lane); } }
}
constexpr int CV_A = 3200, CV_B = 9100, CV_C = 12100, CV_E = 14700;
__device__ __forceinline__ void bg_convert(Frame& F, int first_wg, int n_wg, int it0 = 0, int it1 = 1 << 30) {
    const int lane = opq((int)threadIdx.x) & 63; LAS float* scr = (LAS float*)(F.lds + F.wave * 16384);
    constexpr int I_GU = (D / 64) * (FF / 32), I_DN = (FF / 64) * (D / 32), PER = 2 * I_GU + I_DN, TOTAL = NE * PER;
    int slot0, nslot, nslots;
    if (first_wg < 0) { const int b = (int)blockIdx.x; nslots = 1024; if (b < 128) { slot0 = 3 * b; nslot = 3; } else { slot0 = 384 + 5 * (b - 128); nslot = 5; } }
    else { const int j = (int)blockIdx.x - first_wg; if (j < 0 || j >= n_wg) return; slot0 = j; nslot = 1; nslots = n_wg; }
    for (int sl = 0; sl < nslot; ++sl)
    for (int it = it0 + (slot0 + sl) * NWAVES + F.wave; it < (it1 < TOTAL ? it1 : TOTAL); it += nslots * NWAVES) { const int m = it / PER; int r = it % PER;
        unsigned char* gu = WSP(unsigned char, WS_MGU8) + (size_t)m * 2 * FF * D; unsigned char* dn = WSP(unsigned char, WS_MD8) + (size_t)m * FF * D;
        const unsigned* cm = WSP(unsigned, WS_CTL) + CW_CMAX + (1 + m) * 2 * FF;
#if MOEQ
        if (r < I_GU) { transpose_item_q(F.mw_gate + (size_t)m * D * FF, D, FF, gu, MapGU{0}, cm, scr, r, lane); continue; } r -= I_GU;
        if (r < I_GU) { transpose_item_q(F.mw_up + (size_t)m * D * FF, D, FF, gu, MapGU{1}, cm, scr, r, lane); continue; } r -= I_GU;
#else
        (void)cm;
        if (r < I_GU) { transpose_item8(F.mw_gate + (size_t)m * D * FF, D, FF, gu, MapGU{0}, 32.0f, scr, r, lane); continue; } r -= I_GU;
        if (r < I_GU) { transpose_item8(F.mw_up + (size_t)m * D * FF, D, FF, gu, MapGU{1}, 32.0f, scr, r, lane); continue; } r -= I_GU;
#endif
        transpose_item8(F.mw_down + (size_t)m * FF * D, FF, D, dn, MapId{}, 128.0f, scr, r, lane); }
}

__device__ __forceinline__ void row_load_f32(const float* p, int lane, f32x4 (&v)[4]) {
#pragma unroll
    for (int j = 0; j < 4; ++j) v[j] = *(const f32x4*)(p + 4 * lane + 256 * j);
}
__device__ __forceinline__ void row_load_bf16(const bf16* p, int lane, f32x4 (&v)[4]) {
#pragma unroll
    for (int j = 0; j < 4; ++j) { const v2u w = *(const v2u*)(p + 4 * lane + 256 * j); v[j] = (f32x4){bflo(w.x), bfhi(w.x), bflo(w.y), bfhi(w.y)}; }
}
__device__ __forceinline__ void row_store_bf16(bf16* p, int lane, const f32x4 (&v)[4]) {
#pragma unroll
    for (int j = 0; j < 4; ++j) { v2u w; w.x = pk2(v[j][0], v[j][1]); w.y = pk2(v[j][2], v[j][3]); *(v2u*)(p + 4 * lane + 256 * j) = w; }
}
__device__ __forceinline__ void row_store_f32(float* p, int lane, const f32x4 (&v)[4]) {
#pragma unroll
    for (int j = 0; j < 4; ++j) *(f32x4*)(p + 4 * lane + 256 * j) = v[j];
}
__device__ __forceinline__ void row_ln(f32x4 (&v)[4], const float* g, const float* b, int lane) {
    float s = 0.f;
#pragma unroll
    for (int j = 0; j < 4; ++j) s += (v[j][0] + v[j][1]) + (v[j][2] + v[j][3]);
    const float mean = wave_sum(s) * (1.0f / D); float q = 0.f;
#pragma unroll
    for (int j = 0; j < 4; ++j) { v[j] = v[j] - mean; q += (v[j][0] * v[j][0] + v[j][1] * v[j][1]) + (v[j][2] * v[j][2] + v[j][3] * v[j][3]); }
    const float rstd = 1.0f / sqrtf(wave_sum(q) * (1.0f / D) + LN_EPS);
#pragma unroll
    for (int j = 0; j < 4; ++j) { const f32x4 gg = *(const f32x4*)(g + 4 * lane + 256 * j), bb = *(const f32x4*)(b + 4 * lane + 256 * j); v[j] = v[j] * rstd * gg + bb; }
}
__device__ __forceinline__ const float* modp(Frame& F, int layer, int mr, int part) { return WSP(float, WS_MOD) + (size_t)(layer * 9 + mr) * 6144 + part * 1024; }
__device__ __forceinline__ void row_modulate(f32x4 (&v)[4], const float* sh, const float* sc, int lane) {
#pragma unroll
    for (int j = 0; j < 4; ++j) { const f32x4 a = *(const f32x4*)(sc + 4 * lane + 256 * j), b = *(const f32x4*)(sh + 4 * lane + 256 * j); v[j] = v[j] * (1.0f + a) + b; }
}
__device__ __forceinline__ void res_load(Frame& F, int r, int lane, f32x4 (&v)[4]) {
#if RES16
    row_load_bf16(WSP(bf16, WS_X16) + (size_t)r * D, lane, v);
#else
    row_load_f32(r < NL ? F.out + (size_t)r * D : WSP(float, WS_XC) + (size_t)(r - NL) * D, lane, v);
#endif
}
__device__ __forceinline__ void res_store(Frame& F, int r, int lane, const f32x4 (&v)[4]) {
#if RES16
    row_store_bf16(WSP(bf16, WS_X16) + (size_t)r * D, lane, v);
#else
    row_store_f32(r < NL ? F.out + (size_t)r * D : WSP(float, WS_XC) + (size_t)(r - NL) * D, lane, v);
#endif
}
__device__ __forceinline__ void row_store_q8(unsigned char* p, float* st, int lane, const f32x4 (&v)[4]) {
    float mx = 0.f;
#pragma unroll
    for (int j = 0; j < 4; ++j) mx = fmaxf(fmaxf(mx, fmaxf(fabsf(v[j][0]), fabsf(v[j][1]))), fmaxf(fabsf(v[j][2]), fabsf(v[j][3])));
    mx = wave_max_abs(mx);
    const float inv = mx > 0.f ? 127.0f / mx : 0.f;
#pragma unroll
    for (int j = 0; j < 4; ++j) *(unsigned*)(p + 4 * lane + 256 * j) = pk4_i8(v[j][0], v[j][1], v[j][2], v[j][3], inv);
    if (lane == 0) *st = mx * (1.0f / 127.0f);
}
__device__ __forceinline__ void p_h0(Frame& F) {
    const int gw = F.vcu * NWAVES + F.wave, NGW = F.G * NWAVES, lane = (opq((int)threadIdx.x) & 63);
    for (int r = gw; r < MT; r += NGW) { const int mr = r < NL ? (r >> 12) : 8; const float* xr = r < NL ? F.x + (size_t)r * D : F.ctx + (size_t)(r - NL) * D;
        f32x4 v[4]; row_load_f32(xr, lane, v); row_modulate(v, modp(F, 0, mr, 0), modp(F, 0, mr, 1), lane);
#if INQ
        row_store_q8(WSP(unsigned char, WS_T8L0) + (size_t)r * D, WSP(float, WS_SH) + r, lane, v); }
#else
        row_store_bf16(WSP(bf16, WS_ACT) + (size_t)r * D, lane, v); }
#endif
}
__device__ __forceinline__ void p_ln1(Frame& F, int layer) {
    const int lane = (opq((int)threadIdx.x) & 63);
    if (layer == 0) {
        const int gw = F.vcu * NWAVES + F.wave, NGW = F.G * NWAVES;
#if ((REP_MASK) >> 15) & 1
        for (int r = gw; r < MT; r += NGW) { const int mr = r < NL ? (r >> 12) : 8; const float* xr = r < NL ? F.x + (size_t)r * D : F.ctx + (size_t)(r - NL) * D;
            bf16* ar = WSP(bf16, WS_ACT) + (size_t)r * D;
            f32x4 v[4], y[4]; row_load_f32(xr, lane, v); row_load_bf16(ar, lane, y); const float* g1 = modp(F, 0, mr, 2);
#pragma unroll
            for (int j = 0; j < 4; ++j) v[j] = ALPHA * v[j] + *(const f32x4*)(g1 + 4 * lane + 256 * j) * y[j];
            row_ln(v, F.ln1_g, F.ln1_b, lane); row_store_bf16(WSP(bf16, WS_PROJ) + (size_t)r * D, lane, v);
            row_modulate(v, modp(F, 0, mr, 3), modp(F, 0, mr, 4), lane);
            row_store_q8(WSP(unsigned char, WS_PROJ) + 80 * MiB + (size_t)r * D, (float*)(WSP(unsigned char, WS_PROJ) + 118 * MiB) + r, lane, v);
        }
        __syncthreads();
#endif
        for (int r_ = gw; r_ < MT; r_ += NGW) { const int r = (REV_MASK & 8) ? MT - 1 - r_ : r_;
            const int mr = r < NL ? (r >> 12) : 8;
            bf16* ar = WSP(bf16, WS_ACT) + (size_t)r * D;
#if RESADD
            f32x4 v[4]; row_load_bf16(ar, lane, v);
#else
            const float* xr = r < NL ? F.x + (size_t)r * D : F.ctx + (size_t)(r - NL) * D;
            f32x4 v[4], y[4]; row_load_f32(xr, lane, v); row_load_bf16(ar, lane, y); const float* g1 = modp(F, 0, mr, 2);
#pragma unroll
            for (int j = 0; j < 4; ++j) v[j] = ALPHA * v[j] + *(const f32x4*)(g1 + 4 * lane + 256 * j) * y[j];
#endif
            row_ln(v, F.ln1_g, F.ln1_b, lane); res_store(F, r, lane, v);
            row_modulate(v, modp(F, 0, mr, 3), modp(F, 0, mr, 4), lane);
            row_store_q8(WSP(unsigned char, WS_T8L0) + (size_t)r * D, WSP(float, WS_ST) + r, lane, v);
        }
        return;
    }
    LAS int* lcnt = (LAS int*)F.lds; LAS int* lbase = lcnt + 8; LAS int* rinfo = lcnt + 16;
    float rt[16][8];
#pragma unroll
    for (int j = 0; j < 4; ++j)
#pragma unroll
        for (int q = 0; q < 4; ++q) { const float* rp = F.router + (size_t)(4 * lane + 256 * j + q) * 8; const f32x4 a = *(const f32x4*)rp, b = *(const f32x4*)(rp + 4);
            rt[j * 4 + q][0] = a[0]; rt[j * 4 + q][1] = a[1]; rt[j * 4 + q][2] = a[2]; rt[j * 4 + q][3] = a[3]; rt[j * 4 + q][4] = b[0]; rt[j * 4 + q][5] = b[1]; rt[j * 4 + q][6] = b[2]; rt[j * 4 + q][7] = b[3]; }
    for (int rb = blockIdx.x; rb < NL / 128; rb += F.G) {
        if ((int)threadIdx.x < 8) lcnt[threadIdx.x] = 0;
        __syncthreads();
#if ((REP_MASK) >> 14) & 1
        for (int ii = 0; ii < 32; ++ii) { const int i = ii >> 1; const bool real = (ii & 1) != 0;
#else
        for (int i = 0; i < 16; ++i) { const bool real = true;
#endif
            const int rl = F.wave * 16 + i, r = rb * 128 + rl, mr = r >> 12;
            bf16* ar = WSP(bf16, WS_ACT) + (size_t)r * D;
#if RESADD
            f32x4 v[4]; row_load_bf16(ar, lane, v);
#else
            f32x4 v[4], y[4]; res_load(F, r, lane, v); row_load_bf16(ar, lane, y); const float* g1 = modp(F, 1, mr, 2);
#pragma unroll
            for (int j = 0; j < 4; ++j) v[j] = ALPHA * v[j] + *(const f32x4*)(g1 + 4 * lane + 256 * j) * y[j];
#endif
            row_ln(v, F.ln1_g + D, F.ln1_b + D, lane); if (real) res_store(F, r, lane, v); else row_store_bf16(WSP(bf16, WS_PROJ) + (size_t)r * D, lane, v);
            row_modulate(v, modp(F, 1, mr, 3), modp(F, 1, mr, 4), lane);
#if MOEQ
            row_store_q8(WSP(unsigned char, WS_T8) + (size_t)r * D, WSP(float, WS_ST) + r, lane, v);
#else
            { unsigned char* t8 = (real ? WSP(unsigned char, WS_T8) : WSP(unsigned char, WS_PROJ) + 80 * MiB) + (size_t)r * D;
#pragma unroll
              for (int j = 0; j < 4; ++j) *(unsigned*)(t8 + 4 * lane + 256 * j) = pk4_fp8s(v[j][0], v[j][1], v[j][2], v[j][3], 4.0f); }
#endif
            float lg[8];
#pragma unroll
            for (int e = 0; e < 8; ++e) { float s = 0.f;
#pragma unroll
                for (int j = 0; j < 4; ++j)
#pragma unroll
                    for (int q = 0; q < 4; ++q) s += v[j][q] * rt[j * 4 + q][e];
                lg[e] = wave_sum(s); }
            int i1 = 0; float v1 = lg[0];
#pragma unroll
            for (int e = 1; e < 8; ++e) if (lg[e] > v1) { v1 = lg[e]; i1 = e; }
            int i2 = -1; float v2 = -3.0e38f;
#pragma unroll
            for (int e = 0; e < 8; ++e) if (e != i1 && lg[e] > v2) { v2 = lg[e]; i2 = e; }
            const float ex = __expf(v2 - v1), w1 = 1.0f / (1.0f + ex), w2 = ex / (1.0f + ex);
            if (lane == 0 && real) { const int p1 = __hip_atomic_fetch_add(lcnt + i1, 1, __ATOMIC_RELAXED, __HIP_MEMORY_SCOPE_WORKGROUP), p2 = __hip_atomic_fetch_add(lcnt + i2, 1, __ATOMIC_RELAXED, __HIP_MEMORY_SCOPE_WORKGROUP);
                LAS int* ri = rinfo + rl * 6; ri[0] = i1; ri[1] = p1; ri[2] = __float_as_int(w1); ri[3] = i2; ri[4] = p2; ri[5] = __float_as_int(w2); }
        }
        __syncthreads();
        if ((int)threadIdx.x < 8) lbase[threadIdx.x] = (int)__hip_atomic_fetch_add((unsigned*)(WSP(unsigned, WS_CTL) + CW_GCNT + 64 * threadIdx.x), (unsigned)lcnt[threadIdx.x], RLX_AGENT);
        __syncthreads();
        if ((int)threadIdx.x < 256) { const int rl = (int)threadIdx.x >> 1, s = (int)threadIdx.x & 1; const LAS int* ri = rinfo + rl * 6 + 3 * s; const int e = ri[0], pos = lbase[e] + ri[1];
            WSP(int, WS_LIST)[e * LCAP + pos] = ((rb * 128 + rl) << 1) | s; WSP(float, WS_LGATE)[e * LCAP + pos] = __int_as_float(ri[2]); }
        __syncthreads();
    }
}
__device__ __forceinline__ void p_route(Frame& F) {
    const int tid = opq((int)threadIdx.x);
    LAS int* lcnt = (LAS int*)F.lds; LAS int* lbase = lcnt + 8; LAS int* rinfo = lcnt + 16;
    const float* pl = WSP(float, WS_PLOG);
    for (int rb = blockIdx.x; rb < NL / 128; rb += F.G) {
        if (tid < 8) lcnt[tid] = 0;
        __syncthreads();
        if (tid < 128) { const int r = rb * 128 + tid; float lg[8];
#pragma unroll
            for (int e = 0; e < 8; ++e) lg[e] = 0.f;
#pragma unroll
            for (int pn = 0; pn < 4; ++pn) { const f32x4 a = *(const f32x4*)(pl + ((size_t)pn * NL + r) * 8), b = *(const f32x4*)(pl + ((size_t)pn * NL + r) * 8 + 4);
                lg[0] += a[0]; lg[1] += a[1]; lg[2] += a[2]; lg[3] += a[3]; lg[4] += b[0]; lg[5] += b[1]; lg[6] += b[2]; lg[7] += b[3]; }
            int i1 = 0; float v1 = lg[0];
#pragma unroll
            for (int e = 1; e < 8; ++e) if (lg[e] > v1) { v1 = lg[e]; i1 = e; }
            int i2 = -1; float v2 = -3.0e38f;
#pragma unroll
            for (int e = 0; e < 8; ++e) if (e != i1 && lg[e] > v2) { v2 = lg[e]; i2 = e; }
            const float ex = __expf(v2 - v1), w1 = 1.0f / (1.0f + ex), w2 = ex / (1.0f + ex);
            const int p1 = __hip_atomic_fetch_add(lcnt + i1, 1, __ATOMIC_RELAXED, __HIP_MEMORY_SCOPE_WORKGROUP), p2 = __hip_atomic_fetch_add(lcnt + i2, 1, __ATOMIC_RELAXED, __HIP_MEMORY_SCOPE_WORKGROUP);
            LAS int* ri = rinfo + tid * 6; ri[0] = i1; ri[1] = p1; ri[2] = __float_as_int(w1); ri[3] = i2; ri[4] = p2; ri[5] = __float_as_int(w2); }
        __syncthreads();
        if (tid < 8) lbase[tid] = (int)__hip_atomic_fetch_add((unsigned*)(WSP(unsigned, WS_CTL) + CW_GCNT + 64 * tid), (unsigned)lcnt[tid], RLX_AGENT);
        __syncthreads();
        if (tid < 256) { const int rl = tid >> 1, s = tid & 1; const LAS int* ri = rinfo + rl * 6 + 3 * s; const int e = ri[0], pos = lbase[e] + ri[1];
            WSP(int, WS_LIST)[e * LCAP + pos] = ((rb * 128 + rl) << 1) | s; WSP(float, WS_LGATE)[e * LCAP + pos] = __int_as_float(ri[2]); }
        __syncthreads();
    }
}
__device__ __forceinline__ void p_ln2_l0(Frame& F) {
    const int lane = (opq((int)threadIdx.x) & 63), gw = F.vcu * NWAVES + F.wave, NGW = F.G * NWAVES;
#if ((REP_MASK) >> 12) & 1
    for (int r = gw; r < MT; r += NGW) { const int mr = r < NL ? (r >> 12) : 8;
        bf16* ar = WSP(bf16, WS_ACT) + (size_t)r * D;
        f32x4 v[4], y[4]; res_load(F, r, lane, v); row_load_bf16(ar, lane, y); const float* g2 = modp(F, 0, mr, 5);
#pragma unroll
        for (int j = 0; j < 4; ++j) v[j] = ALPHA * v[j] + *(const f32x4*)(g2 + 4 * lane + 256 * j) * y[j];
        row_ln(v, F.ln2_g, F.ln2_b, lane); row_store_bf16(WSP(bf16, WS_HID) + (size_t)r * D, lane, v);
        row_modulate(v, modp(F, 1, mr, 0), modp(F, 1, mr, 1), lane);
        row_store_q8(WSP(unsigned char, WS_HID) + 80 * MiB + (size_t)r * D, (float*)(WSP(unsigned char, WS_HID) + 120 * MiB) + r, lane, v); }
    __syncthreads();
#endif
    for (int r = gw; r < MT; r += NGW) { const int mr = r < NL ? (r >> 12) : 8;
        bf16* ar = WSP(bf16, WS_ACT) + (size_t)r * D;
#if RESADD
        f32x4 v[4]; row_load_bf16(ar, lane, v);
#else
        f32x4 v[4], y[4]; res_load(F, r, lane, v); row_load_bf16(ar, lane, y); const float* g2 = modp(F, 0, mr, 5);
#pragma unroll
        for (int j = 0; j < 4; ++j) v[j] = ALPHA * v[j] + *(const f32x4*)(g2 + 4 * lane + 256 * j) * y[j];
#endif
        row_ln(v, F.ln2_g, F.ln2_b, lane); res_store(F, r, lane, v);
        row_modulate(v, modp(F, 1, mr, 0), modp(F, 1, mr, 1), lane);
#if INQ
        row_store_q8(WSP(unsigned char, WS_T8L0) + (size_t)r * D, WSP(float, WS_SH) + r, lane, v); }
#else
        row_store_bf16(ar, lane, v); }
#endif
}
__device__ __forceinline__ void p_final(Frame& F) {
    const int lane = (opq((int)threadIdx.x) & 63), gw = F.vcu * NWAVES + F.wave, NGW = F.G * NWAVES;
    for (int r = gw; r < NL; r += NGW) { const int mr = r >> 12; float* xo = F.out + (size_t)r * D;
        f32x4 v[4], y0[4], y1[4]; res_load(F, r, lane, v); row_load_bf16(WSP(bf16, WS_Y) + (size_t)r * D, lane, y0); row_load_bf16(WSP(bf16, WS_Y) + (size_t)(NL + r) * D, lane, y1); const float* g2 = modp(F, 1, mr, 5);
#pragma unroll
        for (int j = 0; j < 4; ++j) v[j] = ALPHA * v[j] + *(const f32x4*)(g2 + 4 * lane + 256 * j) * (y0[j] + y1[j]);
        row_ln(v, F.ln2_g + D, F.ln2_b + D, lane);
#if defined(ATTN_CHECK) || defined(MIX_CHECK)
        if ((__hip_atomic_load(WSP(unsigned, WS_CTL) + 8, RLX_AGENT) | __hip_atomic_load(WSP(unsigned, WS_CTL) + 9, RLX_AGENT) * CHK_POOL | __hip_atomic_load(WSP(unsigned, WS_CTL) + 10, RLX_AGENT) * CHK_KV | __hip_atomic_load(WSP(unsigned, WS_CTL) + 11, RLX_AGENT) * CHK_RET) != 0u) { const float qn = 0.0f;
#pragma unroll
            for (int j = 0; j < 4; ++j) v[j] = (f32x4){qn, qn, qn, qn}; }
#endif
        row_store_f32(xo, lane, v); }
}

__device__ __forceinline__ int chunk_row0(int b, int cid) { return cid < 2 ? NL + b * CTXL + cid * 128 : b * SEQ + (cid - 2) * 128; }
namespace att {
using bf16x8 = __attribute__((ext_vector_type(8))) short;
using s16x4 = __attribute__((ext_vector_type(4))) short;
using f32x16 = __attribute__((ext_vector_type(16))) float;
using u32x4 = __attribute__((ext_vector_type(4))) unsigned;
typedef short v4i16_t __attribute__((ext_vector_type(4)));
typedef __attribute__((address_space(3))) const char* lds_cptr;
constexpr int SLOTB = 8192, LDS_K = 0, LDS_V = 2 * SLOTB, LDS_WS = 4 * SLOTB, LDS_OST = LDS_WS + 8 * 256, LDS_TOTAL = LDS_OST + 8 * 4096;
constexpr float THR = 8.0f, NEGBIG = -1.0e30f;
__device__ __forceinline__ int crow(int r, int hi) { return (r & 3) + 8 * (r >> 2) + 4 * hi; }
__device__ __forceinline__ void glds16(const void* gsrc, unsigned lds_dst) { unsigned keep;
    asm volatile("s_mov_b32 %0, m0\n\ts_mov_b32 m0, %2\n\ts_nop 0\n\tglobal_load_lds_dwordx4 %1, off\n\ts_mov_b32 m0, %0" : "=&s"(keep) : "v"(gsrc), "s"(lds_dst) : "memory"); }
__device__ __forceinline__ s16x4 vtr(lds_cptr p) { return __builtin_bit_cast(s16x4, __builtin_amdgcn_ds_read_tr16_b64_v4i16((__attribute__((address_space(3))) v4i16_t*)p)); }
__device__ __forceinline__ unsigned cvtpk(float lo, float hi) { f32x2_t v = {lo, hi}; bf16x2_t b = __builtin_convertvector(v, bf16x2_t); return __builtin_bit_cast(unsigned, b); }

__device__ __forceinline__ void attn_unit(Frame& F, int layer, int b, int qb, int kvh, bool isctx) {
    const int tid = opq((int)threadIdx.x), lane = tid & 63, r32 = lane & 31, hi = lane >> 5; const int wid = __builtin_amdgcn_readfirstlane(tid >> 6);
    const int g = wid >> 1, qh = wid & 1, head = kvh * 4 + g;
    const bf16* P = WSP(bf16, WS_PROJ);
    const int qrow0 = (isctx ? NL + b * CTXL : b * SEQ) + qb * 128 + qh * 64;
    const int tlo = isctx ? 0 : (qb == 0 ? 2 : 0), thi = isctx ? 0 : (qb == SEQ / 128 - 1 ? 4 : 6), nloc = thi - tlo, ntiles = nloc + 4;
    const lds_cptr shm = (lds_cptr)F.lds; const unsigned lds0 = (unsigned)(uintptr_t)F.lds;
    LAS float* wsf = (LAS float*)(F.lds + LDS_WS) + wid * 64;
    bf16x8 qr[2][4];
#pragma unroll
    for (int rb = 0; rb < 2; ++rb)
#pragma unroll
        for (int d0 = 0; d0 < 4; ++d0) qr[rb][d0] = *(const bf16x8*)(P + (size_t)(qrow0 + 32 * rb + r32) * INW + head * 64 + d0 * 16 + hi * 8);
    __builtin_amdgcn_s_waitcnt(0x0F70);
    float m[2], l[2]; f32x16 o[2][2];
    { const float s0 = F.sink[layer * 8 + head] * LOG2E;
#pragma unroll
      for (int rb = 0; rb < 2; ++rb) { m[rb] = s0; l[rb] = hi == 0 ? 1.0f : 0.0f; o[rb][0] = f32x16{}; o[rb][1] = f32x16{}; } }
    auto tile_row = [&](int i) -> int { return i < nloc ? b * SEQ + qb * 128 - 128 + 64 * (tlo + i) : NL + b * CTXL + 64 * (i - nloc); };
    auto dma = [&](int i) { const int kr = tile_row(i); const unsigned slot = (unsigned)(i & 1) * SLOTB;
        glds16(P + (size_t)(kr + lane) * INW + C_K + kvh * 64 + wid * 8, (unsigned)__builtin_amdgcn_readfirstlane(lds0 + LDS_K + slot + wid * 1024));
        glds16(P + (size_t)(kr + 16 * (wid & 3) + (lane >> 2)) * INW + C_V + kvh * 64 + (wid >> 2) * 32 + (lane & 3) * 8, (unsigned)__builtin_amdgcn_readfirstlane(lds0 + LDS_V + slot + wid * 1024)); };
    dma(0);
    for (int i = 0; i < ntiles; ++i) {
        if (i + 1 < ntiles) { dma(i + 1); asm volatile("s_waitcnt vmcnt(2)\n\ts_barrier" ::: "memory"); }
        else asm volatile("s_waitcnt vmcnt(0)\n\ts_barrier" ::: "memory");
        const lds_cptr kp = shm + LDS_K + (i & 1) * SLOTB + hi * 1024 + r32 * 16;
        const lds_cptr vp = shm + LDS_V + (i & 1) * SLOTB + ((lane >> 4) & 1) * 32 + (lane & 3) * 8 + (4 * hi + ((lane & 15) >> 2)) * 64;
        const bool local = i < nloc; const int c = local ? 128 - 64 * (tlo + i) : 0;
        bool act[2], partial[2]; f32x16 p0[2], p1[2];
#pragma unroll
        for (int rb = 0; rb < 2; ++rb) { const int q0 = qh * 64 + rb * 32; act[rb] = true; partial[rb] = false;
            if (local) { const int dlo = q0 - 63 + c, dhi = q0 + 31 + c; act[rb] = !(dlo > 128 || dhi < -128); partial[rb] = !(dlo >= -128 && dhi <= 128); } }
#pragma unroll
        for (int rb = 0; rb < 2; ++rb) { if (!act[rb]) continue;
            { const float nm = -m[rb];
#pragma unroll
              for (int r = 0; r < 16; ++r) { p0[rb][r] = nm; p1[rb][r] = nm; } }
#pragma unroll
            for (int d0 = 0; d0 < 4; ++d0) { const bf16x8 k0 = *(const __attribute__((address_space(3))) bf16x8*)(kp + d0 * 2048), k1 = *(const __attribute__((address_space(3))) bf16x8*)(kp + d0 * 2048 + 512);
                p0[rb] = __builtin_amdgcn_mfma_f32_32x32x16_bf16(k0, qr[rb][d0], p0[rb], 0, 0, 0); p1[rb] = __builtin_amdgcn_mfma_f32_32x32x16_bf16(k1, qr[rb][d0], p1[rb], 0, 0, 0); } }
#pragma unroll
        for (int rb = 0; rb < 2; ++rb) { if (!act[rb]) continue;
            const int q0 = qh * 64 + rb * 32;
            if (partial[rb]) { const int qq = q0 + r32 + c;
#pragma unroll
                for (int r = 0; r < 16; ++r) { const int dl = qq - crow(r, hi); if (dl > 128 || dl < -128) p0[rb][r] = NEGBIG; if (dl - 32 > 128 || dl - 32 < -128) p1[rb][r] = NEGBIG; } }
            float rm = fmaxf(p0[rb][0], p1[rb][0]);
#pragma unroll
            for (int r = 1; r < 16; ++r) rm = fmaxf(rm, fmaxf(p0[rb][r], p1[rb][r]));
            { auto rr = __builtin_amdgcn_permlane32_swap(__float_as_uint(rm), __float_as_uint(rm), false, false); rm = fmaxf(__uint_as_float(rr[0]), __uint_as_float(rr[1])); }
            if (__any(rm > THR)) {
                const float dl = fmaxf(rm, 0.f); m[rb] += dl;
#pragma unroll
                for (int r = 0; r < 16; ++r) { p0[rb][r] -= dl; p1[rb][r] -= dl; }
                const float f = __builtin_amdgcn_exp2f(-dl); l[rb] *= f; if (hi == 0) wsf[r32] = f;
                asm volatile("s_waitcnt lgkmcnt(0)" ::: "memory");
#pragma unroll
                for (int r = 0; r < 16; ++r) { const float fr = wsf[crow(r, hi)]; o[rb][0][r] *= fr; o[rb][1][r] *= fr; }
            }
            float sacc = 0.f;
#pragma unroll
            for (int r = 0; r < 16; ++r) { p0[rb][r] = __builtin_amdgcn_exp2f(p0[rb][r]); p1[rb][r] = __builtin_amdgcn_exp2f(p1[rb][r]); sacc += p0[rb][r] + p1[rb][r]; }
            l[rb] += sacc;
            u32x4 pw[4];
#pragma unroll
            for (int k = 0; k < 4; ++k) { pw[0][k] = cvtpk(p0[rb][2 * k], p0[rb][2 * k + 1]); pw[1][k] = cvtpk(p0[rb][8 + 2 * k], p0[rb][9 + 2 * k]); pw[2][k] = cvtpk(p1[rb][2 * k], p1[rb][2 * k + 1]); pw[3][k] = cvtpk(p1[rb][8 + 2 * k], p1[rb][9 + 2 * k]); }
#pragma unroll
            for (int d0 = 0; d0 < 2; ++d0) {
#pragma unroll
                for (int ks = 0; ks < 4; ++ks) { const s16x4 lo = vtr(vp + d0 * 4096 + ks * 1024), hh = vtr(vp + d0 * 4096 + ks * 1024 + 512);
                    const bf16x8 vf = (bf16x8){lo[0], lo[1], lo[2], lo[3], hh[0], hh[1], hh[2], hh[3]};
                    o[rb][d0] = __builtin_amdgcn_mfma_f32_32x32x16_bf16(__builtin_bit_cast(bf16x8, pw[ks]), vf, o[rb][d0], 0, 0, 0); } }
        }
        asm volatile("s_waitcnt lgkmcnt(0)\n\ts_barrier" ::: "memory");
    }
    LAS bf16* stg = (LAS bf16*)(F.lds + LDS_OST) + wid * 2048;
#pragma unroll
    for (int rb = 0; rb < 2; ++rb) {
        float lt = l[rb]; { auto rr = __builtin_amdgcn_permlane32_swap(__float_as_uint(lt), __float_as_uint(lt), false, false); lt = __uint_as_float(rr[0]) + __uint_as_float(rr[1]); }
        if (hi == 0) wsf[r32] = 1.0f / lt;
        asm volatile("s_waitcnt lgkmcnt(0)" ::: "memory");
#pragma unroll
        for (int r = 0; r < 16; ++r) { const float rl = wsf[crow(r, hi)]; const int orow = crow(r, hi);
            stg[orow * 64 + r32] = (bf16)(pk2(o[rb][0][r] * rl, 0.f) & 0xffffu); stg[orow * 64 + 32 + r32] = (bf16)(pk2(o[rb][1][r] * rl, 0.f) & 0xffffu); }
        asm volatile("s_waitcnt lgkmcnt(0)" ::: "memory");
        bf16* Ow = WSP(bf16, WS_MIX) + (size_t)(qrow0 + 32 * rb) * D + head * 64;
#pragma unroll
        for (int k = 0; k < 4; ++k) { const int row = k * 8 + (lane >> 3), ch = lane & 7; const v4u v = *(const LAS v4u*)(stg + row * 64 + ch * 8); *(v4u*)(Ow + (size_t)row * D + ch * 8) = v; }
        asm volatile("s_waitcnt lgkmcnt(0)" ::: "memory");
    }
}
}
__device__ __forceinline__ void p_attn(Frame& F, int layer) {
    const int vcu = (blockIdx.x % 8) * (F.G / 8) + blockIdx.x / 8;
    for (int u = vcu * 2; u < 512; u += 2 * F.G) { att::attn_unit(F, layer, u >> 6, (u >> 1) & 31, u & 1, false); att::attn_unit(F, layer, (u + 1) >> 6, ((u + 1) >> 1) & 31, (u + 1) & 1, false); }
    if (layer == 0) for (int v = blockIdx.x; v < 32; v += F.G) att::attn_unit(F, layer, v >> 2, (v >> 1) & 1, v & 1, true);
}
namespace att2 {
using bf16=unsigned short;
using bf16x8=__attribute__((ext_vector_type(8)))short;
using s16x4=__attribute__((ext_vector_type(4)))short;
using f32x16=__attribute__((ext_vector_type(16)))float;
using u32x4=__attribute__((ext_vector_type(4)))unsigned;
constexpr int NW=8,QBLK=32,KVBLK=64;
__device__ __forceinline__ int crow(int r,int hi){return (r&3)+8*(r>>2)+4*hi;}
#define SBAR() __builtin_amdgcn_sched_barrier(0)
__device__ __forceinline__ void wmask(f32x16&p0,f32x16&p1,int c,int qq,int hi){
  const float NEG=-INFINITY; const int d0=qq+c-4*hi;
  #pragma unroll
  for(int r=0;r<16;++r){const int dl=d0-((r&3)+8*(r>>2)); if(dl>128||dl<-128)p0[r]=NEG; if(dl-32>128||dl-32<-128)p1[r]=NEG;}
}

constexpr int NSLOT=3, SLOTB=8192;
constexpr int LDS_K=0, LDS_V=NSLOT*SLOTB, LDS_WS=2*NSLOT*SLOTB, LDS_OST=LDS_WS+NW*64*4, LDS_BYTES=LDS_OST+NW*4096;
constexpr float C2=0.125f*1.4426950408889634f;
__device__ __forceinline__ void glds16(const void*gsrc,unsigned lds_dst){unsigned keep;
  asm volatile("s_mov_b32 %0, m0\n\ts_mov_b32 m0, %2\n\ts_nop 0\n\tglobal_load_lds_dwordx4 %1, off\n\ts_mov_b32 m0, %0":"=&s"(keep):"v"(gsrc),"s"(lds_dst):"memory");}
__device__ __forceinline__ float max3f(float a,float b,float c){float r;asm("v_max3_f32 %0, %1, %2, %3":"=v"(r):"v"(a),"v"(b),"v"(c));return r;}
__device__ __forceinline__ float max2f(float a,float b){float r;asm("v_max_f32_e32 %0, %1, %2":"=v"(r):"v"(a),"v"(b));return r;}
__device__ __forceinline__ float fadd_s(float a,float b){float r;asm("v_add_f32_e32 %0, %1, %2":"=v"(r):"v"(a),"v"(b));return r;}
__device__ __forceinline__ float fsub_s(float a,float b){float r;asm("v_sub_f32_e32 %0, %1, %2":"=v"(r):"v"(a),"v"(b));return r;}
typedef float f32x2_t __attribute__((ext_vector_type(2))); typedef __bf16 bf16x2_t __attribute__((ext_vector_type(2)));
__device__ __forceinline__ unsigned cvtpk_s(float lo,float hi){f32x2_t v={lo,hi};bf16x2_t b=__builtin_convertvector(v,bf16x2_t);return __builtin_bit_cast(unsigned,b);}
#define WAIT_BAR(N) asm volatile("s_waitcnt vmcnt(" #N ") lgkmcnt(0)\n\ts_barrier":::"memory")

typedef __attribute__((address_space(3))) const char* lds_cptr;
__device__ __forceinline__ void qkt(f32x16&p0,f32x16&p1,lds_cptr Kslot,const bf16x8*qr,const f32x16&negm,int r32,int hi){
  const lds_cptr kb=Kslot+hi*1024+r32*16;
  #pragma unroll
  for(int d0=0;d0<4;++d0){
    const bf16x8 b0=*(const __attribute__((address_space(3))) bf16x8*)(kb+d0*2048);
    const bf16x8 b1=*(const __attribute__((address_space(3))) bf16x8*)(kb+d0*2048+512);
    if(d0==0){p0=__builtin_amdgcn_mfma_f32_32x32x16_bf16(b0,qr[0],negm,0,0,0);p1=__builtin_amdgcn_mfma_f32_32x32x16_bf16(b1,qr[0],negm,0,0,0);}
    else{p0=__builtin_amdgcn_mfma_f32_32x32x16_bf16(b0,qr[d0],p0,0,0,0);p1=__builtin_amdgcn_mfma_f32_32x32x16_bf16(b1,qr[d0],p1,0,0,0);}}
}
typedef short v4i16_t __attribute__((ext_vector_type(4)));
__device__ __forceinline__ void kload8(bf16x8*kf,lds_cptr kp){
  kf[0]=*(const __attribute__((address_space(3))) bf16x8*)(kp);      kf[1]=*(const __attribute__((address_space(3))) bf16x8*)(kp+512);
  kf[2]=*(const __attribute__((address_space(3))) bf16x8*)(kp+2048); kf[3]=*(const __attribute__((address_space(3))) bf16x8*)(kp+2560);
  kf[4]=*(const __attribute__((address_space(3))) bf16x8*)(kp+4096); kf[5]=*(const __attribute__((address_space(3))) bf16x8*)(kp+4608);
  kf[6]=*(const __attribute__((address_space(3))) bf16x8*)(kp+6144); kf[7]=*(const __attribute__((address_space(3))) bf16x8*)(kp+6656);
}
__device__ __forceinline__ void kload2(bf16x8*kf,lds_cptr kp,int j){ kf[2*j]=*(const __attribute__((address_space(3))) bf16x8*)(kp+j*2048); kf[2*j+1]=*(const __attribute__((address_space(3))) bf16x8*)(kp+j*2048+512); }
__device__ __forceinline__ s16x4 vtr(lds_cptr p){ return __builtin_bit_cast(s16x4,__builtin_amdgcn_ds_read_tr16_b64_v4i16((__attribute__((address_space(3))) v4i16_t*)p)); }
__device__ __forceinline__ float rowmax(const f32x16&p0,const f32x16&p1){
  float a=max3f(p0[0],p0[1],p1[0]),b=max3f(p0[2],p0[3],p1[1]);a=max3f(a,p1[2],p1[3]);
  #pragma unroll
  for(int r=4;r<16;r+=4){a=max3f(a,p0[r],p0[r+1]);b=max3f(b,p0[r+2],p0[r+3]);a=max3f(a,p1[r],p1[r+1]);b=max3f(b,p1[r+2],p1[r+3]);}
  const float m=max2f(a,b);
  auto rr=__builtin_amdgcn_permlane32_swap(__float_as_uint(m),__float_as_uint(m),false,false);
  return max2f(__uint_as_float(rr[0]),__uint_as_float(rr[1]));
}
__device__ __forceinline__ void pv(f32x16*o,int vb,bf16x8 pa0,bf16x8 pa1,bf16x8 pa2,bf16x8 pa3){
  #pragma unroll
  for(int d0=0;d0<2;++d0){s16x4 lo[4],hi[4];
    #pragma unroll
    for(int ks=0;ks<4;++ks){
      asm volatile("ds_read_b64_tr_b16 %0,%1 offset:%c2":"=&v"(lo[ks]):"v"(vb),"i"(d0*4096+ks*1024):"memory");
      asm volatile("ds_read_b64_tr_b16 %0,%1 offset:%c2":"=&v"(hi[ks]):"v"(vb),"i"(d0*4096+ks*1024+512):"memory");}
    asm volatile("s_waitcnt lgkmcnt(0)":::"memory");SBAR();
    #define PK(k) (bf16x8){lo[k][0],lo[k][1],lo[k][2],lo[k][3],hi[k][0],hi[k][1],hi[k][2],hi[k][3]}
    o[d0]=__builtin_amdgcn_mfma_f32_32x32x16_bf16(pa0,PK(0),o[d0],0,0,0);
    o[d0]=__builtin_amdgcn_mfma_f32_32x32x16_bf16(pa1,PK(1),o[d0],0,0,0);
    o[d0]=__builtin_amdgcn_mfma_f32_32x32x16_bf16(pa2,PK(2),o[d0],0,0,0);
    o[d0]=__builtin_amdgcn_mfma_f32_32x32x16_bf16(pa3,PK(3),o[d0],0,0,0);
    #undef PK
  }
}

#ifndef ATTN_STORE16
#define ATTN_STORE16(p,v) (*(u32x4*)(p)=(v))
#endif
template<int THRL> __device__ __forceinline__ void attn_unit(int b,int qb,int kvh,int hp,bool isctx,const bf16*P,bf16*O,float sink_l2_h0,float sink_l2_h1,LAS unsigned char*shm){
  const int tid=threadIdx.x,lane=tid&63,r32=lane&31,hi=lane>>5; const int wid=__builtin_amdgcn_readfirstlane(tid>>6);
  const int head=kvh*4+hp*2+(wid>>2), rbk=wid&3;
  const long qrow0=(isctx?(long)NL+b*CTXL:(long)b*SEQ)+qb*128+rbk*QBLK;
  const bf16*Qw=P+qrow0*INW+head*64;
  const int nfull=isctx?0:2, nmask=isctx?0:((qb==0||qb==SEQ/128-1)?2:4);
  auto trow=[&](int t)->long{ if(t<nfull) return (long)b*SEQ+qb*128+64*t; if(t<nfull+4) return (long)NL+b*CTXL+64*(t-nfull);
    const int i=t-nfull-4; const int tl=(qb==0)?4+i:((i<2)?i:i+2); return (long)b*SEQ+qb*128-128+64*tl; };
  auto tcw=[&](int t)->int{ if(t<nfull+4) return 1<<20; const int i=t-nfull-4; const int tl=(qb==0)?4+i:((i<2)?i:i+2); return 128-64*tl; };
  const unsigned lds0=(unsigned)(uintptr_t)shm;
  LAS float*wsf=(LAS float*)(shm+LDS_WS)+wid*64;
  const unsigned koff=(unsigned)(lane*INW+C_K+kvh*64+wid*8)*2u;
  const unsigned voff=(unsigned)((16*(wid&3)+(lane>>2))*INW+C_V+kvh*64+(wid>>2)*32+(lane&3)*8)*2u;
  const unsigned kdst=lds0+LDS_K+wid*1024, vdst=lds0+LDS_V+wid*1024;
  #define DMA_K(t,slot) pg8::glds16s(koff,(const char*)P+trow(t)*(long)(INW*2),(unsigned)__builtin_amdgcn_readfirstlane(kdst+(slot)))
  #define DMA_V(t,slot) pg8::glds16s(voff,(const char*)P+trow(t)*(long)(INW*2),(unsigned)__builtin_amdgcn_readfirstlane(vdst+(slot)))
  const int vb0=(int)(lds0+LDS_V)+((lane>>4)&1)*32+(lane&3)*8+(4*hi+((lane&15)>>2))*64;
  const lds_cptr Kbase=(lds_cptr)shm+LDS_K; bf16x8 kf[8];
  const lds_cptr shm3=(lds_cptr)shm; const lds_cptr kp0=shm3+LDS_K+hi*1024+r32*16; const lds_cptr vp0=shm3+LDS_V+((lane>>4)&1)*32+(lane&3)*8+(4*hi+((lane&15)>>2))*64;
  const int NT=nfull+4+nmask;
  DMA_K(0,0);DMA_V(0,0);DMA_K(1,SLOTB);
  bf16x8 qr[4];
  #pragma unroll
  for(int d0=0;d0<4;++d0)qr[d0]=*reinterpret_cast<const bf16x8*>(&Qw[(long)r32*INW+d0*16+hi*8]);
  float mhat=0.f,l_reg=0.f;f32x16 o[2];o[0]=f32x16{};o[1]=f32x16{};f32x16 negm=f32x16{};asm volatile("":"+v"(negm));
  const int qq=rbk*QBLK+r32;
  #define CMASK(P0,P1,t) do{ if((t)>=NT-4){ const int cw_=tcw(t); if(cw_!=(1<<20)) wmask(P0,P1,cw_,qq,hi); } }while(0)
  bool resc=false;
  #define START(P0,P1) do{ const float rm=rowmax(P0,P1); resc=false; \
    { const float dl=rm; mhat=fadd_s(mhat,dl); \
      _Pragma("unroll") for(int r=0;r<16;++r){P0[r]=fsub_s(P0[r],dl);P1[r]=fsub_s(P1[r],dl);} \
      _Pragma("unroll") for(int r=0;r<16;++r)negm[r]=-mhat; asm volatile("":"+v"(negm)); } \
    _Pragma("unroll") for(int r=0;r<16;++r)P0[r]=__builtin_amdgcn_exp2f(P0[r]); }while(0)
  #define RESC() do{ if(resc){ asm volatile("s_waitcnt lgkmcnt(0)":::"memory"); \
      _Pragma("unroll") for(int d_=0;d_<2;++d_) _Pragma("unroll") for(int r=0;r<16;++r)o[d_][r]*=wsf[crow(r,hi)]; } }while(0)
  f32x16 pA0,pA1,pB0,pB1;
  int sl_prev=0,sl_cur=0,sl_next=SLOTB;
  #define ROT() do{sl_prev=sl_cur;sl_cur=sl_next;sl_next=(sl_next==(NSLOT-1)*SLOTB)?0:sl_next+SLOTB;}while(0)
  DMA_K(2,2*SLOTB);
  WAIT_BAR(3);
  qkt(pA0,pA1,Kbase,qr,negm,r32,hi);asm volatile("s_nop 15\n\ts_nop 7":"+v"(pA0),"+v"(pA1));CMASK(pA0,pA1,0);
  START(pA0,pA1);
  _Pragma("unroll") for(int r=0;r<16;++r)pA1[r]=__builtin_amdgcn_exp2f(pA1[r]);
  WAIT_BAR(0);
  DMA_K(3,0);DMA_V(1,SLOTB);
  ROT();
  kload8(kf,kp0+sl_cur);
  WAIT_BAR(2);
  s16x4 vlo[8],vhi[8]; u32x4 pw0,pw1,pw2,pw3;
  #define PKW(P,B) cvtpk_s(P[B],P[B+1])
  #define PAF(k) __builtin_bit_cast(bf16x8,pw##k)
  #define VFR(i) (bf16x8){vlo[i][0],vlo[i][1],vlo[i][2],vlo[i][3],vhi[i][0],vhi[i][1],vhi[i][2],vhi[i][3]}
  #define PIN(x) asm volatile("":"+v"(x))
  #define MX3(a,b,c) __builtin_fmaxf(__builtin_fmaxf((a),(b)),(c))
  #define GAPA(MF,A0,A1,A2,A3,W0,W1,PW) do{ MF; sacc+=A0; sacc+=A1; sacc+=A2; sacc+=A3; PIN(sacc); W0; W1; PIN(PW); SBAR(); }while(0)
  #define EX(v) __builtin_amdgcn_exp2f(v)
  #define GAPB(MF,X,B) do{ MF; X[B]=EX(X[B]); X[B+1]=EX(X[B+1]); X[B+2]=EX(X[B+2]); X[B+3]=EX(X[B+3]); PIN(X); SBAR(); }while(0)
  #define VRD(i) do{ vlo[i]=vtr(vp_+(((i)>>2)*4096+((i)&3)*1024)); vhi[i]=vtr(vp_+(((i)>>2)*4096+((i)&3)*1024+512)); }while(0)
  #define KRD(G,j) do{ if(G){ kload2(kf,kp0+sl_next,j); SBAR(); } }while(0)
  #define STEP(C0,C1,P0,P1,t,GK,GV,GL) do{ SBAR(); \
    const lds_cptr vp_=vp0+sl_prev; \
    VRD(0); SBAR(); float sacc=(P0[0]+P0[1]); \
    GAPA(C0=__builtin_amdgcn_mfma_f32_32x32x16_bf16(kf[0],qr[0],negm,0,0,0), P0[2],P0[3],P0[4],P0[5],     pw0[0]=PKW(P0,0), pw0[1]=PKW(P0,2), pw0); \
    VRD(4); SBAR(); GAPA(C1=__builtin_amdgcn_mfma_f32_32x32x16_bf16(kf[1],qr[0],negm,0,0,0), P0[6],P0[7],P0[8],P0[9],     pw0[2]=PKW(P0,4), pw0[3]=PKW(P0,6), pw0); \
    VRD(1); SBAR(); GAPA(C0=__builtin_amdgcn_mfma_f32_32x32x16_bf16(kf[2],qr[1],C0,0,0,0),   P0[10],P0[11],P0[12],P0[13], pw1[0]=PKW(P0,8), pw1[1]=PKW(P0,10), pw1); \
    VRD(5); SBAR(); GAPA(C1=__builtin_amdgcn_mfma_f32_32x32x16_bf16(kf[3],qr[1],C1,0,0,0),   P0[14],P0[15],P1[0],P1[1],   pw1[2]=PKW(P0,12),pw1[3]=PKW(P0,14), pw1); \
    VRD(2); SBAR(); GAPA(C0=__builtin_amdgcn_mfma_f32_32x32x16_bf16(kf[4],qr[2],C0,0,0,0),   P1[2],P1[3],P1[4],P1[5],     pw2[0]=PKW(P1,0), pw2[1]=PKW(P1,2), pw2); \
    VRD(6); SBAR(); GAPA(C1=__builtin_amdgcn_mfma_f32_32x32x16_bf16(kf[5],qr[2],C1,0,0,0),   P1[6],P1[7],P1[8],P1[9],     pw2[2]=PKW(P1,4), pw2[3]=PKW(P1,6), pw2); \
    VRD(3); SBAR(); GAPA(C0=__builtin_amdgcn_mfma_f32_32x32x16_bf16(kf[6],qr[3],C0,0,0,0),   P1[10],P1[11],P1[12],P1[13], pw3[0]=PKW(P1,8), pw3[1]=PKW(P1,10), pw3); \
    VRD(7); SBAR(); GAPA(C1=__builtin_amdgcn_mfma_f32_32x32x16_bf16(kf[7],qr[3],C1,0,0,0),   P1[14],P1[15],0.f,0.f,       pw3[2]=PKW(P1,12),pw3[3]=PKW(P1,14), pw3); \
    l_reg+=sacc; \
    if(GK){DMA_K((t)+3,sl_cur);} if(GV){DMA_V((t)+1,sl_next);} \
    CMASK(C0,C1,t); \
    { float a=MX3(C0[0],C0[1],C1[0]),b=MX3(C0[2],C0[3],C1[1]); a=MX3(a,C1[2],C1[3]); \
      _Pragma("unroll") for(int r=4;r<16;r+=4){a=MX3(a,C0[r],C0[r+1]);b=MX3(b,C0[r+2],C0[r+3]);a=MX3(a,C1[r],C1[r+1]);b=MX3(b,C1[r+2],C1[r+3]);} \
      float rm=__builtin_fmaxf(a,b); { auto rr=__builtin_amdgcn_permlane32_swap(__float_as_uint(rm),__float_as_uint(rm),false,false); rm=__builtin_fmaxf(__uint_as_float(rr[0]),__uint_as_float(rr[1])); } \
      resc=false; \
      if(__builtin_expect(__any(rm>(float)THRL),0)){ const float dl=__builtin_fmaxf(rm,0.f); mhat+=dl; \
        _Pragma("unroll") for(int r=0;r<16;++r){C0[r]-=dl;C1[r]-=dl;} \
        _Pragma("unroll") for(int r=0;r<16;++r)negm[r]=-mhat; asm volatile("":"+v"(negm)); \
        const float f=__builtin_amdgcn_exp2f(-dl); l_reg*=f; if(hi==0)wsf[r32]=f; resc=true; } } \
    SBAR(); \
    GAPB(o[0]=__builtin_amdgcn_mfma_f32_32x32x16_bf16(PAF(0),VFR(0),o[0],0,0,0), C0,0); \
    GAPB(o[1]=__builtin_amdgcn_mfma_f32_32x32x16_bf16(PAF(0),VFR(4),o[1],0,0,0), C0,4); \
    KRD(GL,0); GAPB(o[0]=__builtin_amdgcn_mfma_f32_32x32x16_bf16(PAF(1),VFR(1),o[0],0,0,0), C0,8); \
    KRD(GL,1); GAPB(o[1]=__builtin_amdgcn_mfma_f32_32x32x16_bf16(PAF(1),VFR(5),o[1],0,0,0), C0,12); \
    KRD(GL,2); GAPB(o[0]=__builtin_amdgcn_mfma_f32_32x32x16_bf16(PAF(2),VFR(2),o[0],0,0,0), C1,0); \
    KRD(GL,3); GAPB(o[1]=__builtin_amdgcn_mfma_f32_32x32x16_bf16(PAF(2),VFR(6),o[1],0,0,0), C1,4); \
    GAPB(o[0]=__builtin_amdgcn_mfma_f32_32x32x16_bf16(PAF(3),VFR(3),o[0],0,0,0), C1,8); \
    GAPB(o[1]=__builtin_amdgcn_mfma_f32_32x32x16_bf16(PAF(3),VFR(7),o[1],0,0,0), C1,12); \
    }while(0)
  int t=1;
  #undef CMASK
  #define CMASK(P0,P1,t) do{}while(0)
  for(;t+5<NT;t+=2){
    STEP(pB0,pB1,pA0,pA1,t,true,true,true);     WAIT_BAR(2); RESC(); ROT();
    STEP(pA0,pA1,pB0,pB1,t+1,true,true,true);   WAIT_BAR(2); RESC(); ROT();
  }
  #undef CMASK
  #define CMASK(P0,P1,t) do{ if((t)>=NT-4){ const int cw_=tcw(t); if(cw_!=(1<<20)) wmask(P0,P1,cw_,qq,hi); } }while(0)
  #define ENDW(tt) do{ if((tt)+3<NT){WAIT_BAR(2);} else if((tt)+2<NT){WAIT_BAR(1);} else {WAIT_BAR(0);} }while(0)
  for(;t+1<NT;t+=2){
    STEP(pB0,pB1,pA0,pA1,t,(t+3<NT),(t+1<NT),(t+1<NT));       ENDW(t);   RESC(); ROT();
    STEP(pA0,pA1,pB0,pB1,t+1,(t+4<NT),(t+2<NT),(t+2<NT));     ENDW(t+1); RESC(); ROT();
  }
  STEP(pB0,pB1,pA0,pA1,NT-1,false,false,false); RESC();
  { float sacc=pB0[0]+pB0[1]; _Pragma("unroll") for(int r=2;r<16;++r)sacc+=pB0[r]; _Pragma("unroll") for(int r=0;r<16;++r)sacc+=pB1[r]; l_reg+=sacc;
    pw0=(u32x4){PKW(pB0,0),PKW(pB0,2),PKW(pB0,4),PKW(pB0,6)};pw1=(u32x4){PKW(pB0,8),PKW(pB0,10),PKW(pB0,12),PKW(pB0,14)};pw2=(u32x4){PKW(pB1,0),PKW(pB1,2),PKW(pB1,4),PKW(pB1,6)};pw3=(u32x4){PKW(pB1,8),PKW(pB1,10),PKW(pB1,12),PKW(pB1,14)};
    SBAR(); pv(o,vb0+sl_cur,PAF(0),PAF(1),PAF(2),PAF(3)); }
  #undef PKW
  #undef PAF
  #undef VFR
  #undef PIN
  #undef MX3
  #undef GAPA
  #undef GAPB
  #undef EX
  #undef VRD
  #undef KRD
  #undef STEP
  #undef ENDW
  {auto rr=__builtin_amdgcn_permlane32_swap(__float_as_uint(l_reg),__float_as_uint(l_reg),false,false);l_reg=__uint_as_float(rr[0])+__uint_as_float(rr[1]);}
  l_reg+=__builtin_amdgcn_exp2f(((wid>>2)?sink_l2_h1:sink_l2_h0)-mhat);
  if(hi==0)wsf[32+r32]=l_reg;asm volatile("s_waitcnt lgkmcnt(0)":::"memory");
  float rli[16];
  #pragma unroll
  for(int r=0;r<16;++r)rli[r]=__builtin_amdgcn_rcpf(wsf[32+crow(r,hi)]);
  bf16*Ow=O+qrow0*(long)D+head*64;
  { LAS bf16*stg=(LAS bf16*)(shm+LDS_OST)+wid*2048;
    #pragma unroll
    for(int r=0;r<16;++r){const int orow=crow(r,hi);
      #pragma unroll
      for(int d0=0;d0<2;++d0)stg[orow*64+d0*32+r32]=(bf16)(cvtpk_s(o[d0][r]*rli[r],0.f)&0xffffu);}
    asm volatile("s_waitcnt lgkmcnt(0)":::"memory");
    #pragma unroll
    for(int i=0;i<4;++i){const int row=i*8+(lane>>3),ch=lane&7; const u32x4 v=*(const LAS u32x4*)(stg+row*64+ch*8); ATTN_STORE16(Ow+(long)row*D+ch*8,v);} }
  asm volatile("s_waitcnt lgkmcnt(0)\n\ts_barrier":::"memory");
  #undef DMA_K
  #undef DMA_V
  #undef CMASK
  #undef START
  #undef RESC
  #undef ROT
}
constexpr int ATTN_LDS_BYTES=LDS_BYTES;
#undef SBAR
#undef WAIT_BAR
}

__device__ __forceinline__ void p_attn2(Frame& F, int layer) {
    const int vcu = (blockIdx.x % 8) * (F.G / 8) + blockIdx.x / 8;
    const bf16* P = WSP(bf16, WS_PROJ); bf16* O = WSP(bf16, WS_MIX);
    for (int u = vcu * 4; u < 1024; u += 4 * F.G)
        for (int k = 0; k < (((REP_MASK) >> 3) & 1 ? 8 : 4); ++k) { const int uu = u + (k & 3), b = uu >> 7, qb = (uu >> 2) & 31, kvh = (uu >> 1) & 1, hp = uu & 1;
            att2::attn_unit<8>(b, qb, kvh, hp, false, P, O, F.sink[layer * 8 + kvh * 4 + hp * 2] * LOG2E, F.sink[layer * 8 + kvh * 4 + hp * 2 + 1] * LOG2E, F.lds); }
    if (layer == 0) for (int v = blockIdx.x; v < 64; v += F.G) { const int b = v >> 3, qb = (v >> 2) & 1, kvh = (v >> 1) & 1, hp = v & 1;
        att2::attn_unit<8>(b, qb, kvh, hp, true, P, O, F.sink[kvh * 4 + hp * 2] * LOG2E, F.sink[kvh * 4 + hp * 2 + 1] * LOG2E, F.lds); }
}
#ifndef ATT2
#define ATT2 1
#endif
#if ATT2
#define P_ATTN p_attn2
#else
#define P_ATTN p_attn
#endif
namespace mixb {
using att::bf16x8; using att::s16x4; using att::f32x16; using att::u32x4; using att::lds_cptr; using att::vtr; using att::crow; using att::cvtpk;
__device__ __forceinline__ bf16x8 tr_pair(lds_cptr p, int second_off) { const s16x4 lo = vtr(p), hh = vtr(p + second_off); return (bf16x8){lo[0], lo[1], lo[2], lo[3], hh[0], hh[1], hh[2], hh[3]}; }
__device__ __forceinline__ void unpack8(const v4u w, float (&f)[8]) { f[0] = bflo(w.x); f[1] = bfhi(w.x); f[2] = bflo(w.y); f[3] = bfhi(w.y); f[4] = bflo(w.z); f[5] = bfhi(w.z); f[6] = bflo(w.w); f[7] = bfhi(w.w); }
__device__ __forceinline__ v4u pack8(const float (&f)[8]) { v4u w; w.x = pk2(f[0], f[1]); w.y = pk2(f[2], f[3]); w.z = pk2(f[4], f[5]); w.w = pk2(f[6], f[7]); return w; }
__device__ __forceinline__ float half_sum(float v) {
#pragma unroll
    for (int o = 1; o < 32; o <<= 1) v += __shfl_xor(v, o);
    return v;
}
__device__ __forceinline__ void kv_unit(Frame& F, int layer, int b, int cid, int hp) {
    const int tid = opq((int)threadIdx.x), lane = tid & 63, r32 = lane & 31, hi = lane >> 5; const int wid = __builtin_amdgcn_readfirstlane(tid >> 6);
    const bf16* P = WSP(bf16, WS_PROJ); const int row0 = chunk_row0(b, cid);
    __syncthreads();
#pragma unroll
    for (int it = 0; it < 2; ++it) { const int idx = tid + it * NTHR, hs = idx >> 9, t = (idx >> 2) & 127, c = idx & 3, h = 2 * hp + hs;
        const v4u w = *(const v4u*)(P + (size_t)(row0 + t) * INW + C_RK + h * 32 + c * 8); float f[8], a[8], bb[8]; unpack8(w, f);
        const float wf = __expf(F.lgf[layer * 4 + h] * (float)(127 - t)), wb = __expf(F.lgb[layer * 4 + h] * (float)t);
#pragma unroll
        for (int j = 0; j < 8; ++j) { a[j] = f[j] * wf; bb[j] = f[j] * wb; }
        LAS unsigned char* d = F.lds + hs * 32768 + t * 64 + c * 16; *(LAS v4u*)d = pack8(a); *(LAS v4u*)(d + 8192) = pack8(bb); }
#pragma unroll
    for (int it = 0; it < 4; ++it) { const int idx = tid + it * NTHR, hs = idx >> 10, t = (idx >> 3) & 127, c = idx & 7, h = 2 * hp + hs;
        *(LAS v4u*)(F.lds + hs * 32768 + 16384 + (c >> 2) * 8192 + t * 64 + (c & 3) * 16) = *(const v4u*)(P + (size_t)(row0 + t) * INW + C_RV + h * 64 + c * 8); }
    __syncthreads();
    const int hs = wid >> 2, h = 2 * hp + hs, dir = (wid >> 1) & 1, eh = wid & 1;
    const int natoff = (8 * hi + ((lane & 15) >> 2)) * 64 + ((lane >> 4) & 1) * 32 + (lane & 3) * 8;
    const lds_cptr ab = (lds_cptr)F.lds + hs * 32768 + dir * 8192 + natoff, bb = (lds_cptr)F.lds + hs * 32768 + 16384 + eh * 8192 + natoff;
    f32x16 acc = f32x16{};
#pragma unroll
    for (int ks = 0; ks < 8; ++ks) acc = __builtin_amdgcn_mfma_f32_32x32x16_bf16(tr_pair(ab + ks * 1024, 256), tr_pair(bb + ks * 1024, 256), acc, 0, 0, 0);
    float* dst = WSP(float, WS_KVS) + ((size_t)((dir * 8 + b) * 4 + h) * NCHK + cid) * 2048 + 32 * eh + r32;
#pragma unroll
    for (int r = 0; r < 16; ++r) dst[crow(r, hi) * 64] = acc[r];
}
__device__ __forceinline__ void ret_unit(Frame& F, int layer, int b, int cid, int hp) {
    const int tid = opq((int)threadIdx.x), lane = tid & 63, r32 = lane & 31, hi = lane >> 5; const int wid = __builtin_amdgcn_readfirstlane(tid >> 6);
    const bf16* P = WSP(bf16, WS_PROJ); const int row0 = chunk_row0(b, cid);
    constexpr int HB = 40960;
    v4u qraw[2], rgraw[4];
    { const int hs_ = wid >> 2, h_ = 2 * hp + hs_, qb_ = wid & 3;
#pragma unroll
      for (int ks = 0; ks < 2; ++ks) qraw[ks] = *(const v4u*)(P + (size_t)(row0 + 32 * qb_ + r32) * INW + C_RQ + h_ * 32 + 16 * ks + 8 * hi);
#pragma unroll
      for (int k = 0; k < 4; ++k) rgraw[k] = *(const v4u*)(P + (size_t)(row0 + 32 * qb_ + k * 8 + (lane >> 3)) * INW + C_RG + h_ * 64 + (lane & 7) * 8); }
    __syncthreads();
#pragma unroll
    for (int it = 0; it < 2; ++it) { const int idx = tid + it * NTHR, hs = idx >> 9, t = (idx >> 2) & 127, c = idx & 3, h = 2 * hp + hs;
        const v4u w = *(const v4u*)(P + (size_t)(row0 + t) * INW + C_RK + h * 32 + c * 8); float f[8], a[8], bb[8]; unpack8(w, f);
        const float sf = __expf(-F.lgf[layer * 4 + h] * (float)t), sb = __expf(F.lgb[layer * 4 + h] * (float)t);
#pragma unroll
        for (int j = 0; j < 8; ++j) { a[j] = f[j] * sf; bb[j] = f[j] * sb; }
        LAS unsigned char* d = F.lds + hs * HB + c * 2048 + t * 16; *(LAS v4u*)d = pack8(a); *(LAS v4u*)(d + 8192) = pack8(bb); }
#pragma unroll
    for (int it = 0; it < 4; ++it) { const int idx = tid + it * NTHR, hs = idx >> 10, t = (idx >> 3) & 127, c = idx & 7, h = 2 * hp + hs;
        *(LAS v4u*)(F.lds + hs * HB + 16384 + (c >> 2) * 8192 + t * 64 + (c & 3) * 16) = *(const v4u*)(P + (size_t)(row0 + t) * INW + C_RV + h * 64 + c * 8); }
#pragma unroll
    for (int it = 0; it < 4; ++it) { const int idx = tid + it * NTHR, hs = idx >> 10, dir = (idx >> 9) & 1, d = (idx >> 4) & 31, e4 = idx & 15, h = 2 * hp + hs;
        const f32x4 v = *(const f32x4*)(WSP(float, WS_KVS) + ((size_t)((dir * 8 + b) * 4 + h) * NCHK + cid) * 2048 + d * 64 + e4 * 4);
        const float fac = dir ? __expf(F.lgb[layer * 4 + h] * 128.0f) : __expf(F.lgf[layer * 4 + h]);
        v2u w; w.x = pk2(v[0] * fac, v[1] * fac); w.y = pk2(v[2] * fac, v[3] * fac);
        *(LAS v2u*)(F.lds + hs * HB + 32768 + dir * 4096 + (e4 >> 3) * 2048 + d * 64 + (e4 & 7) * 8) = w; }
    __syncthreads();
    const int hs = wid >> 2, h = 2 * hp + hs, qb = wid & 3, n = 32 * qb + r32;
    const lds_cptr hb = (lds_cptr)F.lds + hs * HB;
    bf16x8 qf[2], qbk[2];
    { const float sf = __expf(F.lgf[layer * 4 + h] * (float)n), sb = __expf(-F.lgb[layer * 4 + h] * (float)n);
#pragma unroll
      for (int ks = 0; ks < 2; ++ks) { float f[8], a[8], bb[8]; unpack8(qraw[ks], f);
#pragma unroll
          for (int j = 0; j < 8; ++j) { a[j] = f[j] * sf; bb[j] = f[j] * sb; }
          qf[ks] = __builtin_bit_cast(bf16x8, pack8(a)); qbk[ks] = __builtin_bit_cast(bf16x8, pack8(bb)); } }
    const int qoff = ((lane & 15) >> 2) * 64 + ((lane >> 4) & 1) * 32 + (lane & 3) * 8;
    const int natoff = 8 * hi * 64 + qoff, permoff = 4 * hi * 64 + qoff;
    f32x16 o[2]; o[0] = f32x16{}; o[1] = f32x16{};
#pragma unroll
    for (int eh = 0; eh < 2; ++eh)
#pragma unroll
        for (int ks = 0; ks < 2; ++ks) {
            o[eh] = __builtin_amdgcn_mfma_f32_32x32x16_bf16(qf[ks], tr_pair(hb + 32768 + eh * 2048 + ks * 1024 + natoff, 256), o[eh], 0, 0, 0);
            o[eh] = __builtin_amdgcn_mfma_f32_32x32x16_bf16(qbk[ks], tr_pair(hb + 36864 + eh * 2048 + ks * 1024 + natoff, 256), o[eh], 0, 0, 0); }
#pragma unroll
    for (int kb = 0; kb < 4; ++kb) {
        f32x16 x = f32x16{};
        if (kb <= qb) { f32x16 xf = f32x16{};
#pragma unroll
            for (int ks = 0; ks < 2; ++ks) xf = __builtin_amdgcn_mfma_f32_32x32x16_bf16(*(const __attribute__((address_space(3))) bf16x8*)(hb + (2 * ks + hi) * 2048 + (32 * kb + r32) * 16), qf[ks], xf, 0, 0, 0);
            if (kb == qb) {
#pragma unroll
                for (int r = 0; r < 16; ++r) xf[r] = crow(r, hi) <= r32 ? xf[r] : 0.f; }
            x = xf; }
        if (kb >= qb) { f32x16 xb = f32x16{};
#pragma unroll
            for (int ks = 0; ks < 2; ++ks) xb = __builtin_amdgcn_mfma_f32_32x32x16_bf16(*(const __attribute__((address_space(3))) bf16x8*)(hb + 8192 + (2 * ks + hi) * 2048 + (32 * kb + r32) * 16), qbk[ks], xb, 0, 0, 0);
            if (kb == qb) {
#pragma unroll
                for (int r = 0; r < 16; ++r) xb[r] = crow(r, hi) >= r32 ? xb[r] : 0.f; }
            x = x + xb; }
        u32x4 pw[2];
#pragma unroll
        for (int k = 0; k < 4; ++k) { pw[0][k] = cvtpk(x[2 * k], x[2 * k + 1]); pw[1][k] = cvtpk(x[8 + 2 * k], x[9 + 2 * k]); }
#pragma unroll
        for (int eh = 0; eh < 2; ++eh)
#pragma unroll
            for (int k2 = 0; k2 < 2; ++k2) o[eh] = __builtin_amdgcn_mfma_f32_32x32x16_bf16(__builtin_bit_cast(bf16x8, pw[k2]), tr_pair(hb + 16384 + eh * 8192 + (32 * kb + 16 * k2) * 64 + permoff, 512), o[eh], 0, 0, 0);
    }
    LAS float* stg = (LAS float*)(F.lds + 2 * HB) + wid * 2048;
#pragma unroll
    for (int r = 0; r < 16; ++r) { stg[crow(r, hi) * 64 + r32] = o[0][r]; stg[crow(r, hi) * 64 + 32 + r32] = o[1][r]; }
    asm volatile("s_waitcnt lgkmcnt(0)" ::: "memory");
#pragma unroll
    for (int k = 0; k < 4; ++k) { const int row = k * 8 + (lane >> 3), ch = lane & 7; const size_t grow = (size_t)(row0 + 32 * qb + row);
        const f32x4 v0 = *(const LAS f32x4*)(stg + row * 64 + ch * 8), v1 = *(const LAS f32x4*)(stg + row * 64 + ch * 8 + 4);
        float s = (v0[0] + v0[1]) + (v0[2] + v0[3]) + (v1[0] + v1[1]) + (v1[2] + v1[3]);
        s += __shfl_xor(s, 1); s += __shfl_xor(s, 2); s += __shfl_xor(s, 4);
        const float mean = s * (1.0f / 64.0f); const f32x4 d0 = v0 - mean, d1 = v1 - mean;
        float q = (d0[0] * d0[0] + d0[1] * d0[1]) + (d0[2] * d0[2] + d0[3] * d0[3]) + (d1[0] * d1[0] + d1[1] * d1[1]) + (d1[2] * d1[2] + d1[3] * d1[3]);
        q += __shfl_xor(q, 1); q += __shfl_xor(q, 2); q += __shfl_xor(q, 4);
        const float rstd = 1.0f / sqrtf(q * (1.0f / 64.0f) + LN_EPS);
        float rg[8], y[8]; unpack8(rgraw[k], rg);
#pragma unroll
        for (int j = 0; j < 8; ++j) y[j] = rg[j] * __builtin_amdgcn_rcpf(1.0f + __builtin_amdgcn_exp2f(-LOG2E * rg[j])) * ((j < 4 ? d0[j] : d1[j - 4]) * rstd);
        *(v4u*)(WSP(bf16, WS_MIX) + grow * D + 768 + h * 64 + ch * 8) = pack8(y); }
}
__device__ __forceinline__ void pool_unit(Frame& F, int layer, int s, int blk) {
    const int tid = opq((int)threadIdx.x), lane = tid & 63, r32 = lane & 31, hi = lane >> 5; const int wid = __builtin_amdgcn_readfirstlane(tid >> 6);
    const bool isctx = s >= 8; const int b = s & 7, len = isctx ? CTXL : SEQ, row0 = isctx ? NL + b * CTXL : b * SEQ, t0 = blk * 128;
    const bf16* P = WSP(bf16, WS_PROJ);
    constexpr int UST = 528, PWB = 144 * UST, PST = 144;
    __syncthreads();
#pragma unroll
    for (int it = 0; it < 9; ++it) { const int idx = tid + it * NTHR, rr = idx >> 5, c = idx & 31, t = t0 - 8 + rr; v4u w = (v4u){0u, 0u, 0u, 0u};
        if (t >= 0 && t < len) w = *(const v4u*)(P + (size_t)(row0 + t) * INW + C_U + c * 8);
        *(LAS v4u*)(F.lds + rr * UST + c * 16) = w; }
    for (int idx = tid; idx < 16384; idx += NTHR) { const int g = idx >> 12, c = (idx >> 6) & 63, d = idx & 63;
        *(LAS bf16*)(F.lds + PWB + (g * 64 + d) * PST + c * 2) = (bf16)(pk2(F.pool_w[(size_t)layer * 16384 + idx], 0.f) & 0xffffu); }
    __syncthreads();
    const int rbk = wid & 3, ch = wid >> 2, t = 32 * rbk + r32, tt = t0 + t;
    const lds_cptr ub = (lds_cptr)F.lds + (t + 8) * UST + hi * 16;
    bf16* dstrow = WSP(bf16, WS_MIX) + (size_t)(row0 + tt) * D + 512 + 32 * ch + 4 * hi;
#pragma unroll
    for (int g = 0; g < 4; ++g) { const int hw = 1 << g; const float inv = 1.0f / (float)(min(tt + hw, len) - max(tt - hw, 0));
        f32x16 acc = f32x16{};
#pragma unroll
        for (int ks = 0; ks < 4; ++ks) { const lds_cptr up = ub + g * 128 + ks * 32; float sum[8], own[8];
#pragma unroll
            for (int j = 0; j < 8; ++j) sum[j] = 0.f;
#pragma unroll
            for (int dt = -hw; dt < hw; ++dt) { float f[8]; unpack8(*(const __attribute__((address_space(3))) v4u*)(up + dt * UST), f);
#pragma unroll
                for (int j = 0; j < 8; ++j) sum[j] += f[j]; }
            unpack8(*(const __attribute__((address_space(3))) v4u*)up, own);
#pragma unroll
            for (int j = 0; j < 8; ++j) sum[j] = sum[j] * inv - own[j];
            const bf16x8 df = __builtin_bit_cast(bf16x8, pack8(sum));
            const bf16x8 wf = *(const __attribute__((address_space(3))) bf16x8*)((lds_cptr)F.lds + PWB + (g * 64 + 32 * ch + r32) * PST + (16 * ks + 8 * hi) * 2);
            acc = __builtin_amdgcn_mfma_f32_32x32x16_bf16(wf, df, acc, 0, 0, 0); }
        const float* ps = F.pool_scale + layer * 256 + g * 64 + 32 * ch + 4 * hi;
#pragma unroll
        for (int rq = 0; rq < 4; ++rq) { const f32x4 sc = *(const f32x4*)(ps + 8 * rq); v2u w; w.x = pk2(acc[4 * rq] * sc[0], acc[4 * rq + 1] * sc[1]); w.y = pk2(acc[4 * rq + 2] * sc[2], acc[4 * rq + 3] * sc[3]);
            *(v2u*)(dstrow + g * 64 + 8 * rq) = w; }
    }
}
}
__device__ __forceinline__ void p_mix(Frame& F, int layer) {
#if !ATTN_LATE
    P_ATTN(F, layer);
#endif
    const int n_pool = 256 + (layer == 0 ? 16 : 0);
    REPEAT(4) for (int u = (blockIdx.x + F.G - 64) % F.G; u < n_pool; u += F.G) { if (u < 256) mixb::pool_unit(F, layer, u >> 5, u & 31); else mixb::pool_unit(F, layer, 8 + ((u - 256) >> 1), (u - 256) & 1); }
    REPEAT(7) for (int u = (blockIdx.x + F.G - 128) % F.G; u < 8 * NCHK * 2; u += F.G) mixb::kv_unit(F, layer, u / (NCHK * 2), (u >> 1) % NCHK, u & 1);
    __syncthreads();
}
__device__ __forceinline__ void p_ret(Frame& F, int layer) {
    if (layer == 0) { for (int u = blockIdx.x; u < 8 * NCHK * 2; u += F.G) mixb::ret_unit(F, layer, u / (NCHK * 2), (u >> 1) % NCHK, u & 1);
        if (CONV_SPREAD != 0 && (TAILQ & 1) != 0 && F.G == 256) { __syncthreads(); bg_convert(F, 32, 224, CV_A, CV_B); } }
    else { for (int u = blockIdx.x; u < 8 * 32 * 2; u += F.G) mixb::ret_unit(F, layer, u >> 6, 2 + ((u >> 1) & 31), u & 1); }
    __syncthreads();
#if ATTN_LATE
    P_ATTN(F, layer);
    __syncthreads();
#endif
}
#if defined(MIX_CHECK)
__device__ __forceinline__ void chk(Frame& F, float a, float ref, float abs_t, float rel_t, int word) { const float d = fabsf(a - ref); if (!(d <= abs_t + rel_t * fabsf(ref))) atomicOr(WSP(unsigned, WS_CTL) + word, 1u); }
#endif
__device__ __forceinline__ void attn_naive_unit(Frame& F, int layer, int b, int qb, int kvh, bool isctx) {
    const int tid = opq((int)threadIdx.x), qq = tid & 127, g = tid >> 7, head = kvh * 4 + g;
    const bf16* P = WSP(bf16, WS_PROJ);
    const int qrow = isctx ? NL + b * CTXL + qb * 128 + qq : b * SEQ + qb * 128 + qq;
    LAS unsigned* kt = (LAS unsigned*)F.lds;
    LAS unsigned* vt = kt + 64 * 32;
    unsigned q[32];
#pragma unroll
    for (int i = 0; i < 8; ++i) { const v4u w = *(const v4u*)(P + (size_t)qrow * INW + head * 64 + i * 8); q[4 * i] = w.x; q[4 * i + 1] = w.y; q[4 * i + 2] = w.z; q[4 * i + 3] = w.w; }
    float m = F.sink[layer * 8 + head] * LOG2E, l = 1.0f, o[64];
#pragma unroll
    for (int d = 0; d < 64; ++d) o[d] = 0.f;
    const int qpos = qb * 128 + qq;
    for (int tile = isctx ? 6 : 0; tile < 10; ++tile) {
        int krow0, kpos0 = 0; const bool local = tile < 6;
        if (local) { kpos0 = qb * 128 - 128 + 64 * tile; if (kpos0 < 0 || kpos0 >= SEQ) continue; krow0 = b * SEQ + kpos0; }
        else krow0 = NL + b * CTXL + 64 * (tile - 6);
        __syncthreads();
        { const int r = tid >> 3, ch = tid & 7; const bf16* src = P + (size_t)(krow0 + r) * INW + kvh * 64 + ch * 8;
          *(LAS v4u*)(kt + r * 32 + ch * 4) = *(const v4u*)(src + C_K); *(LAS v4u*)(vt + r * 32 + ch * 4) = *(const v4u*)(src + C_V); }
        __syncthreads();
        for (int j = 0; j < 64; ++j) {
            float s = 0.f;
#pragma unroll
            for (int i = 0; i < 32; ++i) s = dot2bf(q[i], kt[j * 32 + i], s);
            const int dlt = qpos - (kpos0 + j); const bool valid = !local || (dlt <= 128 && dlt >= -128);
            if (valid) {
                if (s > m) { const float f = __builtin_amdgcn_exp2f(m - s); l *= f;
#pragma unroll
                    for (int d = 0; d < 64; ++d) o[d] *= f;
                    m = s; }
                const float p = __builtin_amdgcn_exp2f(s - m); l += p;
#pragma unroll
                for (int i = 0; i < 32; ++i) { const unsigned w = vt[j * 32 + i]; o[2 * i] += p * bflo(w); o[2 * i + 1] += p * bfhi(w); }
            }
        }
    }
    const float rl = 1.0f / l;
    bf16* dst = WSP(bf16, WS_MIX) + (size_t)qrow * D + head * 64;
#if defined(ATTN_CHECK)
    { bool bad = false;
#pragma unroll
      for (int i = 0; i < 8; ++i) { const v4u w = *(const v4u*)(dst + 8 * i); const float r8[8] = {bflo(w.x), bfhi(w.x), bflo(w.y), bfhi(w.y), bflo(w.z), bfhi(w.z), bflo(w.w), bfhi(w.w)};
#pragma unroll
          for (int k = 0; k < 8; ++k) { const float a = o[8 * i + k] * rl, d = fabsf(a - r8[k]); if (!(d <= ATTN_CHECK_ABS + ATTN_CHECK_REL * fabsf(a))) bad = true; } }
      if (bad) atomicOr(WSP(unsigned, WS_CTL) + 8, 1u); }
#endif
#pragma unroll
    for (int i = 0; i < 8; ++i) { v4u w; w.x = pk2(o[8 * i] * rl, o[8 * i + 1] * rl); w.y = pk2(o[8 * i + 2] * rl, o[8 * i + 3] * rl); w.z = pk2(o[8 * i + 4] * rl, o[8 * i + 5] * rl); w.w = pk2(o[8 * i + 6] * rl, o[8 * i + 7] * rl); *(v4u*)(dst + 8 * i) = w; }
    __syncthreads();
}
__device__ __forceinline__ void pool_naive_unit(Frame& F, int layer, int s, int blk) {
    const int tid = opq((int)threadIdx.x); const bool isctx = s >= 8; const int b = s & 7, len = isctx ? CTXL : SEQ, row0 = isctx ? NL + b * CTXL : b * SEQ, t0 = blk * 128;
    const bf16* P = WSP(bf16, WS_PROJ);
    LAS float* ub = (LAS float*)F.lds;
    LAS float* pwb = ub + 144 * 64;
    LAS float* db = pwb + 64 * 64;
    for (int g = 0; g < 4; ++g) { const int hw = 1 << g;
        __syncthreads();
        for (int idx = tid; idx < 144 * 8; idx += NTHR) { const int rr = idx >> 3, ch = idx & 7, t = t0 - 8 + rr; v4u w = (v4u){0u, 0u, 0u, 0u};
            if (t >= 0 && t < len) w = *(const v4u*)(P + (size_t)(row0 + t) * INW + C_U + g * 64 + ch * 8);
            LAS float* d = ub + rr * 64 + ch * 8; d[0] = bflo(w.x); d[1] = bfhi(w.x); d[2] = bflo(w.y); d[3] = bfhi(w.y); d[4] = bflo(w.z); d[5] = bfhi(w.z); d[6] = bflo(w.w); d[7] = bfhi(w.w); }
        for (int idx = tid; idx < 4096; idx += NTHR) pwb[idx] = F.pool_w[(size_t)(layer * 4 + g) * 4096 + idx];
        __syncthreads();
        for (int idx = tid; idx < 8192; idx += NTHR) { const int t = idx >> 6, c = idx & 63, tt = t0 + t; const int lo = max(tt - hw, 0), hi = min(tt + hw, len); float sum = 0.f;
            for (int p = lo; p < hi; ++p) sum += ub[(p - t0 + 8) * 64 + c];
            db[t * 65 + c] = sum / (float)(hi - lo) - ub[(t + 8) * 64 + c]; }
        __syncthreads();
        const int t = tid & 127, dq = tid >> 7; float acc[16];
#pragma unroll
        for (int i = 0; i < 16; ++i) acc[i] = 0.f;
        for (int c = 0; c < 64; ++c) { const float xv = db[t * 65 + c];
#pragma unroll
            for (int i = 0; i < 16; ++i) acc[i] += xv * pwb[c * 64 + dq * 16 + i]; }
        const float* ps = F.pool_scale + layer * 256 + g * 64 + dq * 16;
        bf16* dst = WSP(bf16, WS_MIX) + (size_t)(row0 + t0 + t) * D + 512 + g * 64 + dq * 16;
#if defined(MIX_CHECK)
#pragma unroll
        for (int i = 0; i < 2; ++i) { const v4u w = *(const v4u*)(dst + 8 * i); const float r8[8] = {bflo(w.x), bfhi(w.x), bflo(w.y), bfhi(w.y), bflo(w.z), bfhi(w.z), bflo(w.w), bfhi(w.w)};
#pragma unroll
            for (int k = 0; k < 8; ++k) chk(F, r8[k], acc[8 * i + k] * ps[8 * i + k], 0.02f, 0.03f, 9); }
#endif
#pragma unroll
        for (int i = 0; i < 2; ++i) { v4u w; w.x = pk2(acc[8 * i] * ps[8 * i], acc[8 * i + 1] * ps[8 * i + 1]); w.y = pk2(acc[8 * i + 2] * ps[8 * i + 2], acc[8 * i + 3] * ps[8 * i + 3]);
            w.z = pk2(acc[8 * i + 4] * ps[8 * i + 4], acc[8 * i + 5] * ps[8 * i + 5]); w.w = pk2(acc[8 * i + 6] * ps[8 * i + 6], acc[8 * i + 7] * ps[8 * i + 7]); *(v4u*)(dst + 8 * i) = w; }
    }
    __syncthreads();
}
__device__ __forceinline__ void kv_naive_unit(Frame& F, int layer, int b, int h, int cid) {
    const int tid = opq((int)threadIdx.x); const bf16* P = WSP(bf16, WS_PROJ); const int row0 = chunk_row0(b, cid);
    LAS float* kf = (LAS float*)F.lds;
    LAS float* vf = kf + 128 * 32;
    LAS float* wf = vf + 128 * 64;
    const float lgf = F.lgf[layer * 4 + h], lgb = F.lgb[layer * 4 + h];
    __syncthreads();
    { const int r = tid >> 2, ch = tid & 3; const v4u w = *(const v4u*)(P + (size_t)(row0 + r) * INW + C_RK + h * 32 + ch * 8); LAS float* d = kf + r * 32 + ch * 8;
      d[0] = bflo(w.x); d[1] = bfhi(w.x); d[2] = bflo(w.y); d[3] = bfhi(w.y); d[4] = bflo(w.z); d[5] = bfhi(w.z); d[6] = bflo(w.w); d[7] = bfhi(w.w); }
    for (int idx = tid; idx < 1024; idx += NTHR) { const int r = idx >> 3, ch = idx & 7; const v4u w = *(const v4u*)(P + (size_t)(row0 + r) * INW + C_RV + h * 64 + ch * 8); LAS float* d = vf + r * 64 + ch * 8;
      d[0] = bflo(w.x); d[1] = bfhi(w.x); d[2] = bflo(w.y); d[3] = bfhi(w.y); d[4] = bflo(w.z); d[5] = bfhi(w.z); d[6] = bflo(w.w); d[7] = bfhi(w.w); }
    if (tid < 128) { wf[tid] = __expf(lgf * (float)(127 - tid)); wf[128 + tid] = __expf(lgb * (float)tid); }
    __syncthreads();
    const int i = tid >> 4, e0 = (tid & 15) * 4; f32x4 af = (f32x4){0.f, 0.f, 0.f, 0.f}, ab = af;
    for (int m = 0; m < 128; ++m) { const float kk = kf[m * 32 + i]; const f32x4 vv = *(const LAS f32x4*)(vf + m * 64 + e0); af += (kk * wf[m]) * vv; ab += (kk * wf[128 + m]) * vv; }
    float* dst = WSP(float, WS_KVS) + ((size_t)(b * 4 + h) * NCHK + cid) * 2048 + i * 64 + e0;
#if defined(MIX_CHECK)
    { const f32x4 cf = *(const f32x4*)dst, cb = *(const f32x4*)(dst + (size_t)32 * NCHK * 2048);
#pragma unroll
      for (int k = 0; k < 4; ++k) { chk(F, cf[k], af[k], 0.05f, 0.03f, 10); chk(F, cb[k], ab[k], 0.05f, 0.03f, 10); } }
#endif
    *(f32x4*)dst = af; *(f32x4*)(dst + (size_t)32 * NCHK * 2048) = ab;
    __syncthreads();
}
__device__ __forceinline__ void p_scan(Frame& F, int layer) {
    for (int gid = blockIdx.x * NTHR + opq((int)threadIdx.x); gid < 2 * 32 * 2048; gid += F.G * NTHR) {
        const int dir = gid >> 16, bh = (gid >> 11) & 31, e = gid & 2047; const float lg = (dir ? F.lgb : F.lgf)[layer * 4 + (bh & 3)]; const float G = __expf(lg * 128.0f);
        float* base = WSP(float, WS_KVS) + ((size_t)(dir * 32 + bh) * NCHK) * 2048 + e;
        float kv[NCHK];
#pragma unroll
        for (int c = 0; c < NCHK; ++c) kv[c] = base[(size_t)c * 2048];
#if ((REP_MASK) >> 16) & 1
        { float* dm = WSP(float, WS_ACT) + ((size_t)(dir * 32 + bh) * NCHK) * 2048 + e; float S = 0.f;
          if (dir == 0) {
#pragma unroll
            for (int c = 0; c < NCHK; ++c) { dm[(size_t)c * 2048] = S; S = G * S + kv[c]; }
          } else { dm[2048] = S; S = G * S + kv[1]; dm[0] = S; S = G * S + kv[0];
#pragma unroll
            for (int c = NCHK - 1; c >= 2; --c) { dm[(size_t)c * 2048] = S; S = G * S + kv[c]; } }
          asm volatile("s_waitcnt vmcnt(0)" ::: "memory");
#pragma unroll
          for (int c = 0; c < NCHK; ++c) kv[c] = base[(size_t)c * 2048]; }
#endif
        float S = 0.f;
        if (dir == 0) {
#pragma unroll
            for (int c = 0; c < NCHK; ++c) { base[(size_t)c * 2048] = S; S = G * S + kv[c]; }
        } else {
            base[2048] = S; S = G * S + kv[1]; base[0] = S; S = G * S + kv[0];
#pragma unroll
            for (int c = NCHK - 1; c >= 2; --c) { base[(size_t)c * 2048] = S; S = G * S + kv[c]; }
        }
    }
}
__device__ __forceinline__ void ret_naive_unit(Frame& F, int layer, int b, int h, int cid) {
    const int tid = opq((int)threadIdx.x); const bf16* P = WSP(bf16, WS_PROJ); const int row0 = chunk_row0(b, cid);
    LAS float* kf = (LAS float*)F.lds;
    LAS float* qf = kf + 128 * 33;
    LAS float* vf = qf + 128 * 33;
    LAS float* Am = vf + 128 * 64;
    LAS float* Sf = Am + 128 * 129;
    LAS float* red = Sf + 2 * 2048;
    const float lgf = F.lgf[layer * 4 + h], lgb = F.lgb[layer * 4 + h];
    __syncthreads();
    { const int r = tid >> 2, ch = tid & 3; const v4u w = *(const v4u*)(P + (size_t)(row0 + r) * INW + C_RK + h * 32 + ch * 8); LAS float* d = kf + r * 33 + ch * 8;
      d[0] = bflo(w.x); d[1] = bfhi(w.x); d[2] = bflo(w.y); d[3] = bfhi(w.y); d[4] = bflo(w.z); d[5] = bfhi(w.z); d[6] = bflo(w.w); d[7] = bfhi(w.w); }
    { const int r = tid >> 2, ch = tid & 3; const v4u w = *(const v4u*)(P + (size_t)(row0 + r) * INW + C_RQ + h * 32 + ch * 8); LAS float* d = qf + r * 33 + ch * 8;
      d[0] = bflo(w.x); d[1] = bfhi(w.x); d[2] = bflo(w.y); d[3] = bfhi(w.y); d[4] = bflo(w.z); d[5] = bfhi(w.z); d[6] = bflo(w.w); d[7] = bfhi(w.w); }
    for (int idx = tid; idx < 1024; idx += NTHR) { const int r = idx >> 3, ch = idx & 7; const v4u w = *(const v4u*)(P + (size_t)(row0 + r) * INW + C_RV + h * 64 + ch * 8); LAS float* d = vf + r * 64 + ch * 8;
      d[0] = bflo(w.x); d[1] = bfhi(w.x); d[2] = bflo(w.y); d[3] = bfhi(w.y); d[4] = bflo(w.z); d[5] = bfhi(w.z); d[6] = bflo(w.w); d[7] = bfhi(w.w); }
    { const float* sp = WSP(float, WS_KVS) + ((size_t)(b * 4 + h) * NCHK + cid) * 2048;
      for (int idx = tid; idx < 2048; idx += NTHR) { Sf[idx] = sp[idx]; Sf[2048 + idx] = sp[(size_t)32 * NCHK * 2048 + idx]; } }
    const int n = tid & 127, qt = tid >> 7;
    __syncthreads();
#pragma unroll 1
    for (int mm = 0; mm < 32; ++mm) { const int m = qt * 32 + mm; float s = 0.f;
#pragma unroll 8
        for (int d = 0; d < 32; ++d) s += qf[n * 33 + d] * kf[m * 33 + d];
        const float w = m < n ? __expf(lgf * (float)(n - m)) : (m > n ? __expf(lgb * (float)(m - n)) : 2.0f);
        Am[n * 129 + m] = s * w; }
    __syncthreads();
    float o[16];
#pragma unroll
    for (int i = 0; i < 16; ++i) o[i] = 0.f;
#pragma unroll 2
    for (int m = 0; m < 128; ++m) { const float a = Am[n * 129 + m];
#pragma unroll
        for (int i = 0; i < 4; ++i) { const f32x4 vv = *(const LAS f32x4*)(vf + m * 64 + qt * 16 + 4 * i); o[4 * i] += a * vv[0]; o[4 * i + 1] += a * vv[1]; o[4 * i + 2] += a * vv[2]; o[4 * i + 3] += a * vv[3]; } }
    const float cf = __expf(lgf * (float)(n + 1)), cb = __expf(lgb * (float)(128 - n));
#pragma unroll 2
    for (int d = 0; d < 32; ++d) { const float qv = qf[n * 33 + d]; const float q1 = qv * cf, q2 = qv * cb;
#pragma unroll
        for (int i = 0; i < 4; ++i) { const f32x4 sf = *(const LAS f32x4*)(Sf + d * 64 + qt * 16 + 4 * i), sb = *(const LAS f32x4*)(Sf + 2048 + d * 64 + qt * 16 + 4 * i);
            o[4 * i] += q1 * sf[0] + q2 * sb[0]; o[4 * i + 1] += q1 * sf[1] + q2 * sb[1]; o[4 * i + 2] += q1 * sf[2] + q2 * sb[2]; o[4 * i + 3] += q1 * sf[3] + q2 * sb[3]; } }
    float s = 0.f;
#pragma unroll
    for (int i = 0; i < 16; ++i) s += o[i];
    red[n * 4 + qt] = s;
    __syncthreads();
    const float mean = (red[n * 4] + red[n * 4 + 1] + red[n * 4 + 2] + red[n * 4 + 3]) * (1.0f / 64.0f);
    __syncthreads();
    float qd = 0.f;
#pragma unroll
    for (int i = 0; i < 16; ++i) { o[i] -= mean; qd += o[i] * o[i]; }
    red[n * 4 + qt] = qd;
    __syncthreads();
    const float rstd = 1.0f / sqrtf((red[n * 4] + red[n * 4 + 1] + red[n * 4 + 2] + red[n * 4 + 3]) * (1.0f / 64.0f) + LN_EPS);
    const bf16* rgp = P + (size_t)(row0 + n) * INW + C_RG + h * 64 + qt * 16; bf16* dst = WSP(bf16, WS_MIX) + (size_t)(row0 + n) * D + 768 + h * 64 + qt * 16;
#pragma unroll
    for (int i = 0; i < 2; ++i) { const v4u w = *(const v4u*)(rgp + 8 * i); const float r8[8] = {bflo(w.x), bfhi(w.x), bflo(w.y), bfhi(w.y), bflo(w.z), bfhi(w.z), bflo(w.w), bfhi(w.w)}; float y8[8];
#pragma unroll
        for (int k = 0; k < 8; ++k) y8[k] = r8[k] / (1.0f + __expf(-r8[k])) * (o[8 * i + k] * rstd);
#if defined(MIX_CHECK)
        { const v4u cw = *(const v4u*)(dst + 8 * i); const float c8[8] = {bflo(cw.x), bfhi(cw.x), bflo(cw.y), bfhi(cw.y), bflo(cw.z), bfhi(cw.z), bflo(cw.w), bfhi(cw.w)};
#pragma unroll
          for (int k = 0; k < 8; ++k) chk(F, c8[k], y8[k], 0.03f, 0.04f, 11); }
#endif
        v4u ow; ow.x = pk2(y8[0], y8[1]); ow.y = pk2(y8[2], y8[3]); ow.z = pk2(y8[4], y8[5]); ow.w = pk2(y8[6], y8[7]); *(v4u*)(dst + 8 * i) = ow; }
    __syncthreads();
}
__device__ __forceinline__ void p_mix_naive(Frame& F, int layer, const XcdBarrier& bar) {
#if defined(MIX_CHECK)
    p_mix(F, layer); xcd_barrier(bar);
#endif
#if defined(ATTN_CHECK)
    P_ATTN(F, layer); xcd_barrier(bar);
#endif
#if defined(ATTN_NAIVE) || defined(ATTN_CHECK)
    const int n_att = 512 + (layer == 0 ? 32 : 0);
    for (int u = blockIdx.x; u < n_att; u += F.G) {
        if (u < 512) attn_naive_unit(F, layer, u >> 6, (u >> 1) & 31, u & 1, false);
        else { const int v = u - 512; attn_naive_unit(F, layer, v >> 2, (v >> 1) & 1, v & 1, true); }
    }
#elif !defined(MIX_CHECK)
    P_ATTN(F, layer);
#endif
    const int n_pool = 256 + (layer == 0 ? 16 : 0);
    for (int u = blockIdx.x; u < n_pool; u += F.G) { if (u < 256) pool_naive_unit(F, layer, u >> 5, u & 31); else pool_naive_unit(F, layer, 8 + ((u - 256) >> 1), (u - 256) & 1); }
    for (int u = blockIdx.x; u < 32 * NCHK; u += F.G) kv_naive_unit(F, layer, u / (4 * NCHK), (u / NCHK) & 3, u % NCHK);
}
__device__ __forceinline__ void p_ret_naive(Frame& F, int layer, const XcdBarrier& bar) {
#if defined(MIX_CHECK)
    p_ret(F, layer); xcd_barrier(bar);
#endif
    for (int u = blockIdx.x; u < 32 * NCHK; u += F.G) { const int cid = u % NCHK; if (layer == 1 && cid < 2) continue; ret_naive_unit(F, layer, u / (4 * NCHK), (u / NCHK) & 3, cid); }
}
#ifndef MK_N_LAUNCHES
#define MK_N_LAUNCHES 1
#endif
constexpr int NPHASE = 20;
struct Args { const float* in[24]; float* out; unsigned char* ws; int ph_lo, ph_hi; };

__device__ __forceinline__ int moe_tiles(Frame& F, volatile LAS unsigned* MISC) {
    __syncthreads();
    if (threadIdx.x == 0) { int acc = 0;
        for (int e = 0; e < NE; ++e) { const int c = (int)__hip_atomic_load(WSP(unsigned, WS_CTL) + CW_GCNT + 64 * e, RLX_AGENT); MISC[16 + NE + 1 + e] = (unsigned)c; MISC[16 + e] = (unsigned)acc; acc += (c + 255) >> 8; }
        MISC[16 + NE] = (unsigned)acc; }
    __syncthreads();
    return __builtin_amdgcn_readfirstlane((int)MISC[16 + NE]);
}

#ifndef TIME_MASK
#define TIME_MASK 0
#endif
#define TIC(k) unsigned long long tic_ = 0; if (((TIME_MASK) >> (k)) & 1) tic_ = wall_clock64();
#define TOC(k) if (((TIME_MASK) >> (k)) & 1) { __syncthreads(); const unsigned long long t1_ = wall_clock64(); while (wall_clock64() - t1_ < t1_ - tic_) __builtin_amdgcn_s_sleep(8); }
#define IN(k) (lo <= (k) && (k) < hi)
#define SEAM(k) do { if (IN(k) && IN((k) + 1)) { xcd_barrier(bar); REPEAT(13) xcd_barrier(bar); } } while (0)
template <int layer> __device__ __forceinline__ void layer_front(Frame& F, const XcdBarrier& bar, const int lo, const int hi) {
        const int pb = 2 + 9 * layer;
        if (IN(pb)) { TIC(pb)
#if INQ
            pg8::StaticOrder S; S.init(WSP(unsigned char, WS_T8L0), WSP(unsigned char, WS_WIN) + (size_t)layer * INW * D, MT, INW, D, F.G, (int)blockIdx.x); S.rev = (REV_MASK & 4) != 0;
            { LAS f32x4* rl_ = (LAS f32x4*)(F.lds + ROPE_LDS); rl_[threadIdx.x] = WSP(f32x4, WS_ROPE)[threadIdx.x]; __syncthreads(); }
            pg8::EpiInProj<true> E{WSP(bf16, WS_PROJ), (const LAS float*)(F.lds + ROPE_LDS), WSP(float, WS_SH), (const float*)(WSP(unsigned, WS_CTL) + CW_CMAX + CM_WIN + layer * INW)};
            REPEAT(2) pg8::gemm_phase<2>(F.lds, D, S, E);
            if constexpr (layer == 0 && CONV_SPREAD != 0) { if (F.G == 256) { __syncthreads(); bg_convert(F, 184, 72, 0, CV_A); __syncthreads(); } }
#else
            pg8::StaticOrder S; S.init(WSP(bf16, WS_ACT), WSP(bf16, WS_WIN) + (size_t)layer * INW * D, MT, INW, 2 * D, F.G, (int)blockIdx.x);
            { LAS f32x4* rl_ = (LAS f32x4*)(F.lds + ROPE_LDS); rl_[threadIdx.x] = WSP(f32x4, WS_ROPE)[threadIdx.x]; __syncthreads(); }
            pg8::EpiInProj<false> E{WSP(bf16, WS_PROJ), (const LAS float*)(F.lds + ROPE_LDS), nullptr, nullptr};
            pg8::gemm_phase<0>(F.lds, 2 * D, S, E);
#endif
        TOC(pb) } SEAM(pb);
#if defined(MIX_NAIVE) || defined(MIX_CHECK) || defined(ATTN_CHECK) || defined(ATTN_NAIVE)
        if (IN(pb + 1)) { TIC(pb + 1) p_mix_naive(F, layer, bar); TOC(pb + 1) } SEAM(pb + 1);
#else
        if (IN(pb + 1)) { TIC(pb + 1) p_mix(F, layer); TOC(pb + 1) } SEAM(pb + 1);
#endif
        if (IN(pb + 2)) { TIC(pb + 2) p_scan(F, layer); TOC(pb + 2) } SEAM(pb + 2);
#if defined(MIX_NAIVE) || defined(MIX_CHECK) || defined(ATTN_CHECK) || defined(ATTN_NAIVE)
        if (IN(pb + 3)) { TIC(pb + 3) p_ret_naive(F, layer, bar); TOC(pb + 3) } SEAM(pb + 3);
#else
        if (IN(pb + 3)) { TIC(pb + 3) REPEAT(5) p_ret(F, layer); TOC(pb + 3) } SEAM(pb + 3);
#endif
#if FUSE_LN
        if (IN(pb + 4)) { TIC(pb + 4)
            constexpr int total = (layer == 0 ? MT : NL) / 256 * 4;
            const float* modl = WSP(float, WS_MOD) + (size_t)layer * 9 * 6144;
            pg8::PanelStats st{(unsigned*)(F.ws + WS_XB + (layer == 0 ? 0 : 2) * XB_BANK), WSP(unsigned, WS_CTL) + CW_SEAM + (layer == 0 ? 0 : 2) * SEAM_BANK, WSP(unsigned, WS_CTL) + CW_TMO, LN_EPS, 0x700u};
#pragma unroll
            for (int sl = 0; sl * 256 < total; ++sl) {
                pg8::SliceOrder S{sl * 256, total, F.vcu, 2 * D, (const char*)WSP(bf16, WS_MIX), (const char*)(WSP(bf16, WS_WOUT) + (size_t)layer * D * D)};
                if constexpr (layer == 0) {
                    pg8::EpiLN<FFN0_FP8 != 0, false> E{F.x, F.ctx, F.out, WSP(float, WS_XC), modl + 2 * 1024, modl + 3 * 1024, modl + 4 * 1024, F.ln1_g, F.ln1_b, WSP(bf16, WS_ACT), WSP(unsigned char, WS_T8), nullptr, nullptr, st};
                    pg8::gemm_phase<0>(F.lds, 2 * D, S, E);
                } else {
                    pg8::EpiLN<true, true> E{F.out, F.out, F.out, F.out, modl + 2 * 1024, modl + 3 * 1024, modl + 4 * 1024, F.ln1_g + D, F.ln1_b + D, nullptr, WSP(unsigned char, WS_T8), WSP(float, WS_PLOG), F.router, st};
                    pg8::gemm_phase<0>(F.lds, 2 * D, S, E);
                }
                __syncthreads();
            }
        TOC(pb + 4) } SEAM(pb + 4);
        if constexpr (layer == 1) { if (IN(pb + 5)) { TIC(pb + 5) p_route(F); TOC(pb + 5) } SEAM(pb + 5); }
#else
        if (IN(pb + 4)) { TIC(pb + 4)
#if RESADD
            pg8::EpiRes<layer == 0> E{F.ws, 1.0f, WS_ACT, WS_X16, WS_MOD + ((size_t)layer * 9 * 6144 + 2 * 1024) * 4};
#else
            pg8::EpiBf16 E{WSP(bf16, WS_ACT), D, 1.0f};
#endif
            if constexpr (layer == 0 && OUT_SK != 0) {
                pg8::StaticOrderT<true> S; S.init(WSP(bf16, WS_MIX), WSP(bf16, WS_WOUT), MT, D, 2 * D, F.G, (int)blockIdx.x);
                S.sk.init((MT / 256) * (D / 256), 2 * D / 128, F.G, (int)blockIdx.x, F.out, WSP(unsigned, WS_CTL) + CW_SK, (unsigned)(pb + 4 + 1));
                pg8::gemm_phase<0>(F.lds, 2 * D, S, E);
            } else {
                pg8::StaticOrder S; S.init(WSP(bf16, WS_MIX), WSP(bf16, WS_WOUT) + (size_t)layer * D * D, layer == 0 ? MT : NL, D, 2 * D, F.G, (int)blockIdx.x, (TAILQ & 1) != 0); S.rev = (REV_MASK & 16) != 0;
                REPEAT(6) { pg8::gemm_phase<0>(F.lds, 2 * D, S, E); if (TAILQ & 1) pg8::gemm_tail<0>(F.lds, 2 * D, S, E); }
                if constexpr (layer == 0 && CONV_SPREAD != 0 && (TAILQ & 1) != 0) { if (F.G == 256) { __syncthreads(); bg_convert(F, 128, 128, CV_B, CV_C); __syncthreads(); } }
            }
        TOC(pb + 4) } SEAM(pb + 4);
        if (IN(pb + 5)) { TIC(pb + 5) p_ln1(F, layer); TOC(pb + 5) } SEAM(pb + 5);
#endif
        if constexpr (layer == 0) {
#if FFN0_FP8
        if (IN(8)) { TIC(8)
            pg8::StaticOrder S; S.init(WSP(unsigned char, WS_T8), WSP(unsigned char, WS_FGU), MT, 2 * FF, D, F.G, (int)blockIdx.x);
            pg8::EpiSwiGLU8 E{WSP(unsigned char, WS_HID), FF, 1.0f / 128.0f, 4.0f};
            pg8::gemm_phase<1>(F.lds, D, S, E);
        TOC(8) } SEAM(8);
        if (IN(9)) { TIC(9)
            pg8::StaticOrder S; S.init(WSP(unsigned char, WS_HID), WSP(unsigned char, WS_FD), MT, D, FF, F.G, (int)blockIdx.x);
            pg8::EpiBf16 E{WSP(bf16, WS_ACT), D, 1.0f / 512.0f};
            pg8::gemm_phase<1>(F.lds, FF, S, E);
        TOC(9) } SEAM(9);
#else
        if (IN(8)) { TIC(8)
            pg8::StaticOrder S; S.init(WSP(unsigned char, WS_T8L0), WSP(unsigned char, WS_FGU), MT, 2 * FF, D, F.G, (int)blockIdx.x);
#if HID_FP8
            pg8::EpiSwiGLUq<true, false> E{WSP(unsigned char, WS_HID), FF, WSP(float, WS_ST), (const float*)(WSP(unsigned, WS_CTL) + CW_CMAX), nullptr, 4.0f};
#else
            pg8::EpiSwiGLUq<false, false> E{WSP(bf16, WS_HID), FF, WSP(float, WS_ST), (const float*)(WSP(unsigned, WS_CTL) + CW_CMAX), nullptr, 1.0f};
#endif
            REPEAT(8) pg8::gemm_phase<2>(F.lds, D, S, E);
            if constexpr (CONV_SPREAD != 0) { if (F.G == 256) { __syncthreads(); bg_convert(F, 176, 80, CV_C, CV_E); __syncthreads(); } }
        TOC(8) } SEAM(8);
#if FUSE_LN
        if (IN(9)) { TIC(9)
            const float* mod0 = WSP(float, WS_MOD), *mod1 = WSP(float, WS_MOD) + (size_t)9 * 6144;
            pg8::PanelStats st{(unsigned*)(F.ws + WS_XB + XB_BANK), WSP(unsigned, WS_CTL) + CW_SEAM + SEAM_BANK, WSP(unsigned, WS_CTL) + CW_TMO, LN_EPS, 0x740u};
#pragma unroll
            for (int sl = 0; sl < 3; ++sl) {
                pg8::SliceOrder S{sl * 256, MT / 256 * 4, F.vcu, 2 * FF, (const char*)WSP(bf16, WS_HID), (const char*)WSP(bf16, WS_FD)};
                pg8::EpiLN<false, false> E{F.out, WSP(float, WS_XC), F.out, WSP(float, WS_XC), mod0 + 5 * 1024, mod1 + 0 * 1024, mod1 + 1 * 1024, F.ln2_g, F.ln2_b, WSP(bf16, WS_ACT), nullptr, nullptr, nullptr, st};
                pg8::gemm_phase<0>(F.lds, 2 * FF, S, E);
                __syncthreads();
            }
        TOC(9) } SEAM(9);
#else
        if (IN(9)) { TIC(9)
#if FFD_SK
            pg8::StaticOrderT<true> S; S.init(WSP(bf16, WS_HID), WSP(bf16, WS_FD), MT, D, 2 * FF, F.G, (int)blockIdx.x);
            S.sk.init((MT / 256) * (D / 256), 2 * FF / 128, F.G, (int)blockIdx.x, F.out, WSP(unsigned, WS_CTL) + CW_SK, 10u);
            pg8::EpiBf16 E{WSP(bf16, WS_ACT), D, 1.0f};
            pg8::gemm_phase<0>(F.lds, 2 * FF, S, E);
#if BGCONV
            __syncthreads(); bg_convert(F, 0, F.G); __syncthreads();
#endif
#else
#if HID_FP8
            pg8::StaticOrder S; S.init(WSP(unsigned char, WS_HID), WSP(unsigned char, WS_FD), MT, D, FF, F.G, (int)blockIdx.x, (TAILQ & 2) != 0); S.rev = (REV_MASK & 1) != 0;
#if RESADD
            pg8::EpiRes<false> E{F.ws, 1.0f / 512.0f, WS_ACT, WS_X16, WS_MOD + (size_t)5 * 1024 * 4};
#else
            pg8::EpiBf16 E{WSP(bf16, WS_ACT), D, 1.0f / 512.0f};
#endif
            REPEAT(9) { pg8::gemm_phase<1>(F.lds, FF, S, E); if (TAILQ & 2) pg8::gemm_tail<1>(F.lds, FF, S, E); }
#else
            pg8::StaticOrder S; S.init(WSP(bf16, WS_HID), WSP(bf16, WS_FD), MT, D, 2 * FF, F.G, (int)blockIdx.x, (TAILQ & 2) != 0); S.rev = (REV_MASK & 1) != 0;
            pg8::EpiBf16 E{WSP(bf16, WS_ACT), D, 1.0f};
            REPEAT(9) { pg8::gemm_phase<0>(F.lds, 2 * FF, S, E); if (TAILQ & 2) pg8::gemm_tail<0>(F.lds, 2 * FF, S, E); }
#endif
#if BGCONV
            __syncthreads(); REPEAT(10) { const int cv0 = (CONV_SPREAD != 0 && (TAILQ & 1) != 0 && F.G == 256) ? CV_E : 0; if (F.G == 256 && !(TAILQ & 2)) bg_convert(F, 32, 224, cv0); else if (F.G == 256) bg_convert(F, -1, 256, cv0); else bg_convert(F, 0, F.G); __syncthreads(); }
#endif
#endif
        TOC(9) } SEAM(9);
#endif
#endif
#if !FUSE_LN
        if (IN(10)) { TIC(10) p_ln2_l0(F); TOC(10) } SEAM(10);
#endif
        }
}

__global__ void __launch_bounds__(NTHR, 2) hybrid_fwd(Args args) {
    extern __shared__ __attribute__((aligned(16))) unsigned char lds_raw[];
    Frame F;
    F.lds = (LAS unsigned char*)lds_raw;
    F.wave = __builtin_amdgcn_readfirstlane((int)threadIdx.x >> 6);
    F.G = gridDim.x; { const int bx = blockIdx.x; F.vcu = (F.G % 8 == 0) ? (bx % 8) * (F.G / 8) + bx / 8 : bx; }
    F.ws = args.ws; F.out = args.out;
    F.x = args.in[0]; F.c = args.in[1]; F.ctx = args.in[2]; F.c_ctx = args.in[3]; F.w_mod = args.in[4]; F.b_mod = args.in[5]; F.w_in = args.in[6]; F.sink = args.in[7];
    F.pool_w = args.in[8]; F.pool_scale = args.in[9]; F.lgf = args.in[10]; F.lgb = args.in[11]; F.w_out = args.in[12]; F.ln1_g = args.in[13]; F.ln1_b = args.in[14]; F.ln2_g = args.in[15]; F.ln2_b = args.in[16];
    F.fw_gate = args.in[17]; F.fw_up = args.in[18]; F.fw_down = args.in[19]; F.router = args.in[20]; F.mw_gate = args.in[21]; F.mw_up = args.in[22]; F.mw_down = args.in[23];
    volatile LAS unsigned* MISC = (volatile LAS unsigned*)(F.lds + MISC_OFF);
    if (threadIdx.x < 64) MISC[threadIdx.x] = 0u;
    __syncthreads();
    const int lo = args.ph_lo, hi = args.ph_hi;
    XcdBarrier bar; bar.bar = WSP(unsigned, WS_CTL) + CW_BAR; bar.x = 0; bar.st = nullptr;
    if (hi - lo > 1) bar = xcd_barrier_post(WSP(unsigned, WS_CTL) + CW_BAR, MISC + 8);

    if (IN(0)) { TIC(0) REPEAT(0) p_prep(F); TOC(0) } SEAM(0);
    if (IN(1)) { TIC(1) REPEAT(1) { p_h0(F); __syncthreads(); } REPEAT(11) { quant_dense_gu(F); REPSYNC(11) } TOC(1) } SEAM(1);
    layer_front<0>(F, bar, lo, hi);
    layer_front<1>(F, bar, lo, hi);
    if (IN(17)) { TIC(17)
        pg8::MoeOrder<true> S; S.nrt = moe_tiles(F, MISC); S.tbl = (const LAS int*)(MISC + 16);
        S.T0 = 0; S.nN = 2 * FF / 256; S.G = F.G; S.c = (int)blockIdx.x; S.KB = D;
        S.A = (const char*)WSP(unsigned char, WS_T8); S.Bt = (const char*)WSP(unsigned char, WS_MGU8); S.bstride = (size_t)2 * FF * D; S.list = WSP(int, WS_LIST);
#if MOEQ
        pg8::EpiSwiGLUq<true, true> E{WSP(unsigned char, WS_HID8), FF, WSP(float, WS_ST), (const float*)(WSP(unsigned, WS_CTL) + CW_CMAX) + 2 * FF, WSP(int, WS_LIST), 4.0f};
        pg8::gemm_phase<2>(F.lds, D, S, E);
#else
        pg8::EpiSwiGLU8 E{WSP(unsigned char, WS_HID8), FF, 1.0f / 128.0f, 4.0f};
#if ((REP_MASK) >> 13) & 2
        S.i0 = 0; S.i1 = 12; pg8::gemm_phase<1>(F.lds, D, S, E); xcd_barrier(bar); S.i0 = 12; S.i1 = 1 << 30; pg8::gemm_phase<1>(F.lds, D, S, E);
#else
        REPEAT(17) pg8::gemm_phase<1>(F.lds, D, S, E);
#endif
#endif
    TOC(17) } SEAM(17);
    if (IN(18)) { TIC(18)
        pg8::MoeOrder<false, MOE_SK != 0> S; S.nrt = moe_tiles(F, MISC); S.tbl = (const LAS int*)(MISC + 16);
        S.T0 = 0; S.nN = D / 256; S.G = F.G; S.c = (int)blockIdx.x; S.KB = FF;
        S.rev = (REV_MASK & 2) != 0;
        if constexpr (MOE_SK != 0) S.sk.init(S.nrt * (D / 256), FF / 128, F.G, (int)blockIdx.x, F.out, WSP(unsigned, WS_CTL) + CW_SK, 19u);
        S.A = (const char*)WSP(unsigned char, WS_HID8); S.Bt = (const char*)WSP(unsigned char, WS_MD8); S.bstride = (size_t)FF * D; S.list = WSP(int, WS_LIST);
        pg8::EpiMoeDown E{WSP(bf16, WS_Y), WSP(int, WS_LIST), WSP(float, WS_LGATE), 1.0f / 512.0f};
        S.tail.init(S.nrt * S.nN, F.G, (int)blockIdx.x, (TAILQ & 4) != 0);
        REPEAT(18) { pg8::gemm_phase<1>(F.lds, FF, S, E); if (TAILQ & 4) pg8::gemm_tail<1>(F.lds, FF, S, E); }
    TOC(18) } SEAM(18);
    if (IN(19)) { TIC(19) REPEAT(19) p_final(F); TOC(19) }
#undef IN
#undef SEAM
}

extern "C" void kernel_launch(void* const* d_in, const int* in_sizes, int n_in, void* d_out, int out_size, void* d_ws, size_t ws_size, hipStream_t stream) {
    static int grid = 0;
    if (grid == 0) {
        if (n_in != 24 || out_size != NL * D || ws_size < WS_END) { fprintf(stderr, "kernel_launch: unexpected shapes (n_in %d, out %d, ws %zu < %zu); nothing launched\n", n_in, out_size, ws_size, (size_t)WS_END); grid = -1; return; }
        int dev = 0, cus = 0, per_cu = 0;
        if (hipGetDevice(&dev) != hipSuccess || hipDeviceGetAttribute(&cus, hipDeviceAttributeMultiprocessorCount, dev) != hipSuccess) { grid = -1; return; }
        if (hipFuncSetAttribute((const void*)hybrid_fwd, hipFuncAttributeMaxDynamicSharedMemorySize, LDS_BYTES) != hipSuccess) { fprintf(stderr, "kernel_launch: hipFuncSetAttribute failed\n"); grid = -1; return; }
        if (hipOccupancyMaxActiveBlocksPerMultiprocessor(&per_cu, (const void*)hybrid_fwd, NTHR, LDS_BYTES) != hipSuccess || per_cu < 1) { fprintf(stderr, "kernel_launch: occupancy query says %d\n", per_cu); }
        (void)hipGetLastError();
        grid = cus;
    }
    if (grid < 0) return;
    if (hipMemsetAsync((char*)d_ws + WS_CTL, 0, CTL_ZERO_BYTES, stream) != hipSuccess) return;
    Args a{};
    for (int i = 0; i < 24; ++i) a.in[i] = (const float*)d_in[i];
    a.out = (float*)d_out; a.ws = (unsigned char*)d_ws;
#if MK_N_LAUNCHES == 1
    a.ph_lo = 0; a.ph_hi = NPHASE;
    hipLaunchKernelGGL(hybrid_fwd, dim3(grid), dim3(NTHR), LDS_BYTES, stream, a);
#else
    for (int p = 0; p < NPHASE; ++p) { a.ph_lo = p; a.ph_hi = p + 1; hipLaunchKernelGGL(hybrid_fwd, dim3(grid), dim3(NTHR), LDS_BYTES, stream, a); }
#endif
}
```

```cpp
#include <hip/hip_runtime.h>
#include <cstdio>
#include <cstdint>
#define MK_N_LAUNCHES 1
#ifndef INQ
#define INQ 1
#endif
#ifndef MOEQ
#define MOEQ 0
#endif
#ifndef BGCONV
#define BGCONV 1
#endif
#ifndef RES16
#define RES16 1
#endif
#ifndef FUSE_LN
#define FUSE_LN 0
#endif
#ifndef MOE_SK
#define MOE_SK 0
#endif
#ifndef FFD_SK
#define FFD_SK 0
#endif
#ifndef OUT_SK
#define OUT_SK 0
#endif
#ifndef REV_MASK
#define REV_MASK 15
#endif
#ifndef ATTN_LATE
#define ATTN_LATE 0
#endif
#ifndef TAILQ
#define TAILQ 7
#endif
#ifndef CONV_SPREAD
#define CONV_SPREAD 0
#endif
#ifndef HID_FP8
#define HID_FP8 1
#endif
#ifndef RESADD
#define RESADD 0
#endif
#ifndef WGM_SET
#define WGM_SET 4
#endif
#ifndef FFN0_FP8
#define FFN0_FP8 0
#endif
#ifndef REP_MASK
#define REP_MASK 0
#endif
#if ((REP_MASK) >> 0) & 1
#define REPEAT_0 _Pragma("unroll 1") for (int rep_ = 0; rep_ < 2; ++rep_)
#define REPSYNC_0 __syncthreads();
#else
#define REPEAT_0
#define REPSYNC_0
#endif
#if ((REP_MASK) >> 1) & 1
#define REPEAT_1 _Pragma("unroll 1") for (int rep_ = 0; rep_ < 2; ++rep_)
#define REPSYNC_1 __syncthreads();
#else
#define REPEAT_1
#define REPSYNC_1
#endif
#if ((REP_MASK) >> 2) & 1
#define REPEAT_2 _Pragma("unroll 1") for (int rep_ = 0; rep_ < 2; ++rep_)
#define REPSYNC_2 __syncthreads();
#else
#define REPEAT_2
#define REPSYNC_2
#endif
#if ((REP_MASK) >> 3) & 1
#define REPEAT_3 _Pragma("unroll 1") for (int rep_ = 0; rep_ < 2; ++rep_)
#define REPSYNC_3 __syncthreads();
#else
#define REPEAT_3
#define REPSYNC_3
#endif
#if ((REP_MASK) >> 4) & 1
#define REPEAT_4 _Pragma("unroll 1") for (int rep_ = 0; rep_ < 2; ++rep_)
#define REPSYNC_4 __syncthreads();
#else
#define REPEAT_4
#define REPSYNC_4
#endif
#if ((REP_MASK) >> 5) & 1
#define REPEAT_5 _Pragma("unroll 1") for (int rep_ = 0; rep_ < 2; ++rep_)
#define REPSYNC_5 __syncthreads();
#else
#define REPEAT_5
#define REPSYNC_5
#endif
#if ((REP_MASK) >> 6) & 1
#define REPEAT_6 _Pragma("unroll 1") for (int rep_ = 0; rep_ < 2; ++rep_)
#define REPSYNC_6 __syncthreads();
#else
#define REPEAT_6
#define REPSYNC_6
#endif
#if ((REP_MASK) >> 7) & 1
#define REPEAT_7 _Pragma("unroll 1") for (int rep_ = 0; rep_ < 2; ++rep_)
#define REPSYNC_7 __syncthreads();
#else
#define REPEAT_7
#define REPSYNC_7
#endif
#if ((REP_MASK) >> 8) & 1
#define REPEAT_8 _Pragma("unroll 1") for (int rep_ = 0; rep_ < 2; ++rep_)
#define REPSYNC_8 __syncthreads();
#else
#define REPEAT_8
#define REPSYNC_8
#endif
#if ((REP_MASK) >> 9) & 1
#define REPEAT_9 _Pragma("unroll 1") for (int rep_ = 0; rep_ < 2; ++rep_)
#define REPSYNC_9 __syncthreads();
#else
#define REPEAT_9
#define REPSYNC_9
#endif
#if ((REP_MASK) >> 10) & 1
#define REPEAT_10 _Pragma("unroll 1") for (int rep_ = 0; rep_ < 2; ++rep_)
#define REPSYNC_10 __syncthreads();
#else
#define REPEAT_10
#define REPSYNC_10
#endif
#if ((REP_MASK) >> 11) & 1
#define REPEAT_11 _Pragma("unroll 1") for (int rep_ = 0; rep_ < 2; ++rep_)
#define REPSYNC_11 __syncthreads();
#else
#define REPEAT_11
#define REPSYNC_11
#endif
#if ((REP_MASK) >> 12) & 1
#define REPEAT_12 _Pragma("unroll 1") for (int rep_ = 0; rep_ < 2; ++rep_)
#define REPSYNC_12 __syncthreads();
#else
#define REPEAT_12
#define REPSYNC_12
#endif
#if ((REP_MASK) >> 13) & 1
#define REPEAT_13 _Pragma("unroll 1") for (int rep_ = 0; rep_ < 2; ++rep_)
#define REPSYNC_13 __syncthreads();
#else
#define REPEAT_13 if (false)
#define REPSYNC_13
#endif
#if ((REP_MASK) >> 14) & 1
#define REPEAT_14 _Pragma("unroll 1") for (int rep_ = 0; rep_ < 2; ++rep_)
#define REPSYNC_14 __syncthreads();
#else
#define REPEAT_14
#define REPSYNC_14
#endif
#if ((REP_MASK) >> 15) & 1
#define REPEAT_15 _Pragma("unroll 1") for (int rep_ = 0; rep_ < 2; ++rep_)
#define REPSYNC_15 __syncthreads();
#else
#define REPEAT_15
#define REPSYNC_15
#endif
#if ((REP_MASK) >> 16) & 1
#define REPEAT_16 _Pragma("unroll 1") for (int rep_ = 0; rep_ < 2; ++rep_)
#define REPSYNC_16 __syncthreads();
#else
#define REPEAT_16
#define REPSYNC_16
#endif
#if ((REP_MASK) >> 17) & 1
#define REPEAT_17 _Pragma("unroll 1") for (int rep_ = 0; rep_ < 2; ++rep_)
#define REPSYNC_17 __syncthreads();
#else
#define REPEAT_17
#define REPSYNC_17
#endif
#if ((REP_MASK) >> 18) & 1
#define REPEAT_18 _Pragma("unroll 1") for (int rep_ = 0; rep_ < 2; ++rep_)
#define REPSYNC_18 __syncthreads();
#else
#define REPEAT_18
#define REPSYNC_18
#endif
#if ((REP_MASK) >> 19) & 1
#define REPEAT_19 _Pragma("unroll 1") for (int rep_ = 0; rep_ < 2; ++rep_)
#define REPSYNC_19 __syncthreads();
#else
#define REPEAT_19
#define REPSYNC_19
#endif
#define REPEAT(bit) REPEAT_##bit
#define REPSYNC(bit) REPSYNC_##bit
__device__ __forceinline__ int opq(int v) { asm volatile("" : "+v"(v)); return v; }
namespace pg8 {
#define PG8_LAS __attribute__((address_space(3)))
typedef unsigned short bf16_t;
typedef short bf16x8 __attribute__((ext_vector_type(8)));
typedef float f32x4 __attribute__((ext_vector_type(4)));
typedef float f32x2 __attribute__((ext_vector_type(2)));
typedef unsigned u32x4 __attribute__((ext_vector_type(4)));
constexpr int BM = 256, BK = 64, HALF = 128, HTB = HALF * BK * 2  , STAGE_BYTES = 8 * HTB, NXCD = 8, WGM = WGM_SET;

__host__ __device__ __forceinline__ int lds_byte(int r, int c) { const int st = (r >> 4) * 2 + (c >> 5), rr = r & 15, cc = c & 31, ob = rr * 64 + cc * 2; return st * 1024 + (ob ^ (((ob >> 9) & 1) << 5)); }
__host__ __device__ __forceinline__ void stage_rc(int b, int& R, int& C) { const int st = b / 1024, sb = b % 1024, swz = sb ^ (((sb >> 9) & 1) << 5); R = (st >> 1) * 16 + swz / 64; C = (st & 1) * 32 + (swz % 64) / 2; }
__host__ __device__ __forceinline__ int perm32(int rho) { const int n = rho >> 4, i = rho & 15; return 8 * (i >> 2) + 4 * n + (i & 3); }

struct Unit { int pm, pn, e, rt, cnt; const char* ab; const char* bb; int nt, part, slot; };

__device__ __forceinline__ void tile_from_L(int L, int nM, int nN, int& pm, int& pn) {
    const int nwg = nM * nN;
    int wgid = L; { const int q = nwg / NXCD, r = nwg % NXCD, xcd = wgid % NXCD, off = wgid / NXCD; wgid = (xcd < r ? xcd * (q + 1) : r * (q + 1) + (xcd - r) * q) + off; }
    const int nig = WGM * nN, gid = wgid / nig, fm = gid * WGM, gsz = (nM - fm) < WGM ? (nM - fm) : WGM;
    pm = fm + ((wgid % nig) % gsz); pn = (wgid % nig) / gsz;
}
__device__ __forceinline__ bool tile_order(int i, int G, int c, int nM, int nN, int& pm, int& pn, bool rev = false) {
    const int nwg = nM * nN; const long L = (long)i * G + c; if (L >= nwg) return false;
    int wgid = (int)L; { const int q = nwg / NXCD, r = nwg % NXCD, xcd = wgid % NXCD; int off = wgid / NXCD; if (rev) off = q + (xcd < r ? 1 : 0) - 1 - off;
        wgid = (xcd < r ? xcd * (q + 1) : r * (q + 1) + (xcd - r) * q) + off; }
    const int nig = WGM * nN, gid = wgid / nig, fm = gid * WGM, gsz = (nM - fm) < WGM ? (nM - fm) : WGM;
    pm = fm + ((wgid % nig) % gsz); pn = (wgid % nig) / gsz; return true;
}
struct StreamK {
    int on, x, W, F, P, a, b, c; float* slots; unsigned* flags; unsigned tag;
    __device__ __forceinline__ void init(int n, int ntile, int G, int c_, float* slots_, unsigned* flags_, unsigned tag_) {
        c = c_; slots = slots_; flags = flags_; tag = tag_; on = 0; P = ntile >> 1; x = c_ & 7; W = G >> 3; F = 0; a = 0; b = 0;
        if ((G & 7) == 0 && (ntile & 1) == 0) { const int k = c_ >> 3, nx = (n - x + 7) >> 3;
            if (nx >= W) { on = 1; F = nx / W - 1; const int T = (nx - F * W) * P; a = (k * T) / W; b = ((k + 1) * T) / W; } }
    }
    __device__ __forceinline__ bool next(int i, int n, int G, int& L, int& p0, int& np, int& part) const {
        if (!on || i < F) { L = i * G + c; p0 = 0; np = P; part = 0; return L < n; }
        const int q = a / P + (i - F); const int s = a > q * P ? a : q * P, e = b < (q + 1) * P ? b : (q + 1) * P;
        if (s >= e) return false;
        L = (F * W + q) * 8 + x; p0 = s - q * P; np = e - s; part = p0 > 0 ? 1 : (np < P ? 2 : 0); return true;
    }
};
struct TailPlan { int F = 1 << 30, rem = 0, x = 0, W = 1;
    __device__ __forceinline__ void init(int n, int G, int c, bool enable) { F = 1 << 30; rem = 0; x = c & 7; W = G >> 3;
        if (enable && (G & 7) == 0 && W > 0) { const int nx = (n - x + 7) >> 3, f = nx / W, r = nx - f * W; if (r > 0 && r <= 8 && f > 0) { F = f; rem = r; } } }
    __device__ __forceinline__ bool quarter(int j, int c, int& cq, int& ai, int& bj) const { const int v = (c >> 3) + W * j, q = v >> 2; if (q >= rem) return false; cq = q * 8 + x; ai = (v >> 1) & 1; bj = v & 1; return true; }
};
template <bool SK_> struct StaticOrderT {
    static constexpr bool GATHER = false, SK = SK_;
    int nM, nN, G, c, KB; const char* A; const char* Bt;
    bool rev = false;
    StreamK sk; TailPlan tail;
    __device__ __forceinline__ void init(const void* A_, const void* Bt_, int M, int N, int KB_, int G_, int c_, bool tail_ = false) { A = (const char*)A_; Bt = (const char*)Bt_; nM = M / BM; nN = N / BM; KB = KB_; G = G_; c = c_; tail.init(nM * nN, G_, c_, tail_); }
    __device__ __forceinline__ bool tail_next(int j, Unit& u, int& ai, int& bj) const {
        int cq, pm, pn; if (!tail.quarter(j, c, cq, ai, bj) || !tile_order(tail.F, G, cq, nM, nN, pm, pn, rev)) return false;
        u.pm = pm; u.pn = pn; u.e = 0; u.rt = pm; u.cnt = 1 << 30; u.ab = A + (size_t)pm * BM * KB; u.bb = Bt + (size_t)pn * BM * KB; return true;
    }
    __device__ __forceinline__ bool next(int i, Unit& u) const {
        int pm, pn; if (i >= tail.F) return false;
        if constexpr (SK) { int L, p0, np, part; if (!sk.next(i, nM * nN, G, L, p0, np, part)) return false;
            tile_from_L(L, nM, nN, pm, pn);
            u.pm = pm; u.pn = pn; u.e = 0; u.rt = pm; u.cnt = 1 << 30; u.ab = A + (size_t)pm * BM * KB + (size_t)p0 * 256; u.bb = Bt + (size_t)pn * BM * KB + (size_t)p0 * 256;
            u.nt = 2 * np; u.part = part; u.slot = part == 2 ? c + 8 : c; return true; }
        else { if (!tile_order(i, G, c, nM, nN, pm, pn, rev)) return false;
            u.pm = pm; u.pn = pn; u.e = 0; u.rt = pm; u.cnt = 1 << 30; u.ab = A + (size_t)pm * BM * KB; u.bb = Bt + (size_t)pn * BM * KB; return true; }
    }
    __device__ __forceinline__ void aoff(const Unit&, int tid, unsigned (&va)[2][2]) const {
#pragma unroll
        for (int i = 0; i < 2; ++i) { int R, C; stage_rc(tid * 16 + i * 8192, R, C);
#pragma unroll
            for (int h = 0; h < 2; ++h) va[h][i] = (unsigned)((R + HALF * h) * KB + C * 2); }
    }
};
typedef StaticOrderT<false> StaticOrder;

typedef int v8i32 __attribute__((ext_vector_type(8)));
typedef int v4i32 __attribute__((ext_vector_type(4)));
__device__ __forceinline__ v8i32 cat8(bf16x8 a, bf16x8 b) { const v4i32 x = __builtin_bit_cast(v4i32, a), y = __builtin_bit_cast(v4i32, b); return (v8i32){x[0], x[1], x[2], x[3], y[0], y[1], y[2], y[3]}; }
__device__ __forceinline__ void glds16s(unsigned voff, const void* sbase, unsigned lds_dst) { unsigned keep;
    asm volatile("s_mov_b32 %0, m0\n\ts_mov_b32 m0, %3\n\ts_nop 0\n\tglobal_load_lds_dwordx4 %1, %2\n\ts_mov_b32 m0, %0" : "=&s"(keep) : "v"(voff), "s"(sbase), "s"(lds_dst) : "memory"); }
__device__ __forceinline__ unsigned cvt_pk_bf16(float lo, float hi) { unsigned r; asm volatile("v_cvt_pk_bf16_f32 %0, %1, %2" : "=v"(r) : "v"(lo), "v"(hi)); return r; }

template <int MODE  , class Epi, class Sched>
__device__ __forceinline__ void gemm_phase(PG8_LAS unsigned char* lds, const int KB, const Sched& S, const Epi& E) {
    const int tid = opq((int)threadIdx.x), wid = __builtin_amdgcn_readfirstlane(tid >> 6), lane = tid & 63, wr = wid >> 2, wc = wid & 3, fr = lane & 15, fq = lane >> 4;
    const int nt = KB / 128;
    unsigned voffB[2];
#pragma unroll
    for (int i = 0; i < 2; ++i) { int R, C; stage_rc(tid * 16 + i * 8192, R, C); const int Rb = Epi::PERM ? ((R & ~31) + perm32(R & 31)) : R; voffB[i] = (unsigned)(Rb * KB + C * 2); }
    const size_t kstep = (size_t)(BK * 2);
    const size_t hstep = (size_t)HALF * KB;
    const unsigned ldsw = (unsigned)wid * 1024u;
    const int aoff = lds_byte(wr * 64 + fr, fq * 8), boff = lds_byte(wc * 32 + fr, fq * 8);
    const unsigned lds0 = (unsigned)(uintptr_t)lds;
#define PG8_SA(b, h) (((b) * 2 + (h)) * HTB)
#define PG8_SB(b, h) ((4 + (b) * 2 + (h)) * HTB)
#define PG8_STAGE(bufoff, gbase, voff) do { _Pragma("unroll") for (int _i = 0; _i < 2; ++_i) glds16s((voff)[_i], (const void*)(gbase), lds0 + (unsigned)(bufoff) + ldsw + (unsigned)(_i * 8192)); } while (0)
#define PG8_LD8(p) __builtin_shufflevector(*(const PG8_LAS v4i32*)(p), *(const PG8_LAS v4i32*)((p) + 1024), 0, 1, 2, 3, 4, 5, 6, 7)
#define PG8_LDA(dst, b, h) do { _Pragma("unroll") for (int m = 0; m < 4; ++m) dst[m] = PG8_LD8(lds + PG8_SA(b, h) + aoff + m * 2048); } while (0)
#define PG8_LDB(dst, b, h) do { _Pragma("unroll") for (int n = 0; n < 2; ++n) dst[n] = PG8_LD8(lds + PG8_SB(b, h) + boff + n * 2048); } while (0)
#define PG8_LO(v) __builtin_bit_cast(bf16x8, __builtin_shufflevector(v, v, 0, 1, 2, 3))
#define PG8_HI(v) __builtin_bit_cast(bf16x8, __builtin_shufflevector(v, v, 4, 5, 6, 7))
#define PG8_MMA(ai, bj, At, Bt) do { __builtin_amdgcn_s_setprio(1); _Pragma("unroll") for (int m = 0; m < 4; ++m) _Pragma("unroll") for (int n = 0; n < 2; ++n) { \
        if constexpr (MODE == 1) acc[ai][bj][m][n] = __builtin_amdgcn_mfma_scale_f32_16x16x128_f8f6f4(Bt[n], At[m], acc[ai][bj][m][n], 0, 0, 0, 0, 0, 0); \
        else if constexpr (MODE == 2) { v4i32 c_ = __builtin_bit_cast(v4i32, acc[ai][bj][m][n]); \
               c_ = __builtin_amdgcn_mfma_i32_16x16x64_i8(__builtin_shufflevector(Bt[n], Bt[n], 0, 1, 2, 3), __builtin_shufflevector(At[m], At[m], 0, 1, 2, 3), c_, 0, 0, 0); \
               c_ = __builtin_amdgcn_mfma_i32_16x16x64_i8(__builtin_shufflevector(Bt[n], Bt[n], 4, 5, 6, 7), __builtin_shufflevector(At[m], At[m], 4, 5, 6, 7), c_, 0, 0, 0); \
               acc[ai][bj][m][n] = __builtin_bit_cast(f32x4, c_); } \
        else { acc[ai][bj][m][n] = __builtin_amdgcn_mfma_f32_16x16x32_bf16(PG8_LO(Bt[n]), PG8_LO(At[m]), acc[ai][bj][m][n], 0, 0, 0); \
               acc[ai][bj][m][n] = __builtin_amdgcn_mfma_f32_16x16x32_bf16(PG8_HI(Bt[n]), PG8_HI(At[m]), acc[ai][bj][m][n], 0, 0, 0); } } \
        __builtin_amdgcn_s_setprio(0); } while (0)
#define PG8_WAIT_V(n) asm volatile("s_waitcnt vmcnt(" #n ")" ::: "memory")
#define PG8_WAIT_L(n) asm volatile("s_waitcnt lgkmcnt(" #n ")" ::: "memory")
#define PG8_BAR __builtin_amdgcn_s_barrier()
#define PG8_SCHED __builtin_amdgcn_sched_barrier(0)
    Unit cur, nxt; int ui = 0;
    if (!S.next(0, cur)) return;
    unsigned va[2][2];
    S.aoff(cur, tid, va);
    f32x4 acc[2][2][4][2];
#define PG8_ACC_INIT(U) do { \
    bool ld_ = false; if constexpr (Sched::SK) ld_ = (U).part == 2; \
    if (ld_) { const int t2 = opq((int)threadIdx.x); const char* sb = (const char*)S.sk.slots + (size_t)(U).slot * (size_t)(BM * BM * 4); const unsigned vo = (unsigned)t2 * 16u; unsigned* fl = S.sk.flags + (U).slot * 16; \
        if (t2 == 0) { unsigned sp_ = 0; while (__hip_atomic_load(fl, __ATOMIC_RELAXED, __HIP_MEMORY_SCOPE_AGENT) != S.sk.tag) { __builtin_amdgcn_s_sleep(1); if (++sp_ > (1u << 24)) break; } \
            } \
        PG8_BAR; \
        _Pragma("unroll") for (int a = 0; a < 2; ++a) _Pragma("unroll") for (int b = 0; b < 2; ++b) _Pragma("unroll") for (int m = 0; m < 4; ++m) _Pragma("unroll") for (int n = 0; n < 2; ++n) \
            asm volatile("global_load_dwordx4 %0, %1, %2 sc1" : "=v"(acc[a][b][m][n]) : "v"(vo), "s"(sb + (((a * 2 + b) * 4 + m) * 2 + n) * 8192) : "memory");        \
        asm volatile("s_waitcnt vmcnt(0)" ::: "memory"); \
    } else { \
        _Pragma("unroll") for (int a = 0; a < 2; ++a) _Pragma("unroll") for (int b = 0; b < 2; ++b) _Pragma("unroll") for (int m = 0; m < 4; ++m) _Pragma("unroll") for (int n = 0; n < 2; ++n) acc[a][b][m][n] = (f32x4){0.f, 0.f, 0.f, 0.f}; \
    } } while (0)
    PG8_ACC_INIT(cur);
    v8i32 At[4], B0[2], B1[2];
    const char* cA = cur.ab; const char* cB = cur.bb;
    PG8_STAGE(PG8_SB(0, 0), cB, voffB); PG8_STAGE(PG8_SB(0, 1), cB + hstep, voffB); PG8_STAGE(PG8_SA(0, 0), cA, va[0]); PG8_STAGE(PG8_SA(0, 1), cA, va[1]);
    if (wr == 1) PG8_BAR;
    PG8_WAIT_V(2); PG8_BAR;
    PG8_STAGE(PG8_SB(1, 0), cB + kstep, voffB); PG8_STAGE(PG8_SA(1, 0), cA + kstep, va[0]); PG8_STAGE(PG8_SB(1, 1), cB + hstep + kstep, voffB);
    PG8_WAIT_V(6); PG8_BAR;
    for (;;) {
        const bool has_next = S.next(ui + 1, nxt);
        const char* nA = has_next ? nxt.ab : cA; const char* nB = has_next ? nxt.bb : cB;
        if constexpr (Sched::GATHER) {
            if (has_next && wid == 0) glds16s((unsigned)lane * 16u, S.list_src(nxt), lds0 + (unsigned)STAGE_BYTES + (unsigned)(((ui + 1) & 1) * 1024)); }
        int ntu = nt; if constexpr (Sched::SK) ntu = cur.nt;
#pragma unroll 1
        for (int t = 0; t < ntu; t += 2) {
            const bool last = (t == ntu - 2);
            const char* a1 = cA + (size_t)(t + 1) * kstep;
            const char* a2 = last ? nA : cA + (size_t)(t + 2) * kstep; const char* b2 = last ? nB : cB + (size_t)(t + 2) * kstep;
            const char* a3 = a2 + kstep; const char* b3 = b2 + kstep;
            PG8_LDB(B0, 0, 0); PG8_LDB(B1, 0, 1); PG8_SCHED; PG8_LDA(At, 0, 0); PG8_STAGE(PG8_SA(1, 1), a1, va[1]);
            if constexpr (Sched::GATHER) { if (last && has_next) S.aoff_lds(nxt, opq((int)threadIdx.x), (const PG8_LAS int*)(lds + STAGE_BYTES + ((ui + 1) & 1) * 1024), va); }
            PG8_WAIT_V(8); PG8_WAIT_L(0); PG8_BAR; PG8_MMA(0, 0, At, B0); PG8_MMA(0, 1, At, B1); PG8_BAR; PG8_SCHED;
            PG8_LDA(At, 0, 1); PG8_STAGE(PG8_SB(0, 0), b2, voffB); PG8_STAGE(PG8_SB(0, 1), b2 + hstep, voffB); PG8_STAGE(PG8_SA(0, 0), a2, va[0]);
            PG8_WAIT_V(8); PG8_WAIT_L(0); PG8_BAR; PG8_MMA(1, 0, At, B0); PG8_MMA(1, 1, At, B1); PG8_BAR; PG8_SCHED;
            PG8_LDB(B0, 1, 0); PG8_LDB(B1, 1, 1); PG8_SCHED; PG8_LDA(At, 1, 0); PG8_STAGE(PG8_SA(0, 1), a2, va[1]);
            PG8_WAIT_V(8); PG8_WAIT_L(0); PG8_BAR; PG8_MMA(0, 0, At, B0); PG8_MMA(0, 1, At, B1); PG8_BAR; PG8_SCHED;
            PG8_LDA(At, 1, 1); PG8_STAGE(PG8_SB(1, 0), b3, voffB); PG8_STAGE(PG8_SB(1, 1), b3 + hstep, voffB); PG8_STAGE(PG8_SA(1, 0), a3, va[0]);
            PG8_WAIT_V(8); PG8_WAIT_L(0); PG8_BAR; PG8_MMA(1, 0, At, B0); PG8_MMA(1, 1, At, B1); PG8_BAR; PG8_SCHED;
        }
        if (wr == 0) PG8_BAR;
        if constexpr (Sched::SK) {
            if (cur.part == 1) { const int t2 = opq((int)threadIdx.x); const char* sb = (const char*)S.sk.slots + (size_t)cur.slot * (size_t)(BM * BM * 4); const unsigned vo = (unsigned)t2 * 16u; unsigned* fl = S.sk.flags + cur.slot * 16;
                {
#pragma unroll
                    for (int a = 0; a < 2; ++a)
#pragma unroll
                        for (int b = 0; b < 2; ++b)
#pragma unroll
                            for (int m = 0; m < 4; ++m)
#pragma unroll
                                for (int n = 0; n < 2; ++n) asm volatile("global_store_dwordx4 %0, %1, %2 sc1" :: "v"(vo), "v"(acc[a][b][m][n]), "s"(sb + (((a * 2 + b) * 4 + m) * 2 + n) * 8192) : "memory");
                    PG8_WAIT_V(0); PG8_BAR;
                    if (t2 == 0) __hip_atomic_store(fl, S.sk.tag, __ATOMIC_RELAXED, __HIP_MEMORY_SCOPE_AGENT);
                }
            }
        }
        if constexpr (!Epi::AFTER_DRAIN) { if (!Sched::SK || cur.part != 1) { const int l2 = opq((int)threadIdx.x) & 63; E(acc, cur, wr, wc, l2 & 15, l2 >> 4); } }
        if (!has_next) break;
        PG8_ACC_INIT(nxt);
        cur = nxt; cA = nA; cB = nB; ++ui;
        if (wr == 1) PG8_BAR;
    }
    PG8_WAIT_V(0);
    PG8_BAR;
    if constexpr (Epi::AFTER_DRAIN) { const int l2 = opq((int)threadIdx.x) & 63; E.fused(acc, cur, wr, wc, l2 & 15, l2 >> 4, lds, wid, l2); }
#undef PG8_ACC_INIT
#undef PG8_SA
#undef PG8_SB
#undef PG8_STAGE
#undef PG8_LDA
#undef PG8_LDB
#undef PG8_LD8
#undef PG8_LO
#undef PG8_HI
#undef PG8_MMA
#undef PG8_WAIT_V
#undef PG8_WAIT_L
#undef PG8_BAR
#undef PG8_SCHED
}
template <int MODE, class Epi, class Sched>
__device__ __forceinline__ void gemm_tail(PG8_LAS unsigned char* lds, const int KB, const Sched& S, const Epi& E) {
    static_assert(MODE == 0 || MODE == 1, "bf16 or fp8");
    const int tid = opq((int)threadIdx.x), wid = __builtin_amdgcn_readfirstlane(tid >> 6), lane = tid & 63, wr = wid >> 2, wc = wid & 3, fr = lane & 15, fq = lane >> 4;
    const int nt = KB / 128;
    unsigned voffB[2];
#pragma unroll
    for (int i = 0; i < 2; ++i) { int R, C; stage_rc(tid * 16 + i * 8192, R, C); const int Rb = Epi::PERM ? ((R & ~31) + perm32(R & 31)) : R; voffB[i] = (unsigned)(Rb * KB + C * 2); }
    const unsigned ldsw = (unsigned)wid * 1024u, lds0 = (unsigned)(uintptr_t)lds;
    const int aoff = lds_byte(wr * 64 + fr, fq * 8), boff = lds_byte(wc * 32 + fr, fq * 8);
    for (int j = 0;; ++j) {
        Unit u; int ai, bj; if (!S.tail_next(j, u, ai, bj)) break;
        unsigned va[2][2]; S.aoff(u, tid, va);
        const unsigned va0 = ai ? va[1][0] : va[0][0], va1 = ai ? va[1][1] : va[0][1];
        const char* cA = u.ab; const char* cB = u.bb + (size_t)bj * HALF * KB;
        f32x4 acc[4][2];
#pragma unroll
        for (int m = 0; m < 4; ++m)
#pragma unroll
            for (int n = 0; n < 2; ++n) acc[m][n] = (f32x4){0.f, 0.f, 0.f, 0.f};
#define PG8T_STAGE(t, b) do { const unsigned d_ = lds0 + (unsigned)((b) * 2 * HTB) + ldsw; const char* a_ = cA + (size_t)(t) * 128; const char* b_ = cB + (size_t)(t) * 128; \
        glds16s(va0, a_, d_); glds16s(va1, a_, d_ + 8192u); glds16s(voffB[0], b_, d_ + (unsigned)HTB); glds16s(voffB[1], b_, d_ + (unsigned)HTB + 8192u); } while (0)
        PG8T_STAGE(0, 0);
#pragma unroll 1
        for (int t = 0; t < nt; ++t) { const int b = t & 1;
            if (t + 1 < nt) { PG8T_STAGE(t + 1, b ^ 1); asm volatile("s_waitcnt vmcnt(4)" ::: "memory"); } else asm volatile("s_waitcnt vmcnt(0)" ::: "memory");
            __builtin_amdgcn_s_barrier();
            v8i32 At[4], Bt[2];
            const PG8_LAS unsigned char* ab_ = lds + b * 2 * HTB + aoff; const PG8_LAS unsigned char* bb_ = lds + b * 2 * HTB + HTB + boff;
#pragma unroll
            for (int m = 0; m < 4; ++m) At[m] = __builtin_shufflevector(*(const PG8_LAS v4i32*)(ab_ + m * 2048), *(const PG8_LAS v4i32*)(ab_ + m * 2048 + 1024), 0, 1, 2, 3, 4, 5, 6, 7);
#pragma unroll
            for (int n = 0; n < 2; ++n) Bt[n] = __builtin_shufflevector(*(const PG8_LAS v4i32*)(bb_ + n * 2048), *(const PG8_LAS v4i32*)(bb_ + n * 2048 + 1024), 0, 1, 2, 3, 4, 5, 6, 7);
#pragma unroll
            for (int m = 0; m < 4; ++m)
#pragma unroll
                for (int n = 0; n < 2; ++n) {
                    if constexpr (MODE == 1) acc[m][n] = __builtin_amdgcn_mfma_scale_f32_16x16x128_f8f6f4(Bt[n], At[m], acc[m][n], 0, 0, 0, 0, 0, 0);
                    else { acc[m][n] = __builtin_amdgcn_mfma_f32_16x16x32_bf16(__builtin_bit_cast(bf16x8, __builtin_shufflevector(Bt[n], Bt[n], 0, 1, 2, 3)), __builtin_bit_cast(bf16x8, __builtin_shufflevector(At[m], At[m], 0, 1, 2, 3)), acc[m][n], 0, 0, 0);
                           acc[m][n] = __builtin_amdgcn_mfma_f32_16x16x32_bf16(__builtin_bit_cast(bf16x8, __builtin_shufflevector(Bt[n], Bt[n], 4, 5, 6, 7)), __builtin_bit_cast(bf16x8, __builtin_shufflevector(At[m], At[m], 4, 5, 6, 7)), acc[m][n], 0, 0, 0); } }
            asm volatile("s_waitcnt lgkmcnt(0)" ::: "memory");
            __builtin_amdgcn_s_barrier();
        }
#undef PG8T_STAGE
        { const int l2 = opq((int)threadIdx.x) & 63; E.quarter(acc, u, ai, bj, wr, wc, l2 & 15, l2 >> 4); }
    }
    asm volatile("s_waitcnt vmcnt(0)" ::: "memory");
    __builtin_amdgcn_s_barrier();
}
}
constexpr int D = 1024, NB = 8, SEQ = 4096, CTXL = 256, NL = NB * SEQ, NC = NB * CTXL, MT = NL + NC;
constexpr int INW = 1792, FF = 2816, NE = 8;
constexpr int C_Q = 0, C_K = 512, C_V = 640, C_U = 768, C_RQ = 1024, C_RK = 1152, C_RV = 1280, C_RG = 1536;
constexpr int NCHK = 34;
constexpr float LN_EPS = 1e-5f, LOG2E = 1.4426950408889634f;
constexpr float QSCALE = 0.125f * LOG2E;
constexpr float RSCALE = 0.17677669529663687f;
constexpr float ALPHA = 1.4142135623730951f;
constexpr int LCAP = 32768;

namespace pg8 {
__device__ __forceinline__ void store8(bf16_t* p, f32x4 v0, f32x4 v1) {
    u32x4 w; w.x = cvt_pk_bf16(v0[0], v0[1]); w.y = cvt_pk_bf16(v0[2], v0[3]); w.z = cvt_pk_bf16(v1[0], v1[1]); w.w = cvt_pk_bf16(v1[2], v1[3]); *(u32x4*)p = w;
}
typedef float f32x2_t __attribute__((ext_vector_type(2)));
struct EpiBf16 {
    static constexpr bool PERM = true, AFTER_DRAIN = false;
    bf16_t* O; int ldc; float scale;
    __device__ __forceinline__ void operator()(const f32x4 (&acc)[2][2][4][2], const Unit& u, int wr, int wc, int fr, int fq) const {
        const int row0 = u.pm * BM + wr * 64 + fr, col0 = u.pn * BM + wc * 32 + 8 * fq;
#pragma unroll
        for (int ai = 0; ai < 2; ++ai)
#pragma unroll
            for (int m = 0; m < 4; ++m) { bf16_t* rowp = O + (size_t)(row0 + ai * HALF + m * 16) * ldc + col0;
#pragma unroll
                for (int bj = 0; bj < 2; ++bj) store8(rowp + bj * HALF, acc[ai][bj][m][0] * scale, acc[ai][bj][m][1] * scale); }
    }
    __device__ __forceinline__ void quarter(const f32x4 (&a)[4][2], const Unit& u, int ai, int bj, int wr, int wc, int fr, int fq) const {
        const int row0 = u.pm * BM + ai * HALF + wr * 64 + fr, col0 = u.pn * BM + bj * HALF + wc * 32 + 8 * fq;
#pragma unroll
        for (int m = 0; m < 4; ++m) store8(O + (size_t)(row0 + m * 16) * ldc + col0, a[m][0] * scale, a[m][1] * scale);
    }
};
template <bool XF32> struct EpiRes {
    static constexpr bool PERM = true, AFTER_DRAIN = false;
    unsigned char* ws; float scale; size_t o_out, o_x16, o_g;
    __device__ __forceinline__ const float* grow(const Unit& u, int col) const { const int mr = u.pm < (NL / BM) ? (u.pm * BM) >> 12 : 8; return (const float*)(ws + o_g) + (size_t)mr * 6144 + col; }
    __device__ __forceinline__ void one(int row, int col, f32x4 a0, f32x4 a1, f32x4 g0, f32x4 g1, f32x4 x0, f32x4 x1) const { store8((bf16_t*)(ws + o_out) + (size_t)row * D + col, x0 * ALPHA + g0 * a0, x1 * ALPHA + g1 * a1); }
    __device__ __forceinline__ const float* xbase(const Unit& u) const {
        const float* const* ka = (const float* const*)__builtin_amdgcn_kernarg_segment_ptr(); return u.pm < (NL / BM) ? ka[0] : ka[2] - (size_t)NL * D; }
    __device__ __forceinline__ void ldx(const float* xb, int row, int col, f32x4& x0, f32x4& x1) const {
        if constexpr (XF32) { const float* p = xb + (size_t)row * D + col; x0 = *(const f32x4*)p; x1 = *(const f32x4*)(p + 4); }
        else { const u32x4 w = *(const u32x4*)((const bf16_t*)(ws + o_x16) + (size_t)row * D + col);
            x0 = (f32x4){__uint_as_float(w.x << 16), __uint_as_float(w.x & 0xffff0000u), __uint_as_float(w.y << 16), __uint_as_float(w.y & 0xffff0000u)};
            x1 = (f32x4){__uint_as_float(w.z << 16), __uint_as_float(w.z & 0xffff0000u), __uint_as_float(w.w << 16), __uint_as_float(w.w & 0xffff0000u)}; }
    }
    __device__ __forceinline__ void operator()(const f32x4 (&acc)[2][2][4][2], const Unit& u, int wr, int wc, int fr, int fq) const {
        const int row0 = u.pm * BM + wr * 64 + fr, col0 = u.pn * BM + wc * 32 + 8 * fq; const float* g = grow(u, col0); const float* xb = XF32 ? xbase(u) : nullptr;
        f32x4 gv[2][2];
#pragma unroll
        for (int bj = 0; bj < 2; ++bj)
#pragma unroll
            for (int n = 0; n < 2; ++n) gv[bj][n] = *(const f32x4*)(g + bj * HALF + 4 * n) * scale;
#pragma unroll
        for (int ai = 0; ai < 2; ++ai) { f32x4 xa[4][2][2];
#pragma unroll
            for (int m = 0; m < 4; ++m)
#pragma unroll
                for (int bj = 0; bj < 2; ++bj) ldx(xb, row0 + ai * HALF + m * 16, col0 + bj * HALF, xa[m][bj][0], xa[m][bj][1]);
#pragma unroll
            for (int m = 0; m < 4; ++m)
#pragma unroll
                for (int bj = 0; bj < 2; ++bj) one(row0 + ai * HALF + m * 16, col0 + bj * HALF, acc[ai][bj][m][0], acc[ai][bj][m][1], gv[bj][0], gv[bj][1], xa[m][bj][0], xa[m][bj][1]); }
    }
    __device__ __forceinline__ void quarter(const f32x4 (&a)[4][2], const Unit& u, int ai, int bj, int wr, int wc, int fr, int fq) const {
        const int row0 = u.pm * BM + ai * HALF + wr * 64 + fr, col0 = u.pn * BM + bj * HALF + wc * 32 + 8 * fq; const float* g = grow(u, col0);
        const f32x4 g0 = *(const f32x4*)g * scale, g1 = *(const f32x4*)(g + 4) * scale; f32x4 xa[4][2]; const float* xb = XF32 ? xbase(u) : nullptr;
#pragma unroll
        for (int m = 0; m < 4; ++m) ldx(xb, row0 + m * 16, col0, xa[m][0], xa[m][1]);
#pragma unroll
        for (int m = 0; m < 4; ++m) one(row0 + m * 16, col0, a[m][0], a[m][1], g0, g1, xa[m][0], xa[m][1]);
    }
};
template <bool Q  > struct EpiInProj {
    static constexpr bool PERM = true, AFTER_DRAIN = false;
    bf16_t* O; const PG8_LAS float* rope;
    const float* sa; const float* sw;
    __device__ __forceinline__ void operator()(const f32x4 (&acc)[2][2][4][2], const Unit& u, int wr, int wc, int fr, int fq) const {
        const int row0 = u.pm * BM + wr * 64 + fr; const bool lat = u.pm < (NL / BM);
        float rs8[2][4];
        f32x4 cw[2][2];
        if constexpr (Q) {
#pragma unroll
            for (int ai = 0; ai < 2; ++ai)
#pragma unroll
                for (int m = 0; m < 4; ++m) rs8[ai][m] = sa[row0 + ai * HALF + m * 16];
#pragma unroll
            for (int bj = 0; bj < 2; ++bj)
#pragma unroll
                for (int n = 0; n < 2; ++n) cw[bj][n] = *(const f32x4*)(sw + (2 * u.pn + bj) * HALF + wc * 32 + 8 * fq + 4 * n) * (1.0f / 127.0f);
        }
#pragma unroll
        for (int bj = 0; bj < 2; ++bj) {
            const int seg = 2 * u.pn + bj;
            const bool rope_on = lat && seg <= 4; const float sc = seg <= 3 ? QSCALE : (seg == 9 ? RSCALE : 1.0f);
#pragma unroll
            for (int ai = 0; ai < 2; ++ai)
#pragma unroll
                for (int m = 0; m < 4; ++m) { const int row = row0 + ai * HALF + m * 16;
                    f32x4 v0 = acc[ai][bj][m][0], v1 = acc[ai][bj][m][1];
                    if constexpr (Q) { const float s = rs8[ai][m]; const v4i32 i0 = __builtin_bit_cast(v4i32, v0), i1 = __builtin_bit_cast(v4i32, v1);
                        v0 = (f32x4){(float)i0[0], (float)i0[1], (float)i0[2], (float)i0[3]} * (cw[bj][0] * s); v1 = (f32x4){(float)i1[0], (float)i1[1], (float)i1[2], (float)i1[3]} * (cw[bj][1] * s); }
                    if (rope_on) { const int t = row & (SEQ - 1); const int pos = (wc & 1) ? (t & 63) : (t >> 6);
                        const f32x4 c4 = *(const PG8_LAS f32x4*)(rope + pos * 16 + 4 * fq), s4 = *(const PG8_LAS f32x4*)(rope + 1024 + pos * 16 + 4 * fq);
                        const f32x4 o0 = v0 * c4 - v1 * s4, o1 = v0 * s4 + v1 * c4; v0 = o0; v1 = o1; }
                    v0 = v0 * sc; v1 = v1 * sc;
                    store8(O + (size_t)row * INW + seg * HALF + wc * 32 + 8 * fq, v0, v1); }
        }
    }
};
struct EpiSwiGLU {
    static constexpr bool PERM = true, AFTER_DRAIN = false;
    bf16_t* H; int ldh;
    __device__ __forceinline__ void operator()(const f32x4 (&acc)[2][2][4][2], const Unit& u, int wr, int wc, int fr, int fq) const {
        const int row0 = u.pm * BM + wr * 64 + fr, col0 = u.pn * HALF + wc * 32 + 8 * fq;
#pragma unroll
        for (int ai = 0; ai < 2; ++ai)
#pragma unroll
            for (int m = 0; m < 4; ++m) { f32x4 h[2];
#pragma unroll
                for (int n = 0; n < 2; ++n) { const f32x4 g = acc[ai][0][m][n], up = acc[ai][1][m][n];
#pragma unroll
                    for (int i = 0; i < 4; ++i) h[n][i] = g[i] * __builtin_amdgcn_rcpf(1.0f + __builtin_amdgcn_exp2f(-LOG2E * g[i])) * up[i]; }
                store8(H + (size_t)(row0 + ai * HALF + m * 16) * ldh + col0, h[0], h[1]); }
    }
};
__device__ __forceinline__ unsigned pk4_fp8(float a, float b, float c, float d) {
    a = __builtin_amdgcn_fmed3f(a, -448.f, 448.f); b = __builtin_amdgcn_fmed3f(b, -448.f, 448.f); c = __builtin_amdgcn_fmed3f(c, -448.f, 448.f); d = __builtin_amdgcn_fmed3f(d, -448.f, 448.f);
    int w = __builtin_amdgcn_cvt_pk_fp8_f32(a, b, 0, false); w = __builtin_amdgcn_cvt_pk_fp8_f32(c, d, w, true); return (unsigned)w; }
struct EpiSwiGLU8 {
    static constexpr bool PERM = true, AFTER_DRAIN = false;
    unsigned char* H; int ldh; float in_scale, out_scale;
    __device__ __forceinline__ void operator()(const f32x4 (&acc)[2][2][4][2], const Unit& u, int wr, int wc, int fr, int fq) const {
        const int row0 = u.pm * BM + wr * 64 + fr, col0 = u.pn * HALF + wc * 32 + 8 * fq;
        const float k1 = -LOG2E * in_scale, invC = 1.0f / (in_scale * in_scale * out_scale);
#pragma unroll
        for (int ai = 0; ai < 2; ++ai)
#pragma unroll
            for (int m = 0; m < 4; ++m) { f32x4 h[2];
#pragma unroll
                for (int n = 0; n < 2; ++n) { const f32x4 G = acc[ai][0][m][n], U = acc[ai][1][m][n];
#pragma unroll
                    for (int p = 0; p < 2; ++p) { const f32x2_t g2 = {G[2 * p], G[2 * p + 1]}, u2 = {U[2 * p], U[2 * p + 1]}; const f32x2_t mm = g2 * k1;
                        const f32x2_t e = {__builtin_amdgcn_exp2f(mm.x), __builtin_amdgcn_exp2f(mm.y)}; const f32x2_t d = __builtin_elementwise_fma(e, (f32x2_t){invC, invC}, (f32x2_t){invC, invC});
                        const f32x2_t r = {__builtin_amdgcn_rcpf(d.x), __builtin_amdgcn_rcpf(d.y)}; const f32x2_t hh = (g2 * u2) * r; h[n][2 * p] = hh.x; h[n][2 * p + 1] = hh.y; } }
                typedef unsigned u32x2 __attribute__((ext_vector_type(2))); u32x2 w; w.x = pk4_fp8(h[0][0], h[0][1], h[0][2], h[0][3]); w.y = pk4_fp8(h[1][0], h[1][1], h[1][2], h[1][3]);
                *(u32x2*)(H + (size_t)(row0 + ai * HALF + m * 16) * ldh + col0) = w; }
    }
};
template <bool OUT8, bool GATH> struct EpiSwiGLUq {
    static constexpr bool PERM = true, AFTER_DRAIN = false;
    void* H; int ldh; const float* st; const float* sw; const int* list; float out_scale;
    __device__ __forceinline__ void operator()(const f32x4 (&acc)[2][2][4][2], const Unit& u, int wr, int wc, int fr, int fq) const {
        const int row0 = u.pm * BM + wr * 64 + fr, col0 = u.pn * HALF + wc * 32 + 8 * fq;
        const float* swp = sw + (size_t)u.e * 2 * FF + u.pn * BM + wc * 32 + 8 * fq;
        f32x4 sg[2], su[2];
#pragma unroll
        for (int n = 0; n < 2; ++n) { sg[n] = *(const f32x4*)(swp + 4 * n) * (1.0f / 127.0f); su[n] = *(const f32x4*)(swp + HALF + 4 * n) * (out_scale / 127.0f); }
        f32x4 cg[2], sgu[2];
#pragma unroll
        for (int n = 0; n < 2; ++n) { cg[n] = sg[n] * -LOG2E; sgu[n] = sg[n] * su[n]; }
        float sa8[2][4];
#pragma unroll
        for (int ai = 0; ai < 2; ++ai)
#pragma unroll
            for (int m = 0; m < 4; ++m) { const int rl = ai * HALF + wr * 64 + m * 16 + fr;
                if constexpr (GATH) { const int pos = u.rt * BM + rl; sa8[ai][m] = pos < u.cnt ? st[list[u.e * LCAP + pos] >> 1] : 0.f; } else sa8[ai][m] = st[u.pm * BM + rl]; }
#pragma unroll
        for (int ai = 0; ai < 2; ++ai)
#pragma unroll
            for (int m = 0; m < 4; ++m) { const float sa = sa8[ai][m], isa2 = __builtin_amdgcn_rcpf(sa * sa);
                f32x4 h[2];
#pragma unroll
                for (int n = 0; n < 2; ++n) { const v4i32 gi = __builtin_bit_cast(v4i32, acc[ai][0][m][n]), ui = __builtin_bit_cast(v4i32, acc[ai][1][m][n]);
#pragma unroll
                    for (int p = 0; p < 2; ++p) { const f32x2_t g2 = {(float)gi[2 * p], (float)gi[2 * p + 1]}, u2 = {(float)ui[2 * p], (float)ui[2 * p + 1]};
                        const f32x2_t mm = (g2 * (f32x2_t){cg[n][2 * p], cg[n][2 * p + 1]}) * sa;
                        const f32x2_t e = {__builtin_amdgcn_exp2f(mm.x), __builtin_amdgcn_exp2f(mm.y)}; const f32x2_t d = __builtin_elementwise_fma(e, (f32x2_t){isa2, isa2}, (f32x2_t){isa2, isa2});
                        const f32x2_t r = {__builtin_amdgcn_rcpf(d.x), __builtin_amdgcn_rcpf(d.y)}; const f32x2_t hh = ((g2 * u2) * (f32x2_t){sgu[n][2 * p], sgu[n][2 * p + 1]}) * r; h[n][2 * p] = hh.x; h[n][2 * p + 1] = hh.y; } }
                if constexpr (OUT8) { typedef unsigned u32x2 __attribute__((ext_vector_type(2))); u32x2 w; w.x = pk4_fp8(h[0][0], h[0][1], h[0][2], h[0][3]); w.y = pk4_fp8(h[1][0], h[1][1], h[1][2], h[1][3]);
                    *(u32x2*)((unsigned char*)H + (size_t)(row0 + ai * HALF + m * 16) * ldh + col0) = w; }
                else store8((bf16_t*)H + (size_t)(row0 + ai * HALF + m * 16) * ldh + col0, h[0], h[1]); }
    }
};
struct EpiMoeDown {
    static constexpr bool PERM = true, AFTER_DRAIN = false;
    bf16_t* Y; const int* list; const float* lgate; float scale;
    __device__ __forceinline__ void operator()(const f32x4 (&acc)[2][2][4][2], const Unit& u, int wr, int wc, int fr, int fq) const {
        const int col0 = u.pn * BM + wc * 32 + 8 * fq;
#pragma unroll
        for (int ai = 0; ai < 2; ++ai)
#pragma unroll
            for (int m = 0; m < 4; ++m) { const int pos = u.rt * BM + ai * HALF + wr * 64 + m * 16 + fr;
                if (pos < u.cnt) { const int ent = list[u.e * LCAP + pos]; const float g = lgate[u.e * LCAP + pos] * scale;
                    bf16_t* rowp = Y + ((size_t)(ent & 1) * NL + (size_t)(ent >> 1)) * D + col0;
#pragma unroll
                    for (int bj = 0; bj < 2; ++bj) store8(rowp + bj * HALF, acc[ai][bj][m][0] * g, acc[ai][bj][m][1] * g); } }
    }
    __device__ __forceinline__ void quarter(const f32x4 (&a)[4][2], const Unit& u, int ai, int bj, int wr, int wc, int fr, int fq) const {
        const int col0 = u.pn * BM + bj * HALF + wc * 32 + 8 * fq;
#pragma unroll
        for (int m = 0; m < 4; ++m) { const int pos = u.rt * BM + ai * HALF + wr * 64 + m * 16 + fr;
            if (pos < u.cnt) { const int ent = list[u.e * LCAP + pos]; const float g = lgate[u.e * LCAP + pos] * scale;
                store8(Y + ((size_t)(ent & 1) * NL + (size_t)(ent >> 1)) * D + col0, a[m][0] * g, a[m][1] * g); } }
    }
};
template <bool GATHER_, bool SK_ = false> struct MoeOrder {
    static constexpr bool GATHER = GATHER_, SK = SK_;
    int nrt, nN, G, c, KB, T0; const PG8_LAS int* tbl;
    const char* A; const char* Bt; size_t bstride; const int* list;
    bool rev = false;
    StreamK sk; TailPlan tail;
#if ((REP_MASK) >> 13) & 2
    int i0 = 0, i1 = 1 << 30;
#endif
    __device__ __forceinline__ void fill(Unit& u, int pm, int pn, int p0) const {
        const int T = T0 + pm; int e = 0;
#pragma unroll
        for (int j = 1; j < NE; ++j) e += (T >= tbl[j]) ? 1 : 0;
        e = __builtin_amdgcn_readfirstlane(e);
        u.pm = pm; u.pn = pn; u.e = e; u.rt = T - __builtin_amdgcn_readfirstlane(tbl[e]); u.cnt = __builtin_amdgcn_readfirstlane(tbl[NE + 1 + e]);
        u.ab = GATHER ? A : A + (size_t)pm * BM * KB + (size_t)p0 * 256; u.bb = Bt + (size_t)e * bstride + (size_t)pn * BM * KB + (size_t)p0 * 256;
    }
    __device__ __forceinline__ bool tail_next(int j, Unit& u, int& ai, int& bj) const {
        int cq, pm, pn; if (nrt <= 0 || !tail.quarter(j, c, cq, ai, bj) || !tile_order(tail.F, G, cq, nrt, nN, pm, pn, rev)) return false;
        fill(u, pm, pn, 0); return true;
    }
    __device__ __forceinline__ bool next(int i, Unit& u) const {
        int pm, pn, p0 = 0; if (i >= tail.F) return false;
#if ((REP_MASK) >> 13) & 2
        i += i0; if (i >= i1) return false;
#endif
        if constexpr (SK) { int L, np, part; if (nrt <= 0 || !sk.next(i, nrt * nN, G, L, p0, np, part)) return false;
            tile_from_L(L, nrt, nN, pm, pn); u.nt = 2 * np; u.part = part; u.slot = part == 2 ? c + 8 : c; }
        else { if (nrt <= 0 || !tile_order(i, G, c, nrt, nN, pm, pn, rev)) return false; }
        fill(u, pm, pn, p0); return true;
    }
    __device__ __forceinline__ const void* list_src(const Unit& u) const { return (const void*)(list + (size_t)u.e * LCAP + (size_t)u.rt * BM); }
    __device__ __forceinline__ void aoff_lds(const Unit& u, int tid, const PG8_LAS int* slot, unsigned (&va)[2][2]) const {
#pragma unroll
        for (int i = 0; i < 2; ++i) { int R, C; stage_rc(tid * 16 + i * 8192, R, C);
#pragma unroll
            for (int h = 0; h < 2; ++h) { const int rl = R + HALF * h; const int ent = slot[rl]; const int tok = (u.rt * BM + rl) < u.cnt ? (ent >> 1) : 0; va[h][i] = (unsigned)(tok * KB + C * 2); } }
    }
    __device__ __forceinline__ void aoff(const Unit& u, int tid, unsigned (&va)[2][2]) const {
#pragma unroll
        for (int i = 0; i < 2; ++i) { int R, C; stage_rc(tid * 16 + i * 8192, R, C);
#pragma unroll
            for (int h = 0; h < 2; ++h) {
                if (GATHER) { const int pos = u.rt * BM + R + HALF * h; const int tok = pos < u.cnt ? (list[u.e * LCAP + pos] >> 1) : 0; va[h][i] = (unsigned)(tok * KB + C * 2); }
                else va[h][i] = (unsigned)((R + HALF * h) * KB + C * 2); } }
    }
};
}
namespace pg8 {
struct PanelStats {
    unsigned* xbuf;
    unsigned* cnt;
    unsigned* tmo;
    float eps; unsigned code;
    __device__ __forceinline__ bool run(const f32x4 (&v)[2][2][4][2], const Unit& u, int wr, int wc, int fr, int fq, PG8_LAS unsigned char* lds, int wid, int lane) const {
        typedef float f32x2v __attribute__((ext_vector_type(2)));
        PG8_LAS f32x2v* P = (PG8_LAS f32x2v*)lds;
        PG8_LAS f32x2v* S = (PG8_LAS f32x2v*)(lds + 8192);
        PG8_LAS unsigned* flag = (PG8_LAS unsigned*)(lds + 8192 + 2048);
#pragma unroll
        for (int ai = 0; ai < 2; ++ai)
#pragma unroll
            for (int m = 0; m < 4; ++m) {
                float s = 0.f;
#pragma unroll
                for (int bj = 0; bj < 2; ++bj)
#pragma unroll
                    for (int n = 0; n < 2; ++n) { const f32x4 x = v[ai][bj][m][n]; s += (x[0] + x[1]) + (x[2] + x[3]); }
                s += __shfl_xor(s, 16); s += __shfl_xor(s, 32);
                const float mw = s * (1.0f / 64.0f); float q = 0.f;
#pragma unroll
                for (int bj = 0; bj < 2; ++bj)
#pragma unroll
                    for (int n = 0; n < 2; ++n) { const f32x4 d = v[ai][bj][m][n] - mw; q += (d[0] * d[0] + d[1] * d[1]) + (d[2] * d[2] + d[3] * d[3]); }
                q += __shfl_xor(q, 16); q += __shfl_xor(q, 32);
                if (fq == 0) P[(ai * HALF + wr * 64 + m * 16 + fr) * 4 + wc] = (f32x2v){mw, q};
            }
        asm volatile("s_waitcnt lgkmcnt(0)" ::: "memory"); __builtin_amdgcn_s_barrier(); asm volatile("" ::: "memory");
        const int row = wid * 32 + (lane & 31);
        if (lane < 32) {
            const f32x2v a = P[row * 4 + 0], b = P[row * 4 + 1], c = P[row * 4 + 2], d = P[row * 4 + 3];
            const float mt = (a.x + b.x + c.x + d.x) * 0.25f;
            const float da = a.x - mt, db = b.x - mt, dc = c.x - mt, dd = d.x - mt;
            const float m2 = (a.y + b.y) + (c.y + d.y) + 64.0f * ((da * da + db * db) + (dc * dc + dd * dd));
            unsigned long long* slot = (unsigned long long*)xbuf + ((size_t)(u.pm * BM + row) * 4 + u.pn);
            __hip_atomic_store(slot, ((unsigned long long)__float_as_uint(m2) << 32) | __float_as_uint(mt), __ATOMIC_RELAXED, __HIP_MEMORY_SCOPE_AGENT);
        }
        asm volatile("s_waitcnt vmcnt(0)" ::: "memory");
        if (lane == 0) __hip_atomic_fetch_add(cnt + 64 * u.pm, 1u, __ATOMIC_RELAXED, __HIP_MEMORY_SCOPE_AGENT);
        if (wid == 0) {
            bool dead = false; const unsigned long long t0 = __builtin_amdgcn_s_memrealtime(); const unsigned want = 32u;
            for (;;) {
                if ((unsigned)__builtin_amdgcn_readfirstlane(__hip_atomic_load(cnt + 64 * u.pm, __ATOMIC_RELAXED, __HIP_MEMORY_SCOPE_AGENT)) >= want) break;
                if (__builtin_amdgcn_s_memrealtime() - t0 > 2000000ull) {
                    if (lane == 0) { unsigned expect = 0u; __hip_atomic_compare_exchange_strong(tmo + 1, &expect, code | (unsigned)(u.pm & 0xff), __ATOMIC_RELAXED, __ATOMIC_RELAXED, __HIP_MEMORY_SCOPE_AGENT);
                                     __hip_atomic_store(tmo, 1u, __ATOMIC_RELAXED, __HIP_MEMORY_SCOPE_AGENT); }
                    dead = true; break; }
                __builtin_amdgcn_s_sleep(2);
            }
            __builtin_amdgcn_fence(__ATOMIC_ACQUIRE, "agent");
            if (lane == 0) flag[0] = dead ? 1u : 0u;
        }
        asm volatile("s_waitcnt vmcnt(0) lgkmcnt(0)" ::: "memory"); __builtin_amdgcn_s_barrier(); asm volatile("" ::: "memory");
        const bool bad = flag[0] != 0u;
        if (lane < 32) {
            const unsigned long long* slot = (const unsigned long long*)xbuf + (size_t)(u.pm * BM + row) * 4; float mt[4], m2[4]; float ms = 0.f;
#pragma unroll
            for (int t = 0; t < 4; ++t) { const unsigned long long w = __hip_atomic_load(slot + t, __ATOMIC_RELAXED, __HIP_MEMORY_SCOPE_AGENT); mt[t] = __uint_as_float((unsigned)w); m2[t] = __uint_as_float((unsigned)(w >> 32)); ms += mt[t]; }
            const float mean = ms * 0.25f; float q = 0.f;
#pragma unroll
            for (int t = 0; t < 4; ++t) { const float dm = mt[t] - mean; q += m2[t] + 256.0f * dm * dm; }
            S[row] = (f32x2v){mean, 1.0f / sqrtf(q * (1.0f / 1024.0f) + eps)};
        }
        asm volatile("s_waitcnt lgkmcnt(0)" ::: "memory"); __builtin_amdgcn_s_barrier(); asm volatile("" ::: "memory");
        return bad;
    }
};
template <bool OUT8, bool ROUTE> struct EpiLN {
    static constexpr bool PERM = true, AFTER_DRAIN = true;
    const float* xin_lat; const float* xin_ctx; float* xo_lat; float* xo_ctx;
    const float* mod_g; const float* mod_sh; const float* mod_sc;
    const float* gam; const float* bet;
    bf16_t* tout; unsigned char* t8; float* plog; const float* router;
    PanelStats st;
    __device__ __forceinline__ void fused(f32x4 (&acc)[2][2][4][2], const Unit& u, int wr, int wc, int fr, int fq, PG8_LAS unsigned char* lds, int wid, int lane) const {
        typedef float f32x2v __attribute__((ext_vector_type(2)));
        const bool lat = u.pm < (1 << 7); const int mr = lat ? (u.pm >> 4) : 8;
        const float* xin = lat ? xin_lat : xin_ctx - (size_t)(1 << 15) * 1024; float* xo = lat ? xo_lat : xo_ctx - (size_t)(1 << 15) * 1024;
        const int col0 = u.pn * BM + wc * 32 + 8 * fq; const int row0 = u.pm * BM + wr * 64 + fr;
        PG8_LAS float* Rl = (PG8_LAS float*)(lds + 16384);
        PG8_LAS float* PLs = (PG8_LAS float*)(lds + 24576);
        if constexpr (ROUTE) { const int t = threadIdx.x; ((PG8_LAS f32x4*)Rl)[t] = ((const f32x4*)(router + (size_t)u.pn * BM * 8))[t]; ((PG8_LAS f32x4*)PLs)[t] = (f32x4){0.f, 0.f, 0.f, 0.f}; }
        { f32x4 gv[2][2];
#pragma unroll
          for (int bj = 0; bj < 2; ++bj)
#pragma unroll
              for (int n = 0; n < 2; ++n) gv[bj][n] = *(const f32x4*)(mod_g + (size_t)mr * 6144 + col0 + bj * HALF + 4 * n);
#pragma unroll
          for (int ai = 0; ai < 2; ++ai)
#pragma unroll
              for (int m = 0; m < 4; ++m) { const float* xr = xin + (size_t)(row0 + ai * HALF + m * 16) * 1024 + col0;
#pragma unroll
                  for (int bj = 0; bj < 2; ++bj)
#pragma unroll
                      for (int n = 0; n < 2; ++n) acc[ai][bj][m][n] = 1.4142135623730951f * *(const f32x4*)(xr + bj * HALF + 4 * n) + gv[bj][n] * acc[ai][bj][m][n];
                  asm volatile("" : "+v"(acc[ai][0][m][0]), "+v"(acc[ai][0][m][1]), "+v"(acc[ai][1][m][0]), "+v"(acc[ai][1][m][1]));
                  if (m & 1) asm volatile("" ::: "memory"); } }
        st.run(acc, u, wr, wc, fr, fq, lds, wid, lane);
        const PG8_LAS f32x2v* S = (const PG8_LAS f32x2v*)(lds + 8192);
#pragma unroll
        for (int bj = 0; bj < 2; ++bj) {
            f32x4 ga[2], be[2], sc[2], sh[2];
#pragma unroll
            for (int n = 0; n < 2; ++n) { const int c = col0 + bj * HALF + 4 * n; ga[n] = *(const f32x4*)(gam + c); be[n] = *(const f32x4*)(bet + c); sc[n] = *(const f32x4*)(mod_sc + (size_t)mr * 6144 + c) + 1.0f; sh[n] = *(const f32x4*)(mod_sh + (size_t)mr * 6144 + c); }
#pragma unroll
            for (int ai = 0; ai < 2; ++ai)
#pragma unroll
                for (int m = 0; m < 4; ++m) { const int r = ai * HALF + wr * 64 + m * 16 + fr; const f32x2v sr = S[r]; const size_t off = (size_t)(u.pm * BM + r) * 1024 + col0 + bj * HALF;
                    f32x4 t[2];
#pragma unroll
                    for (int n = 0; n < 2; ++n) { const f32x4 x1 = (acc[ai][bj][m][n] - sr.x) * sr.y * ga[n] + be[n]; *(f32x4*)(xo + off + 4 * n) = x1; t[n] = x1 * sc[n] + sh[n]; if constexpr (ROUTE) acc[ai][bj][m][n] = t[n]; }
                    if constexpr (OUT8) { typedef unsigned u32x2 __attribute__((ext_vector_type(2))); u32x2 w; w.x = pk4_fp8(t[0][0] * 4.0f, t[0][1] * 4.0f, t[0][2] * 4.0f, t[0][3] * 4.0f); w.y = pk4_fp8(t[1][0] * 4.0f, t[1][1] * 4.0f, t[1][2] * 4.0f, t[1][3] * 4.0f); *(u32x2*)(t8 + off) = w; }
                    else store8(tout + off, t[0], t[1]);
                    if (m & 1) asm volatile("" ::: "memory"); }
        }
        if constexpr (ROUTE) {
#pragma unroll
            for (int ai = 0; ai < 2; ++ai)
#pragma unroll
                for (int m = 0; m < 4; ++m) { float pl[8];
#pragma unroll
                    for (int e = 0; e < 8; ++e) pl[e] = 0.f;
#pragma unroll
                    for (int bj = 0; bj < 2; ++bj)
#pragma unroll
                        for (int n = 0; n < 2; ++n)
#pragma unroll
                            for (int i = 0; i < 4; ++i) { const PG8_LAS float* rr = Rl + (wc * 32 + 8 * fq + bj * HALF + 4 * n + i) * 8; const f32x4 r0 = *(const PG8_LAS f32x4*)rr, r1 = *(const PG8_LAS f32x4*)(rr + 4); const float tv = acc[ai][bj][m][n][i];
                                pl[0] += tv * r0[0]; pl[1] += tv * r0[1]; pl[2] += tv * r0[2]; pl[3] += tv * r0[3]; pl[4] += tv * r1[0]; pl[5] += tv * r1[1]; pl[6] += tv * r1[2]; pl[7] += tv * r1[3]; }
#pragma unroll
                    for (int e = 0; e < 8; ++e) { pl[e] += __shfl_xor(pl[e], 16); pl[e] += __shfl_xor(pl[e], 32); }
                    if (fq == 0) { PG8_LAS float* d = PLs + (ai * HALF + wr * 64 + m * 16 + fr) * 8;
#pragma unroll
                        for (int e = 0; e < 8; ++e) __hip_atomic_fetch_add(d + e, pl[e], __ATOMIC_RELAXED, __HIP_MEMORY_SCOPE_WORKGROUP); } }
            asm volatile("s_waitcnt lgkmcnt(0)" ::: "memory"); __builtin_amdgcn_s_barrier(); asm volatile("" ::: "memory");
            { const int t = threadIdx.x; ((f32x4*)(plog + ((size_t)u.pn * (1 << 15) + (size_t)u.pm * BM) * 8))[t] = ((const PG8_LAS f32x4*)PLs)[t]; }
        }
    }
};
struct SliceOrder {
    static constexpr bool GATHER = false, SK = false;
    int base, total, v, KB; const char* A; const char* Bt;
    __device__ __forceinline__ bool next(int i, Unit& u) const {
        const int L = base + v; if (i != 0 || L >= total) return false;
        u.pm = L >> 2; u.pn = L & 3; u.e = 0; u.rt = u.pm; u.cnt = 1 << 30; u.ab = A + (size_t)u.pm * BM * KB; u.bb = Bt + (size_t)u.pn * BM * KB; return true;
    }
    __device__ __forceinline__ void aoff(const Unit&, int tid, unsigned (&va)[2][2]) const {
#pragma unroll
        for (int i = 0; i < 2; ++i) { int R, C; stage_rc(tid * 16 + i * 8192, R, C);
#pragma unroll
            for (int h = 0; h < 2; ++h) va[h][i] = (unsigned)((R + HALF * h) * KB + C * 2); }
    }
};
}
constexpr size_t MiB = 1u << 20;
constexpr size_t WS_CTL = 0, CTL_ZERO_BYTES = 1 * MiB;
constexpr size_t WS_MOD = 1 * MiB;
constexpr size_t WS_ROPE = 1 * MiB + 512 * 1024;
constexpr size_t WS_ST = 1 * MiB + 768 * 1024;
constexpr size_t WS_SH = 4 * MiB;
constexpr int CM_WIN = 9 * 2 * FF;
constexpr size_t WS_T8L0 = 451 * MiB;
constexpr size_t WS_LIST = 2 * MiB, WS_LGATE = 3 * MiB;
constexpr size_t WS_KVS = 8 * MiB;
constexpr size_t WS_XC = 26 * MiB;
constexpr size_t WS_WIN = 34 * MiB, WS_WOUT = 41 * MiB, WS_FGU = 45 * MiB, WS_FD = 56 * MiB;
constexpr size_t WS_MGU8 = 62 * MiB, WS_MD8 = 106 * MiB;
#if RES16
constexpr size_t WS_X16 = 128 * MiB;
constexpr size_t WS_ACT = 196 * MiB;
constexpr size_t WS_PROJ = 264 * MiB, WS_MIX = 383 * MiB;
constexpr size_t WS_HID = 264 * MiB;
constexpr size_t WS_T8 = 8 * MiB;
constexpr size_t WS_Y = 196 * MiB, WS_HID8 = 324 * MiB;
constexpr size_t WS_END = 506 * MiB;
static_assert(!FFN0_FP8, "RES16 places T8 over layer-0 data");
static_assert(WS_T8L0 + (size_t)MT * D <= WS_END && WS_MIX + (size_t)MT * D * 2 <= WS_T8L0, "T8L0");
static_assert(WS_MD8 + (size_t)NE * FF * D <= WS_X16 && WS_X16 + (size_t)MT * D * 2 <= WS_ACT && WS_T8 + (size_t)NL * D <= WS_MGU8, "map");
#else
constexpr size_t WS_T8 = 128 * MiB;
constexpr size_t WS_ACT = 194 * MiB;
constexpr size_t WS_PROJ = 262 * MiB, WS_MIX = 381 * MiB;
constexpr size_t WS_HID = 262 * MiB;
constexpr size_t WS_Y = 160 * MiB, WS_HID8 = 288 * MiB;
constexpr size_t WS_END = 470 * MiB;
static_assert(WS_MD8 + (size_t)NE * FF * D <= WS_T8 && WS_T8 + (size_t)MT * D <= WS_ACT, "map");
#endif
static_assert(WS_WIN + (size_t)2 * INW * D * 2 <= WS_WOUT && WS_FGU + (size_t)2 * FF * D * 2 <= WS_FD && WS_FD + (size_t)FF * D * 2 <= WS_MGU8 && WS_MGU8 + (size_t)NE * 2 * FF * D <= WS_MD8, "weights map");
static_assert(WS_ACT + (size_t)MT * D * 2 <= WS_PROJ && WS_PROJ + (size_t)MT * INW * 2 <= WS_MIX && WS_MIX + (size_t)MT * D * 2 <= WS_END && WS_HID + (size_t)MT * FF * 2 <= WS_END, "act map");
static_assert(WS_Y + (size_t)2 * NL * D * 2 <= WS_HID8 && WS_HID8 + (size_t)264 * 256 * FF <= WS_END && WS_KVS + (size_t)2 * 32 * NCHK * 2048 * 4 <= WS_XC, "moe map");
constexpr int CW_TMO = 0;
constexpr int CW_GCNT = 1024;
constexpr int CW_BGQ = 2048;
constexpr int CW_CMAX = 65536;
constexpr int CW_BAR = 4096;
constexpr int CW_SK = 200000;
constexpr int CW_SEAM = 16384, SEAM_BANK = 136 * 64;
constexpr size_t WS_XB = 4 * MiB, XB_BANK = (size_t)MT * 4 * 8;
constexpr size_t WS_PLOG = WS_KVS;

constexpr int RING_BYTES = 131072;
constexpr int SCR_BYTES = 155648;
constexpr int ROPE_LDS = 139264;
constexpr int MISC_OFF = SCR_BYTES;
constexpr int LDS_BYTES = SCR_BYTES + 256;

#define GAS __attribute__((address_space(1)))
#define LAS __attribute__((address_space(3)))
typedef unsigned short bf16;
typedef unsigned v4u __attribute__((ext_vector_type(4)));
typedef unsigned v2u __attribute__((ext_vector_type(2)));
typedef float f32x4 __attribute__((ext_vector_type(4)));
typedef __bf16 bf16x2_t __attribute__((ext_vector_type(2)));
typedef float f32x2_t __attribute__((ext_vector_type(2)));
#define RLX_AGENT __ATOMIC_RELAXED, __HIP_MEMORY_SCOPE_AGENT
__device__ __forceinline__ unsigned pk2(float lo, float hi) { f32x2_t v = {lo, hi}; bf16x2_t b = __builtin_convertvector(v, bf16x2_t); return __builtin_bit_cast(unsigned, b); }
__device__ __forceinline__ float bflo(unsigned w) { return __uint_as_float(w << 16); }
__device__ __forceinline__ float bfhi(unsigned w) { return __uint_as_float(w & 0xffff0000u); }
__device__ __forceinline__ float dot2bf(unsigned a, unsigned b, float c) { return __builtin_amdgcn_fdot2_f32_bf16(__builtin_bit_cast(bf16x2_t, a), __builtin_bit_cast(bf16x2_t, b), c, false); }
template <int CTRL, int ROWMASK> __device__ __forceinline__ float dpp_f(float v) { return __int_as_float(__builtin_amdgcn_update_dpp(0, __float_as_int(v), CTRL, ROWMASK, 0xF, false)); }
__device__ __forceinline__ float wave_sum(float v) {
    v += dpp_f<0xB1, 0xF>(v); v += dpp_f<0x4E, 0xF>(v); v += dpp_f<0x141, 0xF>(v); v += dpp_f<0x140, 0xF>(v);
    v += dpp_f<0x142, 0xA>(v); v += dpp_f<0x143, 0xC>(v);
    return __int_as_float(__builtin_amdgcn_readlane(__float_as_int(v), 63));
}
__device__ __forceinline__ float wave_max_abs(float v) {
    v = fmaxf(v, dpp_f<0xB1, 0xF>(v)); v = fmaxf(v, dpp_f<0x4E, 0xF>(v)); v = fmaxf(v, dpp_f<0x141, 0xF>(v)); v = fmaxf(v, dpp_f<0x140, 0xF>(v));
    v = fmaxf(v, dpp_f<0x142, 0xA>(v)); v = fmaxf(v, dpp_f<0x143, 0xC>(v));
    return __int_as_float(__builtin_amdgcn_readlane(__float_as_int(v), 63));
}

#define XB_TMO      128
#define XB_XCNT(j)  (256  + 64 * (j))
#define XB_XSUB(j)  (1280 + 64 * (j))
#define XB_XGEN(j)  (2304 + 64 * (j))
#define XB_TOP      3328
#define XB_TOPGEN   3392
#define XCD_BAR_WORDS 3456
#define XB_SPIN_CAP (1u << 18)
__device__ __forceinline__ unsigned xb_ld(unsigned* p)              { return __hip_atomic_load(p, __ATOMIC_RELAXED, __HIP_MEMORY_SCOPE_AGENT); }
__device__ __forceinline__ unsigned xb_add(unsigned* p, unsigned v) { return __hip_atomic_fetch_add(p, v, __ATOMIC_RELAXED, __HIP_MEMORY_SCOPE_AGENT); }
__device__ __forceinline__ unsigned xb_xcc_id() { return (unsigned)__builtin_amdgcn_s_getreg((3 << 11) | 20) & 0xFu; }
#define XB_SPIN(cond, bar) do { unsigned _sp = 0; while (cond) { __builtin_amdgcn_s_sleep(1); \
    if ((++_sp & 255u) == 0u) { if (xb_ld(&(bar)[XB_TMO])) break; if (_sp > XB_SPIN_CAP) { atomicAdd(&(bar)[XB_TMO], 1u); break; } } } } while (0)
struct XcdBarrier { unsigned* bar; unsigned x; volatile LAS unsigned* st; };
__device__ __forceinline__ XcdBarrier xcd_barrier_post(unsigned* bar, volatile LAS unsigned* st) {
    XcdBarrier b; b.bar = bar; b.x = xb_xcc_id(); b.st = st;
    if (threadIdx.x == 0) (void)xb_add(&bar[XB_XCNT(b.x)], 1u);
    return b;
}
__device__ __forceinline__ void xcd_barrier_complete(unsigned* bar, unsigned x, unsigned& nloc, unsigned& nx) {
    const unsigned G = gridDim.x * gridDim.y * gridDim.z;
    unsigned sum, cnt, mine, sp = 0u;
    for (;;) {
        sum = 0u; cnt = 0u; mine = 0u;
#pragma unroll
        for (unsigned j = 0; j < 16; ++j) { const unsigned c = xb_ld(&bar[XB_XCNT(j)]); sum += c; cnt += (c > 0u) ? 1u : 0u; mine = (j == x) ? c : mine; }
        if (sum == G) break;
        __builtin_amdgcn_s_sleep(1);
        if ((++sp & 255u) == 0u) { if (xb_ld(&bar[XB_TMO])) break; if (sp > XB_SPIN_CAP) { atomicAdd(&bar[XB_TMO], 1u); break; } }
    }
    nloc = mine > 0u ? mine : 1u; nx = cnt > 0u ? cnt : 1u;
}
__device__ __forceinline__ void xcd_barrier(const XcdBarrier& b) {
    asm volatile("s_waitcnt vmcnt(0)" ::: "memory");
    __syncthreads();
    if (threadIdx.x == 0) {
        unsigned* bar = b.bar;
        __builtin_amdgcn_s_waitcnt(0);
        unsigned nloc = b.st[0], nx = b.st[1];
        if (nloc == 0u) { xcd_barrier_complete(bar, b.x, nloc, nx); b.st[0] = nloc; b.st[1] = nx; }
        const unsigned old = xb_add(&bar[XB_XSUB(b.x)], 1u);
        const unsigned gen = old / nloc;
        if (old + 1u == (gen + 1u) * nloc) {
            __builtin_amdgcn_fence(__ATOMIC_RELEASE, "agent");
            asm volatile("s_waitcnt vmcnt(0)" ::: "memory");
            const unsigned og = xb_add(&bar[XB_TOP], 1u);
            const unsigned tg = og / nx;
            if (og + 1u == (tg + 1u) * nx) xb_add(&bar[XB_TOPGEN], 1u);
            else XB_SPIN(xb_ld(&bar[XB_TOPGEN]) == tg, bar);
            __builtin_amdgcn_fence(__ATOMIC_ACQUIRE, "agent");
            xb_add(&bar[XB_XGEN(b.x)], 1u);
            asm volatile("s_waitcnt vmcnt(0)" ::: "memory");
        } else {
            XB_SPIN(xb_ld(&bar[XB_XGEN(b.x)]) == gen, bar);
            __builtin_amdgcn_fence(__ATOMIC_ACQUIRE, "agent");
            asm volatile("s_waitcnt vmcnt(0)" ::: "memory");
        }
    }
    __syncthreads();
}

constexpr int NWAVES = 8, NTHR = 512;
struct Frame {
    LAS unsigned char* lds;
    int wave, vcu, G;
    unsigned char* ws; float* out;
    const float *x, *c, *ctx, *c_ctx, *w_mod, *b_mod, *w_in, *sink, *pool_w, *pool_scale, *lgf, *lgb, *w_out, *ln1_g, *ln1_b, *ln2_g, *ln2_b;
    const float *fw_gate, *fw_up, *fw_down, *router, *mw_gate, *mw_up, *mw_down;
};
#define WSP(T, off) ((T*)(F.ws + (off)))

__device__ __forceinline__ void tile_to_lds(const float* W, int N, int k0, int n0, LAS float* scr, int lane) {
    const int rr = lane >> 3, c4 = (lane & 7) * 4; f32x4 v[8];
#pragma unroll
    for (int i = 0; i < 8; ++i) v[i] = *(const f32x4*)(W + (size_t)(k0 + 8 * i + rr) * N + n0 + c4);
#pragma unroll
    for (int i = 0; i < 8; ++i) { LAS float* d = scr + (8 * i + rr) * 33 + c4; d[0] = v[i][0]; d[1] = v[i][1]; d[2] = v[i][2]; d[3] = v[i][3]; }
    asm volatile("s_waitcnt lgkmcnt(0)" ::: "memory");
}
template <class RowMap>
__device__ __forceinline__ void transpose_item(const float* W, int K, int N, bf16* WT, const RowMap& rowmap, LAS float* scr, int item, int lane) {
    const int nblk = N / 32, kb = item / nblk, nb = item % nblk, k0 = 64 * kb, n0 = 32 * nb;
    tile_to_lds(W, N, k0, n0, scr, lane);
    const int c = lane & 7;
#pragma unroll
    for (int j = 0; j < 4; ++j) { const int n = (lane >> 3) + 8 * j; const LAS float* s = scr + (8 * c) * 33 + n;
        v4u o; o.x = pk2(s[0 * 33], s[1 * 33]); o.y = pk2(s[2 * 33], s[3 * 33]); o.z = pk2(s[4 * 33], s[5 * 33]); o.w = pk2(s[6 * 33], s[7 * 33]);
        *(GAS v4u*)(WT + (size_t)rowmap(n0 + n) * K + k0 + 8 * c) = o; }
    asm volatile("s_waitcnt lgkmcnt(0)" ::: "memory");
}
__device__ __forceinline__ unsigned pk4_fp8s(float a, float b, float c, float d, float s) { return pg8::pk4_fp8(a * s, b * s, c * s, d * s); }
template <class RowMap>
__device__ __forceinline__ void transpose_item8(const float* W, int K, int N, unsigned char* WT, const RowMap& rowmap, float scale, LAS float* scr, int item, int lane) {
    const int nblk = N / 32, kb = item / nblk, nb = item % nblk, k0 = 64 * kb, n0 = 32 * nb;
    tile_to_lds(W, N, k0, n0, scr, lane);
    const int c = lane & 7;
#pragma unroll
    for (int j = 0; j < 4; ++j) { const int n = (lane >> 3) + 8 * j; const LAS float* s = scr + (8 * c) * 33 + n;
        v2u o; o.x = pk4_fp8s(s[0 * 33], s[1 * 33], s[2 * 33], s[3 * 33], scale); o.y = pk4_fp8s(s[4 * 33], s[5 * 33], s[6 * 33], s[7 * 33], scale);
        *(GAS v2u*)(WT + (size_t)rowmap(n0 + n) * K + k0 + 8 * c) = o; }
    asm volatile("s_waitcnt lgkmcnt(0)" ::: "memory");
}
template <class RowMap>
__device__ __forceinline__ void colmax_item(const float* W, int N, unsigned* cmax, const RowMap& rowmap, int item, int lane) {
    const int nblk = N / 32, kb = item / nblk, nb = item % nblk, k0 = 64 * kb, n0 = 32 * nb;
    const int rr = lane >> 3, c4 = (lane & 7) * 4; f32x4 v[8];
#pragma unroll
    for (int i = 0; i < 8; ++i) v[i] = *(const f32x4*)(W + (size_t)(k0 + 8 * i + rr) * N + n0 + c4);
    float mx[4];
#pragma unroll
    for (int q = 0; q < 4; ++q) { float m = fabsf(v[0][q]);
#pragma unroll
        for (int i = 1; i < 8; ++i) m = fmaxf(m, fabsf(v[i][q]));
        m = fmaxf(m, __shfl_xor(m, 8)); m = fmaxf(m, __shfl_xor(m, 16)); m = fmaxf(m, __shfl_xor(m, 32)); mx[q] = m; }
    if (lane < 8) {
#pragma unroll
        for (int q = 0; q < 4; ++q) atomicMax(cmax + rowmap(n0 + c4 + q), __float_as_uint(mx[q])); }
}
__device__ __forceinline__ unsigned pk4_i8(float a, float b, float c, float d, float inv) {
    const int q0 = (int)__builtin_rintf(a * inv), q1 = (int)__builtin_rintf(b * inv), q2 = (int)__builtin_rintf(c * inv), q3 = (int)__builtin_rintf(d * inv);
    return (unsigned)(q0 & 255) | ((unsigned)(q1 & 255) << 8) | ((unsigned)(q2 & 255) << 16) | ((unsigned)(q3 & 255) << 24);
}
template <class RowMap>
__device__ __forceinline__ void transpose_item_q(const float* W, int K, int N, unsigned char* WT, const RowMap& rowmap, const unsigned* cmax, LAS float* scr, int item, int lane) {
    const int nblk = N / 32, kb = item / nblk, nb = item % nblk, k0 = 64 * kb, n0 = 32 * nb;
    tile_to_lds(W, N, k0, n0, scr, lane);
    const int c = lane & 7;
#pragma unroll
    for (int j = 0; j < 4; ++j) { const int n = (lane >> 3) + 8 * j; const LAS float* s = scr + (8 * c) * 33 + n; const int row = rowmap(n0 + n);
        const float mx = __uint_as_float(cmax[row]); const float inv = mx > 0.f ? 127.0f / mx : 0.f;
        v2u o; o.x = pk4_i8(s[0 * 33], s[1 * 33], s[2 * 33], s[3 * 33], inv); o.y = pk4_i8(s[4 * 33], s[5 * 33], s[6 * 33], s[7 * 33], inv);
        *(GAS v2u*)(WT + (size_t)row * K + k0 + 8 * c) = o; }
    asm volatile("s_waitcnt lgkmcnt(0)" ::: "memory");
}
struct MapId { __device__ __forceinline__ int operator()(int n) const { return n; } };
struct MapInProj {
    __device__ __forceinline__ int operator()(int n) const { if (n >= C_V) return n; const int dd = n & 31, j = dd & 15, x2 = dd >> 4; return (n & ~31) + 8 * (j >> 2) + 4 * x2 + (j & 3); } };
struct MapGU { int up; __device__ __forceinline__ int operator()(int n) const { return 256 * (n >> 7) + 128 * up + (n & 127); } };

__device__ __forceinline__ void p_prep(Frame& F) {
    const int tid = opq((int)threadIdx.x), lane = tid & 63, wave = F.wave;
    LAS float* sv = (LAS float*)F.lds;
    LAS float* red = sv + 1024 * 12;
    bool have_sv = false;
    for (int un = blockIdx.x; un < 2 * 96; un += F.G) {
        if (!have_sv) {
            for (int idx = tid; idx < 9 * 1024; idx += NTHR) { const int r = idx >> 10, k = idx & 1023; const float v = r < 8 ? F.c[r * 1024 + k] : F.c_ctx[k]; sv[k * 12 + r] = v / (1.0f + __expf(-v)); }
            have_sv = true; __syncthreads();
        }
        const int layer = un / 96, cc = un % 96, col = cc * 64 + lane;
        float acc[9];
#pragma unroll
        for (int r = 0; r < 9; ++r) acc[r] = 0.f;
        const float* wp = F.w_mod + ((size_t)layer * 1024 + wave * 128) * 6144 + col;
#pragma unroll 8
        for (int kk = 0; kk < 128; ++kk) { const float wv = wp[(size_t)kk * 6144]; const LAS float* s = sv + (wave * 128 + kk) * 12;
            const f32x4 s0 = *(const LAS f32x4*)s, s1 = *(const LAS f32x4*)(s + 4); const float s8 = s[8];
            acc[0] += s0[0] * wv; acc[1] += s0[1] * wv; acc[2] += s0[2] * wv; acc[3] += s0[3] * wv; acc[4] += s1[0] * wv; acc[5] += s1[1] * wv; acc[6] += s1[2] * wv; acc[7] += s1[3] * wv; acc[8] += s8 * wv; }
#pragma unroll
        for (int r = 0; r < 9; ++r) red[(wave * 9 + r) * 64 + lane] = acc[r];
        __syncthreads();
        for (int idx = tid; idx < 9 * 64; idx += NTHR) { const int r = idx >> 6, ln = idx & 63; float s = F.b_mod[layer * 6144 + cc * 64 + ln];
#pragma unroll
            for (int w = 0; w < 8; ++w) s += red[(w * 9 + r) * 64 + ln];
            WSP(float, WS_MOD)[(size_t)(layer * 9 + r) * 6144 + cc * 64 + ln] = s; }
        __syncthreads();
    }
    if (blockIdx.x == F.G - 1) { for (int idx = tid; idx < 1024; idx += NTHR) { const int pos = idx >> 4, j = idx & 15; const float inv = powf(10000.0f, -(float)j / 16.0f); const float ang = (float)pos * inv;
            WSP(float, WS_ROPE)[idx] = cosf(ang); WSP(float, WS_ROPE)[1024 + idx] = sinf(ang); } }
    __syncthreads();
    LAS float* scr = (LAS float*)(F.lds + wave * 16384);
    const int gw = F.vcu * NWAVES + wave, NGW = F.G * NWAVES;
    constexpr int I_IN = (D / 64) * (INW / 32), I_OUT = (D / 64) * (D / 32), I_GU = (D / 64) * (FF / 32), I_DN = (FF / 64) * (D / 32);
    constexpr int N_CVT = 2 * (I_IN + I_OUT) + I_DN, N_MAX = (MOEQ ? 1 + NE : 1) * 2 * I_GU;
    unsigned* cmax = WSP(unsigned, WS_CTL) + CW_CMAX;
    for (int it = gw; it < N_CVT + N_MAX; it += NGW) {
        int r = it;
#if INQ
        if (r < 2 * I_IN) { const int l = r / I_IN; colmax_item(F.w_in + (size_t)l * D * INW, INW, cmax + CM_WIN + l * INW, MapInProj{}, r % I_IN, lane); continue; } r -= 2 * I_IN;
#else
        if (r < 2 * I_IN) { const int l = r / I_IN; transpose_item(F.w_in + (size_t)l * D * INW, D, INW, WSP(bf16, WS_WIN) + (size_t)l * INW * D, MapInProj{}, scr, r % I_IN, lane); continue; } r -= 2 * I_IN;
#endif
        if (r < 2 * I_OUT) { const int l = r / I_OUT; transpose_item(F.w_out + (size_t)l * D * D, D, D, WSP(bf16, WS_WOUT) + (size_t)l * D * D, MapId{}, scr, r % I_OUT, lane); continue; } r -= 2 * I_OUT;
#if HID_FP8
        if (r < I_DN) { transpose_item8(F.fw_down, FF, D, WSP(unsigned char, WS_FD), MapId{}, 128.0f, scr, r, lane); continue; } r -= I_DN;
#else
        if (r < I_DN) { transpose_item(F.fw_down, FF, D, WSP(bf16, WS_FD), MapId{}, scr, r, lane); continue; } r -= I_DN;
#endif
        const int m = r / (2 * I_GU), up = (r / I_GU) & 1, item = r % I_GU;
        const float* w = m == 0 ? (up ? F.fw_up : F.fw_gate) : (up ? F.mw_up : F.mw_gate) + (size_t)(m - 1) * D * FF;
        colmax_item(w, FF, cmax + m * 2 * FF, MapGU{up}, item, lane);
    }
}
__device__ __forceinline__ void quant_dense_gu(Frame& F) {
    const int lane = opq((int)threadIdx.x) & 63; LAS float* scr = (LAS float*)(F.lds + F.wave * 16384);
    constexpr int I_GU = (D / 64) * (FF / 32);
    constexpr int I_IN = (D / 64) * (INW / 32);
    for (int it = F.vcu * NWAVES + F.wave; it < 2 * I_GU + (INQ ? 2 * I_IN : 0); it += F.G * NWAVES) {
        if (it < 2 * I_GU) { const int up = it / I_GU; transpose_item_q(up ? F.fw_up : F.fw_gate, D, FF, WSP(unsigned char, WS_FGU), MapGU{up}, WSP(unsigned, WS_CTL) + CW_CMAX, scr, it % I_GU, lane); }
        else { const int r = it - 2 * I_GU, l = r / I_IN; transpose_item_q(F.w_in + (size_t)l * D * INW, D, INW, WSP(unsigned char, WS_WIN) + (size_t)l * INW * D, MapInProj{}, WSP(unsigned, WS_CTL) + CW_CMAX + CM_WIN + l * INW, scr, r % I_IN, lane); } }
}
constexpr int CV_A = 3200, CV_B = 9100, CV_C = 12100, CV_E = 14700;
__device__ __forceinline__ void bg_convert(Frame& F, int first_wg, int n_wg, int it0 = 0, int it1 = 1 << 30) {
    const int lane = opq((int)threadIdx.x) & 63; LAS float* scr = (LAS float*)(F.lds + F.wave * 16384);
    constexpr int I_GU = (D / 64) * (FF / 32), I_DN = (FF / 64) * (D / 32), PER = 2 * I_GU + I_DN, TOTAL = NE * PER;
    int slot0, nslot, nslots;
    if (first_wg < 0) { const int b = (int)blockIdx.x; nslots = 1024; if (b < 128) { slot0 = 3 * b; nslot = 3; } else { slot0 = 384 + 5 * (b - 128); nslot = 5; } }
    else { const int j = (int)blockIdx.x - first_wg; if (j < 0 || j >= n_wg) return; slot0 = j; nslot = 1; nslots = n_wg; }
    for (int sl = 0; sl < nslot; ++sl)
    for (int it = it0 + (slot0 + sl) * NWAVES + F.wave; it < (it1 < TOTAL ? it1 : TOTAL); it += nslots * NWAVES) { const int m = it / PER; int r = it % PER;
        unsigned char* gu = WSP(unsigned char, WS_MGU8) + (size_t)m * 2 * FF * D; unsigned char* dn = WSP(unsigned char, WS_MD8) + (size_t)m * FF * D;
        const unsigned* cm = WSP(unsigned, WS_CTL) + CW_CMAX + (1 + m) * 2 * FF;
#if MOEQ
        if (r < I_GU) { transpose_item_q(F.mw_gate + (size_t)m * D * FF, D, FF, gu, MapGU{0}, cm, scr, r, lane); continue; } r -= I_GU;
        if (r < I_GU) { transpose_item_q(F.mw_up + (size_t)m * D * FF, D, FF, gu, MapGU{1}, cm, scr, r, lane); continue; } r -= I_GU;
#else
        (void)cm;
        if (r < I_GU) { transpose_item8(F.mw_gate + (size_t)m * D * FF, D, FF, gu, MapGU{0}, 32.0f, scr, r, lane); continue; } r -= I_GU;
        if (r < I_GU) { transpose_item8(F.mw_up + (size_t)m * D * FF, D, FF, gu, MapGU{1}, 32.0f, scr, r, lane); continue; } r -= I_GU;
#endif
        transpose_item8(F.mw_down + (size_t)m * FF * D, FF, D, dn, MapId{}, 128.0f, scr, r, lane); }
}

__device__ __forceinline__ void row_load_f32(const float* p, int lane, f32x4 (&v)[4]) {
#pragma unroll
    for (int j = 0; j < 4; ++j) v[j] = *(const f32x4*)(p + 4 * lane + 256 * j);
}
__device__ __forceinline__ void row_load_bf16(const bf16* p, int lane, f32x4 (&v)[4]) {
#pragma unroll
    for (int j = 0; j < 4; ++j) { const v2u w = *(const v2u*)(p + 4 * lane + 256 * j); v[j] = (f32x4){bflo(w.x), bfhi(w.x), bflo(w.y), bfhi(w.y)}; }
}
__device__ __forceinline__ void row_store_bf16(bf16* p, int lane, const f32x4 (&v)[4]) {
#pragma unroll
    for (int j = 0; j < 4; ++j) { v2u w; w.x = pk2(v[j][0], v[j][1]); w.y = pk2(v[j][2], v[j][3]); *(v2u*)(p + 4 * lane + 256 * j) = w; }
}
__device__ __forceinline__ void row_store_f32(float* p, int lane, const f32x4 (&v)[4]) {
#pragma unroll
    for (int j = 0; j < 4; ++j) *(f32x4*)(p + 4 * lane + 256 * j) = v[j];
}
__device__ __forceinline__ void row_ln(f32x4 (&v)[4], const float* g, const float* b, int lane) {
    float s = 0.f;
#pragma unroll
    for (int j = 0; j < 4; ++j) s += (v[j][0] + v[j][1]) + (v[j][2] + v[j][3]);
    const float mean = wave_sum(s) * (1.0f / D); float q = 0.f;
#pragma unroll
    for (int j = 0; j < 4; ++j) { v[j] = v[j] - mean; q += (v[j][0] * v[j][0] + v[j][1] * v[j][1]) + (v[j][2] * v[j][2] + v[j][3] * v[j][3]); }
    const float rstd = 1.0f / sqrtf(wave_sum(q) * (1.0f / D) + LN_EPS);
#pragma unroll
    for (int j = 0; j < 4; ++j) { const f32x4 gg = *(const f32x4*)(g + 4 * lane + 256 * j), bb = *(const f32x4*)(b + 4 * lane + 256 * j); v[j] = v[j] * rstd * gg + bb; }
}
__device__ __forceinline__ const float* modp(Frame& F, int layer, int mr, int part) { return WSP(float, WS_MOD) + (size_t)(layer * 9 + mr) * 6144 + part * 1024; }
__device__ __forceinline__ void row_modulate(f32x4 (&v)[4], const float* sh, const float* sc, int lane) {
#pragma unroll
    for (int j = 0; j < 4; ++j) { const f32x4 a = *(const f32x4*)(sc + 4 * lane + 256 * j), b = *(const f32x4*)(sh + 4 * lane + 256 * j); v[j] = v[j] * (1.0f + a) + b; }
}
__device__ __forceinline__ void res_load(Frame& F, int r, int lane, f32x4 (&v)[4]) {
#if RES16
    row_load_bf16(WSP(bf16, WS_X16) + (size_t)r * D, lane, v);
#else
    row_load_f32(r < NL ? F.out + (size_t)r * D : WSP(float, WS_XC) + (size_t)(r - NL) * D, lane, v);
#endif
}
__device__ __forceinline__ void res_store(Frame& F, int r, int lane, const f32x4 (&v)[4]) {
#if RES16
    row_store_bf16(WSP(bf16, WS_X16) + (size_t)r * D, lane, v);
#else
    row_store_f32(r < NL ? F.out + (size_t)r * D : WSP(float, WS_XC) + (size_t)(r - NL) * D, lane, v);
#endif
}
__device__ __forceinline__ void row_store_q8(unsigned char* p, float* st, int lane, const f32x4 (&v)[4]) {
    float mx = 0.f;
#pragma unroll
    for (int j = 0; j < 4; ++j) mx = fmaxf(fmaxf(mx, fmaxf(fabsf(v[j][0]), fabsf(v[j][1]))), fmaxf(fabsf(v[j][2]), fabsf(v[j][3])));
    mx = wave_max_abs(mx);
    const float inv = mx > 0.f ? 127.0f / mx : 0.f;
#pragma unroll
    for (int j = 0; j < 4; ++j) *(unsigned*)(p + 4 * lane + 256 * j) = pk4_i8(v[j][0], v[j][1], v[j][2], v[j][3], inv);
    if (lane == 0) *st = mx * (1.0f / 127.0f);
}
__device__ __forceinline__ void p_h0(Frame& F) {
    const int gw = F.vcu * NWAVES + F.wave, NGW = F.G * NWAVES, lane = (opq((int)threadIdx.x) & 63);
    for (int r = gw; r < MT; r += NGW) { const int mr = r < NL ? (r >> 12) : 8; const float* xr = r < NL ? F.x + (size_t)r * D : F.ctx + (size_t)(r - NL) * D;
        f32x4 v[4]; row_load_f32(xr, lane, v); row_modulate(v, modp(F, 0, mr, 0), modp(F, 0, mr, 1), lane);
#if INQ
        row_store_q8(WSP(unsigned char, WS_T8L0) + (size_t)r * D, WSP(float, WS_SH) + r, lane, v); }
#else
        row_store_bf16(WSP(bf16, WS_ACT) + (size_t)r * D, lane, v); }
#endif
}
__device__ __forceinline__ void p_ln1(Frame& F, int layer) {
    const int lane = (opq((int)threadIdx.x) & 63);
    if (layer == 0) {
        const int gw = F.vcu * NWAVES + F.wave, NGW = F.G * NWAVES;
#if ((REP_MASK) >> 15) & 1
        for (int r = gw; r < MT; r += NGW) { const int mr = r < NL ? (r >> 12) : 8; const float* xr = r < NL ? F.x + (size_t)r * D : F.ctx + (size_t)(r - NL) * D;
            bf16* ar = WSP(bf16, WS_ACT) + (size_t)r * D;
            f32x4 v[4], y[4]; row_load_f32(xr, lane, v); row_load_bf16(ar, lane, y); const float* g1 = modp(F, 0, mr, 2);
#pragma unroll
            for (int j = 0; j < 4; ++j) v[j] = ALPHA * v[j] + *(const f32x4*)(g1 + 4 * lane + 256 * j) * y[j];
            row_ln(v, F.ln1_g, F.ln1_b, lane); row_store_bf16(WSP(bf16, WS_PROJ) + (size_t)r * D, lane, v);
            row_modulate(v, modp(F, 0, mr, 3), modp(F, 0, mr, 4), lane);
            row_store_q8(WSP(unsigned char, WS_PROJ) + 80 * MiB + (size_t)r * D, (float*)(WSP(unsigned char, WS_PROJ) + 118 * MiB) + r, lane, v);
        }
        __syncthreads();
#endif
        for (int r_ = gw; r_ < MT; r_ += NGW) { const int r = (REV_MASK & 8) ? MT - 1 - r_ : r_;
            const int mr = r < NL ? (r >> 12) : 8;
            bf16* ar = WSP(bf16, WS_ACT) + (size_t)r * D;
#if RESADD
            f32x4 v[4]; row_load_bf16(ar, lane, v);
#else
            const float* xr = r < NL ? F.x + (size_t)r * D : F.ctx + (size_t)(r - NL) * D;
            f32x4 v[4], y[4]; row_load_f32(xr, lane, v); row_load_bf16(ar, lane, y); const float* g1 = modp(F, 0, mr, 2);
#pragma unroll
            for (int j = 0; j < 4; ++j) v[j] = ALPHA * v[j] + *(const f32x4*)(g1 + 4 * lane + 256 * j) * y[j];
#endif
            row_ln(v, F.ln1_g, F.ln1_b, lane); res_store(F, r, lane, v);
            row_modulate(v, modp(F, 0, mr, 3), modp(F, 0, mr, 4), lane);
            row_store_q8(WSP(unsigned char, WS_T8L0) + (size_t)r * D, WSP(float, WS_ST) + r, lane, v);
        }
        return;
    }
    LAS int* lcnt = (LAS int*)F.lds; LAS int* lbase = lcnt + 8; LAS int* rinfo = lcnt + 16;
    float rt[16][8];
#pragma unroll
    for (int j = 0; j < 4; ++j)
#pragma unroll
        for (int q = 0; q < 4; ++q) { const float* rp = F.router + (size_t)(4 * lane + 256 * j + q) * 8; const f32x4 a = *(const f32x4*)rp, b = *(const f32x4*)(rp + 4);
            rt[j * 4 + q][0] = a[0]; rt[j * 4 + q][1] = a[1]; rt[j * 4 + q][2] = a[2]; rt[j * 4 + q][3] = a[3]; rt[j * 4 + q][4] = b[0]; rt[j * 4 + q][5] = b[1]; rt[j * 4 + q][6] = b[2]; rt[j * 4 + q][7] = b[3]; }
    for (int rb = blockIdx.x; rb < NL / 128; rb += F.G) {
        if ((int)threadIdx.x < 8) lcnt[threadIdx.x] = 0;
        __syncthreads();
#if ((REP_MASK) >> 14) & 1
        for (int ii = 0; ii < 32; ++ii) { const int i = ii >> 1; const bool real = (ii & 1) != 0;
#else
        for (int i = 0; i < 16; ++i) { const bool real = true;
#endif
            const int rl = F.wave * 16 + i, r = rb * 128 + rl, mr = r >> 12;
            bf16* ar = WSP(bf16, WS_ACT) + (size_t)r * D;
#if RESADD
            f32x4 v[4]; row_load_bf16(ar, lane, v);
#else
            f32x4 v[4], y[4]; res_load(F, r, lane, v); row_load_bf16(ar, lane, y); const float* g1 = modp(F, 1, mr, 2);
#pragma unroll
            for (int j = 0; j < 4; ++j) v[j] = ALPHA * v[j] + *(const f32x4*)(g1 + 4 * lane + 256 * j) * y[j];
#endif
            row_ln(v, F.ln1_g + D, F.ln1_b + D, lane); if (real) res_store(F, r, lane, v); else row_store_bf16(WSP(bf16, WS_PROJ) + (size_t)r * D, lane, v);
            row_modulate(v, modp(F, 1, mr, 3), modp(F, 1, mr, 4), lane);
#if MOEQ
            row_store_q8(WSP(unsigned char, WS_T8) + (size_t)r * D, WSP(float, WS_ST) + r, lane, v);
#else
            { unsigned char* t8 = (real ? WSP(unsigned char, WS_T8) : WSP(unsigned char, WS_PROJ) + 80 * MiB) + (size_t)r * D;
#pragma unroll
              for (int j = 0; j < 4; ++j) *(unsigned*)(t8 + 4 * lane + 256 * j) = pk4_fp8s(v[j][0], v[j][1], v[j][2], v[j][3], 4.0f); }
#endif
            float lg[8];
#pragma unroll
            for (int e = 0; e < 8; ++e) { float s = 0.f;
#pragma unroll
                for (int j = 0; j < 4; ++j)
#pragma unroll
                    for (int q = 0; q < 4; ++q) s += v[j][q] * rt[j * 4 + q][e];
                lg[e] = wave_sum(s); }
            int i1 = 0; float v1 = lg[0];
#pragma unroll
            for (int e = 1; e < 8; ++e) if (lg[e] > v1) { v1 = lg[e]; i1 = e; }
            int i2 = -1; float v2 = -3.0e38f;
#pragma unroll
            for (int e = 0; e < 8; ++e) if (e != i1 && lg[e] > v2) { v2 = lg[e]; i2 = e; }
            const float ex = __expf(v2 - v1), w1 = 1.0f / (1.0f + ex), w2 = ex / (1.0f + ex);
            if (lane == 0 && real) { const int p1 = __hip_atomic_fetch_add(lcnt + i1, 1, __ATOMIC_RELAXED, __HIP_MEMORY_SCOPE_WORKGROUP), p2 = __hip_atomic_fetch_add(lcnt + i2, 1, __ATOMIC_RELAXED, __HIP_MEMORY_SCOPE_WORKGROUP);
                LAS int* ri = rinfo + rl * 6; ri[0] = i1; ri[1] = p1; ri[2] = __float_as_int(w1); ri[3] = i2; ri[4] = p2; ri[5] = __float_as_int(w2); }
        }
        __syncthreads();
        if ((int)threadIdx.x < 8) lbase[threadIdx.x] = (int)__hip_atomic_fetch_add((unsigned*)(WSP(unsigned, WS_CTL) + CW_GCNT + 64 * threadIdx.x), (unsigned)lcnt[threadIdx.x], RLX_AGENT);
        __syncthreads();
        if ((int)threadIdx.x < 256) { const int rl = (int)threadIdx.x >> 1, s = (int)threadIdx.x & 1; const LAS int* ri = rinfo + rl * 6 + 3 * s; const int e = ri[0], pos = lbase[e] + ri[1];
            WSP(int, WS_LIST)[e * LCAP + pos] = ((rb * 128 + rl) << 1) | s; WSP(float, WS_LGATE)[e * LCAP + pos] = __int_as_float(ri[2]); }
        __syncthreads();
    }
}
__device__ __forceinline__ void p_route(Frame& F) {
    const int tid = opq((int)threadIdx.x);
    LAS int* lcnt = (LAS int*)F.lds; LAS int* lbase = lcnt + 8; LAS int* rinfo = lcnt + 16;
    const float* pl = WSP(float, WS_PLOG);
    for (int rb = blockIdx.x; rb < NL / 128; rb += F.G) {
        if (tid < 8) lcnt[tid] = 0;
        __syncthreads();
        if (tid < 128) { const int r = rb * 128 + tid; float lg[8];
#pragma unroll
            for (int e = 0; e < 8; ++e) lg[e] = 0.f;
#pragma unroll
            for (int pn = 0; pn < 4; ++pn) { const f32x4 a = *(const f32x4*)(pl + ((size_t)pn * NL + r) * 8), b = *(const f32x4*)(pl + ((size_t)pn * NL + r) * 8 + 4);
                lg[0] += a[0]; lg[1] += a[1]; lg[2] += a[2]; lg[3] += a[3]; lg[4] += b[0]; lg[5] += b[1]; lg[6] += b[2]; lg[7] += b[3]; }
            int i1 = 0; float v1 = lg[0];
#pragma unroll
            for (int e = 1; e < 8; ++e) if (lg[e] > v1) { v1 = lg[e]; i1 = e; }
            int i2 = -1; float v2 = -3.0e38f;
#pragma unroll
            for (int e = 0; e < 8; ++e) if (e != i1 && lg[e] > v2) { v2 = lg[e]; i2 = e; }
            const float ex = __expf(v2 - v1), w1 = 1.0f / (1.0f + ex), w2 = ex / (1.0f + ex);
            const int p1 = __hip_atomic_fetch_add(lcnt + i1, 1, __ATOMIC_RELAXED, __HIP_MEMORY_SCOPE_WORKGROUP), p2 = __hip_atomic_fetch_add(lcnt + i2, 1, __ATOMIC_RELAXED, __HIP_MEMORY_SCOPE_WORKGROUP);
            LAS int* ri = rinfo + tid * 6; ri[0] = i1; ri[1] = p1; ri[2] = __float_as_int(w1); ri[3] = i2; ri[4] = p2; ri[5] = __float_as_int(w2); }
        __syncthreads();
        if (tid < 8) lbase[tid] = (int)__hip_atomic_fetch_add((unsigned*)(WSP(unsigned, WS_CTL) + CW_GCNT + 64 * tid), (unsigned)lcnt[tid], RLX_AGENT);
        __syncthreads();
        if (tid < 256) { const int rl = tid >> 1, s = tid & 1; const LAS int* ri = rinfo + rl * 6 + 3 * s; const int e = ri[0], pos = lbase[e] + ri[1];
            WSP(int, WS_LIST)[e * LCAP + pos] = ((rb * 128 + rl) << 1) | s; WSP(float, WS_LGATE)[e * LCAP + pos] = __int_as_float(ri[2]); }
        __syncthreads();
    }
}
__device__ __forceinline__ void p_ln2_l0(Frame& F) {
    const int lane = (opq((int)threadIdx.x) & 63), gw = F.vcu * NWAVES + F.wave, NGW = F.G * NWAVES;
#if ((REP_MASK) >> 12) & 1
    for (int r = gw; r < MT; r += NGW) { const int mr = r < NL ? (r >> 12) : 8;
        bf16* ar = WSP(bf16, WS_ACT) + (size_t)r * D;
        f32x4 v[4], y[4]; res_load(F, r, lane, v); row_load_bf16(ar, lane, y); const float* g2 = modp(F, 0, mr, 5);
#pragma unroll
        for (int j = 0; j < 4; ++j) v[j] = ALPHA * v[j] + *(const f32x4*)(g2 + 4 * lane + 256 * j) * y[j];
        row_ln(v, F.ln2_g, F.ln2_b, lane); row_store_bf16(WSP(bf16, WS_HID) + (size_t)r * D, lane, v);
        row_modulate(v, modp(F, 1, mr, 0), modp(F, 1, mr, 1), lane);
        row_store_q8(WSP(unsigned char, WS_HID) + 80 * MiB + (size_t)r * D, (float*)(WSP(unsigned char, WS_HID) + 120 * MiB) + r, lane, v); }
    __syncthreads();
#endif
    for (int r = gw; r < MT; r += NGW) { const int mr = r < NL ? (r >> 12) : 8;
        bf16* ar = WSP(bf16, WS_ACT) + (size_t)r * D;
#if RESADD
        f32x4 v[4]; row_load_bf16(ar, lane, v);
#else
        f32x4 v[4], y[4]; res_load(F, r, lane, v); row_load_bf16(ar, lane, y); const float* g2 = modp(F, 0, mr, 5);
#pragma unroll
        for (int j = 0; j < 4; ++j) v[j] = ALPHA * v[j] + *(const f32x4*)(g2 + 4 * lane + 256 * j) * y[j];
#endif
        row_ln(v, F.ln2_g, F.ln2_b, lane); res_store(F, r, lane, v);
        row_modulate(v, modp(F, 1, mr, 0), modp(F, 1, mr, 1), lane);
#if INQ
        row_store_q8(WSP(unsigned char, WS_T8L0) + (size_t)r * D, WSP(float, WS_SH) + r, lane, v); }
#else
        row_store_bf16(ar, lane, v); }
#endif
}
__device__ __forceinline__ void p_final(Frame& F) {
    const int lane = (opq((int)threadIdx.x) & 63), gw = F.vcu * NWAVES + F.wave, NGW = F.G * NWAVES;
    for (int r = gw; r < NL; r += NGW) { const int mr = r >> 12; float* xo = F.out + (size_t)r * D;
        f32x4 v[4], y0[4], y1[4]; res_load(F, r, lane, v); row_load_bf16(WSP(bf16, WS_Y) + (size_t)r * D, lane, y0); row_load_bf16(WSP(bf16, WS_Y) + (size_t)(NL + r) * D, lane, y1); const float* g2 = modp(F, 1, mr, 5);
#pragma unroll
        for (int j = 0; j < 4; ++j) v[j] = ALPHA * v[j] + *(const f32x4*)(g2 + 4 * lane + 256 * j) * (y0[j] + y1[j]);
        row_ln(v, F.ln2_g + D, F.ln2_b + D, lane);
#if defined(ATTN_CHECK) || defined(MIX_CHECK)
        if ((__hip_atomic_load(WSP(unsigned, WS_CTL) + 8, RLX_AGENT) | __hip_atomic_load(WSP(unsigned, WS_CTL) + 9, RLX_AGENT) * CHK_POOL | __hip_atomic_load(WSP(unsigned, WS_CTL) + 10, RLX_AGENT) * CHK_KV | __hip_atomic_load(WSP(unsigned, WS_CTL) + 11, RLX_AGENT) * CHK_RET) != 0u) { const float qn = 0.0f;
#pragma unroll
            for (int j = 0; j < 4; ++j) v[j] = (f32x4){qn, qn, qn, qn}; }
#endif
        row_store_f32(xo, lane, v); }
}

__device__ __forceinline__ int chunk_row0(int b, int cid) { return cid < 2 ? NL + b * CTXL + cid * 128 : b * SEQ + (cid - 2) * 128; }
namespace att {
using bf16x8 = __attribute__((ext_vector_type(8))) short;
using s16x4 = __attribute__((ext_vector_type(4))) short;
using f32x16 = __attribute__((ext_vector_type(16))) float;
using u32x4 = __attribute__((ext_vector_type(4))) unsigned;
typedef short v4i16_t __attribute__((ext_vector_type(4)));
typedef __attribute__((address_space(3))) const char* lds_cptr;
constexpr int SLOTB = 8192, LDS_K = 0, LDS_V = 2 * SLOTB, LDS_WS = 4 * SLOTB, LDS_OST = LDS_WS + 8 * 256, LDS_TOTAL = LDS_OST + 8 * 4096;
constexpr float THR = 8.0f, NEGBIG = -1.0e30f;
__device__ __forceinline__ int crow(int r, int hi) { return (r & 3) + 8 * (r >> 2) + 4 * hi; }
__device__ __forceinline__ void glds16(const void* gsrc, unsigned lds_dst) { unsigned keep;
    asm volatile("s_mov_b32 %0, m0\n\ts_mov_b32 m0, %2\n\ts_nop 0\n\tglobal_load_lds_dwordx4 %1, off\n\ts_mov_b32 m0, %0" : "=&s"(keep) : "v"(gsrc), "s"(lds_dst) : "memory"); }
__device__ __forceinline__ s16x4 vtr(lds_cptr p) { return __builtin_bit_cast(s16x4, __builtin_amdgcn_ds_read_tr16_b64_v4i16((__attribute__((address_space(3))) v4i16_t*)p)); }
__device__ __forceinline__ unsigned cvtpk(float lo, float hi) { f32x2_t v = {lo, hi}; bf16x2_t b = __builtin_convertvector(v, bf16x2_t); return __builtin_bit_cast(unsigned, b); }

__device__ __forceinline__ void attn_unit(Frame& F, int layer, int b, int qb, int kvh, bool isctx) {
    const int tid = opq((int)threadIdx.x), lane = tid & 63, r32 = lane & 31, hi = lane >> 5; const int wid = __builtin_amdgcn_readfirstlane(tid >> 6);
    const int g = wid >> 1, qh = wid & 1, head = kvh * 4 + g;
    const bf16* P = WSP(bf16, WS_PROJ);
    const int qrow0 = (isctx ? NL + b * CTXL : b * SEQ) + qb * 128 + qh * 64;
    const int tlo = isctx ? 0 : (qb == 0 ? 2 : 0), thi = isctx ? 0 : (qb == SEQ / 128 - 1 ? 4 : 6), nloc = thi - tlo, ntiles = nloc + 4;
    const lds_cptr shm = (lds_cptr)F.lds; const unsigned lds0 = (unsigned)(uintptr_t)F.lds;
    LAS float* wsf = (LAS float*)(F.lds + LDS_WS) + wid * 64;
    bf16x8 qr[2][4];
#pragma unroll
    for (int rb = 0; rb < 2; ++rb)
#pragma unroll
        for (int d0 = 0; d0 < 4; ++d0) qr[rb][d0] = *(const bf16x8*)(P + (size_t)(qrow0 + 32 * rb + r32) * INW + head * 64 + d0 * 16 + hi * 8);
    __builtin_amdgcn_s_waitcnt(0x0F70);
    float m[2], l[2]; f32x16 o[2][2];
    { const float s0 = F.sink[layer * 8 + head] * LOG2E;
#pragma unroll
      for (int rb = 0; rb < 2; ++rb) { m[rb] = s0; l[rb] = hi == 0 ? 1.0f : 0.0f; o[rb][0] = f32x16{}; o[rb][1] = f32x16{}; } }
    auto tile_row = [&](int i) -> int { return i < nloc ? b * SEQ + qb * 128 - 128 + 64 * (tlo + i) : NL + b * CTXL + 64 * (i - nloc); };
    auto dma = [&](int i) { const int kr = tile_row(i); const unsigned slot = (unsigned)(i & 1) * SLOTB;
        glds16(P + (size_t)(kr + lane) * INW + C_K + kvh * 64 + wid * 8, (unsigned)__builtin_amdgcn_readfirstlane(lds0 + LDS_K + slot + wid * 1024));
        glds16(P + (size_t)(kr + 16 * (wid & 3) + (lane >> 2)) * INW + C_V + kvh * 64 + (wid >> 2) * 32 + (lane & 3) * 8, (unsigned)__builtin_amdgcn_readfirstlane(lds0 + LDS_V + slot + wid * 1024)); };
    dma(0);
    for (int i = 0; i < ntiles; ++i) {
        if (i + 1 < ntiles) { dma(i + 1); asm volatile("s_waitcnt vmcnt(2)\n\ts_barrier" ::: "memory"); }
        else asm volatile("s_waitcnt vmcnt(0)\n\ts_barrier" ::: "memory");
        const lds_cptr kp = shm + LDS_K + (i & 1) * SLOTB + hi * 1024 + r32 * 16;
        const lds_cptr vp = shm + LDS_V + (i & 1) * SLOTB + ((lane >> 4) & 1) * 32 + (lane & 3) * 8 + (4 * hi + ((lane & 15) >> 2)) * 64;
        const bool local = i < nloc; const int c = local ? 128 - 64 * (tlo + i) : 0;
        bool act[2], partial[2]; f32x16 p0[2], p1[2];
#pragma unroll
        for (int rb = 0; rb < 2; ++rb) { const int q0 = qh * 64 + rb * 32; act[rb] = true; partial[rb] = false;
            if (local) { const int dlo = q0 - 63 + c, dhi = q0 + 31 + c; act[rb] = !(dlo > 128 || dhi < -128); partial[rb] = !(dlo >= -128 && dhi <= 128); } }
#pragma unroll
        for (int rb = 0; rb < 2; ++rb) { if (!act[rb]) continue;
            { const float nm = -m[rb];
#pragma unroll
              for (int r = 0; r < 16; ++r) { p0[rb][r] = nm; p1[rb][r] = nm; } }
#pragma unroll
            for (int d0 = 0; d0 < 4; ++d0) { const bf16x8 k0 = *(const __attribute__((address_space(3))) bf16x8*)(kp + d0 * 2048), k1 = *(const __attribute__((address_space(3))) bf16x8*)(kp + d0 * 2048 + 512);
                p0[rb] = __builtin_amdgcn_mfma_f32_32x32x16_bf16(k0, qr[rb][d0], p0[rb], 0, 0, 0); p1[rb] = __builtin_amdgcn_mfma_f32_32x32x16_bf16(k1, qr[rb][d0], p1[rb], 0, 0, 0); } }
#pragma unroll
        for (int rb = 0; rb < 2; ++rb) { if (!act[rb]) continue;
            const int q0 = qh * 64 + rb * 32;
            if (partial[rb]) { const int qq = q0 + r32 + c;
#pragma unroll
                for (int r = 0; r < 16; ++r) { const int dl = qq - crow(r, hi); if (dl > 128 || dl < -128) p0[rb][r] = NEGBIG; if (dl - 32 > 128 || dl - 32 < -128) p1[rb][r] = NEGBIG; } }
            float rm = fmaxf(p0[rb][0], p1[rb][0]);
#pragma unroll
            for (int r = 1; r < 16; ++r) rm = fmaxf(rm, fmaxf(p0[rb][r], p1[rb][r]));
            { auto rr = __builtin_amdgcn_permlane32_swap(__float_as_uint(rm), __float_as_uint(rm), false, false); rm = fmaxf(__uint_as_float(rr[0]), __uint_as_float(rr[1])); }
            if (__any(rm > THR)) {
                const float dl = fmaxf(rm, 0.f); m[rb] += dl;
#pragma unroll
                for (int r = 0; r < 16; ++r) { p0[rb][r] -= dl; p1[rb][r] -= dl; }
                const float f = __builtin_amdgcn_exp2f(-dl); l[rb] *= f; if (hi == 0) wsf[r32] = f;
                asm volatile("s_waitcnt lgkmcnt(0)" ::: "memory");
#pragma unroll
                for (int r = 0; r < 16; ++r) { const float fr = wsf[crow(r, hi)]; o[rb][0][r] *= fr; o[rb][1][r] *= fr; }
            }
            float sacc = 0.f;
#pragma unroll
            for (int r = 0; r < 16; ++r) { p0[rb][r] = __builtin_amdgcn_exp2f(p0[rb][r]); p1[rb][r] = __builtin_amdgcn_exp2f(p1[rb][r]); sacc += p0[rb][r] + p1[rb][r]; }
            l[rb] += sacc;
            u32x4 pw[4];
#pragma unroll
            for (int k = 0; k < 4; ++k) { pw[0][k] = cvtpk(p0[rb][2 * k], p0[rb][2 * k + 1]); pw[1][k] = cvtpk(p0[rb][8 + 2 * k], p0[rb][9 + 2 * k]); pw[2][k] = cvtpk(p1[rb][2 * k], p1[rb][2 * k + 1]); pw[3][k] = cvtpk(p1[rb][8 + 2 * k], p1[rb][9 + 2 * k]); }
#pragma unroll
            for (int d0 = 0; d0 < 2; ++d0) {
#pragma unroll
                for (int ks = 0; ks < 4; ++ks) { const s16x4 lo = vtr(vp + d0 * 4096 + ks * 1024), hh = vtr(vp + d0 * 4096 + ks * 1024 + 512);
                    const bf16x8 vf = (bf16x8){lo[0], lo[1], lo[2], lo[3], hh[0], hh[1], hh[2], hh[3]};
                    o[rb][d0] = __builtin_amdgcn_mfma_f32_32x32x16_bf16(__builtin_bit_cast(bf16x8, pw[ks]), vf, o[rb][d0], 0, 0, 0); } }
        }
        asm volatile("s_waitcnt lgkmcnt(0)\n\ts_barrier" ::: "memory");
    }
    LAS bf16* stg = (LAS bf16*)(F.lds + LDS_OST) + wid * 2048;
#pragma unroll
    for (int rb = 0; rb < 2; ++rb) {
        float lt = l[rb]; { auto rr = __builtin_amdgcn_permlane32_swap(__float_as_uint(lt), __float_as_uint(lt), false, false); lt = __uint_as_float(rr[0]) + __uint_as_float(rr[1]); }
        if (hi == 0) wsf[r32] = 1.0f / lt;
        asm volatile("s_waitcnt lgkmcnt(0)" ::: "memory");
#pragma unroll
        for (int r = 0; r < 16; ++r) { const float rl = wsf[crow(r, hi)]; const int orow = crow(r, hi);
            stg[orow * 64 + r32] = (bf16)(pk2(o[rb][0][r] * rl, 0.f) & 0xffffu); stg[orow * 64 + 32 + r32] = (bf16)(pk2(o[rb][1][r] * rl, 0.f) & 0xffffu); }
        asm volatile("s_waitcnt lgkmcnt(0)" ::: "memory");
        bf16* Ow = WSP(bf16, WS_MIX) + (size_t)(qrow0 + 32 * rb) * D + head * 64;
#pragma unroll
        for (int k = 0; k < 4; ++k) { const int row = k * 8 + (lane >> 3), ch = lane & 7; const v4u v = *(const LAS v4u*)(stg + row * 64 + ch * 8); *(v4u*)(Ow + (size_t)row * D + ch * 8) = v; }
        asm volatile("s_waitcnt lgkmcnt(0)" ::: "memory");
    }
}
}
__device__ __forceinline__ void p_attn(Frame& F, int layer) {
    const int vcu = (blockIdx.x % 8) * (F.G / 8) + blockIdx.x / 8;
    for (int u = vcu * 2; u < 512; u += 2 * F.G) { att::attn_unit(F, layer, u >> 6, (u >> 1) & 31, u & 1, false); att::attn_unit(F, layer, (u + 1) >> 6, ((u + 1) >> 1) & 31, (u + 1) & 1, false); }
    if (layer == 0) for (int v = blockIdx.x; v < 32; v += F.G) att::attn_unit(F, layer, v >> 2, (v >> 1) & 1, v & 1, true);
}
namespace att2 {
using bf16=unsigned short;
using bf16x8=__attribute__((ext_vector_type(8)))short;
using s16x4=__attribute__((ext_vector_type(4)))short;
using f32x16=__attribute__((ext_vector_type(16)))float;
using u32x4=__attribute__((ext_vector_type(4)))unsigned;
constexpr int NW=8,QBLK=32,KVBLK=64;
__device__ __forceinline__ int crow(int r,int hi){return (r&3)+8*(r>>2)+4*hi;}
#define SBAR() __builtin_amdgcn_sched_barrier(0)
__device__ __forceinline__ void wmask(f32x16&p0,f32x16&p1,int c,int qq,int hi){
  const float NEG=-INFINITY; const int d0=qq+c-4*hi;
  #pragma unroll
  for(int r=0;r<16;++r){const int dl=d0-((r&3)+8*(r>>2)); if(dl>128||dl<-128)p0[r]=NEG; if(dl-32>128||dl-32<-128)p1[r]=NEG;}
}

constexpr int NSLOT=3, SLOTB=8192;
constexpr int LDS_K=0, LDS_V=NSLOT*SLOTB, LDS_WS=2*NSLOT*SLOTB, LDS_OST=LDS_WS+NW*64*4, LDS_BYTES=LDS_OST+NW*4096;
constexpr float C2=0.125f*1.4426950408889634f;
__device__ __forceinline__ void glds16(const void*gsrc,unsigned lds_dst){unsigned keep;
  asm volatile("s_mov_b32 %0, m0\n\ts_mov_b32 m0, %2\n\ts_nop 0\n\tglobal_load_lds_dwordx4 %1, off\n\ts_mov_b32 m0, %0":"=&s"(keep):"v"(gsrc),"s"(lds_dst):"memory");}
__device__ __forceinline__ float max3f(float a,float b,float c){float r;asm("v_max3_f32 %0, %1, %2, %3":"=v"(r):"v"(a),"v"(b),"v"(c));return r;}
__device__ __forceinline__ float max2f(float a,float b){float r;asm("v_max_f32_e32 %0, %1, %2":"=v"(r):"v"(a),"v"(b));return r;}
__device__ __forceinline__ float fadd_s(float a,float b){float r;asm("v_add_f32_e32 %0, %1, %2":"=v"(r):"v"(a),"v"(b));return r;}
__device__ __forceinline__ float fsub_s(float a,float b){float r;asm("v_sub_f32_e32 %0, %1, %2":"=v"(r):"v"(a),"v"(b));return r;}
typedef float f32x2_t __attribute__((ext_vector_type(2))); typedef __bf16 bf16x2_t __attribute__((ext_vector_type(2)));
__device__ __forceinline__ unsigned cvtpk_s(float lo,float hi){f32x2_t v={lo,hi};bf16x2_t b=__builtin_convertvector(v,bf16x2_t);return __builtin_bit_cast(unsigned,b);}
#define WAIT_BAR(N) asm volatile("s_waitcnt vmcnt(" #N ") lgkmcnt(0)\n\ts_barrier":::"memory")

typedef __attribute__((address_space(3))) const char* lds_cptr;
__device__ __forceinline__ void qkt(f32x16&p0,f32x16&p1,lds_cptr Kslot,const bf16x8*qr,const f32x16&negm,int r32,int hi){
  const lds_cptr kb=Kslot+hi*1024+r32*16;
  #pragma unroll
  for(int d0=0;d0<4;++d0){
    const bf16x8 b0=*(const __attribute__((address_space(3))) bf16x8*)(kb+d0*2048);
    const bf16x8 b1=*(const __attribute__((address_space(3))) bf16x8*)(kb+d0*2048+512);
    if(d0==0){p0=__builtin_amdgcn_mfma_f32_32x32x16_bf16(b0,qr[0],negm,0,0,0);p1=__builtin_amdgcn_mfma_f32_32x32x16_bf16(b1,qr[0],negm,0,0,0);}
    else{p0=__builtin_amdgcn_mfma_f32_32x32x16_bf16(b0,qr[d0],p0,0,0,0);p1=__builtin_amdgcn_mfma_f32_32x32x16_bf16(b1,qr[d0],p1,0,0,0);}}
}
typedef short v4i16_t __attribute__((ext_vector_type(4)));
__device__ __forceinline__ void kload8(bf16x8*kf,lds_cptr kp){
  kf[0]=*(const __attribute__((address_space(3))) bf16x8*)(kp);      kf[1]=*(const __attribute__((address_space(3))) bf16x8*)(kp+512);
  kf[2]=*(const __attribute__((address_space(3))) bf16x8*)(kp+2048); kf[3]=*(const __attribute__((address_space(3))) bf16x8*)(kp+2560);
  kf[4]=*(const __attribute__((address_space(3))) bf16x8*)(kp+4096); kf[5]=*(const __attribute__((address_space(3))) bf16x8*)(kp+4608);
  kf[6]=*(const __attribute__((address_space(3))) bf16x8*)(kp+6144); kf[7]=*(const __attribute__((address_space(3))) bf16x8*)(kp+6656);
}
__device__ __forceinline__ void kload2(bf16x8*kf,lds_cptr kp,int j){ kf[2*j]=*(const __attribute__((address_space(3))) bf16x8*)(kp+j*2048); kf[2*j+1]=*(const __attribute__((address_space(3))) bf16x8*)(kp+j*2048+512); }
__device__ __forceinline__ s16x4 vtr(lds_cptr p){ return __builtin_bit_cast(s16x4,__builtin_amdgcn_ds_read_tr16_b64_v4i16((__attribute__((address_space(3))) v4i16_t*)p)); }
__device__ __forceinline__ float rowmax(const f32x16&p0,const f32x16&p1){
  float a=max3f(p0[0],p0[1],p1[0]),b=max3f(p0[2],p0[3],p1[1]);a=max3f(a,p1[2],p1[3]);
  #pragma unroll
  for(int r=4;r<16;r+=4){a=max3f(a,p0[r],p0[r+1]);b=max3f(b,p0[r+2],p0[r+3]);a=max3f(a,p1[r],p1[r+1]);b=max3f(b,p1[r+2],p1[r+3]);}
  const float m=max2f(a,b);
  auto rr=__builtin_amdgcn_permlane32_swap(__float_as_uint(m),__float_as_uint(m),false,false);
  return max2f(__uint_as_float(rr[0]),__uint_as_float(rr[1]));
}
__device__ __forceinline__ void pv(f32x16*o,int vb,bf16x8 pa0,bf16x8 pa1,bf16x8 pa2,bf16x8 pa3){
  #pragma unroll
  for(int d0=0;d0<2;++d0){s16x4 lo[4],hi[4];
    #pragma unroll
    for(int ks=0;ks<4;++ks){
      asm volatile("ds_read_b64_tr_b16 %0,%1 offset:%c2":"=&v"(lo[ks]):"v"(vb),"i"(d0*4096+ks*1024):"memory");
      asm volatile("ds_read_b64_tr_b16 %0,%1 offset:%c2":"=&v"(hi[ks]):"v"(vb),"i"(d0*4096+ks*1024+512):"memory");}
    asm volatile("s_waitcnt lgkmcnt(0)":::"memory");SBAR();
    #define PK(k) (bf16x8){lo[k][0],lo[k][1],lo[k][2],lo[k][3],hi[k][0],hi[k][1],hi[k][2],hi[k][3]}
    o[d0]=__builtin_amdgcn_mfma_f32_32x32x16_bf16(pa0,PK(0),o[d0],0,0,0);
    o[d0]=__builtin_amdgcn_mfma_f32_32x32x16_bf16(pa1,PK(1),o[d0],0,0,0);
    o[d0]=__builtin_amdgcn_mfma_f32_32x32x16_bf16(pa2,PK(2),o[d0],0,0,0);
    o[d0]=__builtin_amdgcn_mfma_f32_32x32x16_bf16(pa3,PK(3),o[d0],0,0,0);
    #undef PK
  }
}

#ifndef ATTN_STORE16
#define ATTN_STORE16(p,v) (*(u32x4*)(p)=(v))
#endif
template<int THRL> __device__ __forceinline__ void attn_unit(int b,int qb,int kvh,int hp,bool isctx,const bf16*P,bf16*O,float sink_l2_h0,float sink_l2_h1,LAS unsigned char*shm){
  const int tid=threadIdx.x,lane=tid&63,r32=lane&31,hi=lane>>5; const int wid=__builtin_amdgcn_readfirstlane(tid>>6);
  const int head=kvh*4+hp*2+(wid>>2), rbk=wid&3;
  const long qrow0=(isctx?(long)NL+b*CTXL:(long)b*SEQ)+qb*128+rbk*QBLK;
  const bf16*Qw=P+qrow0*INW+head*64;
  const int nfull=isctx?0:2, nmask=isctx?0:((qb==0||qb==SEQ/128-1)?2:4);
  auto trow=[&](int t)->long{ if(t<nfull) return (long)b*SEQ+qb*128+64*t; if(t<nfull+4) return (long)NL+b*CTXL+64*(t-nfull);
    const int i=t-nfull-4; const int tl=(qb==0)?4+i:((i<2)?i:i+2); return (long)b*SEQ+qb*128-128+64*tl; };
  auto tcw=[&](int t)->int{ if(t<nfull+4) return 1<<20; const int i=t-nfull-4; const int tl=(qb==0)?4+i:((i<2)?i:i+2); return 128-64*tl; };
  const unsigned lds0=(unsigned)(uintptr_t)shm;
  LAS float*wsf=(LAS float*)(shm+LDS_WS)+wid*64;
  const unsigned koff=(unsigned)(lane*INW+C_K+kvh*64+wid*8)*2u;
  const unsigned voff=(unsigned)((16*(wid&3)+(lane>>2))*INW+C_V+kvh*64+(wid>>2)*32+(lane&3)*8)*2u;
  const unsigned kdst=lds0+LDS_K+wid*1024, vdst=lds0+LDS_V+wid*1024;
  #define DMA_K(t,slot) pg8::glds16s(koff,(const char*)P+trow(t)*(long)(INW*2),(unsigned)__builtin_amdgcn_readfirstlane(kdst+(slot)))
  #define DMA_V(t,slot) pg8::glds16s(voff,(const char*)P+trow(t)*(long)(INW*2),(unsigned)__builtin_amdgcn_readfirstlane(vdst+(slot)))
  const int vb0=(int)(lds0+LDS_V)+((lane>>4)&1)*32+(lane&3)*8+(4*hi+((lane&15)>>2))*64;
  const lds_cptr Kbase=(lds_cptr)shm+LDS_K; bf16x8 kf[8];
  const lds_cptr shm3=(lds_cptr)shm; const lds_cptr kp0=shm3+LDS_K+hi*1024+r32*16; const lds_cptr vp0=shm3+LDS_V+((lane>>4)&1)*32+(lane&3)*8+(4*hi+((lane&15)>>2))*64;
  const int NT=nfull+4+nmask;
  DMA_K(0,0);DMA_V(0,0);DMA_K(1,SLOTB);
  bf16x8 qr[4];
  #pragma unroll
  for(int d0=0;d0<4;++d0)qr[d0]=*reinterpret_cast<const bf16x8*>(&Qw[(long)r32*INW+d0*16+hi*8]);
  float mhat=0.f,l_reg=0.f;f32x16 o[2];o[0]=f32x16{};o[1]=f32x16{};f32x16 negm=f32x16{};asm volatile("":"+v"(negm));
  const int qq=rbk*QBLK+r32;
  #define CMASK(P0,P1,t) do{ if((t)>=NT-4){ const int cw_=tcw(t); if(cw_!=(1<<20)) wmask(P0,P1,cw_,qq,hi); } }while(0)
  bool resc=false;
  #define START(P0,P1) do{ const float rm=rowmax(P0,P1); resc=false; \
    { const float dl=rm; mhat=fadd_s(mhat,dl); \
      _Pragma("unroll") for(int r=0;r<16;++r){P0[r]=fsub_s(P0[r],dl);P1[r]=fsub_s(P1[r],dl);} \
      _Pragma("unroll") for(int r=0;r<16;++r)negm[r]=-mhat; asm volatile("":"+v"(negm)); } \
    _Pragma("unroll") for(int r=0;r<16;++r)P0[r]=__builtin_amdgcn_exp2f(P0[r]); }while(0)
  #define RESC() do{ if(resc){ asm volatile("s_waitcnt lgkmcnt(0)":::"memory"); \
      _Pragma("unroll") for(int d_=0;d_<2;++d_) _Pragma("unroll") for(int r=0;r<16;++r)o[d_][r]*=wsf[crow(r,hi)]; } }while(0)
  f32x16 pA0,pA1,pB0,pB1;
  int sl_prev=0,sl_cur=0,sl_next=SLOTB;
  #define ROT() do{sl_prev=sl_cur;sl_cur=sl_next;sl_next=(sl_next==(NSLOT-1)*SLOTB)?0:sl_next+SLOTB;}while(0)
  DMA_K(2,2*SLOTB);
  WAIT_BAR(3);
  qkt(pA0,pA1,Kbase,qr,negm,r32,hi);asm volatile("s_nop 15\n\ts_nop 7":"+v"(pA0),"+v"(pA1));CMASK(pA0,pA1,0);
  START(pA0,pA1);
  _Pragma("unroll") for(int r=0;r<16;++r)pA1[r]=__builtin_amdgcn_exp2f(pA1[r]);
  WAIT_BAR(0);
  DMA_K(3,0);DMA_V(1,SLOTB);
  ROT();
  kload8(kf,kp0+sl_cur);
  WAIT_BAR(2);
  s16x4 vlo[8],vhi[8]; u32x4 pw0,pw1,pw2,pw3;
  #define PKW(P,B) cvtpk_s(P[B],P[B+1])
  #define PAF(k) __builtin_bit_cast(bf16x8,pw##k)
  #define VFR(i) (bf16x8){vlo[i][0],vlo[i][1],vlo[i][2],vlo[i][3],vhi[i][0],vhi[i][1],vhi[i][2],vhi[i][3]}
  #define PIN(x) asm volatile("":"+v"(x))
  #define MX3(a,b,c) __builtin_fmaxf(__builtin_fmaxf((a),(b)),(c))
  #define GAPA(MF,A0,A1,A2,A3,W0,W1,PW) do{ MF; sacc+=A0; sacc+=A1; sacc+=A2; sacc+=A3; PIN(sacc); W0; W1; PIN(PW); SBAR(); }while(0)
  #define EX(v) __builtin_amdgcn_exp2f(v)
  #define GAPB(MF,X,B) do{ MF; X[B]=EX(X[B]); X[B+1]=EX(X[B+1]); X[B+2]=EX(X[B+2]); X[B+3]=EX(X[B+3]); PIN(X); SBAR(); }while(0)
  #define VRD(i) do{ vlo[i]=vtr(vp_+(((i)>>2)*4096+((i)&3)*1024)); vhi[i]=vtr(vp_+(((i)>>2)*4096+((i)&3)*1024+512)); }while(0)
  #define KRD(G,j) do{ if(G){ kload2(kf,kp0+sl_next,j); SBAR(); } }while(0)
  #define STEP(C0,C1,P0,P1,t,GK,GV,GL) do{ SBAR(); \
    const lds_cptr vp_=vp0+sl_prev; \
    VRD(0); SBAR(); float sacc=(P0[0]+P0[1]); \
    GAPA(C0=__builtin_amdgcn_mfma_f32_32x32x16_bf16(kf[0],qr[0],negm,0,0,0), P0[2],P0[3],P0[4],P0[5],     pw0[0]=PKW(P0,0), pw0[1]=PKW(P0,2), pw0); \
    VRD(4); SBAR(); GAPA(C1=__builtin_amdgcn_mfma_f32_32x32x16_bf16(kf[1],qr[0],negm,0,0,0), P0[6],P0[7],P0[8],P0[9],     pw0[2]=PKW(P0,4), pw0[3]=PKW(P0,6), pw0); \
    VRD(1); SBAR(); GAPA(C0=__builtin_amdgcn_mfma_f32_32x32x16_bf16(kf[2],qr[1],C0,0,0,0),   P0[10],P0[11],P0[12],P0[13], pw1[0]=PKW(P0,8), pw1[1]=PKW(P0,10), pw1); \
    VRD(5); SBAR(); GAPA(C1=__builtin_amdgcn_mfma_f32_32x32x16_bf16(kf[3],qr[1],C1,0,0,0),   P0[14],P0[15],P1[0],P1[1],   pw1[2]=PKW(P0,12),pw1[3]=PKW(P0,14), pw1); \
    VRD(2); SBAR(); GAPA(C0=__builtin_amdgcn_mfma_f32_32x32x16_bf16(kf[4],qr[2],C0,0,0,0),   P1[2],P1[3],P1[4],P1[5],     pw2[0]=PKW(P1,0), pw2[1]=PKW(P1,2), pw2); \
    VRD(6); SBAR(); GAPA(C1=__builtin_amdgcn_mfma_f32_32x32x16_bf16(kf[5],qr[2],C1,0,0,0),   P1[6],P1[7],P1[8],P1[9],     pw2[2]=PKW(P1,4), pw2[3]=PKW(P1,6), pw2); \
    VRD(3); SBAR(); GAPA(C0=__builtin_amdgcn_mfma_f32_32x32x16_bf16(kf[6],qr[3],C0,0,0,0),   P1[10],P1[11],P1[12],P1[13], pw3[0]=PKW(P1,8), pw3[1]=PKW(P1,10), pw3); \
    VRD(7); SBAR(); GAPA(C1=__builtin_amdgcn_mfma_f32_32x32x16_bf16(kf[7],qr[3],C1,0,0,0),   P1[14],P1[15],0.f,0.f,       pw3[2]=PKW(P1,12),pw3[3]=PKW(P1,14), pw3); \
    l_reg+=sacc; \
    if(GK){DMA_K((t)+3,sl_cur);} if(GV){DMA_V((t)+1,sl_next);} \
    CMASK(C0,C1,t); \
    { float a=MX3(C0[0],C0[1],C1[0]),b=MX3(C0[2],C0[3],C1[1]); a=MX3(a,C1[2],C1[3]); \
      _Pragma("unroll") for(int r=4;r<16;r+=4){a=MX3(a,C0[r],C0[r+1]);b=MX3(b,C0[r+2],C0[r+3]);a=MX3(a,C1[r],C1[r+1]);b=MX3(b,C1[r+2],C1[r+3]);} \
      float rm=__builtin_fmaxf(a,b); { auto rr=__builtin_amdgcn_permlane32_swap(__float_as_uint(rm),__float_as_uint(rm),false,false); rm=__builtin_fmaxf(__uint_as_float(rr[0]),__uint_as_float(rr[1])); } \
      resc=false; \
      if(__builtin_expect(__any(rm>(float)THRL),0)){ const float dl=__builtin_fmaxf(rm,0.f); mhat+=dl; \
        _Pragma("unroll") for(int r=0;r<16;++r){C0[r]-=dl;C1[r]-=dl;} \
        _Pragma("unroll") for(int r=0;r<16;++r)negm[r]=-mhat; asm volatile("":"+v"(negm)); \
        const float f=__builtin_amdgcn_exp2f(-dl); l_reg*=f; if(hi==0)wsf[r32]=f; resc=true; } } \
    SBAR(); \
    GAPB(o[0]=__builtin_amdgcn_mfma_f32_32x32x16_bf16(PAF(0),VFR(0),o[0],0,0,0), C0,0); \
    GAPB(o[1]=__builtin_amdgcn_mfma_f32_32x32x16_bf16(PAF(0),VFR(4),o[1],0,0,0), C0,4); \
    KRD(GL,0); GAPB(o[0]=__builtin_amdgcn_mfma_f32_32x32x16_bf16(PAF(1),VFR(1),o[0],0,0,0), C0,8); \
    KRD(GL,1); GAPB(o[1]=__builtin_amdgcn_mfma_f32_32x32x16_bf16(PAF(1),VFR(5),o[1],0,0,0), C0,12); \
    KRD(GL,2); GAPB(o[0]=__builtin_amdgcn_mfma_f32_32x32x16_bf16(PAF(2),VFR(2),o[0],0,0,0), C1,0); \
    KRD(GL,3); GAPB(o[1]=__builtin_amdgcn_mfma_f32_32x32x16_bf16(PAF(2),VFR(6),o[1],0,0,0), C1,4); \
    GAPB(o[0]=__builtin_amdgcn_mfma_f32_32x32x16_bf16(PAF(3),VFR(3),o[0],0,0,0), C1,8); \
    GAPB(o[1]=__builtin_amdgcn_mfma_f32_32x32x16_bf16(PAF(3),VFR(7),o[1],0,0,0), C1,12); \
    }while(0)
  int t=1;
  #undef CMASK
  #define CMASK(P0,P1,t) do{}while(0)
  for(;t+5<NT;t+=2){
    STEP(pB0,pB1,pA0,pA1,t,true,true,true);     WAIT_BAR(2); RESC(); ROT();
    STEP(pA0,pA1,pB0,pB1,t+1,true,true,true);   WAIT_BAR(2); RESC(); ROT();
  }
  #undef CMASK
  #define CMASK(P0,P1,t) do{ if((t)>=NT-4){ const int cw_=tcw(t); if(cw_!=(1<<20)) wmask(P0,P1,cw_,qq,hi); } }while(0)
  #define ENDW(tt) do{ if((tt)+3<NT){WAIT_BAR(2);} else if((tt)+2<NT){WAIT_BAR(1);} else {WAIT_BAR(0);} }while(0)
  for(;t+1<NT;t+=2){
    STEP(pB0,pB1,pA0,pA1,t,(t+3<NT),(t+1<NT),(t+1<NT));       ENDW(t);   RESC(); ROT();
    STEP(pA0,pA1,pB0,pB1,t+1,(t+4<NT),(t+2<NT),(t+2<NT));     ENDW(t+1); RESC(); ROT();
  }
  STEP(pB0,pB1,pA0,pA1,NT-1,false,false,false); RESC();
  { float sacc=pB0[0]+pB0[1]; _Pragma("unroll") for(int r=2;r<16;++r)sacc+=pB0[r]; _Pragma("unroll") for(int r=0;r<16;++r)sacc+=pB1[r]; l_reg+=sacc;
    pw0=(u32x4){PKW(pB0,0),PKW(pB0,2),PKW(pB0,4),PKW(pB0,6)};pw1=(u32x4){PKW(pB0,8),PKW(pB0,10),PKW(pB0,12),PKW(pB0,14)};pw2=(u32x4){PKW(pB1,0),PKW(pB1,2),PKW(pB1,4),PKW(pB1,6)};pw3=(u32x4){PKW(pB1,8),PKW(pB1,10),PKW(pB1,12),PKW(pB1,14)};
    SBAR(); pv(o,vb0+sl_cur,PAF(0),PAF(1),PAF(2),PAF(3)); }
  #undef PKW
  #undef PAF
  #undef VFR
  #undef PIN
  #undef MX3
  #undef GAPA
  #undef GAPB
  #undef EX
  #undef VRD
  #undef KRD
  #undef STEP
  #undef ENDW
  {auto rr=__builtin_amdgcn_permlane32_swap(__float_as_uint(l_reg),__float_as_uint(l_reg),false,false);l_reg=__uint_as_float(rr[0])+__uint_as_float(rr[1]);}
  l_reg+=__builtin_amdgcn_exp2f(((wid>>2)?sink_l2_h1:sink_l2_h0)-mhat);
  if(hi==0)wsf[32+r32]=l_reg;asm volatile("s_waitcnt lgkmcnt(0)":::"memory");
  float rli[16];
  #pragma unroll
  for(int r=0;r<16;++r)rli[r]=__builtin_amdgcn_rcpf(wsf[32+crow(r,hi)]);
  bf16*Ow=O+qrow0*(long)D+head*64;
  { LAS bf16*stg=(LAS bf16*)(shm+LDS_OST)+wid*2048;
    #pragma unroll
    for(int r=0;r<16;++r){const int orow=crow(r,hi);
      #pragma unroll
      for(int d0=0;d0<2;++d0)stg[orow*64+d0*32+r32]=(bf16)(cvtpk_s(o[d0][r]*rli[r],0.f)&0xffffu);}
    asm volatile("s_waitcnt lgkmcnt(0)":::"memory");
    #pragma unroll
    for(int i=0;i<4;++i){const int row=i*8+(lane>>3),ch=lane&7; const u32x4 v=*(const LAS u32x4*)(stg+row*64+ch*8); ATTN_STORE16(Ow+(long)row*D+ch*8,v);} }
  asm volatile("s_waitcnt lgkmcnt(0)\n\ts_barrier":::"memory");
  #undef DMA_K
  #undef DMA_V
  #undef CMASK
  #undef START
  #undef RESC
  #undef ROT
}
constexpr int ATTN_LDS_BYTES=LDS_BYTES;
#undef SBAR
#undef WAIT_BAR
}

__device__ __forceinline__ void p_attn2(Frame& F, int layer) {
    const int vcu = (blockIdx.x % 8) * (F.G / 8) + blockIdx.x / 8;
    const bf16* P = WSP(bf16, WS_PROJ); bf16* O = WSP(bf16, WS_MIX);
    for (int u = vcu * 4; u < 1024; u += 4 * F.G)
        for (int k = 0; k < (((REP_MASK) >> 3) & 1 ? 8 : 4); ++k) { const int uu = u + (k & 3), b = uu >> 7, qb = (uu >> 2) & 31, kvh = (uu >> 1) & 1, hp = uu & 1;
            att2::attn_unit<8>(b, qb, kvh, hp, false, P, O, F.sink[layer * 8 + kvh * 4 + hp * 2] * LOG2E, F.sink[layer * 8 + kvh * 4 + hp * 2 + 1] * LOG2E, F.lds); }
    if (layer == 0) for (int v = blockIdx.x; v < 64; v += F.G) { const int b = v >> 3, qb = (v >> 2) & 1, kvh = (v >> 1) & 1, hp = v & 1;
        att2::attn_unit<8>(b, qb, kvh, hp, true, P, O, F.sink[kvh * 4 + hp * 2] * LOG2E, F.sink[kvh * 4 + hp * 2 + 1] * LOG2E, F.lds); }
}
#ifndef ATT2
#define ATT2 1
#endif
#if ATT2
#define P_ATTN p_attn2
#else
#define P_ATTN p_attn
#endif
namespace mixb {
using att::bf16x8; using att::s16x4; using att::f32x16; using att::u32x4; using att::lds_cptr; using att::vtr; using att::crow; using att::cvtpk;
__device__ __forceinline__ bf16x8 tr_pair(lds_cptr p, int second_off) { const s16x4 lo = vtr(p), hh = vtr(p + second_off); return (bf16x8){lo[0], lo[1], lo[2], lo[3], hh[0], hh[1], hh[2], hh[3]}; }
__device__ __forceinline__ void unpack8(const v4u w, float (&f)[8]) { f[0] = bflo(w.x); f[1] = bfhi(w.x); f[2] = bflo(w.y); f[3] = bfhi(w.y); f[4] = bflo(w.z); f[5] = bfhi(w.z); f[6] = bflo(w.w); f[7] = bfhi(w.w); }
__device__ __forceinline__ v4u pack8(const float (&f)[8]) { v4u w; w.x = pk2(f[0], f[1]); w.y = pk2(f[2], f[3]); w.z = pk2(f[4], f[5]); w.w = pk2(f[6], f[7]); return w; }
__device__ __forceinline__ float half_sum(float v) {
#pragma unroll
    for (int o = 1; o < 32; o <<= 1) v += __shfl_xor(v, o);
    return v;
}
__device__ __forceinline__ void kv_unit(Frame& F, int layer, int b, int cid, int hp) {
    const int tid = opq((int)threadIdx.x), lane = tid & 63, r32 = lane & 31, hi = lane >> 5; const int wid = __builtin_amdgcn_readfirstlane(tid >> 6);
    const bf16* P = WSP(bf16, WS_PROJ); const int row0 = chunk_row0(b, cid);
    __syncthreads();
#pragma unroll
    for (int it = 0; it < 2; ++it) { const int idx = tid + it * NTHR, hs = idx >> 9, t = (idx >> 2) & 127, c = idx & 3, h = 2 * hp + hs;
        const v4u w = *(const v4u*)(P + (size_t)(row0 + t) * INW + C_RK + h * 32 + c * 8); float f[8], a[8], bb[8]; unpack8(w, f);
        const float wf = __expf(F.lgf[layer * 4 + h] * (float)(127 - t)), wb = __expf(F.lgb[layer * 4 + h] * (float)t);
#pragma unroll
        for (int j = 0; j < 8; ++j) { a[j] = f[j] * wf; bb[j] = f[j] * wb; }
        LAS unsigned char* d = F.lds + hs * 32768 + t * 64 + c * 16; *(LAS v4u*)d = pack8(a); *(LAS v4u*)(d + 8192) = pack8(bb); }
#pragma unroll
    for (int it = 0; it < 4; ++it) { const int idx = tid + it * NTHR, hs = idx >> 10, t = (idx >> 3) & 127, c = idx & 7, h = 2 * hp + hs;
        *(LAS v4u*)(F.lds + hs * 32768 + 16384 + (c >> 2) * 8192 + t * 64 + (c & 3) * 16) = *(const v4u*)(P + (size_t)(row0 + t) * INW + C_RV + h * 64 + c * 8); }
    __syncthreads();
    const int hs = wid >> 2, h = 2 * hp + hs, dir = (wid >> 1) & 1, eh = wid & 1;
    const int natoff = (8 * hi + ((lane & 15) >> 2)) * 64 + ((lane >> 4) & 1) * 32 + (lane & 3) * 8;
    const lds_cptr ab = (lds_cptr)F.lds + hs * 32768 + dir * 8192 + natoff, bb = (lds_cptr)F.lds + hs * 32768 + 16384 + eh * 8192 + natoff;
    f32x16 acc = f32x16{};
#pragma unroll
    for (int ks = 0; ks < 8; ++ks) acc = __builtin_amdgcn_mfma_f32_32x32x16_bf16(tr_pair(ab + ks * 1024, 256), tr_pair(bb + ks * 1024, 256), acc, 0, 0, 0);
    float* dst = WSP(float, WS_KVS) + ((size_t)((dir * 8 + b) * 4 + h) * NCHK + cid) * 2048 + 32 * eh + r32;
#pragma unroll
    for (int r = 0; r < 16; ++r) dst[crow(r, hi) * 64] = acc[r];
}
__device__ __forceinline__ void ret_unit(Frame& F, int layer, int b, int cid, int hp) {
    const int tid = opq((int)threadIdx.x), lane = tid & 63, r32 = lane & 31, hi = lane >> 5; const int wid = __builtin_amdgcn_readfirstlane(tid >> 6);
    const bf16* P = WSP(bf16, WS_PROJ); const int row0 = chunk_row0(b, cid);
    constexpr int HB = 40960;
    v4u qraw[2], rgraw[4];
    { const int hs_ = wid >> 2, h_ = 2 * hp + hs_, qb_ = wid & 3;
#pragma unroll
      for (int ks = 0; ks < 2; ++ks) qraw[ks] = *(const v4u*)(P + (size_t)(row0 + 32 * qb_ + r32) * INW + C_RQ + h_ * 32 + 16 * ks + 8 * hi);
#pragma unroll
      for (int k = 0; k < 4; ++k) rgraw[k] = *(const v4u*)(P + (size_t)(row0 + 32 * qb_ + k * 8 + (lane >> 3)) * INW + C_RG + h_ * 64 + (lane & 7) * 8); }
    __syncthreads();
#pragma unroll
    for (int it = 0; it < 2; ++it) { const int idx = tid + it * NTHR, hs = idx >> 9, t = (idx >> 2) & 127, c = idx & 3, h = 2 * hp + hs;
        const v4u w = *(const v4u*)(P + (size_t)(row0 + t) * INW + C_RK + h * 32 + c * 8); float f[8], a[8], bb[8]; unpack8(w, f);
        const float sf = __expf(-F.lgf[layer * 4 + h] * (float)t), sb = __expf(F.lgb[layer * 4 + h] * (float)t);
#pragma unroll
        for (int j = 0; j < 8; ++j) { a[j] = f[j] * sf; bb[j] = f[j] * sb; }
        LAS unsigned char* d = F.lds + hs * HB + c * 2048 + t * 16; *(LAS v4u*)d = pack8(a); *(LAS v4u*)(d + 8192) = pack8(bb); }
#pragma unroll
    for (int it = 0; it < 4; ++it) { const int idx = tid + it * NTHR, hs = idx >> 10, t = (idx >> 3) & 127, c = idx & 7, h = 2 * hp + hs;
        *(LAS v4u*)(F.lds + hs * HB + 16384 + (c >> 2) * 8192 + t * 64 + (c & 3) * 16) = *(const v4u*)(P + (size_t)(row0 + t) * INW + C_RV + h * 64 + c * 8); }
#pragma unroll
    for (int it = 0; it < 4; ++it) { const int idx = tid + it * NTHR, hs = idx >> 10, dir = (idx >> 9) & 1, d = (idx >> 4) & 31, e4 = idx & 15, h = 2 * hp + hs;
        const f32x4 v = *(const f32x4*)(WSP(float, WS_KVS) + ((size_t)((dir * 8 + b) * 4 + h) * NCHK + cid) * 2048 + d * 64 + e4 * 4);
        const float fac = dir ? __expf(F.lgb[layer * 4 + h] * 128.0f) : __expf(F.lgf[layer * 4 + h]);
        v2u w; w.x = pk2(v[0] * fac, v[1] * fac); w.y = pk2(v[2] * fac, v[3] * fac);
        *(LAS v2u*)(F.lds + hs * HB + 32768 + dir * 4096 + (e4 >> 3) * 2048 + d * 64 + (e4 & 7) * 8) = w; }
    __syncthreads();
    const int hs = wid >> 2, h = 2 * hp + hs, qb = wid & 3, n = 32 * qb + r32;
    const lds_cptr hb = (lds_cptr)F.lds + hs * HB;
    bf16x8 qf[2], qbk[2];
    { const float sf = __expf(F.lgf[layer * 4 + h] * (float)n), sb = __expf(-F.lgb[layer * 4 + h] * (float)n);
#pragma unroll
      for (int ks = 0; ks < 2; ++ks) { float f[8], a[8], bb[8]; unpack8(qraw[ks], f);
#pragma unroll
          for (int j = 0; j < 8; ++j) { a[j] = f[j] * sf; bb[j] = f[j] * sb; }
          qf[ks] = __builtin_bit_cast(bf16x8, pack8(a)); qbk[ks] = __builtin_bit_cast(bf16x8, pack8(bb)); } }
    const int qoff = ((lane & 15) >> 2) * 64 + ((lane >> 4) & 1) * 32 + (lane & 3) * 8;
    const int natoff = 8 * hi * 64 + qoff, permoff = 4 * hi * 64 + qoff;
    f32x16 o[2]; o[0] = f32x16{}; o[1] = f32x16{};
#pragma unroll
    for (int eh = 0; eh < 2; ++eh)
#pragma unroll
        for (int ks = 0; ks < 2; ++ks) {
            o[eh] = __builtin_amdgcn_mfma_f32_32x32x16_bf16(qf[ks], tr_pair(hb + 32768 + eh * 2048 + ks * 1024 + natoff, 256), o[eh], 0, 0, 0);
            o[eh] = __builtin_amdgcn_mfma_f32_32x32x16_bf16(qbk[ks], tr_pair(hb + 36864 + eh * 2048 + ks * 1024 + natoff, 256), o[eh], 0, 0, 0); }
#pragma unroll
    for (int kb = 0; kb < 4; ++kb) {
        f32x16 x = f32x16{};
        if (kb <= qb) { f32x16 xf = f32x16{};
#pragma unroll
            for (int ks = 0; ks < 2; ++ks) xf = __builtin_amdgcn_mfma_f32_32x32x16_bf16(*(const __attribute__((address_space(3))) bf16x8*)(hb + (2 * ks + hi) * 2048 + (32 * kb + r32) * 16), qf[ks], xf, 0, 0, 0);
            if (kb == qb) {
#pragma unroll
                for (int r = 0; r < 16; ++r) xf[r] = crow(r, hi) <= r32 ? xf[r] : 0.f; }
            x = xf; }
        if (kb >= qb) { f32x16 xb = f32x16{};
#pragma unroll
            for (int ks = 0; ks < 2; ++ks) xb = __builtin_amdgcn_mfma_f32_32x32x16_bf16(*(const __attribute__((address_space(3))) bf16x8*)(hb + 8192 + (2 * ks + hi) * 2048 + (32 * kb + r32) * 16), qbk[ks], xb, 0, 0, 0);
            if (kb == qb) {
#pragma unroll
                for (int r = 0; r < 16; ++r) xb[r] = crow(r, hi) >= r32 ? xb[r] : 0.f; }
            x = x + xb; }
        u32x4 pw[2];
#pragma unroll
        for (int k = 0; k < 4; ++k) { pw[0][k] = cvtpk(x[2 * k], x[2 * k + 1]); pw[1][k] = cvtpk(x[8 + 2 * k], x[9 + 2 * k]); }
#pragma unroll
        for (int eh = 0; eh < 2; ++eh)
#pragma unroll
            for (int k2 = 0; k2 < 2; ++k2) o[eh] = __builtin_amdgcn_mfma_f32_32x32x16_bf16(__builtin_bit_cast(bf16x8, pw[k2]), tr_pair(hb + 16384 + eh * 8192 + (32 * kb + 16 * k2) * 64 + permoff, 512), o[eh], 0, 0, 0);
    }
    LAS float* stg = (LAS float*)(F.lds + 2 * HB) + wid * 2048;
#pragma unroll
    for (int r = 0; r < 16; ++r) { stg[crow(r, hi) * 64 + r32] = o[0][r]; stg[crow(r, hi) * 64 + 32 + r32] = o[1][r]; }
    asm volatile("s_waitcnt lgkmcnt(0)" ::: "memory");
#pragma unroll
    for (int k = 0; k < 4; ++k) { const int row = k * 8 + (lane >> 3), ch = lane & 7; const size_t grow = (size_t)(row0 + 32 * qb + row);
        const f32x4 v0 = *(const LAS f32x4*)(stg + row * 64 + ch * 8), v1 = *(const LAS f32x4*)(stg + row * 64 + ch * 8 + 4);
        float s = (v0[0] + v0[1]) + (v0[2] + v0[3]) + (v1[0] + v1[1]) + (v1[2] + v1[3]);
        s += __shfl_xor(s, 1); s += __shfl_xor(s, 2); s += __shfl_xor(s, 4);
        const float mean = s * (1.0f / 64.0f); const f32x4 d0 = v0 - mean, d1 = v1 - mean;
        float q = (d0[0] * d0[0] + d0[1] * d0[1]) + (d0[2] * d0[2] + d0[3] * d0[3]) + (d1[0] * d1[0] + d1[1] * d1[1]) + (d1[2] * d1[2] + d1[3] * d1[3]);
        q += __shfl_xor(q, 1); q += __shfl_xor(q, 2); q += __shfl_xor(q, 4);
        const float rstd = 1.0f / sqrtf(q * (1.0f / 64.0f) + LN_EPS);
        float rg[8], y[8]; unpack8(rgraw[k], rg);
#pragma unroll
        for (int j = 0; j < 8; ++j) y[j] = rg[j] * __builtin_amdgcn_rcpf(1.0f + __builtin_amdgcn_exp2f(-LOG2E * rg[j])) * ((j < 4 ? d0[j] : d1[j - 4]) * rstd);
        *(v4u*)(WSP(bf16, WS_MIX) + grow * D + 768 + h * 64 + ch * 8) = pack8(y); }
}
__device__ __forceinline__ void pool_unit(Frame& F, int layer, int s, int blk) {
    const int tid = opq((int)threadIdx.x), lane = tid & 63, r32 = lane & 31, hi = lane >> 5; const int wid = __builtin_amdgcn_readfirstlane(tid >> 6);
    const bool isctx = s >= 8; const int b = s & 7, len = isctx ? CTXL : SEQ, row0 = isctx ? NL + b * CTXL : b * SEQ, t0 = blk * 128;
    const bf16* P = WSP(bf16, WS_PROJ);
    constexpr int UST = 528, PWB = 144 * UST, PST = 144;
    __syncthreads();
#pragma unroll
    for (int it = 0; it < 9; ++it) { const int idx = tid + it * NTHR, rr = idx >> 5, c = idx & 31, t = t0 - 8 + rr; v4u w = (v4u){0u, 0u, 0u, 0u};
        if (t >= 0 && t < len) w = *(const v4u*)(P + (size_t)(row0 + t) * INW + C_U + c * 8);
        *(LAS v4u*)(F.lds + rr * UST + c * 16) = w; }
    for (int idx = tid; idx < 16384; idx += NTHR) { const int g = idx >> 12, c = (idx >> 6) & 63, d = idx & 63;
        *(LAS bf16*)(F.lds + PWB + (g * 64 + d) * PST + c * 2) = (bf16)(pk2(F.pool_w[(size_t)layer * 16384 + idx], 0.f) & 0xffffu); }
    __syncthreads();
    const int rbk = wid & 3, ch = wid >> 2, t = 32 * rbk + r32, tt = t0 + t;
    const lds_cptr ub = (lds_cptr)F.lds + (t + 8) * UST + hi * 16;
    bf16* dstrow = WSP(bf16, WS_MIX) + (size_t)(row0 + tt) * D + 512 + 32 * ch + 4 * hi;
#pragma unroll
    for (int g = 0; g < 4; ++g) { const int hw = 1 << g; const float inv = 1.0f / (float)(min(tt + hw, len) - max(tt - hw, 0));
        f32x16 acc = f32x16{};
#pragma unroll
        for (int ks = 0; ks < 4; ++ks) { const lds_cptr up = ub + g * 128 + ks * 32; float sum[8], own[8];
#pragma unroll
            for (int j = 0; j < 8; ++j) sum[j] = 0.f;
#pragma unroll
            for (int dt = -hw; dt < hw; ++dt) { float f[8]; unpack8(*(const __attribute__((address_space(3))) v4u*)(up + dt * UST), f);
#pragma unroll
                for (int j = 0; j < 8; ++j) sum[j] += f[j]; }
            unpack8(*(const __attribute__((address_space(3))) v4u*)up, own);
#pragma unroll
            for (int j = 0; j < 8; ++j) sum[j] = sum[j] * inv - own[j];
            const bf16x8 df = __builtin_bit_cast(bf16x8, pack8(sum));
            const bf16x8 wf = *(const __attribute__((address_space(3))) bf16x8*)((lds_cptr)F.lds + PWB + (g * 64 + 32 * ch + r32) * PST + (16 * ks + 8 * hi) * 2);
            acc = __builtin_amdgcn_mfma_f32_32x32x16_bf16(wf, df, acc, 0, 0, 0); }
        const float* ps = F.pool_scale + layer * 256 + g * 64 + 32 * ch + 4 * hi;
#pragma unroll
        for (int rq = 0; rq < 4; ++rq) { const f32x4 sc = *(const f32x4*)(ps + 8 * rq); v2u w; w.x = pk2(acc[4 * rq] * sc[0], acc[4 * rq + 1] * sc[1]); w.y = pk2(acc[4 * rq + 2] * sc[2], acc[4 * rq + 3] * sc[3]);
            *(v2u*)(dstrow + g * 64 + 8 * rq) = w; }
    }
}
}
__device__ __forceinline__ void p_mix(Frame& F, int layer) {
#if !ATTN_LATE
    P_ATTN(F, layer);
#endif
    const int n_pool = 256 + (layer == 0 ? 16 : 0);
    REPEAT(4) for (int u = (blockIdx.x + F.G - 64) % F.G; u < n_pool; u += F.G) { if (u < 256) mixb::pool_unit(F, layer, u >> 5, u & 31); else mixb::pool_unit(F, layer, 8 + ((u - 256) >> 1), (u - 256) & 1); }
    REPEAT(7) for (int u = (blockIdx.x + F.G - 128) % F.G; u < 8 * NCHK * 2; u += F.G) mixb::kv_unit(F, layer, u / (NCHK * 2), (u >> 1) % NCHK, u & 1);
    __syncthreads();
}
__device__ __forceinline__ void p_ret(Frame& F, int layer) {
    if (layer == 0) { for (int u = blockIdx.x; u < 8 * NCHK * 2; u += F.G) mixb::ret_unit(F, layer, u / (NCHK * 2), (u >> 1) % NCHK, u & 1);
        if (CONV_SPREAD != 0 && (TAILQ & 1) != 0 && F.G == 256) { __syncthreads(); bg_convert(F, 32, 224, CV_A, CV_B); } }
    else { for (int u = blockIdx.x; u < 8 * 32 * 2; u += F.G) mixb::ret_unit(F, layer, u >> 6, 2 + ((u >> 1) & 31), u & 1); }
    __syncthreads();
#if ATTN_LATE
    P_ATTN(F, layer);
    __syncthreads();
#endif
}
#if defined(MIX_CHECK)
__device__ __forceinline__ void chk(Frame& F, float a, float ref, float abs_t, float rel_t, int word) { const float d = fabsf(a - ref); if (!(d <= abs_t + rel_t * fabsf(ref))) atomicOr(WSP(unsigned, WS_CTL) + word, 1u); }
#endif
__device__ __forceinline__ void attn_naive_unit(Frame& F, int layer, int b, int qb, int kvh, bool isctx) {
    const int tid = opq((int)threadIdx.x), qq = tid & 127, g = tid >> 7, head = kvh * 4 + g;
    const bf16* P = WSP(bf16, WS_PROJ);
    const int qrow = isctx ? NL + b * CTXL + qb * 128 + qq : b * SEQ + qb * 128 + qq;
    LAS unsigned* kt = (LAS unsigned*)F.lds;
    LAS unsigned* vt = kt + 64 * 32;
    unsigned q[32];
#pragma unroll
    for (int i = 0; i < 8; ++i) { const v4u w = *(const v4u*)(P + (size_t)qrow * INW + head * 64 + i * 8); q[4 * i] = w.x; q[4 * i + 1] = w.y; q[4 * i + 2] = w.z; q[4 * i + 3] = w.w; }
    float m = F.sink[layer * 8 + head] * LOG2E, l = 1.0f, o[64];
#pragma unroll
    for (int d = 0; d < 64; ++d) o[d] = 0.f;
    const int qpos = qb * 128 + qq;
    for (int tile = isctx ? 6 : 0; tile < 10; ++tile) {
        int krow0, kpos0 = 0; const bool local = tile < 6;
        if (local) { kpos0 = qb * 128 - 128 + 64 * tile; if (kpos0 < 0 || kpos0 >= SEQ) continue; krow0 = b * SEQ + kpos0; }
        else krow0 = NL + b * CTXL + 64 * (tile - 6);
        __syncthreads();
        { const int r = tid >> 3, ch = tid & 7; const bf16* src = P + (size_t)(krow0 + r) * INW + kvh * 64 + ch * 8;
          *(LAS v4u*)(kt + r * 32 + ch * 4) = *(const v4u*)(src + C_K); *(LAS v4u*)(vt + r * 32 + ch * 4) = *(const v4u*)(src + C_V); }
        __syncthreads();
        for (int j = 0; j < 64; ++j) {
            float s = 0.f;
#pragma unroll
            for (int i = 0; i < 32; ++i) s = dot2bf(q[i], kt[j * 32 + i], s);
            const int dlt = qpos - (kpos0 + j); const bool valid = !local || (dlt <= 128 && dlt >= -128);
            if (valid) {
                if (s > m) { const float f = __builtin_amdgcn_exp2f(m - s); l *= f;
#pragma unroll
                    for (int d = 0; d < 64; ++d) o[d] *= f;
                    m = s; }
                const float p = __builtin_amdgcn_exp2f(s - m); l += p;
#pragma unroll
                for (int i = 0; i < 32; ++i) { const unsigned w = vt[j * 32 + i]; o[2 * i] += p * bflo(w); o[2 * i + 1] += p * bfhi(w); }
            }
        }
    }
    const float rl = 1.0f / l;
    bf16* dst = WSP(bf16, WS_MIX) + (size_t)qrow * D + head * 64;
#if defined(ATTN_CHECK)
    { bool bad = false;
#pragma unroll
      for (int i = 0; i < 8; ++i) { const v4u w = *(const v4u*)(dst + 8 * i); const float r8[8] = {bflo(w.x), bfhi(w.x), bflo(w.y), bfhi(w.y), bflo(w.z), bfhi(w.z), bflo(w.w), bfhi(w.w)};
#pragma unroll
          for (int k = 0; k < 8; ++k) { const float a = o[8 * i + k] * rl, d = fabsf(a - r8[k]); if (!(d <= ATTN_CHECK_ABS + ATTN_CHECK_REL * fabsf(a))) bad = true; } }
      if (bad) atomicOr(WSP(unsigned, WS_CTL) + 8, 1u); }
#endif
#pragma unroll
    for (int i = 0; i < 8; ++i) { v4u w; w.x = pk2(o[8 * i] * rl, o[8 * i + 1] * rl); w.y = pk2(o[8 * i + 2] * rl, o[8 * i + 3] * rl); w.z = pk2(o[8 * i + 4] * rl, o[8 * i + 5] * rl); w.w = pk2(o[8 * i + 6] * rl, o[8 * i + 7] * rl); *(v4u*)(dst + 8 * i) = w; }
    __syncthreads();
}
__device__ __forceinline__ void pool_naive_unit(Frame& F, int layer, int s, int blk) {
    const int tid = opq((int)threadIdx.x); const bool isctx = s >= 8; const int b = s & 7, len = isctx ? CTXL : SEQ, row0 = isctx ? NL + b * CTXL : b * SEQ, t0 = blk * 128;
    const bf16* P = WSP(bf16, WS_PROJ);
    LAS float* ub = (LAS float*)F.lds;
    LAS float* pwb = ub + 144 * 64;
    LAS float* db = pwb + 64 * 64;
    for (int g = 0; g < 4; ++g) { const int hw = 1 << g;
        __syncthreads();
        for (int idx = tid; idx < 144 * 8; idx += NTHR) { const int rr = idx >> 3, ch = idx & 7, t = t0 - 8 + rr; v4u w = (v4u){0u, 0u, 0u, 0u};
            if (t >= 0 && t < len) w = *(const v4u*)(P + (size_t)(row0 + t) * INW + C_U + g * 64 + ch * 8);
            LAS float* d = ub + rr * 64 + ch * 8; d[0] = bflo(w.x); d[1] = bfhi(w.x); d[2] = bflo(w.y); d[3] = bfhi(w.y); d[4] = bflo(w.z); d[5] = bfhi(w.z); d[6] = bflo(w.w); d[7] = bfhi(w.w); }
        for (int idx = tid; idx < 4096; idx += NTHR) pwb[idx] = F.pool_w[(size_t)(layer * 4 + g) * 4096 + idx];
        __syncthreads();
        for (int idx = tid; idx < 8192; idx += NTHR) { const int t = idx >> 6, c = idx & 63, tt = t0 + t; const int lo = max(tt - hw, 0), hi = min(tt + hw, len); float sum = 0.f;
            for (int p = lo; p < hi; ++p) sum += ub[(p - t0 + 8) * 64 + c];
            db[t * 65 + c] = sum / (float)(hi - lo) - ub[(t + 8) * 64 + c]; }
        __syncthreads();
        const int t = tid & 127, dq = tid >> 7; float acc[16];
#pragma unroll
        for (int i = 0; i < 16; ++i) acc[i] = 0.f;
        for (int c = 0; c < 64; ++c) { const float xv = db[t * 65 + c];
#pragma unroll
            for (int i = 0; i < 16; ++i) acc[i] += xv * pwb[c * 64 + dq * 16 + i]; }
        const float* ps = F.pool_scale + layer * 256 + g * 64 + dq * 16;
        bf16* dst = WSP(bf16, WS_MIX) + (size_t)(row0 + t0 + t) * D + 512 + g * 64 + dq * 16;
#if defined(MIX_CHECK)
#pragma unroll
        for (int i = 0; i < 2; ++i) { const v4u w = *(const v4u*)(dst + 8 * i); const float r8[8] = {bflo(w.x), bfhi(w.x), bflo(w.y), bfhi(w.y), bflo(w.z), bfhi(w.z), bflo(w.w), bfhi(w.w)};
#pragma unroll
            for (int k = 0; k < 8; ++k) chk(F, r8[k], acc[8 * i + k] * ps[8 * i + k], 0.02f, 0.03f, 9); }
#endif
#pragma unroll
        for (int i = 0; i < 2; ++i) { v4u w; w.x = pk2(acc[8 * i] * ps[8 * i], acc[8 * i + 1] * ps[8 * i + 1]); w.y = pk2(acc[8 * i + 2] * ps[8 * i + 2], acc[8 * i + 3] * ps[8 * i + 3]);
            w.z = pk2(acc[8 * i + 4] * ps[8 * i + 4], acc[8 * i + 5] * ps[8 * i + 5]); w.w = pk2(acc[8 * i + 6] * ps[8 * i + 6], acc[8 * i + 7] * ps[8 * i + 7]); *(v4u*)(dst + 8 * i) = w; }
    }
    __syncthreads();
}
__device__ __forceinline__ void kv_naive_unit(Frame& F, int layer, int b, int h, int cid) {
    const int tid = opq((int)threadIdx.x); const bf16* P = WSP(bf16, WS_PROJ); const int row0 = chunk_row0(b, cid);
    LAS float* kf = (LAS float*)F.lds;
    LAS float* vf = kf + 128 * 32;
    LAS float* wf = vf + 128 * 64;
    const float lgf = F.lgf[layer * 4 + h], lgb = F.lgb[layer * 4 + h];
    __syncthreads();
    { const int r = tid >> 2, ch = tid & 3; const v4u w = *(const v4u*)(P + (size_t)(row0 + r) * INW + C_RK + h * 32 + ch * 8); LAS float* d = kf + r * 32 + ch * 8;
      d[0] = bflo(w.x); d[1] = bfhi(w.x); d[2] = bflo(w.y); d[3] = bfhi(w.y); d[4] = bflo(w.z); d[5] = bfhi(w.z); d[6] = bflo(w.w); d[7] = bfhi(w.w); }
    for (int idx = tid; idx < 1024; idx += NTHR) { const int r = idx >> 3, ch = idx & 7; const v4u w = *(const v4u*)(P + (size_t)(row0 + r) * INW + C_RV + h * 64 + ch * 8); LAS float* d = vf + r * 64 + ch * 8;
      d[0] = bflo(w.x); d[1] = bfhi(w.x); d[2] = bflo(w.y); d[3] = bfhi(w.y); d[4] = bflo(w.z); d[5] = bfhi(w.z); d[6] = bflo(w.w); d[7] = bfhi(w.w); }
    if (tid < 128) { wf[tid] = __expf(lgf * (float)(127 - tid)); wf[128 + tid] = __expf(lgb * (float)tid); }
    __syncthreads();
    const int i = tid >> 4, e0 = (tid & 15) * 4; f32x4 af = (f32x4){0.f, 0.f, 0.f, 0.f}, ab = af;
    for (int m = 0; m < 128; ++m) { const float kk = kf[m * 32 + i]; const f32x4 vv = *(const LAS f32x4*)(vf + m * 64 + e0); af += (kk * wf[m]) * vv; ab += (kk * wf[128 + m]) * vv; }
    float* dst = WSP(float, WS_KVS) + ((size_t)(b * 4 + h) * NCHK + cid) * 2048 + i * 64 + e0;
#if defined(MIX_CHECK)
    { const f32x4 cf = *(const f32x4*)dst, cb = *(const f32x4*)(dst + (size_t)32 * NCHK * 2048);
#pragma unroll
      for (int k = 0; k < 4; ++k) { chk(F, cf[k], af[k], 0.05f, 0.03f, 10); chk(F, cb[k], ab[k], 0.05f, 0.03f, 10); } }
#endif
    *(f32x4*)dst = af; *(f32x4*)(dst + (size_t)32 * NCHK * 2048) = ab;
    __syncthreads();
}
__device__ __forceinline__ void p_scan(Frame& F, int layer) {
    for (int gid = blockIdx.x * NTHR + opq((int)threadIdx.x); gid < 2 * 32 * 2048; gid += F.G * NTHR) {
        const int dir = gid >> 16, bh = (gid >> 11) & 31, e = gid & 2047; const float lg = (dir ? F.lgb : F.lgf)[layer * 4 + (bh & 3)]; const float G = __expf(lg * 128.0f);
        float* base = WSP(float, WS_KVS) + ((size_t)(dir * 32 + bh) * NCHK) * 2048 + e;
        float kv[NCHK];
#pragma unroll
        for (int c = 0; c < NCHK; ++c) kv[c] = base[(size_t)c * 2048];
#if ((REP_MASK) >> 16) & 1
        { float* dm = WSP(float, WS_ACT) + ((size_t)(dir * 32 + bh) * NCHK) * 2048 + e; float S = 0.f;
          if (dir == 0) {
#pragma unroll
            for (int c = 0; c < NCHK; ++c) { dm[(size_t)c * 2048] = S; S = G * S + kv[c]; }
          } else { dm[2048] = S; S = G * S + kv[1]; dm[0] = S; S = G * S + kv[0];
#pragma unroll
            for (int c = NCHK - 1; c >= 2; --c) { dm[(size_t)c * 2048] = S; S = G * S + kv[c]; } }
          asm volatile("s_waitcnt vmcnt(0)" ::: "memory");
#pragma unroll
          for (int c = 0; c < NCHK; ++c) kv[c] = base[(size_t)c * 2048]; }
#endif
        float S = 0.f;
        if (dir == 0) {
#pragma unroll
            for (int c = 0; c < NCHK; ++c) { base[(size_t)c * 2048] = S; S = G * S + kv[c]; }
        } else {
            base[2048] = S; S = G * S + kv[1]; base[0] = S; S = G * S + kv[0];
#pragma unroll
            for (int c = NCHK - 1; c >= 2; --c) { base[(size_t)c * 2048] = S; S = G * S + kv[c]; }
        }
    }
}
__device__ __forceinline__ void ret_naive_unit(Frame& F, int layer, int b, int h, int cid) {
    const int tid = opq((int)threadIdx.x); const bf16* P = WSP(bf16, WS_PROJ); const int row0 = chunk_row0(b, cid);
    LAS float* kf = (LAS float*)F.lds;
    LAS float* qf = kf + 128 * 33;
    LAS float* vf = qf + 128 * 33;
    LAS float* Am = vf + 128 * 64;
    LAS float* Sf = Am + 128 * 129;
    LAS float* red = Sf + 2 * 2048;
    const float lgf = F.lgf[layer * 4 + h], lgb = F.lgb[layer * 4 + h];
    __syncthreads();
    { const int r = tid >> 2, ch = tid & 3; const v4u w = *(const v4u*)(P + (size_t)(row0 + r) * INW + C_RK + h * 32 + ch * 8); LAS float* d = kf + r * 33 + ch * 8;
      d[0] = bflo(w.x); d[1] = bfhi(w.x); d[2] = bflo(w.y); d[3] = bfhi(w.y); d[4] = bflo(w.z); d[5] = bfhi(w.z); d[6] = bflo(w.w); d[7] = bfhi(w.w); }
    { const int r = tid >> 2, ch = tid & 3; const v4u w = *(const v4u*)(P + (size_t)(row0 + r) * INW + C_RQ + h * 32 + ch * 8); LAS float* d = qf + r * 33 + ch * 8;
      d[0] = bflo(w.x); d[1] = bfhi(w.x); d[2] = bflo(w.y); d[3] = bfhi(w.y); d[4] = bflo(w.z); d[5] = bfhi(w.z); d[6] = bflo(w.w); d[7] = bfhi(w.w); }
    for (int idx = tid; idx < 1024; idx += NTHR) { const int r = idx >> 3, ch = idx & 7; const v4u w = *(const v4u*)(P + (size_t)(row0 + r) * INW + C_RV + h * 64 + ch * 8); LAS float* d = vf + r * 64 + ch * 8;
      d[0] = bflo(w.x); d[1] = bfhi(w.x); d[2] = bflo(w.y); d[3] = bfhi(w.y); d[4] = bflo(w.z); d[5] = bfhi(w.z); d[6] = bflo(w.w); d[7] = bfhi(w.w); }
    { const float* sp = WSP(float, WS_KVS) + ((size_t)(b * 4 + h) * NCHK + cid) * 2048;
      for (int idx = tid; idx < 2048; idx += NTHR) { Sf[idx] = sp[idx]; Sf[2048 + idx] = sp[(size_t)32 * NCHK * 2048 + idx]; } }
    const int n = tid & 127, qt = tid >> 7;
    __syncthreads();
#pragma unroll 1
    for (int mm = 0; mm < 32; ++mm) { const int m = qt * 32 + mm; float s = 0.f;
#pragma unroll 8
        for (int d = 0; d < 32; ++d) s += qf[n * 33 + d] * kf[m * 33 + d];
        const float w = m < n ? __expf(lgf * (float)(n - m)) : (m > n ? __expf(lgb * (float)(m - n)) : 2.0f);
        Am[n * 129 + m] = s * w; }
    __syncthreads();
    float o[16];
#pragma unroll
    for (int i = 0; i < 16; ++i) o[i] = 0.f;
#pragma unroll 2
    for (int m = 0; m < 128; ++m) { const float a = Am[n * 129 + m];
#pragma unroll
        for (int i = 0; i < 4; ++i) { const f32x4 vv = *(const LAS f32x4*)(vf + m * 64 + qt * 16 + 4 * i); o[4 * i] += a * vv[0]; o[4 * i + 1] += a * vv[1]; o[4 * i + 2] += a * vv[2]; o[4 * i + 3] += a * vv[3]; } }
    const float cf = __expf(lgf * (float)(n + 1)), cb = __expf(lgb * (float)(128 - n));
#pragma unroll 2
    for (int d = 0; d < 32; ++d) { const float qv = qf[n * 33 + d]; const float q1 = qv * cf, q2 = qv * cb;
#pragma unroll
        for (int i = 0; i < 4; ++i) { const f32x4 sf = *(const LAS f32x4*)(Sf + d * 64 + qt * 16 + 4 * i), sb = *(const LAS f32x4*)(Sf + 2048 + d * 64 + qt * 16 + 4 * i);
            o[4 * i] += q1 * sf[0] + q2 * sb[0]; o[4 * i + 1] += q1 * sf[1] + q2 * sb[1]; o[4 * i + 2] += q1 * sf[2] + q2 * sb[2]; o[4 * i + 3] += q1 * sf[3] + q2 * sb[3]; } }
    float s = 0.f;
#pragma unroll
    for (int i = 0; i < 16; ++i) s += o[i];
    red[n * 4 + qt] = s;
    __syncthreads();
    const float mean = (red[n * 4] + red[n * 4 + 1] + red[n * 4 + 2] + red[n * 4 + 3]) * (1.0f / 64.0f);
    __syncthreads();
    float qd = 0.f;
#pragma unroll
    for (int i = 0; i < 16; ++i) { o[i] -= mean; qd += o[i] * o[i]; }
    red[n * 4 + qt] = qd;
    __syncthreads();
    const float rstd = 1.0f / sqrtf((red[n * 4] + red[n * 4 + 1] + red[n * 4 + 2] + red[n * 4 + 3]) * (1.0f / 64.0f) + LN_EPS);
    const bf16* rgp = P + (size_t)(row0 + n) * INW + C_RG + h * 64 + qt * 16; bf16* dst = WSP(bf16, WS_MIX) + (size_t)(row0 + n) * D + 768 + h * 64 + qt * 16;
#pragma unroll
    for (int i = 0; i < 2; ++i) { const v4u w = *(const v4u*)(rgp + 8 * i); const float r8[8] = {bflo(w.x), bfhi(w.x), bflo(w.y), bfhi(w.y), bflo(w.z), bfhi(w.z), bflo(w.w), bfhi(w.w)}; float y8[8];
#pragma unroll
        for (int k = 0; k < 8; ++k) y8[k] = r8[k] / (1.0f + __expf(-r8[k])) * (o[8 * i + k] * rstd);
#if defined(MIX_CHECK)
        { const v4u cw = *(const v4u*)(dst + 8 * i); const float c8[8] = {bflo(cw.x), bfhi(cw.x), bflo(cw.y), bfhi(cw.y), bflo(cw.z), bfhi(cw.z), bflo(cw.w), bfhi(cw.w)};
#pragma unroll
          for (int k = 0; k < 8; ++k) chk(F, c8[k], y8[k], 0.03f, 0.04f, 11); }
#endif
        v4u ow; ow.x = pk2(y8[0], y8[1]); ow.y = pk2(y8[2], y8[3]); ow.z = pk2(y8[4], y8[5]); ow.w = pk2(y8[6], y8[7]); *(v4u*)(dst + 8 * i) = ow; }
    __syncthreads();
}
__device__ __forceinline__ void p_mix_naive(Frame& F, int layer, const XcdBarrier& bar) {
#if defined(MIX_CHECK)
    p_mix(F, layer); xcd_barrier(bar);
#endif
#if defined(ATTN_CHECK)
    P_ATTN(F, layer); xcd_barrier(bar);
#endif
#if defined(ATTN_NAIVE) || defined(ATTN_CHECK)
    const int n_att = 512 + (layer == 0 ? 32 : 0);
    for (int u = blockIdx.x; u < n_att; u += F.G) {
        if (u < 512) attn_naive_unit(F, layer, u >> 6, (u >> 1) & 31, u & 1, false);
        else { const int v = u - 512; attn_naive_unit(F, layer, v >> 2, (v >> 1) & 1, v & 1, true); }
    }
#elif !defined(MIX_CHECK)
    P_ATTN(F, layer);
#endif
    const int n_pool = 256 + (layer == 0 ? 16 : 0);
    for (int u = blockIdx.x; u < n_pool; u += F.G) { if (u < 256) pool_naive_unit(F, layer, u >> 5, u & 31); else pool_naive_unit(F, layer, 8 + ((u - 256) >> 1), (u - 256) & 1); }
    for (int u = blockIdx.x; u < 32 * NCHK; u += F.G) kv_naive_unit(F, layer, u / (4 * NCHK), (u / NCHK) & 3, u % NCHK);
}
__device__ __forceinline__ void p_ret_naive(Frame& F, int layer, const XcdBarrier& bar) {
#if defined(MIX_CHECK)
    p_ret(F, layer); xcd_barrier(bar);
#endif
    for (int u = blockIdx.x; u < 32 * NCHK; u += F.G) { const int cid = u % NCHK; if (layer == 1 && cid < 2) continue; ret_naive_unit(F, layer, u / (4 * NCHK), (u / NCHK) & 3, cid); }
}
#ifndef MK_N_LAUNCHES
#define MK_N_LAUNCHES 1
#endif
constexpr int NPHASE = 20;
struct Args { const float* in[24]; float* out; unsigned char* ws; int ph_lo, ph_hi; };

__device__ __forceinline__ int moe_tiles(Frame& F, volatile LAS unsigned* MISC) {
    __syncthreads();
    if (threadIdx.x == 0) { int acc = 0;
        for (int e = 0; e < NE; ++e) { const int c = (int)__hip_atomic_load(WSP(unsigned, WS_CTL) + CW_GCNT + 64 * e, RLX_AGENT); MISC[16 + NE + 1 + e] = (unsigned)c; MISC[16 + e] = (unsigned)acc; acc += (c + 255) >> 8; }
        MISC[16 + NE] = (unsigned)acc; }
    __syncthreads();
    return __builtin_amdgcn_readfirstlane((int)MISC[16 + NE]);
}

#ifndef TIME_MASK
#define TIME_MASK 0
#endif
#define TIC(k) unsigned long long tic_ = 0; if (((TIME_MASK) >> (k)) & 1) tic_ = wall_clock64();
#define TOC(k) if (((TIME_MASK) >> (k)) & 1) { __syncthreads(); const unsigned long long t1_ = wall_clock64(); while (wall_clock64() - t1_ < t1_ - tic_) __builtin_amdgcn_s_sleep(8); }
#define IN(k) (lo <= (k) && (k) < hi)
#define SEAM(k) do { if (IN(k) && IN((k) + 1)) { xcd_barrier(bar); REPEAT(13) xcd_barrier(bar); } } while (0)
template <int layer> __device__ __forceinline__ void layer_front(Frame& F, const XcdBarrier& bar, const int lo, const int hi) {
        const int pb = 2 + 9 * layer;
        if (IN(pb)) { TIC(pb)
#if INQ
            pg8::StaticOrder S; S.init(WSP(unsigned char, WS_T8L0), WSP(unsigned char, WS_WIN) + (size_t)layer * INW * D, MT, INW, D, F.G, (int)blockIdx.x); S.rev = (REV_MASK & 4) != 0;
            { LAS f32x4* rl_ = (LAS f32x4*)(F.lds + ROPE_LDS); rl_[threadIdx.x] = WSP(f32x4, WS_ROPE)[threadIdx.x]; __syncthreads(); }
            pg8::EpiInProj<true> E{WSP(bf16, WS_PROJ), (const LAS float*)(F.lds + ROPE_LDS), WSP(float, WS_SH), (const float*)(WSP(unsigned, WS_CTL) + CW_CMAX + CM_WIN + layer * INW)};
            REPEAT(2) pg8::gemm_phase<2>(F.lds, D, S, E);
            if constexpr (layer == 0 && CONV_SPREAD != 0) { if (F.G == 256) { __syncthreads(); bg_convert(F, 184, 72, 0, CV_A); __syncthreads(); } }
#else
            pg8::StaticOrder S; S.init(WSP(bf16, WS_ACT), WSP(bf16, WS_WIN) + (size_t)layer * INW * D, MT, INW, 2 * D, F.G, (int)blockIdx.x);
            { LAS f32x4* rl_ = (LAS f32x4*)(F.lds + ROPE_LDS); rl_[threadIdx.x] = WSP(f32x4, WS_ROPE)[threadIdx.x]; __syncthreads(); }
            pg8::EpiInProj<false> E{WSP(bf16, WS_PROJ), (const LAS float*)(F.lds + ROPE_LDS), nullptr, nullptr};
            pg8::gemm_phase<0>(F.lds, 2 * D, S, E);
#endif
        TOC(pb) } SEAM(pb);
#if defined(MIX_NAIVE) || defined(MIX_CHECK) || defined(ATTN_CHECK) || defined(ATTN_NAIVE)
        if (IN(pb + 1)) { TIC(pb + 1) p_mix_naive(F, layer, bar); TOC(pb + 1) } SEAM(pb + 1);
#else
        if (IN(pb + 1)) { TIC(pb + 1) p_mix(F, layer); TOC(pb + 1) } SEAM(pb + 1);
#endif
        if (IN(pb + 2)) { TIC(pb + 2) p_scan(F, layer); TOC(pb + 2) } SEAM(pb + 2);
#if defined(MIX_NAIVE) || defined(MIX_CHECK) || defined(ATTN_CHECK) || defined(ATTN_NAIVE)
        if (IN(pb + 3)) { TIC(pb + 3) p_ret_naive(F, layer, bar); TOC(pb + 3) } SEAM(pb + 3);
#else
        if (IN(pb + 3)) { TIC(pb + 3) REPEAT(5) p_ret(F, layer); TOC(pb + 3) } SEAM(pb + 3);
#endif
#if FUSE_LN
        if (IN(pb + 4)) { TIC(pb + 4)
            constexpr int total = (layer == 0 ? MT : NL) / 256 * 4;
            const float* modl = WSP(float, WS_MOD) + (size_t)layer * 9 * 6144;
            pg8::PanelStats st{(unsigned*)(F.ws + WS_XB + (layer == 0 ? 0 : 2) * XB_BANK), WSP(unsigned, WS_CTL) + CW_SEAM + (layer == 0 ? 0 : 2) * SEAM_BANK, WSP(unsigned, WS_CTL) + CW_TMO, LN_EPS, 0x700u};
#pragma unroll
            for (int sl = 0; sl * 256 < total; ++sl) {
                pg8::SliceOrder S{sl * 256, total, F.vcu, 2 * D, (const char*)WSP(bf16, WS_MIX), (const char*)(WSP(bf16, WS_WOUT) + (size_t)layer * D * D)};
                if constexpr (layer == 0) {
                    pg8::EpiLN<FFN0_FP8 != 0, false> E{F.x, F.ctx, F.out, WSP(float, WS_XC), modl + 2 * 1024, modl + 3 * 1024, modl + 4 * 1024, F.ln1_g, F.ln1_b, WSP(bf16, WS_ACT), WSP(unsigned char, WS_T8), nullptr, nullptr, st};
                    pg8::gemm_phase<0>(F.lds, 2 * D, S, E);
                } else {
                    pg8::EpiLN<true, true> E{F.out, F.out, F.out, F.out, modl + 2 * 1024, modl + 3 * 1024, modl + 4 * 1024, F.ln1_g + D, F.ln1_b + D, nullptr, WSP(unsigned char, WS_T8), WSP(float, WS_PLOG), F.router, st};
                    pg8::gemm_phase<0>(F.lds, 2 * D, S, E);
                }
                __syncthreads();
            }
        TOC(pb + 4) } SEAM(pb + 4);
        if constexpr (layer == 1) { if (IN(pb + 5)) { TIC(pb + 5) p_route(F); TOC(pb + 5) } SEAM(pb + 5); }
#else
        if (IN(pb + 4)) { TIC(pb + 4)
#if RESADD
            pg8::EpiRes<layer == 0> E{F.ws, 1.0f, WS_ACT, WS_X16, WS_MOD + ((size_t)layer * 9 * 6144 + 2 * 1024) * 4};
#else
            pg8::EpiBf16 E{WSP(bf16, WS_ACT), D, 1.0f};
#endif
            if constexpr (layer == 0 && OUT_SK != 0) {
                pg8::StaticOrderT<true> S; S.init(WSP(bf16, WS_MIX), WSP(bf16, WS_WOUT), MT, D, 2 * D, F.G, (int)blockIdx.x);
                S.sk.init((MT / 256) * (D / 256), 2 * D / 128, F.G, (int)blockIdx.x, F.out, WSP(unsigned, WS_CTL) + CW_SK, (unsigned)(pb + 4 + 1));
                pg8::gemm_phase<0>(F.lds, 2 * D, S, E);
            } else {
                pg8::StaticOrder S; S.init(WSP(bf16, WS_MIX), WSP(bf16, WS_WOUT) + (size_t)layer * D * D, layer == 0 ? MT : NL, D, 2 * D, F.G, (int)blockIdx.x, (TAILQ & 1) != 0); S.rev = (REV_MASK & 16) != 0;
                REPEAT(6) { pg8::gemm_phase<0>(F.lds, 2 * D, S, E); if (TAILQ & 1) pg8::gemm_tail<0>(F.lds, 2 * D, S, E); }
                if constexpr (layer == 0 && CONV_SPREAD != 0 && (TAILQ & 1) != 0) { if (F.G == 256) { __syncthreads(); bg_convert(F, 128, 128, CV_B, CV_C); __syncthreads(); } }
            }
        TOC(pb + 4) } SEAM(pb + 4);
        if (IN(pb + 5)) { TIC(pb + 5) p_ln1(F, layer); TOC(pb + 5) } SEAM(pb + 5);
#endif
        if constexpr (layer == 0) {
#if FFN0_FP8
        if (IN(8)) { TIC(8)
            pg8::StaticOrder S; S.init(WSP(unsigned char, WS_T8), WSP(unsigned char, WS_FGU), MT, 2 * FF, D, F.G, (int)blockIdx.x);
            pg8::EpiSwiGLU8 E{WSP(unsigned char, WS_HID), FF, 1.0f / 128.0f, 4.0f};
            pg8::gemm_phase<1>(F.lds, D, S, E);
        TOC(8) } SEAM(8);
        if (IN(9)) { TIC(9)
            pg8::StaticOrder S; S.init(WSP(unsigned char, WS_HID), WSP(unsigned char, WS_FD), MT, D, FF, F.G, (int)blockIdx.x);
            pg8::EpiBf16 E{WSP(bf16, WS_ACT), D, 1.0f / 512.0f};
            pg8::gemm_phase<1>(F.lds, FF, S, E);
        TOC(9) } SEAM(9);
#else
        if (IN(8)) { TIC(8)
            pg8::StaticOrder S; S.init(WSP(unsigned char, WS_T8L0), WSP(unsigned char, WS_FGU), MT, 2 * FF, D, F.G, (int)blockIdx.x);
#if HID_FP8
            pg8::EpiSwiGLUq<true, false> E{WSP(unsigned char, WS_HID), FF, WSP(float, WS_ST), (const float*)(WSP(unsigned, WS_CTL) + CW_CMAX), nullptr, 4.0f};
#else
            pg8::EpiSwiGLUq<false, false> E{WSP(bf16, WS_HID), FF, WSP(float, WS_ST), (const float*)(WSP(unsigned, WS_CTL) + CW_CMAX), nullptr, 1.0f};
#endif
            REPEAT(8) pg8::gemm_phase<2>(F.lds, D, S, E);
            if constexpr (CONV_SPREAD != 0) { if (F.G == 256) { __syncthreads(); bg_convert(F, 176, 80, CV_C, CV_E); __syncthreads(); } }
        TOC(8) } SEAM(8);
#if FUSE_LN
        if (IN(9)) { TIC(9)
            const float* mod0 = WSP(float, WS_MOD), *mod1 = WSP(float, WS_MOD) + (size_t)9 * 6144;
            pg8::PanelStats st{(unsigned*)(F.ws + WS_XB + XB_BANK), WSP(unsigned, WS_CTL) + CW_SEAM + SEAM_BANK, WSP(unsigned, WS_CTL) + CW_TMO, LN_EPS, 0x740u};
#pragma unroll
            for (int sl = 0; sl < 3; ++sl) {
                pg8::SliceOrder S{sl * 256, MT / 256 * 4, F.vcu, 2 * FF, (const char*)WSP(bf16, WS_HID), (const char*)WSP(bf16, WS_FD)};
                pg8::EpiLN<false, false> E{F.out, WSP(float, WS_XC), F.out, WSP(float, WS_XC), mod0 + 5 * 1024, mod1 + 0 * 1024, mod1 + 1 * 1024, F.ln2_g, F.ln2_b, WSP(bf16, WS_ACT), nullptr, nullptr, nullptr, st};
                pg8::gemm_phase<0>(F.lds, 2 * FF, S, E);
                __syncthreads();
            }
        TOC(9) } SEAM(9);
#else
        if (IN(9)) { TIC(9)
#if FFD_SK
            pg8::StaticOrderT<true> S; S.init(WSP(bf16, WS_HID), WSP(bf16, WS_FD), MT, D, 2 * FF, F.G, (int)blockIdx.x);
            S.sk.init((MT / 256) * (D / 256), 2 * FF / 128, F.G, (int)blockIdx.x, F.out, WSP(unsigned, WS_CTL) + CW_SK, 10u);
            pg8::EpiBf16 E{WSP(bf16, WS_ACT), D, 1.0f};
            pg8::gemm_phase<0>(F.lds, 2 * FF, S, E);
#if BGCONV
            __syncthreads(); bg_convert(F, 0, F.G); __syncthreads();
#endif
#else
#if HID_FP8
            pg8::StaticOrder S; S.init(WSP(unsigned char, WS_HID), WSP(unsigned char, WS_FD), MT, D, FF, F.G, (int)blockIdx.x, (TAILQ & 2) != 0); S.rev = (REV_MASK & 1) != 0;
#if RESADD
            pg8::EpiRes<false> E{F.ws, 1.0f / 512.0f, WS_ACT, WS_X16, WS_MOD + (size_t)5 * 1024 * 4};
#else
            pg8::EpiBf16 E{WSP(bf16, WS_ACT), D, 1.0f / 512.0f};
#endif
            REPEAT(9) { pg8::gemm_phase<1>(F.lds, FF, S, E); if (TAILQ & 2) pg8::gemm_tail<1>(F.lds, FF, S, E); }
#else
            pg8::StaticOrder S; S.init(WSP(bf16, WS_HID), WSP(bf16, WS_FD), MT, D, 2 * FF, F.G, (int)blockIdx.x, (TAILQ & 2) != 0); S.rev = (REV_MASK & 1) != 0;
            pg8::EpiBf16 E{WSP(bf16, WS_ACT), D, 1.0f};
            REPEAT(9) { pg8::gemm_phase<0>(F.lds, 2 * FF, S, E); if (TAILQ & 2) pg8::gemm_tail<0>(F.lds, 2 * FF, S, E); }
#endif
#if BGCONV
            __syncthreads(); REPEAT(10) { const int cv0 = (CONV_SPREAD != 0 && (TAILQ & 1) != 0 && F.G == 256) ? CV_E : 0; if (F.G == 256 && !(TAILQ & 2)) bg_convert(F, 32, 224, cv0); else if (F.G == 256) bg_convert(F, -1, 256, cv0); else bg_convert(F, 0, F.G); __syncthreads(); }
#endif
#endif
        TOC(9) } SEAM(9);
#endif
#endif
#if !FUSE_LN
        if (IN(10)) { TIC(10) p_ln2_l0(F); TOC(10) } SEAM(10);
#endif
        }
}

__global__ void __launch_bounds__(NTHR, 2) hybrid_fwd(Args args) {
    extern __shared__ __attribute__((aligned(16))) unsigned char lds_raw[];
    Frame F;
    F.lds = (LAS unsigned char*)lds_raw;
    F.wave = __builtin_amdgcn_readfirstlane((int)threadIdx.x >> 6);
    F.G = gridDim.x; { const int bx = blockIdx.x; F.vcu = (F.G % 8 == 0) ? (bx % 8) * (F.G / 8) + bx / 8 : bx; }
    F.ws = args.ws; F.out = args.out;
    F.x = args.in[0]; F.c = args.in[1]; F.ctx = args.in[2]; F.c_ctx = args.in[3]; F.w_mod = args.in[4]; F.b_mod = args.in[5]; F.w_in = args.in[6]; F.sink = args.in[7];
    F.pool_w = args.in[8]; F.pool_scale = args.in[9]; F.lgf = args.in[10]; F.lgb = args.in[11]; F.w_out = args.in[12]; F.ln1_g = args.in[13]; F.ln1_b = args.in[14]; F.ln2_g = args.in[15]; F.ln2_b = args.in[16];
    F.fw_gate = args.in[17]; F.fw_up = args.in[18]; F.fw_down = args.in[19]; F.router = args.in[20]; F.mw_gate = args.in[21]; F.mw_up = args.in[22]; F.mw_down = args.in[23];
    volatile LAS unsigned* MISC = (volatile LAS unsigned*)(F.lds + MISC_OFF);
    if (threadIdx.x < 64) MISC[threadIdx.x] = 0u;
    __syncthreads();
    const int lo = args.ph_lo, hi = args.ph_hi;
    XcdBarrier bar; bar.bar = WSP(unsigned, WS_CTL) + CW_BAR; bar.x = 0; bar.st = nullptr;
    if (hi - lo > 1) bar = xcd_barrier_post(WSP(unsigned, WS_CTL) + CW_BAR, MISC + 8);

    if (IN(0)) { TIC(0) REPEAT(0) p_prep(F); TOC(0) } SEAM(0);
    if (IN(1)) { TIC(1) REPEAT(1) { p_h0(F); __syncthreads(); } REPEAT(11) { quant_dense_gu(F); REPSYNC(11) } TOC(1) } SEAM(1);
    layer_front<0>(F, bar, lo, hi);
    layer_front<1>(F, bar, lo, hi);
    if (IN(17)) { TIC(17)
        pg8::MoeOrder<true> S; S.nrt = moe_tiles(F, MISC); S.tbl = (const LAS int*)(MISC + 16);
        S.T0 = 0; S.nN = 2 * FF / 256; S.G = F.G; S.c = (int)blockIdx.x; S.KB = D;
        S.A = (const char*)WSP(unsigned char, WS_T8); S.Bt = (const char*)WSP(unsigned char, WS_MGU8); S.bstride = (size_t)2 * FF * D; S.list = WSP(int, WS_LIST);
#if MOEQ
        pg8::EpiSwiGLUq<true, true> E{WSP(unsigned char, WS_HID8), FF, WSP(float, WS_ST), (const float*)(WSP(unsigned, WS_CTL) + CW_CMAX) + 2 * FF, WSP(int, WS_LIST), 4.0f};
        pg8::gemm_phase<2>(F.lds, D, S, E);
#else
        pg8::EpiSwiGLU8 E{WSP(unsigned char, WS_HID8), FF, 1.0f / 128.0f, 4.0f};
#if ((REP_MASK) >> 13) & 2
        S.i0 = 0; S.i1 = 12; pg8::gemm_phase<1>(F.lds, D, S, E); xcd_barrier(bar); S.i0 = 12; S.i1 = 1 << 30; pg8::gemm_phase<1>(F.lds, D, S, E);
#else
        REPEAT(17) pg8::gemm_phase<1>(F.lds, D, S, E);
#endif
#endif
    TOC(17) } SEAM(17);
    if (IN(18)) { TIC(18)
        pg8::MoeOrder<false, MOE_SK != 0> S; S.nrt = moe_tiles(F, MISC); S.tbl = (const LAS int*)(MISC + 16);
        S.T0 = 0; S.nN = D / 256; S.G = F.G; S.c = (int)blockIdx.x; S.KB = FF;
        S.rev = (REV_MASK & 2) != 0;
        if constexpr (MOE_SK != 0) S.sk.init(S.nrt * (D / 256), FF / 128, F.G, (int)blockIdx.x, F.out, WSP(unsigned, WS_CTL) + CW_SK, 19u);
        S.A = (const char*)WSP(unsigned char, WS_HID8); S.Bt = (const char*)WSP(unsigned char, WS_MD8); S.bstride = (size_t)FF * D; S.list = WSP(int, WS_LIST);
        pg8::EpiMoeDown E{WSP(bf16, WS_Y), WSP(int, WS_LIST), WSP(float, WS_LGATE), 1.0f / 512.0f};
        S.tail.init(S.nrt * S.nN, F.G, (int)blockIdx.x, (TAILQ & 4) != 0);
        REPEAT(18) { pg8::gemm_phase<1>(F.lds, FF, S, E); if (TAILQ & 4) pg8::gemm_tail<1>(F.lds, FF, S, E); }
    TOC(18) } SEAM(18);
    if (IN(19)) { TIC(19) REPEAT(19) p_final(F); TOC(19) }
#undef IN
#undef SEAM
}

extern "C" void kernel_launch(void* const* d_in, const int* in_sizes, int n_in, void* d_out, int out_size, void* d_ws, size_t ws_size, hipStream_t stream) {
    static int grid = 0;
    if (grid == 0) {
        if (n_in != 24 || out_size != NL * D || ws_size < WS_END) { fprintf(stderr, "kernel_launch: unexpected shapes (n_in %d, out %d, ws %zu < %zu); nothing launched\n", n_in, out_size, ws_size, (size_t)WS_END); grid = -1; return; }
        int dev = 0, cus = 0, per_cu = 0;
        if (hipGetDevice(&dev) != hipSuccess || hipDeviceGetAttribute(&cus, hipDeviceAttributeMultiprocessorCount, dev) != hipSuccess) { grid = -1; return; }
        if (hipFuncSetAttribute((const void*)hybrid_fwd, hipFuncAttributeMaxDynamicSharedMemorySize, LDS_BYTES) != hipSuccess) { fprintf(stderr, "kernel_launch: hipFuncSetAttribute failed\n"); grid = -1; return; }
        if (hipOccupancyMaxActiveBlocksPerMultiprocessor(&per_cu, (const void*)hybrid_fwd, NTHR, LDS_BYTES) != hipSuccess || per_cu < 1) { fprintf(stderr, "kernel_launch: occupancy query says %d\n", per_cu); }
        (void)hipGetLastError();
        grid = cus;
    }
    if (grid < 0) return;
    if (hipMemsetAsync((char*)d_ws + WS_CTL, 0, CTL_ZERO_BYTES, stream) != hipSuccess) return;
    Args a{};
    for (int i = 0; i < 24; ++i) a.in[i] = (const float*)d_in[i];
    a.out = (float*)d_out; a.ws = (unsigned char*)d_ws;
#if MK_N_LAUNCHES == 1
    a.ph_lo = 0; a.ph_hi = NPHASE;
    hipLaunchKernelGGL(hybrid_fwd, dim3(grid), dim3(NTHR), LDS_BYTES, stream, a);
#else
    for (int p = 0; p < NPHASE; ++p) { a.ph_lo = p; a.ph_hi = p + 1; hipLaunchKernelGGL(hybrid_fwd, dim3(grid), dim3(NTHR), LDS_BYTES, stream, a); }
#endif
}
```

```cpp
#include <hip/hip_runtime.h>
#include <cstdio>
#include <cstdint>
#define MK_N_LAUNCHES 1
#ifndef INQ
#define INQ 1
#endif
#ifndef MOEQ
#define MOEQ 0
#endif
#ifndef BGCONV
#define BGCONV 1
#endif
#ifndef RES16
#define RES16 1
#endif
#ifndef FUSE_LN
#define FUSE_LN 0
#endif
#ifndef MOE_SK
#define MOE_SK 0
#endif
#ifndef FFD_SK
#define FFD_SK 0
#endif
#ifndef OUT_SK
#define OUT_SK 0
#endif
#ifndef REV_MASK
#define REV_MASK 15
#endif
#ifndef ATTN_LATE
#define ATTN_LATE 0
#endif
#ifndef TAILQ
#define TAILQ 7
#endif
#ifndef CONV_SPREAD
#define CONV_SPREAD 0
#endif
#ifndef HID_FP8
#define HID_FP8 1
#endif
#ifndef PFA_MASK
#define PFA_MASK 0
#define PFA_D 4
#endif
#ifndef PINGPONG
#define PINGPONG 0
#endif
#ifndef L1_ONLY_INV
#define L1_ONLY_INV 1
#endif
#ifndef SCAN_FUSE
#define SCAN_FUSE 1
#endif
#ifndef FFN0_FP8
#define FFN0_FP8 0
#endif
#ifndef REP_MASK
#define REP_MASK 0
#endif
#if ((REP_MASK) >> 0) & 1
#define REPEAT_0 _Pragma("unroll 1") for (int rep_ = 0; rep_ < 2; ++rep_)
#define REPSYNC_0 __syncthreads();
#else
#define REPEAT_0
#define REPSYNC_0
#endif
#if ((REP_MASK) >> 1) & 1
#define REPEAT_1 _Pragma("unroll 1") for (int rep_ = 0; rep_ < 2; ++rep_)
#define REPSYNC_1 __syncthreads();
#else
#define REPEAT_1
#define REPSYNC_1
#endif
#if ((REP_MASK) >> 2) & 1
#define REPEAT_2 _Pragma("unroll 1") for (int rep_ = 0; rep_ < 2; ++rep_)
#define REPSYNC_2 __syncthreads();
#else
#define REPEAT_2
#define REPSYNC_2
#endif
#if ((REP_MASK) >> 3) & 1
#define REPEAT_3 _Pragma("unroll 1") for (int rep_ = 0; rep_ < 2; ++rep_)
#define REPSYNC_3 __syncthreads();
#else
#define REPEAT_3
#define REPSYNC_3
#endif
#if ((REP_MASK) >> 4) & 1
#define REPEAT_4 _Pragma("unroll 1") for (int rep_ = 0; rep_ < 2; ++rep_)
#define REPSYNC_4 __syncthreads();
#else
#define REPEAT_4
#define REPSYNC_4
#endif
#if ((REP_MASK) >> 5) & 1
#define REPEAT_5 _Pragma("unroll 1") for (int rep_ = 0; rep_ < 2; ++rep_)
#define REPSYNC_5 __syncthreads();
#else
#define REPEAT_5
#define REPSYNC_5
#endif
#if ((REP_MASK) >> 6) & 1
#define REPEAT_6 _Pragma("unroll 1") for (int rep_ = 0; rep_ < 2; ++rep_)
#define REPSYNC_6 __syncthreads();
#else
#define REPEAT_6
#define REPSYNC_6
#endif
#if ((REP_MASK) >> 7) & 1
#define REPEAT_7 _Pragma("unroll 1") for (int rep_ = 0; rep_ < 2; ++rep_)
#define REPSYNC_7 __syncthreads();
#else
#define REPEAT_7
#define REPSYNC_7
#endif
#if ((REP_MASK) >> 8) & 1
#define REPEAT_8 _Pragma("unroll 1") for (int rep_ = 0; rep_ < 2; ++rep_)
#define REPSYNC_8 __syncthreads();
#else
#define REPEAT_8
#define REPSYNC_8
#endif
#if ((REP_MASK) >> 9) & 1
#define REPEAT_9 _Pragma("unroll 1") for (int rep_ = 0; rep_ < 2; ++rep_)
#define REPSYNC_9 __syncthreads();
#else
#define REPEAT_9
#define REPSYNC_9
#endif
#if ((REP_MASK) >> 10) & 1
#define REPEAT_10 _Pragma("unroll 1") for (int rep_ = 0; rep_ < 2; ++rep_)
#define REPSYNC_10 __syncthreads();
#else
#define REPEAT_10
#define REPSYNC_10
#endif
#if ((REP_MASK) >> 11) & 1
#define REPEAT_11 _Pragma("unroll 1") for (int rep_ = 0; rep_ < 2; ++rep_)
#define REPSYNC_11 __syncthreads();
#else
#define REPEAT_11
#define REPSYNC_11
#endif
#if ((REP_MASK) >> 12) & 1
#define REPEAT_12 _Pragma("unroll 1") for (int rep_ = 0; rep_ < 2; ++rep_)
#define REPSYNC_12 __syncthreads();
#else
#define REPEAT_12
#define REPSYNC_12
#endif
#if ((REP_MASK) >> 13) & 1
#define REPEAT_13 _Pragma("unroll 1") for (int rep_ = 0; rep_ < 2; ++rep_)
#define REPSYNC_13 __syncthreads();
#else
#define REPEAT_13 if (false)
#define REPSYNC_13
#endif
#if ((REP_MASK) >> 14) & 1
#define REPEAT_14 _Pragma("unroll 1") for (int rep_ = 0; rep_ < 2; ++rep_)
#define REPSYNC_14 __syncthreads();
#else
#define REPEAT_14
#define REPSYNC_14
#endif
#if ((REP_MASK) >> 15) & 1
#define REPEAT_15 _Pragma("unroll 1") for (int rep_ = 0; rep_ < 2; ++rep_)
#define REPSYNC_15 __syncthreads();
#else
#define REPEAT_15
#define REPSYNC_15
#endif
#if ((REP_MASK) >> 16) & 1
#define REPEAT_16 _Pragma("unroll 1") for (int rep_ = 0; rep_ < 2; ++rep_)
#define REPSYNC_16 __syncthreads();
#else
#define REPEAT_16
#define REPSYNC_16
#endif
#if ((REP_MASK) >> 17) & 1
#define REPEAT_17 _Pragma("unroll 1") for (int rep_ = 0; rep_ < 2; ++rep_)
#define REPSYNC_17 __syncthreads();
#else
#define REPEAT_17
#define REPSYNC_17
#endif
#if ((REP_MASK) >> 18) & 1
#define REPEAT_18 _Pragma("unroll 1") for (int rep_ = 0; rep_ < 2; ++rep_)
#define REPSYNC_18 __syncthreads();
#else
#define REPEAT_18
#define REPSYNC_18
#endif
#if ((REP_MASK) >> 19) & 1
#define REPEAT_19 _Pragma("unroll 1") for (int rep_ = 0; rep_ < 2; ++rep_)
#define REPSYNC_19 __syncthreads();
#else
#define REPEAT_19
#define REPSYNC_19
#endif
#define REPEAT(bit) REPEAT_##bit
#define REPSYNC(bit) REPSYNC_##bit
__device__ __forceinline__ int opq(int v) { asm volatile("" : "+v"(v)); return v; }
namespace pg8 {
#define PG8_LAS __attribute__((address_space(3)))
typedef unsigned short bf16_t;
typedef short bf16x8 __attribute__((ext_vector_type(8)));
typedef float f32x4 __attribute__((ext_vector_type(4)));
typedef float f32x2 __attribute__((ext_vector_type(2)));
typedef unsigned u32x4 __attribute__((ext_vector_type(4)));
constexpr int BM = 256, BK = 64, HALF = 128, HTB = HALF * BK * 2  , STAGE_BYTES = 8 * HTB, NXCD = 8, WGM = 8;

__host__ __device__ __forceinline__ int lds_byte(int r, int c) { const int st = (r >> 4) * 2 + (c >> 5), rr = r & 15, cc = c & 31, ob = rr * 64 + cc * 2; return st * 1024 + (ob ^ (((ob >> 9) & 1) << 5)); }
__host__ __device__ __forceinline__ void stage_rc(int b, int& R, int& C) { const int st = b / 1024, sb = b % 1024, swz = sb ^ (((sb >> 9) & 1) << 5); R = (st >> 1) * 16 + swz / 64; C = (st & 1) * 32 + (swz % 64) / 2; }
__host__ __device__ __forceinline__ int perm32(int rho) { const int n = rho >> 4, i = rho & 15; return 8 * (i >> 2) + 4 * n + (i & 3); }

struct Unit { int pm, pn, e, rt, cnt; const char* ab; const char* bb; int nt, part, slot; };

__device__ __forceinline__ void tile_from_L(int L, int nM, int nN, int& pm, int& pn) {
    const int nwg = nM * nN;
    int wgid = L; { const int q = nwg / NXCD, r = nwg % NXCD, xcd = wgid % NXCD, off = wgid / NXCD; wgid = (xcd < r ? xcd * (q + 1) : r * (q + 1) + (xcd - r) * q) + off; }
    const int nig = WGM * nN, gid = wgid / nig, fm = gid * WGM, gsz = (nM - fm) < WGM ? (nM - fm) : WGM;
    pm = fm + ((wgid % nig) % gsz); pn = (wgid % nig) / gsz;
}
__device__ __forceinline__ bool tile_order(int i, int G, int c, int nM, int nN, int& pm, int& pn, bool rev = false) {
    const int nwg = nM * nN; const long L = (long)i * G + c; if (L >= nwg) return false;
    int wgid = (int)L; { const int q = nwg / NXCD, r = nwg % NXCD, xcd = wgid % NXCD; int off = wgid / NXCD; if (rev) off = q + (xcd < r ? 1 : 0) - 1 - off;
        wgid = (xcd < r ? xcd * (q + 1) : r * (q + 1) + (xcd - r) * q) + off; }
    const int nig = WGM * nN, gid = wgid / nig, fm = gid * WGM, gsz = (nM - fm) < WGM ? (nM - fm) : WGM;
    pm = fm + ((wgid % nig) % gsz); pn = (wgid % nig) / gsz; return true;
}
struct StreamK {
    int on, x, W, F, P, a, b, c; float* slots; unsigned* flags; unsigned tag;
    __device__ __forceinline__ void init(int n, int ntile, int G, int c_, float* slots_, unsigned* flags_, unsigned tag_) {
        c = c_; slots = slots_; flags = flags_; tag = tag_; on = 0; P = ntile >> 1; x = c_ & 7; W = G >> 3; F = 0; a = 0; b = 0;
        if ((G & 7) == 0 && (ntile & 1) == 0) { const int k = c_ >> 3, nx = (n - x + 7) >> 3;
            if (nx >= W) { on = 1; F = nx / W - 1; const int T = (nx - F * W) * P; a = (k * T) / W; b = ((k + 1) * T) / W; } }
    }
    __device__ __forceinline__ bool next(int i, int n, int G, int& L, int& p0, int& np, int& part) const {
        if (!on || i < F) { L = i * G + c; p0 = 0; np = P; part = 0; return L < n; }
        const int q = a / P + (i - F); const int s = a > q * P ? a : q * P, e = b < (q + 1) * P ? b : (q + 1) * P;
        if (s >= e) return false;
        L = (F * W + q) * 8 + x; p0 = s - q * P; np = e - s; part = p0 > 0 ? 1 : (np < P ? 2 : 0); return true;
    }
};
struct TailPlan { int F = 1 << 30, rem = 0, x = 0, W = 1;
    __device__ __forceinline__ void init(int n, int G, int c, bool enable) { F = 1 << 30; rem = 0; x = c & 7; W = G >> 3;
        if (enable && (G & 7) == 0 && W > 0) { const int nx = (n - x + 7) >> 3, f = nx / W, r = nx - f * W; if (r > 0 && r <= 8 && f > 0) { F = f; rem = r; } } }
    __device__ __forceinline__ bool quarter(int j, int c, int& cq, int& ai, int& bj) const { const int v = (c >> 3) + W * j, q = v >> 2; if (q >= rem) return false; cq = q * 8 + x; ai = (v >> 1) & 1; bj = v & 1; return true; }
};
template <bool SK_> struct StaticOrderT {
    static constexpr bool GATHER = false, SK = SK_;
    int nM, nN, G, c, KB; const char* A; const char* Bt;
    bool rev = false;
    StreamK sk; TailPlan tail;
    __device__ __forceinline__ void init(const void* A_, const void* Bt_, int M, int N, int KB_, int G_, int c_, bool tail_ = false) { A = (const char*)A_; Bt = (const char*)Bt_; nM = M / BM; nN = N / BM; KB = KB_; G = G_; c = c_; tail.init(nM * nN, G_, c_, tail_); }
    __device__ __forceinline__ bool tail_next(int j, Unit& u, int& ai, int& bj) const {
        int cq, pm, pn; if (!tail.quarter(j, c, cq, ai, bj) || !tile_order(tail.F, G, cq, nM, nN, pm, pn, rev)) return false;
        u.pm = pm; u.pn = pn; u.e = 0; u.rt = pm; u.cnt = 1 << 30; u.ab = A + (size_t)pm * BM * KB; u.bb = Bt + (size_t)pn * BM * KB; return true;
    }
    __device__ __forceinline__ bool next(int i, Unit& u) const {
        int pm, pn; if (i >= tail.F) return false;
        if constexpr (SK) { int L, p0, np, part; if (!sk.next(i, nM * nN, G, L, p0, np, part)) return false;
            tile_from_L(L, nM, nN, pm, pn);
            u.pm = pm; u.pn = pn; u.e = 0; u.rt = pm; u.cnt = 1 << 30; u.ab = A + (size_t)pm * BM * KB + (size_t)p0 * 256; u.bb = Bt + (size_t)pn * BM * KB + (size_t)p0 * 256;
            u.nt = 2 * np; u.part = part; u.slot = part == 2 ? c + 8 : c; return true; }
        else { if (!tile_order(i, G, c, nM, nN, pm, pn, rev)) return false;
            u.pm = pm; u.pn = pn; u.e = 0; u.rt = pm; u.cnt = 1 << 30; u.ab = A + (size_t)pm * BM * KB; u.bb = Bt + (size_t)pn * BM * KB; return true; }
    }
    __device__ __forceinline__ void aoff(const Unit&, int tid, unsigned (&va)[2][2]) const {
#pragma unroll
        for (int i = 0; i < 2; ++i) { int R, C; stage_rc(tid * 16 + i * 8192, R, C);
#pragma unroll
            for (int h = 0; h < 2; ++h) va[h][i] = (unsigned)((R + HALF * h) * KB + C * 2); }
    }
};
typedef StaticOrderT<false> StaticOrder;

typedef int v8i32 __attribute__((ext_vector_type(8)));
typedef int v4i32 __attribute__((ext_vector_type(4)));
__device__ __forceinline__ v8i32 cat8(bf16x8 a, bf16x8 b) { const v4i32 x = __builtin_bit_cast(v4i32, a), y = __builtin_bit_cast(v4i32, b); return (v8i32){x[0], x[1], x[2], x[3], y[0], y[1], y[2], y[3]}; }
__device__ __forceinline__ void glds16s(unsigned voff, const void* sbase, unsigned lds_dst) { unsigned keep;
    asm volatile("s_mov_b32 %0, m0\n\ts_mov_b32 m0, %3\n\ts_nop 0\n\tglobal_load_lds_dwordx4 %1, %2\n\ts_mov_b32 m0, %0" : "=&s"(keep) : "v"(voff), "s"(sbase), "s"(lds_dst) : "memory"); }
__device__ __forceinline__ unsigned cvt_pk_bf16(float lo, float hi) { unsigned r; asm volatile("v_cvt_pk_bf16_f32 %0, %1, %2" : "=v"(r) : "v"(lo), "v"(hi)); return r; }

template <int MODE  , int PF = 0, class Epi, class Sched>
__device__ __forceinline__ void gemm_phase(PG8_LAS unsigned char* lds, const int KB, const Sched& S, const Epi& E) {
    const int tid = opq((int)threadIdx.x), wid = __builtin_amdgcn_readfirstlane(tid >> 6), lane = tid & 63, wr = wid >> 2, wc = wid & 3, fr = lane & 15, fq = lane >> 4;
    const int nt = KB / 128;
    unsigned voffB[2];
#pragma unroll
    for (int i = 0; i < 2; ++i) { int R, C; stage_rc(tid * 16 + i * 8192, R, C); const int Rb = Epi::PERM ? ((R & ~31) + perm32(R & 31)) : R; voffB[i] = (unsigned)(Rb * KB + C * 2); }
    const size_t kstep = (size_t)(BK * 2);
    const size_t hstep = (size_t)HALF * KB;
    const unsigned ldsw = (unsigned)wid * 1024u;
    const int aoff = lds_byte(wr * 64 + fr, fq * 8), boff = lds_byte(wc * 32 + fr, fq * 8);
    const unsigned lds0 = (unsigned)(uintptr_t)lds;
#define PG8_SA(b, h) (((b) * 2 + (h)) * HTB)
#define PG8_SB(b, h) ((4 + (b) * 2 + (h)) * HTB)
#define PG8_STAGE(bufoff, gbase, voff) do { _Pragma("unroll") for (int _i = 0; _i < 2; ++_i) glds16s((voff)[_i], (const void*)(gbase), lds0 + (unsigned)(bufoff) + ldsw + (unsigned)(_i * 8192)); } while (0)
#define PG8_LD8(p) __builtin_shufflevector(*(const PG8_LAS v4i32*)(p), *(const PG8_LAS v4i32*)((p) + 1024), 0, 1, 2, 3, 4, 5, 6, 7)
#define PG8_LDA(dst, b, h) do { _Pragma("unroll") for (int m = 0; m < 4; ++m) dst[m] = PG8_LD8(lds + PG8_SA(b, h) + aoff + m * 2048); } while (0)
#define PG8_LDB(dst, b, h) do { _Pragma("unroll") for (int n = 0; n < 2; ++n) dst[n] = PG8_LD8(lds + PG8_SB(b, h) + boff + n * 2048); } while (0)
#define PG8_LO(v) __builtin_bit_cast(bf16x8, __builtin_shufflevector(v, v, 0, 1, 2, 3))
#define PG8_HI(v) __builtin_bit_cast(bf16x8, __builtin_shufflevector(v, v, 4, 5, 6, 7))
#define PG8_MMA(ai, bj, At, Bt) do { __builtin_amdgcn_s_setprio(1); _Pragma("unroll") for (int m = 0; m < 4; ++m) _Pragma("unroll") for (int n = 0; n < 2; ++n) { \
        if constexpr (MODE == 1) acc[ai][bj][m][n] = __builtin_amdgcn_mfma_scale_f32_16x16x128_f8f6f4(Bt[n], At[m], acc[ai][bj][m][n], 0, 0, 0, 0, 0, 0); \
        else if constexpr (MODE == 2) { v4i32 c_ = __builtin_bit_cast(v4i32, acc[ai][bj][m][n]); \
               c_ = __builtin_amdgcn_mfma_i32_16x16x64_i8(__builtin_shufflevector(Bt[n], Bt[n], 0, 1, 2, 3), __builtin_shufflevector(At[m], At[m], 0, 1, 2, 3), c_, 0, 0, 0); \
               c_ = __builtin_amdgcn_mfma_i32_16x16x64_i8(__builtin_shufflevector(Bt[n], Bt[n], 4, 5, 6, 7), __builtin_shufflevector(At[m], At[m], 4, 5, 6, 7), c_, 0, 0, 0); \
               acc[ai][bj][m][n] = __builtin_bit_cast(f32x4, c_); } \
        else { acc[ai][bj][m][n] = __builtin_amdgcn_mfma_f32_16x16x32_bf16(PG8_LO(Bt[n]), PG8_LO(At[m]), acc[ai][bj][m][n], 0, 0, 0); \
               acc[ai][bj][m][n] = __builtin_amdgcn_mfma_f32_16x16x32_bf16(PG8_HI(Bt[n]), PG8_HI(At[m]), acc[ai][bj][m][n], 0, 0, 0); } } \
        __builtin_amdgcn_s_setprio(0); } while (0)
#define PG8_WAIT_V(n) asm volatile("s_waitcnt vmcnt(" #n ")" ::: "memory")
#define PG8_WAIT_LOOP do { if constexpr (PF > 0) PG8_WAIT_V(12); else PG8_WAIT_V(8); } while (0)
#define PG8_PFA(p, h) do { if constexpr (PF > 0) { const int q_ = (p) + PF; const char* g_ = q_ < ntu ? cA + (size_t)q_ * kstep : nA + (size_t)(q_ - ntu) * kstep; \
        _Pragma("unroll") for (int _i = 0; _i < 2; ++_i) glds16s(va[h][_i], (const void*)g_, lds0 + 147456u + ldsw); } } while (0)
#define PG8_WAIT_L(n) asm volatile("s_waitcnt lgkmcnt(" #n ")" ::: "memory")
#define PG8_BAR __builtin_amdgcn_s_barrier()
#define PG8_SCHED __builtin_amdgcn_sched_barrier(0)
    Unit cur, nxt; int ui = 0;
    if (!S.next(0, cur)) return;
    unsigned va[2][2];
    S.aoff(cur, tid, va);
    f32x4 acc[2][2][4][2];
#define PG8_ACC_INIT(U) do { \
    bool ld_ = false; if constexpr (Sched::SK) ld_ = (U).part == 2; \
    if (ld_) { const int t2 = opq((int)threadIdx.x); const char* sb = (const char*)S.sk.slots + (size_t)(U).slot * (size_t)(BM * BM * 4); const unsigned vo = (unsigned)t2 * 16u; unsigned* fl = S.sk.flags + (U).slot * 16; \
        if (t2 == 0) { unsigned sp_ = 0; while (__hip_atomic_load(fl, __ATOMIC_RELAXED, __HIP_MEMORY_SCOPE_AGENT) != S.sk.tag) { __builtin_amdgcn_s_sleep(1); if (++sp_ > (1u << 24)) break; } \
            } \
        PG8_BAR; \
        _Pragma("unroll") for (int a = 0; a < 2; ++a) _Pragma("unroll") for (int b = 0; b < 2; ++b) _Pragma("unroll") for (int m = 0; m < 4; ++m) _Pragma("unroll") for (int n = 0; n < 2; ++n) \
            asm volatile("global_load_dwordx4 %0, %1, %2 sc1" : "=v"(acc[a][b][m][n]) : "v"(vo), "s"(sb + (((a * 2 + b) * 4 + m) * 2 + n) * 8192) : "memory");        \
        asm volatile("s_waitcnt vmcnt(0)" ::: "memory"); \
    } else { \
        _Pragma("unroll") for (int a = 0; a < 2; ++a) _Pragma("unroll") for (int b = 0; b < 2; ++b) _Pragma("unroll") for (int m = 0; m < 4; ++m) _Pragma("unroll") for (int n = 0; n < 2; ++n) acc[a][b][m][n] = (f32x4){0.f, 0.f, 0.f, 0.f}; \
    } } while (0)
    PG8_ACC_INIT(cur);
    v8i32 At[4], B0[2], B1[2];
    const char* cA = cur.ab; const char* cB = cur.bb;
    PG8_STAGE(PG8_SB(0, 0), cB, voffB); PG8_STAGE(PG8_SB(0, 1), cB + hstep, voffB); PG8_STAGE(PG8_SA(0, 0), cA, va[0]); PG8_STAGE(PG8_SA(0, 1), cA, va[1]);
    if (wr == 1) PG8_BAR;
    PG8_WAIT_V(2); PG8_BAR;
    PG8_STAGE(PG8_SB(1, 0), cB + kstep, voffB); PG8_STAGE(PG8_SA(1, 0), cA + kstep, va[0]); PG8_STAGE(PG8_SB(1, 1), cB + hstep + kstep, voffB);
    PG8_WAIT_V(6); PG8_BAR;
    for (;;) {
        const bool has_next = S.next(ui + 1, nxt);
        const char* nA = has_next ? nxt.ab : cA; const char* nB = has_next ? nxt.bb : cB;
        if constexpr (Sched::GATHER) {
            if (has_next && wid == 0) glds16s((unsigned)lane * 16u, S.list_src(nxt), lds0 + (unsigned)STAGE_BYTES + (unsigned)(((ui + 1) & 1) * 1024)); }
        int ntu = nt; if constexpr (Sched::SK) ntu = cur.nt;
#pragma unroll 1
        for (int t = 0; t < ntu; t += 2) {
            const bool last = (t == ntu - 2);
            const char* a1 = cA + (size_t)(t + 1) * kstep;
            const char* a2 = last ? nA : cA + (size_t)(t + 2) * kstep; const char* b2 = last ? nB : cB + (size_t)(t + 2) * kstep;
            const char* a3 = a2 + kstep; const char* b3 = b2 + kstep;
            PG8_LDB(B0, 0, 0); PG8_LDB(B1, 0, 1); PG8_SCHED; PG8_LDA(At, 0, 0); PG8_STAGE(PG8_SA(1, 1), a1, va[1]);
            if constexpr (Sched::GATHER) { if (last && has_next) S.aoff_lds(nxt, opq((int)threadIdx.x), (const PG8_LAS int*)(lds + STAGE_BYTES + ((ui + 1) & 1) * 1024), va); }
            PG8_PFA(t, 0); PG8_WAIT_LOOP; PG8_WAIT_L(0); PG8_BAR; PG8_MMA(0, 0, At, B0); PG8_MMA(0, 1, At, B1); PG8_BAR; PG8_SCHED;
            PG8_LDA(At, 0, 1); PG8_STAGE(PG8_SB(0, 0), b2, voffB); PG8_STAGE(PG8_SB(0, 1), b2 + hstep, voffB); PG8_STAGE(PG8_SA(0, 0), a2, va[0]);
            PG8_PFA(t, 1); PG8_WAIT_LOOP; PG8_WAIT_L(0); PG8_BAR; PG8_MMA(1, 0, At, B0); PG8_MMA(1, 1, At, B1); PG8_BAR; PG8_SCHED;
            PG8_LDB(B0, 1, 0); PG8_LDB(B1, 1, 1); PG8_SCHED; PG8_LDA(At, 1, 0); PG8_STAGE(PG8_SA(0, 1), a2, va[1]);
            PG8_PFA(t + 1, 0); PG8_WAIT_LOOP; PG8_WAIT_L(0); PG8_BAR; PG8_MMA(0, 0, At, B0); PG8_MMA(0, 1, At, B1); PG8_BAR; PG8_SCHED;
            PG8_LDA(At, 1, 1); PG8_STAGE(PG8_SB(1, 0), b3, voffB); PG8_STAGE(PG8_SB(1, 1), b3 + hstep, voffB); PG8_STAGE(PG8_SA(1, 0), a3, va[0]);
            PG8_PFA(t + 1, 1); PG8_WAIT_LOOP; PG8_WAIT_L(0); PG8_BAR; PG8_MMA(1, 0, At, B0); PG8_MMA(1, 1, At, B1); PG8_BAR; PG8_SCHED;
        }
        if (wr == 0) PG8_BAR;
        if constexpr (Sched::SK) {
            if (cur.part == 1) { const int t2 = opq((int)threadIdx.x); const char* sb = (const char*)S.sk.slots + (size_t)cur.slot * (size_t)(BM * BM * 4); const unsigned vo = (unsigned)t2 * 16u; unsigned* fl = S.sk.flags + cur.slot * 16;
                {
#pragma unroll
                    for (int a = 0; a < 2; ++a)
#pragma unroll
                        for (int b = 0; b < 2; ++b)
#pragma unroll
                            for (int m = 0; m < 4; ++m)
#pragma unroll
                                for (int n = 0; n < 2; ++n) asm volatile("global_store_dwordx4 %0, %1, %2 sc1" :: "v"(vo), "v"(acc[a][b][m][n]), "s"(sb + (((a * 2 + b) * 4 + m) * 2 + n) * 8192) : "memory");
                    PG8_WAIT_V(0); PG8_BAR;
                    if (t2 == 0) __hip_atomic_store(fl, S.sk.tag, __ATOMIC_RELAXED, __HIP_MEMORY_SCOPE_AGENT);
                }
            }
        }
        if constexpr (!Epi::AFTER_DRAIN) { if (!Sched::SK || cur.part != 1) { const int l2 = opq((int)threadIdx.x) & 63; E(acc, cur, wr, wc, l2 & 15, l2 >> 4); } }
        if (!has_next) break;
        PG8_ACC_INIT(nxt);
        cur = nxt; cA = nA; cB = nB; ++ui;
        if (wr == 1) PG8_BAR;
    }
    PG8_WAIT_V(0);
    PG8_BAR;
    if constexpr (Epi::AFTER_DRAIN) { const int l2 = opq((int)threadIdx.x) & 63; E.fused(acc, cur, wr, wc, l2 & 15, l2 >> 4, lds, wid, l2); }
#undef PG8_ACC_INIT
#undef PG8_SA
#undef PG8_SB
#undef PG8_STAGE
#undef PG8_LDA
#undef PG8_LDB
#undef PG8_LD8
#undef PG8_LO
#undef PG8_HI
#undef PG8_MMA
#undef PG8_WAIT_V
#undef PG8_WAIT_LOOP
#undef PG8_PFA
#undef PG8_WAIT_L
#undef PG8_BAR
#undef PG8_SCHED
}
template <int MODE, class Epi, class Sched>
__device__ __forceinline__ void gemm_tail(PG8_LAS unsigned char* lds, const int KB, const Sched& S, const Epi& E) {
    static_assert(MODE == 0 || MODE == 1, "bf16 or fp8");
    const int tid = opq((int)threadIdx.x), wid = __builtin_amdgcn_readfirstlane(tid >> 6), lane = tid & 63, wr = wid >> 2, wc = wid & 3, fr = lane & 15, fq = lane >> 4;
    const int nt = KB / 128;
    unsigned voffB[2];
#pragma unroll
    for (int i = 0; i < 2; ++i) { int R, C; stage_rc(tid * 16 + i * 8192, R, C); const int Rb = Epi::PERM ? ((R & ~31) + perm32(R & 31)) : R; voffB[i] = (unsigned)(Rb * KB + C * 2); }
    const unsigned ldsw = (unsigned)wid * 1024u, lds0 = (unsigned)(uintptr_t)lds;
    const int aoff = lds_byte(wr * 64 + fr, fq * 8), boff = lds_byte(wc * 32 + fr, fq * 8);
    for (int j = 0;; ++j) {
        Unit u; int ai, bj; if (!S.tail_next(j, u, ai, bj)) break;
        unsigned va[2][2]; S.aoff(u, tid, va);
        const unsigned va0 = ai ? va[1][0] : va[0][0], va1 = ai ? va[1][1] : va[0][1];
        const char* cA = u.ab; const char* cB = u.bb + (size_t)bj * HALF * KB;
        f32x4 acc[4][2];
#pragma unroll
        for (int m = 0; m < 4; ++m)
#pragma unroll
            for (int n = 0; n < 2; ++n) acc[m][n] = (f32x4){0.f, 0.f, 0.f, 0.f};
#define PG8T_STAGE(t, b) do { const unsigned d_ = lds0 + (unsigned)((b) * 2 * HTB) + ldsw; const char* a_ = cA + (size_t)(t) * 128; const char* b_ = cB + (size_t)(t) * 128; \
        glds16s(va0, a_, d_); glds16s(va1, a_, d_ + 8192u); glds16s(voffB[0], b_, d_ + (unsigned)HTB); glds16s(voffB[1], b_, d_ + (unsigned)HTB + 8192u); } while (0)
        PG8T_STAGE(0, 0);
#pragma unroll 1
        for (int t = 0; t < nt; ++t) { const int b = t & 1;
            if (t + 1 < nt) { PG8T_STAGE(t + 1, b ^ 1); asm volatile("s_waitcnt vmcnt(4)" ::: "memory"); } else asm volatile("s_waitcnt vmcnt(0)" ::: "memory");
            __builtin_amdgcn_s_barrier();
            v8i32 At[4], Bt[2];
            const PG8_LAS unsigned char* ab_ = lds + b * 2 * HTB + aoff; const PG8_LAS unsigned char* bb_ = lds + b * 2 * HTB + HTB + boff;
#pragma unroll
            for (int m = 0; m < 4; ++m) At[m] = __builtin_shufflevector(*(const PG8_LAS v4i32*)(ab_ + m * 2048), *(const PG8_LAS v4i32*)(ab_ + m * 2048 + 1024), 0, 1, 2, 3, 4, 5, 6, 7);
#pragma unroll
            for (int n = 0; n < 2; ++n) Bt[n] = __builtin_shufflevector(*(const PG8_LAS v4i32*)(bb_ + n * 2048), *(const PG8_LAS v4i32*)(bb_ + n * 2048 + 1024), 0, 1, 2, 3, 4, 5, 6, 7);
#pragma unroll
            for (int m = 0; m < 4; ++m)
#pragma unroll
                for (int n = 0; n < 2; ++n) {
                    if constexpr (MODE == 1) acc[m][n] = __builtin_amdgcn_mfma_scale_f32_16x16x128_f8f6f4(Bt[n], At[m], acc[m][n], 0, 0, 0, 0, 0, 0);
                    else { acc[m][n] = __builtin_amdgcn_mfma_f32_16x16x32_bf16(__builtin_bit_cast(bf16x8, __builtin_shufflevector(Bt[n], Bt[n], 0, 1, 2, 3)), __builtin_bit_cast(bf16x8, __builtin_shufflevector(At[m], At[m], 0, 1, 2, 3)), acc[m][n], 0, 0, 0);
                           acc[m][n] = __builtin_amdgcn_mfma_f32_16x16x32_bf16(__builtin_bit_cast(bf16x8, __builtin_shufflevector(Bt[n], Bt[n], 4, 5, 6, 7)), __builtin_bit_cast(bf16x8, __builtin_shufflevector(At[m], At[m], 4, 5, 6, 7)), acc[m][n], 0, 0, 0); } }
            asm volatile("s_waitcnt lgkmcnt(0)" ::: "memory");
            __builtin_amdgcn_s_barrier();
        }
#undef PG8T_STAGE
        { const int l2 = opq((int)threadIdx.x) & 63; E.quarter(acc, u, ai, bj, wr, wc, l2 & 15, l2 >> 4); }
    }
    asm volatile("s_waitcnt vmcnt(0)" ::: "memory");
    __builtin_amdgcn_s_barrier();
}
}
constexpr int D = 1024, NB = 8, SEQ = 4096, CTXL = 256, NL = NB * SEQ, NC = NB * CTXL, MT = NL + NC;
constexpr int INW = 1792, FF = 2816, NE = 8;
constexpr int C_Q = 0, C_K = 512, C_V = 640, C_U = 768, C_RQ = 1024, C_RK = 1152, C_RV = 1280, C_RG = 1536;
constexpr int NCHK = 34;
constexpr float LN_EPS = 1e-5f, LOG2E = 1.4426950408889634f;
constexpr float QSCALE = 0.125f * LOG2E;
constexpr float RSCALE = 0.17677669529663687f;
constexpr float ALPHA = 1.4142135623730951f;
constexpr int LCAP = 32768;

namespace pg8 {
__device__ __forceinline__ void store8(bf16_t* p, f32x4 v0, f32x4 v1) {
    u32x4 w; w.x = cvt_pk_bf16(v0[0], v0[1]); w.y = cvt_pk_bf16(v0[2], v0[3]); w.z = cvt_pk_bf16(v1[0], v1[1]); w.w = cvt_pk_bf16(v1[2], v1[3]); *(u32x4*)p = w;
}
typedef float f32x2_t __attribute__((ext_vector_type(2)));
struct EpiBf16 {
    static constexpr bool PERM = true, AFTER_DRAIN = false;
    bf16_t* O; int ldc; float scale;
    __device__ __forceinline__ void operator()(const f32x4 (&acc)[2][2][4][2], const Unit& u, int wr, int wc, int fr, int fq) const {
        const int row0 = u.pm * BM + wr * 64 + fr, col0 = u.pn * BM + wc * 32 + 8 * fq;
#pragma unroll
        for (int ai = 0; ai < 2; ++ai)
#pragma unroll
            for (int m = 0; m < 4; ++m) { bf16_t* rowp = O + (size_t)(row0 + ai * HALF + m * 16) * ldc + col0;
#pragma unroll
                for (int bj = 0; bj < 2; ++bj) store8(rowp + bj * HALF, acc[ai][bj][m][0] * scale, acc[ai][bj][m][1] * scale); }
    }
    __device__ __forceinline__ void quarter(const f32x4 (&a)[4][2], const Unit& u, int ai, int bj, int wr, int wc, int fr, int fq) const {
        const int row0 = u.pm * BM + ai * HALF + wr * 64 + fr, col0 = u.pn * BM + bj * HALF + wc * 32 + 8 * fq;
#pragma unroll
        for (int m = 0; m < 4; ++m) store8(O + (size_t)(row0 + m * 16) * ldc + col0, a[m][0] * scale, a[m][1] * scale);
    }
};
template <bool Q  > struct EpiInProj {
    static constexpr bool PERM = true, AFTER_DRAIN = false;
    bf16_t* O; const PG8_LAS float* rope;
    const float* sa; const float* sw;
    __device__ __forceinline__ void operator()(const f32x4 (&acc)[2][2][4][2], const Unit& u, int wr, int wc, int fr, int fq) const {
        const int row0 = u.pm * BM + wr * 64 + fr; const bool lat = u.pm < (NL / BM);
        float rs8[2][4];
        f32x4 cw[2][2];
        if constexpr (Q) {
#pragma unroll
            for (int ai = 0; ai < 2; ++ai)
#pragma unroll
                for (int m = 0; m < 4; ++m) rs8[ai][m] = sa[row0 + ai * HALF + m * 16];
#pragma unroll
            for (int bj = 0; bj < 2; ++bj)
#pragma unroll
                for (int n = 0; n < 2; ++n) cw[bj][n] = *(const f32x4*)(sw + (2 * u.pn + bj) * HALF + wc * 32 + 8 * fq + 4 * n) * (1.0f / 127.0f);
        }
#pragma unroll
        for (int bj = 0; bj < 2; ++bj) {
            const int seg = 2 * u.pn + bj;
            const bool rope_on = lat && seg <= 4; const float sc = seg <= 3 ? QSCALE : (seg == 9 ? RSCALE : 1.0f);
#pragma unroll
            for (int ai = 0; ai < 2; ++ai)
#pragma unroll
                for (int m = 0; m < 4; ++m) { const int row = row0 + ai * HALF + m * 16;
                    f32x4 v0 = acc[ai][bj][m][0], v1 = acc[ai][bj][m][1];
                    if constexpr (Q) { const float s = rs8[ai][m]; const v4i32 i0 = __builtin_bit_cast(v4i32, v0), i1 = __builtin_bit_cast(v4i32, v1);
                        v0 = (f32x4){(float)i0[0], (float)i0[1], (float)i0[2], (float)i0[3]} * (cw[bj][0] * s); v1 = (f32x4){(float)i1[0], (float)i1[1], (float)i1[2], (float)i1[3]} * (cw[bj][1] * s); }
                    if (rope_on) { const int t = row & (SEQ - 1); const int pos = (wc & 1) ? (t & 63) : (t >> 6);
                        const f32x4 c4 = *(const PG8_LAS f32x4*)(rope + pos * 16 + 4 * fq), s4 = *(const PG8_LAS f32x4*)(rope + 1024 + pos * 16 + 4 * fq);
                        const f32x4 o0 = v0 * c4 - v1 * s4, o1 = v0 * s4 + v1 * c4; v0 = o0; v1 = o1; }
                    v0 = v0 * sc; v1 = v1 * sc;
                    store8(O + (size_t)row * INW + seg * HALF + wc * 32 + 8 * fq, v0, v1); }
        }
    }
};
struct EpiSwiGLU {
    static constexpr bool PERM = true, AFTER_DRAIN = false;
    bf16_t* H; int ldh;
    __device__ __forceinline__ void operator()(const f32x4 (&acc)[2][2][4][2], const Unit& u, int wr, int wc, int fr, int fq) const {
        const int row0 = u.pm * BM + wr * 64 + fr, col0 = u.pn * HALF + wc * 32 + 8 * fq;
#pragma unroll
        for (int ai = 0; ai < 2; ++ai)
#pragma unroll
            for (int m = 0; m < 4; ++m) { f32x4 h[2];
#pragma unroll
                for (int n = 0; n < 2; ++n) { const f32x4 g = acc[ai][0][m][n], up = acc[ai][1][m][n];
#pragma unroll
                    for (int i = 0; i < 4; ++i) h[n][i] = g[i] * __builtin_amdgcn_rcpf(1.0f + __builtin_amdgcn_exp2f(-LOG2E * g[i])) * up[i]; }
                store8(H + (size_t)(row0 + ai * HALF + m * 16) * ldh + col0, h[0], h[1]); }
    }
};
__device__ __forceinline__ unsigned pk4_fp8(float a, float b, float c, float d) {
    a = __builtin_amdgcn_fmed3f(a, -448.f, 448.f); b = __builtin_amdgcn_fmed3f(b, -448.f, 448.f); c = __builtin_amdgcn_fmed3f(c, -448.f, 448.f); d = __builtin_amdgcn_fmed3f(d, -448.f, 448.f);
    int w = __builtin_amdgcn_cvt_pk_fp8_f32(a, b, 0, false); w = __builtin_amdgcn_cvt_pk_fp8_f32(c, d, w, true); return (unsigned)w; }
struct EpiSwiGLU8 {
    static constexpr bool PERM = true, AFTER_DRAIN = false;
    unsigned char* H; int ldh; float in_scale, out_scale;
    __device__ __forceinline__ void operator()(const f32x4 (&acc)[2][2][4][2], const Unit& u, int wr, int wc, int fr, int fq) const {
        const int row0 = u.pm * BM + wr * 64 + fr, col0 = u.pn * HALF + wc * 32 + 8 * fq;
        const float k1 = -LOG2E * in_scale, invC = 1.0f / (in_scale * in_scale * out_scale);
#pragma unroll
        for (int ai = 0; ai < 2; ++ai)
#pragma unroll
            for (int m = 0; m < 4; ++m) { f32x4 h[2];
#pragma unroll
                for (int n = 0; n < 2; ++n) { const f32x4 G = acc[ai][0][m][n], U = acc[ai][1][m][n];
#pragma unroll
                    for (int p = 0; p < 2; ++p) { const f32x2_t g2 = {G[2 * p], G[2 * p + 1]}, u2 = {U[2 * p], U[2 * p + 1]}; const f32x2_t mm = g2 * k1;
                        const f32x2_t e = {__builtin_amdgcn_exp2f(mm.x), __builtin_amdgcn_exp2f(mm.y)}; const f32x2_t d = __builtin_elementwise_fma(e, (f32x2_t){invC, invC}, (f32x2_t){invC, invC});
                        const f32x2_t r = {__builtin_amdgcn_rcpf(d.x), __builtin_amdgcn_rcpf(d.y)}; const f32x2_t hh = (g2 * u2) * r; h[n][2 * p] = hh.x; h[n][2 * p + 1] = hh.y; } }
                typedef unsigned u32x2 __attribute__((ext_vector_type(2))); u32x2 w; w.x = pk4_fp8(h[0][0], h[0][1], h[0][2], h[0][3]); w.y = pk4_fp8(h[1][0], h[1][1], h[1][2], h[1][3]);
                *(u32x2*)(H + (size_t)(row0 + ai * HALF + m * 16) * ldh + col0) = w; }
    }
};
template <bool OUT8, bool GATH> struct EpiSwiGLUq {
    static constexpr bool PERM = true, AFTER_DRAIN = false;
    void* H; int ldh; const float* st; const float* sw; const int* list; float out_scale;
    __device__ __forceinline__ void operator()(const f32x4 (&acc)[2][2][4][2], const Unit& u, int wr, int wc, int fr, int fq) const {
        const int row0 = u.pm * BM + wr * 64 + fr, col0 = u.pn * HALF + wc * 32 + 8 * fq;
        const float* swp = sw + (size_t)u.e * 2 * FF + u.pn * BM + wc * 32 + 8 * fq;
        f32x4 sg[2], su[2];
#pragma unroll
        for (int n = 0; n < 2; ++n) { sg[n] = *(const f32x4*)(swp + 4 * n) * (1.0f / 127.0f); su[n] = *(const f32x4*)(swp + HALF + 4 * n) * (out_scale / 127.0f); }
        f32x4 cg[2], sgu[2];
#pragma unroll
        for (int n = 0; n < 2; ++n) { cg[n] = sg[n] * -LOG2E; sgu[n] = sg[n] * su[n]; }
        float sa8[2][4];
#pragma unroll
        for (int ai = 0; ai < 2; ++ai)
#pragma unroll
            for (int m = 0; m < 4; ++m) { const int rl = ai * HALF + wr * 64 + m * 16 + fr;
                if constexpr (GATH) { const int pos = u.rt * BM + rl; sa8[ai][m] = pos < u.cnt ? st[list[u.e * LCAP + pos] >> 1] : 0.f; } else sa8[ai][m] = st[u.pm * BM + rl]; }
#pragma unroll
        for (int ai = 0; ai < 2; ++ai)
#pragma unroll
            for (int m = 0; m < 4; ++m) { const float sa = sa8[ai][m], isa2 = __builtin_amdgcn_rcpf(sa * sa);
                f32x4 h[2];
#pragma unroll
                for (int n = 0; n < 2; ++n) { const v4i32 gi = __builtin_bit_cast(v4i32, acc[ai][0][m][n]), ui = __builtin_bit_cast(v4i32, acc[ai][1][m][n]);
#pragma unroll
                    for (int p = 0; p < 2; ++p) { const f32x2_t g2 = {(float)gi[2 * p], (float)gi[2 * p + 1]}, u2 = {(float)ui[2 * p], (float)ui[2 * p + 1]};
                        const f32x2_t mm = (g2 * (f32x2_t){cg[n][2 * p], cg[n][2 * p + 1]}) * sa;
                        const f32x2_t e = {__builtin_amdgcn_exp2f(mm.x), __builtin_amdgcn_exp2f(mm.y)}; const f32x2_t d = __builtin_elementwise_fma(e, (f32x2_t){isa2, isa2}, (f32x2_t){isa2, isa2});
                        const f32x2_t r = {__builtin_amdgcn_rcpf(d.x), __builtin_amdgcn_rcpf(d.y)}; const f32x2_t hh = ((g2 * u2) * (f32x2_t){sgu[n][2 * p], sgu[n][2 * p + 1]}) * r; h[n][2 * p] = hh.x; h[n][2 * p + 1] = hh.y; } }
                if constexpr (OUT8) { typedef unsigned u32x2 __attribute__((ext_vector_type(2))); u32x2 w; w.x = pk4_fp8(h[0][0], h[0][1], h[0][2], h[0][3]); w.y = pk4_fp8(h[1][0], h[1][1], h[1][2], h[1][3]);
                    *(u32x2*)((unsigned char*)H + (size_t)(row0 + ai * HALF + m * 16) * ldh + col0) = w; }
                else store8((bf16_t*)H + (size_t)(row0 + ai * HALF + m * 16) * ldh + col0, h[0], h[1]); }
    }
};
struct EpiMoeDown {
    static constexpr bool PERM = true, AFTER_DRAIN = false;
    bf16_t* Y; const int* list; const float* lgate; float scale;
    __device__ __forceinline__ void operator()(const f32x4 (&acc)[2][2][4][2], const Unit& u, int wr, int wc, int fr, int fq) const {
        const int col0 = u.pn * BM + wc * 32 + 8 * fq;
#pragma unroll
        for (int ai = 0; ai < 2; ++ai)
#pragma unroll
            for (int m = 0; m < 4; ++m) { const int pos = u.rt * BM + ai * HALF + wr * 64 + m * 16 + fr;
                if (pos < u.cnt) { const int ent = list[u.e * LCAP + pos]; const float g = lgate[u.e * LCAP + pos] * scale;
                    bf16_t* rowp = Y + ((size_t)(ent & 1) * NL + (size_t)(ent >> 1)) * D + col0;
#pragma unroll
                    for (int bj = 0; bj < 2; ++bj) store8(rowp + bj * HALF, acc[ai][bj][m][0] * g, acc[ai][bj][m][1] * g); } }
    }
    __device__ __forceinline__ void quarter(const f32x4 (&a)[4][2], const Unit& u, int ai, int bj, int wr, int wc, int fr, int fq) const {
        const int col0 = u.pn * BM + bj * HALF + wc * 32 + 8 * fq;
#pragma unroll
        for (int m = 0; m < 4; ++m) { const int pos = u.rt * BM + ai * HALF + wr * 64 + m * 16 + fr;
            if (pos < u.cnt) { const int ent = list[u.e * LCAP + pos]; const float g = lgate[u.e * LCAP + pos] * scale;
                store8(Y + ((size_t)(ent & 1) * NL + (size_t)(ent >> 1)) * D + col0, a[m][0] * g, a[m][1] * g); } }
    }
};
template <bool GATHER_, bool SK_ = false> struct MoeOrder {
    static constexpr bool GATHER = GATHER_, SK = SK_;
    int nrt, nN, G, c, KB, T0; const PG8_LAS int* tbl;
    const char* A; const char* Bt; size_t bstride; const int* list;
    bool rev = false;
    StreamK sk; TailPlan tail;
#if ((REP_MASK) >> 13) & 2
    int i0 = 0, i1 = 1 << 30;
#endif
    __device__ __forceinline__ void fill(Unit& u, int pm, int pn, int p0) const {
        const int T = T0 + pm; int e = 0;
#pragma unroll
        for (int j = 1; j < NE; ++j) e += (T >= tbl[j]) ? 1 : 0;
        e = __builtin_amdgcn_readfirstlane(e);
        u.pm = pm; u.pn = pn; u.e = e; u.rt = T - __builtin_amdgcn_readfirstlane(tbl[e]); u.cnt = __builtin_amdgcn_readfirstlane(tbl[NE + 1 + e]);
        u.ab = GATHER ? A : A + (size_t)pm * BM * KB + (size_t)p0 * 256; u.bb = Bt + (size_t)e * bstride + (size_t)pn * BM * KB + (size_t)p0 * 256;
    }
    __device__ __forceinline__ bool tail_next(int j, Unit& u, int& ai, int& bj) const {
        int cq, pm, pn; if (nrt <= 0 || !tail.quarter(j, c, cq, ai, bj) || !tile_order(tail.F, G, cq, nrt, nN, pm, pn, rev)) return false;
        fill(u, pm, pn, 0); return true;
    }
    __device__ __forceinline__ bool next(int i, Unit& u) const {
        int pm, pn, p0 = 0; if (i >= tail.F) return false;
#if ((REP_MASK) >> 13) & 2
        i += i0; if (i >= i1) return false;
#endif
        if constexpr (SK) { int L, np, part; if (nrt <= 0 || !sk.next(i, nrt * nN, G, L, p0, np, part)) return false;
            tile_from_L(L, nrt, nN, pm, pn); u.nt = 2 * np; u.part = part; u.slot = part == 2 ? c + 8 : c; }
        else { if (nrt <= 0 || !tile_order(i, G, c, nrt, nN, pm, pn, rev)) return false; }
        fill(u, pm, pn, p0); return true;
    }
    __device__ __forceinline__ const void* list_src(const Unit& u) const { return (const void*)(list + (size_t)u.e * LCAP + (size_t)u.rt * BM); }
    __device__ __forceinline__ void aoff_lds(const Unit& u, int tid, const PG8_LAS int* slot, unsigned (&va)[2][2]) const {
#pragma unroll
        for (int i = 0; i < 2; ++i) { int R, C; stage_rc(tid * 16 + i * 8192, R, C);
#pragma unroll
            for (int h = 0; h < 2; ++h) { const int rl = R + HALF * h; const int ent = slot[rl]; const int tok = (u.rt * BM + rl) < u.cnt ? (ent >> 1) : 0; va[h][i] = (unsigned)(tok * KB + C * 2); } }
    }
    __device__ __forceinline__ void aoff(const Unit& u, int tid, unsigned (&va)[2][2]) const {
#pragma unroll
        for (int i = 0; i < 2; ++i) { int R, C; stage_rc(tid * 16 + i * 8192, R, C);
#pragma unroll
            for (int h = 0; h < 2; ++h) {
                if (GATHER) { const int pos = u.rt * BM + R + HALF * h; const int tok = pos < u.cnt ? (list[u.e * LCAP + pos] >> 1) : 0; va[h][i] = (unsigned)(tok * KB + C * 2); }
                else va[h][i] = (unsigned)((R + HALF * h) * KB + C * 2); } }
    }
};
}
namespace pg8 {
struct PanelStats {
    unsigned* xbuf;
    unsigned* cnt;
    unsigned* tmo;
    float eps; unsigned code;
    __device__ __forceinline__ bool run(const f32x4 (&v)[2][2][4][2], const Unit& u, int wr, int wc, int fr, int fq, PG8_LAS unsigned char* lds, int wid, int lane) const {
        typedef float f32x2v __attribute__((ext_vector_type(2)));
        PG8_LAS f32x2v* P = (PG8_LAS f32x2v*)lds;
        PG8_LAS f32x2v* S = (PG8_LAS f32x2v*)(lds + 8192);
        PG8_LAS unsigned* flag = (PG8_LAS unsigned*)(lds + 8192 + 2048);
#pragma unroll
        for (int ai = 0; ai < 2; ++ai)
#pragma unroll
            for (int m = 0; m < 4; ++m) {
                float s = 0.f;
#pragma unroll
                for (int bj = 0; bj < 2; ++bj)
#pragma unroll
                    for (int n = 0; n < 2; ++n) { const f32x4 x = v[ai][bj][m][n]; s += (x[0] + x[1]) + (x[2] + x[3]); }
                s += __shfl_xor(s, 16); s += __shfl_xor(s, 32);
                const float mw = s * (1.0f / 64.0f); float q = 0.f;
#pragma unroll
                for (int bj = 0; bj < 2; ++bj)
#pragma unroll
                    for (int n = 0; n < 2; ++n) { const f32x4 d = v[ai][bj][m][n] - mw; q += (d[0] * d[0] + d[1] * d[1]) + (d[2] * d[2] + d[3] * d[3]); }
                q += __shfl_xor(q, 16); q += __shfl_xor(q, 32);
                if (fq == 0) P[(ai * HALF + wr * 64 + m * 16 + fr) * 4 + wc] = (f32x2v){mw, q};
            }
        asm volatile("s_waitcnt lgkmcnt(0)" ::: "memory"); __builtin_amdgcn_s_barrier(); asm volatile("" ::: "memory");
        const int row = wid * 32 + (lane & 31);
        if (lane < 32) {
            const f32x2v a = P[row * 4 + 0], b = P[row * 4 + 1], c = P[row * 4 + 2], d = P[row * 4 + 3];
            const float mt = (a.x + b.x + c.x + d.x) * 0.25f;
            const float da = a.x - mt, db = b.x - mt, dc = c.x - mt, dd = d.x - mt;
            const float m2 = (a.y + b.y) + (c.y + d.y) + 64.0f * ((da * da + db * db) + (dc * dc + dd * dd));
            unsigned long long* slot = (unsigned long long*)xbuf + ((size_t)(u.pm * BM + row) * 4 + u.pn);
            __hip_atomic_store(slot, ((unsigned long long)__float_as_uint(m2) << 32) | __float_as_uint(mt), __ATOMIC_RELAXED, __HIP_MEMORY_SCOPE_AGENT);
        }
        asm volatile("s_waitcnt vmcnt(0)" ::: "memory");
        if (lane == 0) __hip_atomic_fetch_add(cnt + 64 * u.pm, 1u, __ATOMIC_RELAXED, __HIP_MEMORY_SCOPE_AGENT);
        if (wid == 0) {
            bool dead = false; const unsigned long long t0 = __builtin_amdgcn_s_memrealtime(); const unsigned want = 32u;
            for (;;) {
                if ((unsigned)__builtin_amdgcn_readfirstlane(__hip_atomic_load(cnt + 64 * u.pm, __ATOMIC_RELAXED, __HIP_MEMORY_SCOPE_AGENT)) >= want) break;
                if (__builtin_amdgcn_s_memrealtime() - t0 > 2000000ull) {
                    if (lane == 0) { unsigned expect = 0u; __hip_atomic_compare_exchange_strong(tmo + 1, &expect, code | (unsigned)(u.pm & 0xff), __ATOMIC_RELAXED, __ATOMIC_RELAXED, __HIP_MEMORY_SCOPE_AGENT);
                                     __hip_atomic_store(tmo, 1u, __ATOMIC_RELAXED, __HIP_MEMORY_SCOPE_AGENT); }
                    dead = true; break; }
                __builtin_amdgcn_s_sleep(2);
            }
            __builtin_amdgcn_fence(__ATOMIC_ACQUIRE, "agent");
            if (lane == 0) flag[0] = dead ? 1u : 0u;
        }
        asm volatile("s_waitcnt vmcnt(0) lgkmcnt(0)" ::: "memory"); __builtin_amdgcn_s_barrier(); asm volatile("" ::: "memory");
        const bool bad = flag[0] != 0u;
        if (lane < 32) {
            const unsigned long long* slot = (const unsigned long long*)xbuf + (size_t)(u.pm * BM + row) * 4; float mt[4], m2[4]; float ms = 0.f;
#pragma unroll
            for (int t = 0; t < 4; ++t) { const unsigned long long w = __hip_atomic_load(slot + t, __ATOMIC_RELAXED, __HIP_MEMORY_SCOPE_AGENT); mt[t] = __uint_as_float((unsigned)w); m2[t] = __uint_as_float((unsigned)(w >> 32)); ms += mt[t]; }
            const float mean = ms * 0.25f; float q = 0.f;
#pragma unroll
            for (int t = 0; t < 4; ++t) { const float dm = mt[t] - mean; q += m2[t] + 256.0f * dm * dm; }
            S[row] = (f32x2v){mean, 1.0f / sqrtf(q * (1.0f / 1024.0f) + eps)};
        }
        asm volatile("s_waitcnt lgkmcnt(0)" ::: "memory"); __builtin_amdgcn_s_barrier(); asm volatile("" ::: "memory");
        return bad;
    }
};
template <bool OUT8, bool ROUTE> struct EpiLN {
    static constexpr bool PERM = true, AFTER_DRAIN = true;
    const float* xin_lat; const float* xin_ctx; float* xo_lat; float* xo_ctx;
    const float* mod_g; const float* mod_sh; const float* mod_sc;
    const float* gam; const float* bet;
    bf16_t* tout; unsigned char* t8; float* plog; const float* router;
    PanelStats st;
    __device__ __forceinline__ void fused(f32x4 (&acc)[2][2][4][2], const Unit& u, int wr, int wc, int fr, int fq, PG8_LAS unsigned char* lds, int wid, int lane) const {
        typedef float f32x2v __attribute__((ext_vector_type(2)));
        const bool lat = u.pm < (1 << 7); const int mr = lat ? (u.pm >> 4) : 8;
        const float* xin = lat ? xin_lat : xin_ctx - (size_t)(1 << 15) * 1024; float* xo = lat ? xo_lat : xo_ctx - (size_t)(1 << 15) * 1024;
        const int col0 = u.pn * BM + wc * 32 + 8 * fq; const int row0 = u.pm * BM + wr * 64 + fr;
        PG8_LAS float* Rl = (PG8_LAS float*)(lds + 16384);
        PG8_LAS float* PLs = (PG8_LAS float*)(lds + 24576);
        if constexpr (ROUTE) { const int t = threadIdx.x; ((PG8_LAS f32x4*)Rl)[t] = ((const f32x4*)(router + (size_t)u.pn * BM * 8))[t]; ((PG8_LAS f32x4*)PLs)[t] = (f32x4){0.f, 0.f, 0.f, 0.f}; }
        { f32x4 gv[2][2];
#pragma unroll
          for (int bj = 0; bj < 2; ++bj)
#pragma unroll
              for (int n = 0; n < 2; ++n) gv[bj][n] = *(const f32x4*)(mod_g + (size_t)mr * 6144 + col0 + bj * HALF + 4 * n);
#pragma unroll
          for (int ai = 0; ai < 2; ++ai)
#pragma unroll
              for (int m = 0; m < 4; ++m) { const float* xr = xin + (size_t)(row0 + ai * HALF + m * 16) * 1024 + col0;
#pragma unroll
                  for (int bj = 0; bj < 2; ++bj)
#pragma unroll
                      for (int n = 0; n < 2; ++n) acc[ai][bj][m][n] = 1.4142135623730951f * *(const f32x4*)(xr + bj * HALF + 4 * n) + gv[bj][n] * acc[ai][bj][m][n];
                  asm volatile("" : "+v"(acc[ai][0][m][0]), "+v"(acc[ai][0][m][1]), "+v"(acc[ai][1][m][0]), "+v"(acc[ai][1][m][1]));
                  if (m & 1) asm volatile("" ::: "memory"); } }
        st.run(acc, u, wr, wc, fr, fq, lds, wid, lane);
        const PG8_LAS f32x2v* S = (const PG8_LAS f32x2v*)(lds + 8192);
#pragma unroll
        for (int bj = 0; bj < 2; ++bj) {
            f32x4 ga[2], be[2], sc[2], sh[2];
#pragma unroll
            for (int n = 0; n < 2; ++n) { const int c = col0 + bj * HALF + 4 * n; ga[n] = *(const f32x4*)(gam + c); be[n] = *(const f32x4*)(bet + c); sc[n] = *(const f32x4*)(mod_sc + (size_t)mr * 6144 + c) + 1.0f; sh[n] = *(const f32x4*)(mod_sh + (size_t)mr * 6144 + c); }
#pragma unroll
            for (int ai = 0; ai < 2; ++ai)
#pragma unroll
                for (int m = 0; m < 4; ++m) { const int r = ai * HALF + wr * 64 + m * 16 + fr; const f32x2v sr = S[r]; const size_t off = (size_t)(u.pm * BM + r) * 1024 + col0 + bj * HALF;
                    f32x4 t[2];
#pragma unroll
                    for (int n = 0; n < 2; ++n) { const f32x4 x1 = (acc[ai][bj][m][n] - sr.x) * sr.y * ga[n] + be[n]; *(f32x4*)(xo + off + 4 * n) = x1; t[n] = x1 * sc[n] + sh[n]; if constexpr (ROUTE) acc[ai][bj][m][n] = t[n]; }
                    if constexpr (OUT8) { typedef unsigned u32x2 __attribute__((ext_vector_type(2))); u32x2 w; w.x = pk4_fp8(t[0][0] * 4.0f, t[0][1] * 4.0f, t[0][2] * 4.0f, t[0][3] * 4.0f); w.y = pk4_fp8(t[1][0] * 4.0f, t[1][1] * 4.0f, t[1][2] * 4.0f, t[1][3] * 4.0f); *(u32x2*)(t8 + off) = w; }
                    else store8(tout + off, t[0], t[1]);
                    if (m & 1) asm volatile("" ::: "memory"); }
        }
        if constexpr (ROUTE) {
#pragma unroll
            for (int ai = 0; ai < 2; ++ai)
#pragma unroll
                for (int m = 0; m < 4; ++m) { float pl[8];
#pragma unroll
                    for (int e = 0; e < 8; ++e) pl[e] = 0.f;
#pragma unroll
                    for (int bj = 0; bj < 2; ++bj)
#pragma unroll
                        for (int n = 0; n < 2; ++n)
#pragma unroll
                            for (int i = 0; i < 4; ++i) { const PG8_LAS float* rr = Rl + (wc * 32 + 8 * fq + bj * HALF + 4 * n + i) * 8; const f32x4 r0 = *(const PG8_LAS f32x4*)rr, r1 = *(const PG8_LAS f32x4*)(rr + 4); const float tv = acc[ai][bj][m][n][i];
                                pl[0] += tv * r0[0]; pl[1] += tv * r0[1]; pl[2] += tv * r0[2]; pl[3] += tv * r0[3]; pl[4] += tv * r1[0]; pl[5] += tv * r1[1]; pl[6] += tv * r1[2]; pl[7] += tv * r1[3]; }
#pragma unroll
                    for (int e = 0; e < 8; ++e) { pl[e] += __shfl_xor(pl[e], 16); pl[e] += __shfl_xor(pl[e], 32); }
                    if (fq == 0) { PG8_LAS float* d = PLs + (ai * HALF + wr * 64 + m * 16 + fr) * 8;
#pragma unroll
                        for (int e = 0; e < 8; ++e) __hip_atomic_fetch_add(d + e, pl[e], __ATOMIC_RELAXED, __HIP_MEMORY_SCOPE_WORKGROUP); } }
            asm volatile("s_waitcnt lgkmcnt(0)" ::: "memory"); __builtin_amdgcn_s_barrier(); asm volatile("" ::: "memory");
            { const int t = threadIdx.x; ((f32x4*)(plog + ((size_t)u.pn * (1 << 15) + (size_t)u.pm * BM) * 8))[t] = ((const PG8_LAS f32x4*)PLs)[t]; }
        }
    }
};
struct SliceOrder {
    static constexpr bool GATHER = false, SK = false;
    int base, total, v, KB; const char* A; const char* Bt;
    __device__ __forceinline__ bool next(int i, Unit& u) const {
        const int L = base + v; if (i != 0 || L >= total) return false;
        u.pm = L >> 2; u.pn = L & 3; u.e = 0; u.rt = u.pm; u.cnt = 1 << 30; u.ab = A + (size_t)u.pm * BM * KB; u.bb = Bt + (size_t)u.pn * BM * KB; return true;
    }
    __device__ __forceinline__ void aoff(const Unit&, int tid, unsigned (&va)[2][2]) const {
#pragma unroll
        for (int i = 0; i < 2; ++i) { int R, C; stage_rc(tid * 16 + i * 8192, R, C);
#pragma unroll
            for (int h = 0; h < 2; ++h) va[h][i] = (unsigned)((R + HALF * h) * KB + C * 2); }
    }
};
}
constexpr size_t MiB = 1u << 20;
constexpr size_t WS_CTL = 0, CTL_ZERO_BYTES = 1 * MiB;
constexpr size_t WS_MOD = 1 * MiB;
constexpr size_t WS_ROPE = 1 * MiB + 512 * 1024;
constexpr size_t WS_ST = 1 * MiB + 768 * 1024;
constexpr size_t WS_SH = 4 * MiB;
constexpr int CM_WIN = 9 * 2 * FF;
constexpr size_t WS_T8L0 = 451 * MiB;
constexpr size_t WS_LIST = 2 * MiB, WS_LGATE = 3 * MiB;
constexpr size_t WS_KVS = 8 * MiB;
constexpr size_t WS_XC = 26 * MiB;
constexpr size_t WS_WIN = 34 * MiB, WS_WOUT = 41 * MiB, WS_FGU = 45 * MiB, WS_FD = 56 * MiB;
constexpr size_t WS_MGU8 = 62 * MiB, WS_MD8 = 106 * MiB;
#if RES16
constexpr size_t WS_X16 = 128 * MiB;
constexpr size_t WS_ACT = 196 * MiB;
constexpr size_t WS_PROJ = 264 * MiB, WS_MIX = 383 * MiB;
constexpr size_t WS_HID = 264 * MiB;
constexpr size_t WS_T8 = 8 * MiB;
constexpr size_t WS_Y = 196 * MiB, WS_HID8 = 324 * MiB;
constexpr size_t WS_END = 506 * MiB;
static_assert(!FFN0_FP8, "RES16 places T8 over layer-0 data");
static_assert(WS_T8L0 + (size_t)MT * D <= WS_END && WS_MIX + (size_t)MT * D * 2 <= WS_T8L0, "T8L0");
static_assert(WS_MD8 + (size_t)NE * FF * D <= WS_X16 && WS_X16 + (size_t)MT * D * 2 <= WS_ACT && WS_T8 + (size_t)NL * D <= WS_MGU8, "map");
#else
constexpr size_t WS_T8 = 128 * MiB;
constexpr size_t WS_ACT = 194 * MiB;
constexpr size_t WS_PROJ = 262 * MiB, WS_MIX = 381 * MiB;
constexpr size_t WS_HID = 262 * MiB;
constexpr size_t WS_Y = 160 * MiB, WS_HID8 = 288 * MiB;
constexpr size_t WS_END = 470 * MiB;
static_assert(WS_MD8 + (size_t)NE * FF * D <= WS_T8 && WS_T8 + (size_t)MT * D <= WS_ACT, "map");
#endif
static_assert(WS_WIN + (size_t)2 * INW * D * 2 <= WS_WOUT && WS_FGU + (size_t)2 * FF * D * 2 <= WS_FD && WS_FD + (size_t)FF * D * 2 <= WS_MGU8 && WS_MGU8 + (size_t)NE * 2 * FF * D <= WS_MD8, "weights map");
static_assert(WS_ACT + (size_t)MT * D * 2 <= WS_PROJ && WS_PROJ + (size_t)MT * INW * 2 <= WS_MIX && WS_MIX + (size_t)MT * D * 2 <= WS_END && WS_HID + (size_t)MT * FF * 2 <= WS_END, "act map");
static_assert(WS_Y + (size_t)2 * NL * D * 2 <= WS_HID8 && WS_HID8 + (size_t)264 * 256 * FF <= WS_END && WS_KVS + (size_t)2 * 32 * NCHK * 2048 * 4 <= WS_XC, "moe map");
constexpr int CW_TMO = 0;
constexpr int CW_GCNT = 1024;
constexpr int CW_BGQ = 2048;
constexpr int CW_CMAX = 65536;
constexpr int CW_BAR = 4096;
constexpr int CW_SCAN = 210000;
constexpr int CW_SK = 200000;
constexpr int CW_SEAM = 16384, SEAM_BANK = 136 * 64;
constexpr size_t WS_XB = 4 * MiB, XB_BANK = (size_t)MT * 4 * 8;
constexpr size_t WS_PLOG = WS_KVS;

constexpr int RING_BYTES = 131072;
constexpr int SCR_BYTES = 155648;
constexpr int ROPE_LDS = 139264;
constexpr int MISC_OFF = SCR_BYTES;
constexpr int LDS_BYTES = SCR_BYTES + 256;

#define GAS __attribute__((address_space(1)))
#define LAS __attribute__((address_space(3)))
typedef unsigned short bf16;
typedef unsigned v4u __attribute__((ext_vector_type(4)));
typedef unsigned v2u __attribute__((ext_vector_type(2)));
typedef float f32x4 __attribute__((ext_vector_type(4)));
typedef __bf16 bf16x2_t __attribute__((ext_vector_type(2)));
typedef float f32x2_t __attribute__((ext_vector_type(2)));
#define RLX_AGENT __ATOMIC_RELAXED, __HIP_MEMORY_SCOPE_AGENT
__device__ __forceinline__ unsigned pk2(float lo, float hi) { f32x2_t v = {lo, hi}; bf16x2_t b = __builtin_convertvector(v, bf16x2_t); return __builtin_bit_cast(unsigned, b); }
__device__ __forceinline__ float bflo(unsigned w) { return __uint_as_float(w << 16); }
__device__ __forceinline__ float bfhi(unsigned w) { return __uint_as_float(w & 0xffff0000u); }
__device__ __forceinline__ float dot2bf(unsigned a, unsigned b, float c) { return __builtin_amdgcn_fdot2_f32_bf16(__builtin_bit_cast(bf16x2_t, a), __builtin_bit_cast(bf16x2_t, b), c, false); }
template <int CTRL, int ROWMASK> __device__ __forceinline__ float dpp_f(float v) { return __int_as_float(__builtin_amdgcn_update_dpp(0, __float_as_int(v), CTRL, ROWMASK, 0xF, false)); }
__device__ __forceinline__ float wave_sum(float v) {
    v += dpp_f<0xB1, 0xF>(v); v += dpp_f<0x4E, 0xF>(v); v += dpp_f<0x141, 0xF>(v); v += dpp_f<0x140, 0xF>(v);
    v += dpp_f<0x142, 0xA>(v); v += dpp_f<0x143, 0xC>(v);
    return __int_as_float(__builtin_amdgcn_readlane(__float_as_int(v), 63));
}
__device__ __forceinline__ float wave_max_abs(float v) {
    v = fmaxf(v, dpp_f<0xB1, 0xF>(v)); v = fmaxf(v, dpp_f<0x4E, 0xF>(v)); v = fmaxf(v, dpp_f<0x141, 0xF>(v)); v = fmaxf(v, dpp_f<0x140, 0xF>(v));
    v = fmaxf(v, dpp_f<0x142, 0xA>(v)); v = fmaxf(v, dpp_f<0x143, 0xC>(v));
    return __int_as_float(__builtin_amdgcn_readlane(__float_as_int(v), 63));
}

#define XB_TMO      128
#define XB_XCNT(j)  (256  + 64 * (j))
#define XB_XSUB(j)  (1280 + 64 * (j))
#define XB_XGEN(j)  (2304 + 64 * (j))
#define XB_TOP      3328
#define XB_TOPGEN   3392
#define XCD_BAR_WORDS 3456
#define XB_SPIN_CAP (1u << 18)
__device__ __forceinline__ unsigned xb_ld(unsigned* p)              { return __hip_atomic_load(p, __ATOMIC_RELAXED, __HIP_MEMORY_SCOPE_AGENT); }
__device__ __forceinline__ unsigned xb_add(unsigned* p, unsigned v) { return __hip_atomic_fetch_add(p, v, __ATOMIC_RELAXED, __HIP_MEMORY_SCOPE_AGENT); }
__device__ __forceinline__ unsigned xb_xcc_id() { return (unsigned)__builtin_amdgcn_s_getreg((3 << 11) | 20) & 0xFu; }
#define XB_SPIN(cond, bar) do { unsigned _sp = 0; while (cond) { __builtin_amdgcn_s_sleep(1); \
    if ((++_sp & 255u) == 0u) { if (xb_ld(&(bar)[XB_TMO])) break; if (_sp > XB_SPIN_CAP) { atomicAdd(&(bar)[XB_TMO], 1u); break; } } } } while (0)
struct XcdBarrier { unsigned* bar; unsigned x; volatile LAS unsigned* st; };
__device__ __forceinline__ XcdBarrier xcd_barrier_post(unsigned* bar, volatile LAS unsigned* st) {
    XcdBarrier b; b.bar = bar; b.x = xb_xcc_id(); b.st = st;
    if (threadIdx.x == 0) (void)xb_add(&bar[XB_XCNT(b.x)], 1u);
    return b;
}
__device__ __forceinline__ void xcd_barrier_complete(unsigned* bar, unsigned x, unsigned& nloc, unsigned& nx) {
    const unsigned G = gridDim.x * gridDim.y * gridDim.z;
    unsigned sum, cnt, mine, sp = 0u;
    for (;;) {
        sum = 0u; cnt = 0u; mine = 0u;
#pragma unroll
        for (unsigned j = 0; j < 16; ++j) { const unsigned c = xb_ld(&bar[XB_XCNT(j)]); sum += c; cnt += (c > 0u) ? 1u : 0u; mine = (j == x) ? c : mine; }
        if (sum == G) break;
        __builtin_amdgcn_s_sleep(1);
        if ((++sp & 255u) == 0u) { if (xb_ld(&bar[XB_TMO])) break; if (sp > XB_SPIN_CAP) { atomicAdd(&bar[XB_TMO], 1u); break; } }
    }
    nloc = mine > 0u ? mine : 1u; nx = cnt > 0u ? cnt : 1u;
}
__device__ __forceinline__ void xcd_barrier(const XcdBarrier& b) {
    asm volatile("s_waitcnt vmcnt(0)" ::: "memory");
    __syncthreads();
    if (threadIdx.x == 0) {
        unsigned* bar = b.bar;
        __builtin_amdgcn_s_waitcnt(0);
        unsigned nloc = b.st[0], nx = b.st[1];
        if (nloc == 0u) { xcd_barrier_complete(bar, b.x, nloc, nx); b.st[0] = nloc; b.st[1] = nx; }
        const unsigned old = xb_add(&bar[XB_XSUB(b.x)], 1u);
        const unsigned gen = old / nloc;
        if (old + 1u == (gen + 1u) * nloc) {
            __builtin_amdgcn_fence(__ATOMIC_RELEASE, "agent");
            asm volatile("s_waitcnt vmcnt(0)" ::: "memory");
            const unsigned og = xb_add(&bar[XB_TOP], 1u);
            const unsigned tg = og / nx;
            if (og + 1u == (tg + 1u) * nx) xb_add(&bar[XB_TOPGEN], 1u);
            else XB_SPIN(xb_ld(&bar[XB_TOPGEN]) == tg, bar);
            __builtin_amdgcn_fence(__ATOMIC_ACQUIRE, "agent");
            xb_add(&bar[XB_XGEN(b.x)], 1u);
            asm volatile("s_waitcnt vmcnt(0)" ::: "memory");
        } else {
            XB_SPIN(xb_ld(&bar[XB_XGEN(b.x)]) == gen, bar);
#if L1_ONLY_INV
            asm volatile("buffer_inv sc0" ::: "memory");
#else
            __builtin_amdgcn_fence(__ATOMIC_ACQUIRE, "agent");
#endif
            asm volatile("s_waitcnt vmcnt(0)" ::: "memory");
        }
    }
    __syncthreads();
}

constexpr int NWAVES = 8, NTHR = 512;
struct Frame {
    LAS unsigned char* lds;
    int wave, vcu, G;
    unsigned char* ws; float* out;
    const float *x, *c, *ctx, *c_ctx, *w_mod, *b_mod, *w_in, *sink, *pool_w, *pool_scale, *lgf, *lgb, *w_out, *ln1_g, *ln1_b, *ln2_g, *ln2_b;
    const float *fw_gate, *fw_up, *fw_down, *router, *mw_gate, *mw_up, *mw_down;
};
#define WSP(T, off) ((T*)(F.ws + (off)))

__device__ __forceinline__ void tile_to_lds(const float* W, int N, int k0, int n0, LAS float* scr, int lane) {
    const int rr = lane >> 3, c4 = (lane & 7) * 4; f32x4 v[8];
#pragma unroll
    for (int i = 0; i < 8; ++i) v[i] = *(const f32x4*)(W + (size_t)(k0 + 8 * i + rr) * N + n0 + c4);
#pragma unroll
    for (int i = 0; i < 8; ++i) { LAS float* d = scr + (8 * i + rr) * 33 + c4; d[0] = v[i][0]; d[1] = v[i][1]; d[2] = v[i][2]; d[3] = v[i][3]; }
    asm volatile("s_waitcnt lgkmcnt(0)" ::: "memory");
}
template <class RowMap>
__device__ __forceinline__ void transpose_item(const float* W, int K, int N, bf16* WT, const RowMap& rowmap, LAS float* scr, int item, int lane) {
    const int nblk = N / 32, kb = item / nblk, nb = item % nblk, k0 = 64 * kb, n0 = 32 * nb;
    tile_to_lds(W, N, k0, n0, scr, lane);
    const int c = lane & 7;
#pragma unroll
    for (int j = 0; j < 4; ++j) { const int n = (lane >> 3) + 8 * j; const LAS float* s = scr + (8 * c) * 33 + n;
        v4u o; o.x = pk2(s[0 * 33], s[1 * 33]); o.y = pk2(s[2 * 33], s[3 * 33]); o.z = pk2(s[4 * 33], s[5 * 33]); o.w = pk2(s[6 * 33], s[7 * 33]);
        *(GAS v4u*)(WT + (size_t)rowmap(n0 + n) * K + k0 + 8 * c) = o; }
    asm volatile("s_waitcnt lgkmcnt(0)" ::: "memory");
}
__device__ __forceinline__ unsigned pk4_fp8s(float a, float b, float c, float d, float s) { return pg8::pk4_fp8(a * s, b * s, c * s, d * s); }
template <class RowMap>
__device__ __forceinline__ void transpose_item8(const float* W, int K, int N, unsigned char* WT, const RowMap& rowmap, float scale, LAS float* scr, int item, int lane) {
    const int nblk = N / 32, kb = item / nblk, nb = item % nblk, k0 = 64 * kb, n0 = 32 * nb;
    tile_to_lds(W, N, k0, n0, scr, lane);
    const int c = lane & 7;
#pragma unroll
    for (int j = 0; j < 4; ++j) { const int n = (lane >> 3) + 8 * j; const LAS float* s = scr + (8 * c) * 33 + n;
        v2u o; o.x = pk4_fp8s(s[0 * 33], s[1 * 33], s[2 * 33], s[3 * 33], scale); o.y = pk4_fp8s(s[4 * 33], s[5 * 33], s[6 * 33], s[7 * 33], scale);
        *(GAS v2u*)(WT + (size_t)rowmap(n0 + n) * K + k0 + 8 * c) = o; }
    asm volatile("s_waitcnt lgkmcnt(0)" ::: "memory");
}
template <class RowMap>
__device__ __forceinline__ void colmax_item(const float* W, int N, unsigned* cmax, const RowMap& rowmap, int item, int lane) {
    const int nblk = N / 32, kb = item / nblk, nb = item % nblk, k0 = 64 * kb, n0 = 32 * nb;
    const int rr = lane >> 3, c4 = (lane & 7) * 4; f32x4 v[8];
#pragma unroll
    for (int i = 0; i < 8; ++i) v[i] = *(const f32x4*)(W + (size_t)(k0 + 8 * i + rr) * N + n0 + c4);
    float mx[4];
#pragma unroll
    for (int q = 0; q < 4; ++q) { float m = fabsf(v[0][q]);
#pragma unroll
        for (int i = 1; i < 8; ++i) m = fmaxf(m, fabsf(v[i][q]));
        m = fmaxf(m, __shfl_xor(m, 8)); m = fmaxf(m, __shfl_xor(m, 16)); m = fmaxf(m, __shfl_xor(m, 32)); mx[q] = m; }
    if (lane < 8) {
#pragma unroll
        for (int q = 0; q < 4; ++q) atomicMax(cmax + rowmap(n0 + c4 + q), __float_as_uint(mx[q])); }
}
__device__ __forceinline__ unsigned pk4_i8(float a, float b, float c, float d, float inv) {
    const int q0 = (int)__builtin_rintf(a * inv), q1 = (int)__builtin_rintf(b * inv), q2 = (int)__builtin_rintf(c * inv), q3 = (int)__builtin_rintf(d * inv);
    return (unsigned)(q0 & 255) | ((unsigned)(q1 & 255) << 8) | ((unsigned)(q2 & 255) << 16) | ((unsigned)(q3 & 255) << 24);
}
template <class RowMap>
__device__ __forceinline__ void transpose_item_q(const float* W, int K, int N, unsigned char* WT, const RowMap& rowmap, const unsigned* cmax, LAS float* scr, int item, int lane) {
    const int nblk = N / 32, kb = item / nblk, nb = item % nblk, k0 = 64 * kb, n0 = 32 * nb;
    tile_to_lds(W, N, k0, n0, scr, lane);
    const int c = lane & 7;
#pragma unroll
    for (int j = 0; j < 4; ++j) { const int n = (lane >> 3) + 8 * j; const LAS float* s = scr + (8 * c) * 33 + n; const int row = rowmap(n0 + n);
        const float mx = __uint_as_float(cmax[row]); const float inv = mx > 0.f ? 127.0f / mx : 0.f;
        v2u o; o.x = pk4_i8(s[0 * 33], s[1 * 33], s[2 * 33], s[3 * 33], inv); o.y = pk4_i8(s[4 * 33], s[5 * 33], s[6 * 33], s[7 * 33], inv);
        *(GAS v2u*)(WT + (size_t)row * K + k0 + 8 * c) = o; }
    asm volatile("s_waitcnt lgkmcnt(0)" ::: "memory");
}
struct MapId { __device__ __forceinline__ int operator()(int n) const { return n; } };
struct MapInProj {
    __device__ __forceinline__ int operator()(int n) const { if (n >= C_V) return n; const int dd = n & 31, j = dd & 15, x2 = dd >> 4; return (n & ~31) + 8 * (j >> 2) + 4 * x2 + (j & 3); } };
struct MapGU { int up; __device__ __forceinline__ int operator()(int n) const { return 256 * (n >> 7) + 128 * up + (n & 127); } };

__device__ __forceinline__ void p_prep(Frame& F) {
    const int tid = opq((int)threadIdx.x), lane = tid & 63, wave = F.wave;
    LAS float* sv = (LAS float*)F.lds;
    LAS float* red = sv + 1024 * 12;
    bool have_sv = false;
    for (int un = blockIdx.x; un < 2 * 96; un += F.G) {
        if (!have_sv) {
            for (int idx = tid; idx < 9 * 1024; idx += NTHR) { const int r = idx >> 10, k = idx & 1023; const float v = r < 8 ? F.c[r * 1024 + k] : F.c_ctx[k]; sv[k * 12 + r] = v / (1.0f + __expf(-v)); }
            have_sv = true; __syncthreads();
        }
        const int layer = un / 96, cc = un % 96, col = cc * 64 + lane;
        float acc[9];
#pragma unroll
        for (int r = 0; r < 9; ++r) acc[r] = 0.f;
        const float* wp = F.w_mod + ((size_t)layer * 1024 + wave * 128) * 6144 + col;
#pragma unroll 8
        for (int kk = 0; kk < 128; ++kk) { const float wv = wp[(size_t)kk * 6144]; const LAS float* s = sv + (wave * 128 + kk) * 12;
            const f32x4 s0 = *(const LAS f32x4*)s, s1 = *(const LAS f32x4*)(s + 4); const float s8 = s[8];
            acc[0] += s0[0] * wv; acc[1] += s0[1] * wv; acc[2] += s0[2] * wv; acc[3] += s0[3] * wv; acc[4] += s1[0] * wv; acc[5] += s1[1] * wv; acc[6] += s1[2] * wv; acc[7] += s1[3] * wv; acc[8] += s8 * wv; }
#pragma unroll
        for (int r = 0; r < 9; ++r) red[(wave * 9 + r) * 64 + lane] = acc[r];
        __syncthreads();
        for (int idx = tid; idx < 9 * 64; idx += NTHR) { const int r = idx >> 6, ln = idx & 63; float s = F.b_mod[layer * 6144 + cc * 64 + ln];
#pragma unroll
            for (int w = 0; w < 8; ++w) s += red[(w * 9 + r) * 64 + ln];
            WSP(float, WS_MOD)[(size_t)(layer * 9 + r) * 6144 + cc * 64 + ln] = s; }
        __syncthreads();
    }
    if (blockIdx.x == F.G - 1) { for (int idx = tid; idx < 1024; idx += NTHR) { const int pos = idx >> 4, j = idx & 15; const float inv = powf(10000.0f, -(float)j / 16.0f); const float ang = (float)pos * inv;
            WSP(float, WS_ROPE)[idx] = cosf(ang); WSP(float, WS_ROPE)[1024 + idx] = sinf(ang); } }
    __syncthreads();
    LAS float* scr = (LAS float*)(F.lds + wave * 16384);
    const int gw = F.vcu * NWAVES + wave, NGW = F.G * NWAVES;
    constexpr int I_IN = (D / 64) * (INW / 32), I_OUT = (D / 64) * (D / 32), I_GU = (D / 64) * (FF / 32), I_DN = (FF / 64) * (D / 32);
    constexpr int N_CVT = 2 * (I_IN + I_OUT) + I_DN, N_MAX = (MOEQ ? 1 + NE : 1) * 2 * I_GU;
    unsigned* cmax = WSP(unsigned, WS_CTL) + CW_CMAX;
    for (int it = gw; it < N_CVT + N_MAX; it += NGW) {
        int r = it;
#if INQ
        if (r < 2 * I_IN) { const int l = r / I_IN; colmax_item(F.w_in + (size_t)l * D * INW, INW, cmax + CM_WIN + l * INW, MapInProj{}, r % I_IN, lane); continue; } r -= 2 * I_IN;
#else
        if (r < 2 * I_IN) { const int l = r / I_IN; transpose_item(F.w_in + (size_t)l * D * INW, D, INW, WSP(bf16, WS_WIN) + (size_t)l * INW * D, MapInProj{}, scr, r % I_IN, lane); continue; } r -= 2 * I_IN;
#endif
        if (r < 2 * I_OUT) { const int l = r / I_OUT; transpose_item(F.w_out + (size_t)l * D * D, D, D, WSP(bf16, WS_WOUT) + (size_t)l * D * D, MapId{}, scr, r % I_OUT, lane); continue; } r -= 2 * I_OUT;
#if HID_FP8
        if (r < I_DN) { transpose_item8(F.fw_down, FF, D, WSP(unsigned char, WS_FD), MapId{}, 128.0f, scr, r, lane); continue; } r -= I_DN;
#else
        if (r < I_DN) { transpose_item(F.fw_down, FF, D, WSP(bf16, WS_FD), MapId{}, scr, r, lane); continue; } r -= I_DN;
#endif
        const int m = r / (2 * I_GU), up = (r / I_GU) & 1, item = r % I_GU;
        const float* w = m == 0 ? (up ? F.fw_up : F.fw_gate) : (up ? F.mw_up : F.mw_gate) + (size_t)(m - 1) * D * FF;
        colmax_item(w, FF, cmax + m * 2 * FF, MapGU{up}, item, lane);
    }
}
__device__ __forceinline__ void quant_dense_gu(Frame& F) {
    const int lane = opq((int)threadIdx.x) & 63; LAS float* scr = (LAS float*)(F.lds + F.wave * 16384);
    constexpr int I_GU = (D / 64) * (FF / 32);
    constexpr int I_IN = (D / 64) * (INW / 32);
    for (int it = F.vcu * NWAVES + F.wave; it < 2 * I_GU + (INQ ? 2 * I_IN : 0); it += F.G * NWAVES) {
        if (it < 2 * I_GU) { const int up = it / I_GU; transpose_item_q(up ? F.fw_up : F.fw_gate, D, FF, WSP(unsigned char, WS_FGU), MapGU{up}, WSP(unsigned, WS_CTL) + CW_CMAX, scr, it % I_GU, lane); }
        else { const int r = it - 2 * I_GU, l = r / I_IN; transpose_item_q(F.w_in + (size_t)l * D * INW, D, INW, WSP(unsigned char, WS_WIN) + (size_t)l * INW * D, MapInProj{}, WSP(unsigned, WS_CTL) + CW_CMAX + CM_WIN + l * INW, scr, r % I_IN, lane); } }
}
constexpr int CV_A = 3200, CV_B = 9100, CV_C = 12100, CV_E = 14700;
__device__ __forceinline__ void bg_convert(Frame& F, int first_wg, int n_wg, int it0 = 0, int it1 = 1 << 30) {
    const int lane = opq((int)threadIdx.x) & 63; LAS float* scr = (LAS float*)(F.lds + F.wave * 16384);
    constexpr int I_GU = (D / 64) * (FF / 32), I_DN = (FF / 64) * (D / 32), PER = 2 * I_GU + I_DN, TOTAL = NE * PER;
    int slot0, nslot, nslots;
    if (first_wg < 0) { const int b = (int)blockIdx.x; nslots = 1024; if (b < 128) { slot0 = 3 * b; nslot = 3; } else { slot0 = 384 + 5 * (b - 128); nslot = 5; } }
    else { const int j = (int)blockIdx.x - first_wg; if (j < 0 || j >= n_wg) return; slot0 = j; nslot = 1; nslots = n_wg; }
    for (int sl = 0; sl < nslot; ++sl)
    for (int it = it0 + (slot0 + sl) * NWAVES + F.wave; it < (it1 < TOTAL ? it1 : TOTAL); it += nslots * NWAVES) { const int m = it / PER; int r = it % PER;
        unsigned char* gu = WSP(unsigned char, WS_MGU8) + (size_t)m * 2 * FF * D; unsigned char* dn = WSP(unsigned char, WS_MD8) + (size_t)m * FF * D;
        const unsigned* cm = WSP(unsigned, WS_CTL) + CW_CMAX + (1 + m) * 2 * FF;
#if MOEQ
        if (r < I_GU) { transpose_item_q(F.mw_gate + (size_t)m * D * FF, D, FF, gu, MapGU{0}, cm, scr, r, lane); continue; } r -= I_GU;
        if (r < I_GU) { transpose_item_q(F.mw_up + (size_t)m * D * FF, D, FF, gu, MapGU{1}, cm, scr, r, lane); continue; } r -= I_GU;
#else
        (void)cm;
        if (r < I_GU) { transpose_item8(F.mw_gate + (size_t)m * D * FF, D, FF, gu, MapGU{0}, 32.0f, scr, r, lane); continue; } r -= I_GU;
        if (r < I_GU) { transpose_item8(F.mw_up + (size_t)m * D * FF, D, FF, gu, MapGU{1}, 32.0f, scr, r, lane); continue; } r -= I_GU;
#endif
        transpose_item8(F.mw_down + (size_t)m * FF * D, FF, D, dn, MapId{}, 128.0f, scr, r, lane); }
}

__device__ __forceinline__ void row_load_f32(const float* p, int lane, f32x4 (&v)[4]) {
#pragma unroll
    for (int j = 0; j < 4; ++j) v[j] = *(const f32x4*)(p + 4 * lane + 256 * j);
}
__device__ __forceinline__ void row_load_bf16(const bf16* p, int lane, f32x4 (&v)[4]) {
#pragma unroll
    for (int j = 0; j < 4; ++j) { const v2u w = *(const v2u*)(p + 4 * lane + 256 * j); v[j] = (f32x4){bflo(w.x), bfhi(w.x), bflo(w.y), bfhi(w.y)}; }
}
__device__ __forceinline__ void row_store_bf16(bf16* p, int lane, const f32x4 (&v)[4]) {
#pragma unroll
    for (int j = 0; j < 4; ++j) { v2u w; w.x = pk2(v[j][0], v[j][1]); w.y = pk2(v[j][2], v[j][3]); *(v2u*)(p + 4 * lane + 256 * j) = w; }
}
__device__ __forceinline__ void row_store_f32(float* p, int lane, const f32x4 (&v)[4]) {
#pragma unroll
    for (int j = 0; j < 4; ++j) *(f32x4*)(p + 4 * lane + 256 * j) = v[j];
}
__device__ __forceinline__ void row_ln(f32x4 (&v)[4], const float* g, const float* b, int lane) {
    float s = 0.f;
#pragma unroll
    for (int j = 0; j < 4; ++j) s += (v[j][0] + v[j][1]) + (v[j][2] + v[j][3]);
    const float mean = wave_sum(s) * (1.0f / D); float q = 0.f;
#pragma unroll
    for (int j = 0; j < 4; ++j) { v[j] = v[j] - mean; q += (v[j][0] * v[j][0] + v[j][1] * v[j][1]) + (v[j][2] * v[j][2] + v[j][3] * v[j][3]); }
    const float rstd = 1.0f / sqrtf(wave_sum(q) * (1.0f / D) + LN_EPS);
#pragma unroll
    for (int j = 0; j < 4; ++j) { const f32x4 gg = *(const f32x4*)(g + 4 * lane + 256 * j), bb = *(const f32x4*)(b + 4 * lane + 256 * j); v[j] = v[j] * rstd * gg + bb; }
}
__device__ __forceinline__ const float* modp(Frame& F, int layer, int mr, int part) { return WSP(float, WS_MOD) + (size_t)(layer * 9 + mr) * 6144 + part * 1024; }
__device__ __forceinline__ void row_modulate(f32x4 (&v)[4], const float* sh, const float* sc, int lane) {
#pragma unroll
    for (int j = 0; j < 4; ++j) { const f32x4 a = *(const f32x4*)(sc + 4 * lane + 256 * j), b = *(const f32x4*)(sh + 4 * lane + 256 * j); v[j] = v[j] * (1.0f + a) + b; }
}
__device__ __forceinline__ void res_load(Frame& F, int r, int lane, f32x4 (&v)[4]) {
#if RES16
    row_load_bf16(WSP(bf16, WS_X16) + (size_t)r * D, lane, v);
#else
    row_load_f32(r < NL ? F.out + (size_t)r * D : WSP(float, WS_XC) + (size_t)(r - NL) * D, lane, v);
#endif
}
__device__ __forceinline__ void res_store(Frame& F, int r, int lane, const f32x4 (&v)[4]) {
#if RES16
    row_store_bf16(WSP(bf16, WS_X16) + (size_t)r * D, lane, v);
#else
    row_store_f32(r < NL ? F.out + (size_t)r * D : WSP(float, WS_XC) + (size_t)(r - NL) * D, lane, v);
#endif
}
__device__ __forceinline__ void row_store_q8(unsigned char* p, float* st, int lane, const f32x4 (&v)[4]) {
    float mx = 0.f;
#pragma unroll
    for (int j = 0; j < 4; ++j) mx = fmaxf(fmaxf(mx, fmaxf(fabsf(v[j][0]), fabsf(v[j][1]))), fmaxf(fabsf(v[j][2]), fabsf(v[j][3])));
    mx = wave_max_abs(mx);
    const float inv = mx > 0.f ? 127.0f / mx : 0.f;
#pragma unroll
    for (int j = 0; j < 4; ++j) *(unsigned*)(p + 4 * lane + 256 * j) = pk4_i8(v[j][0], v[j][1], v[j][2], v[j][3], inv);
    if (lane == 0) *st = mx * (1.0f / 127.0f);
}
__device__ __forceinline__ void p_h0(Frame& F) {
    const int gw = F.vcu * NWAVES + F.wave, NGW = F.G * NWAVES, lane = (opq((int)threadIdx.x) & 63);
    for (int r = gw; r < MT; r += NGW) { const int mr = r < NL ? (r >> 12) : 8; const float* xr = r < NL ? F.x + (size_t)r * D : F.ctx + (size_t)(r - NL) * D;
        f32x4 v[4]; row_load_f32(xr, lane, v); row_modulate(v, modp(F, 0, mr, 0), modp(F, 0, mr, 1), lane);
#if INQ
        row_store_q8(WSP(unsigned char, WS_T8L0) + (size_t)r * D, WSP(float, WS_SH) + r, lane, v); }
#else
        row_store_bf16(WSP(bf16, WS_ACT) + (size_t)r * D, lane, v); }
#endif
}
__device__ __forceinline__ void p_ln1(Frame& F, int layer) {
    const int lane = (opq((int)threadIdx.x) & 63);
    if (layer == 0) {
        const int gw = F.vcu * NWAVES + F.wave, NGW = F.G * NWAVES;
#if ((REP_MASK) >> 15) & 1
        for (int r = gw; r < MT; r += NGW) { const int mr = r < NL ? (r >> 12) : 8; const float* xr = r < NL ? F.x + (size_t)r * D : F.ctx + (size_t)(r - NL) * D;
            bf16* ar = WSP(bf16, WS_ACT) + (size_t)r * D;
            f32x4 v[4], y[4]; row_load_f32(xr, lane, v); row_load_bf16(ar, lane, y); const float* g1 = modp(F, 0, mr, 2);
#pragma unroll
            for (int j = 0; j < 4; ++j) v[j] = ALPHA * v[j] + *(const f32x4*)(g1 + 4 * lane + 256 * j) * y[j];
            row_ln(v, F.ln1_g, F.ln1_b, lane); row_store_bf16(WSP(bf16, WS_PROJ) + (size_t)r * D, lane, v);
            row_modulate(v, modp(F, 0, mr, 3), modp(F, 0, mr, 4), lane);
            row_store_q8(WSP(unsigned char, WS_PROJ) + 80 * MiB + (size_t)r * D, (float*)(WSP(unsigned char, WS_PROJ) + 118 * MiB) + r, lane, v);
        }
        __syncthreads();
#endif
        for (int r_ = gw; r_ < MT; r_ += NGW) { const int r = (REV_MASK & 8) ? MT - 1 - r_ : r_;
            const int mr = r < NL ? (r >> 12) : 8; const float* xr = r < NL ? F.x + (size_t)r * D : F.ctx + (size_t)(r - NL) * D;
            bf16* ar = WSP(bf16, WS_ACT) + (size_t)r * D;
            f32x4 v[4], y[4]; row_load_f32(xr, lane, v); row_load_bf16(ar, lane, y); const float* g1 = modp(F, 0, mr, 2);
#pragma unroll
            for (int j = 0; j < 4; ++j) v[j] = ALPHA * v[j] + *(const f32x4*)(g1 + 4 * lane + 256 * j) * y[j];
            row_ln(v, F.ln1_g, F.ln1_b, lane); res_store(F, r, lane, v);
            row_modulate(v, modp(F, 0, mr, 3), modp(F, 0, mr, 4), lane);
            row_store_q8(WSP(unsigned char, WS_T8L0) + (size_t)r * D, WSP(float, WS_ST) + r, lane, v);
        }
        return;
    }
    LAS int* lcnt = (LAS int*)F.lds; LAS int* lbase = lcnt + 8; LAS int* rinfo = lcnt + 16;
    float rt[16][8];
#pragma unroll
    for (int j = 0; j < 4; ++j)
#pragma unroll
        for (int q = 0; q < 4; ++q) { const float* rp = F.router + (size_t)(4 * lane + 256 * j + q) * 8; const f32x4 a = *(const f32x4*)rp, b = *(const f32x4*)(rp + 4);
            rt[j * 4 + q][0] = a[0]; rt[j * 4 + q][1] = a[1]; rt[j * 4 + q][2] = a[2]; rt[j * 4 + q][3] = a[3]; rt[j * 4 + q][4] = b[0]; rt[j * 4 + q][5] = b[1]; rt[j * 4 + q][6] = b[2]; rt[j * 4 + q][7] = b[3]; }
    for (int rb = blockIdx.x; rb < NL / 128; rb += F.G) {
        if ((int)threadIdx.x < 8) lcnt[threadIdx.x] = 0;
        __syncthreads();
#if ((REP_MASK) >> 14) & 1
        for (int ii = 0; ii < 32; ++ii) { const int i = ii >> 1; const bool real = (ii & 1) != 0;
#else
        for (int i = 0; i < 16; ++i) { const bool real = true;
#endif
            const int rl = F.wave * 16 + i, r = rb * 128 + rl, mr = r >> 12;
            bf16* ar = WSP(bf16, WS_ACT) + (size_t)r * D;
            f32x4 v[4], y[4]; if (PINGPONG) row_load_bf16((const bf16*)F.out + (size_t)r * D, lane, v); else res_load(F, r, lane, v);        row_load_bf16(ar, lane, y); const float* g1 = modp(F, 1, mr, 2);
#pragma unroll
            for (int j = 0; j < 4; ++j) v[j] = ALPHA * v[j] + *(const f32x4*)(g1 + 4 * lane + 256 * j) * y[j];
            row_ln(v, F.ln1_g + D, F.ln1_b + D, lane); if (real) res_store(F, r, lane, v); else row_store_bf16(WSP(bf16, WS_PROJ) + (size_t)r * D, lane, v);
            row_modulate(v, modp(F, 1, mr, 3), modp(F, 1, mr, 4), lane);
#if MOEQ
            row_store_q8(WSP(unsigned char, WS_T8) + (size_t)r * D, WSP(float, WS_ST) + r, lane, v);
#else
            { unsigned char* t8 = (real ? WSP(unsigned char, WS_T8) : WSP(unsigned char, WS_PROJ) + 80 * MiB) + (size_t)r * D;
#pragma unroll
              for (int j = 0; j < 4; ++j) *(unsigned*)(t8 + 4 * lane + 256 * j) = pk4_fp8s(v[j][0], v[j][1], v[j][2], v[j][3], 4.0f); }
#endif
            float lg[8];
#pragma unroll
            for (int e = 0; e < 8; ++e) { float s = 0.f;
#pragma unroll
                for (int j = 0; j < 4; ++j)
#pragma unroll
                    for (int q = 0; q < 4; ++q) s += v[j][q] * rt[j * 4 + q][e];
                lg[e] = wave_sum(s); }
            int i1 = 0; float v1 = lg[0];
#pragma unroll
            for (int e = 1; e < 8; ++e) if (lg[e] > v1) { v1 = lg[e]; i1 = e; }
            int i2 = -1; float v2 = -3.0e38f;
#pragma unroll
            for (int e = 0; e < 8; ++e) if (e != i1 && lg[e] > v2) { v2 = lg[e]; i2 = e; }
            const float ex = __expf(v2 - v1), w1 = 1.0f / (1.0f + ex), w2 = ex / (1.0f + ex);
            if (lane == 0 && real) { const int p1 = __hip_atomic_fetch_add(lcnt + i1, 1, __ATOMIC_RELAXED, __HIP_MEMORY_SCOPE_WORKGROUP), p2 = __hip_atomic_fetch_add(lcnt + i2, 1, __ATOMIC_RELAXED, __HIP_MEMORY_SCOPE_WORKGROUP);
                LAS int* ri = rinfo + rl * 6; ri[0] = i1; ri[1] = p1; ri[2] = __float_as_int(w1); ri[3] = i2; ri[4] = p2; ri[5] = __float_as_int(w2); }
        }
        __syncthreads();
        if ((int)threadIdx.x < 8) lbase[threadIdx.x] = (int)__hip_atomic_fetch_add((unsigned*)(WSP(unsigned, WS_CTL) + CW_GCNT + 64 * threadIdx.x), (unsigned)lcnt[threadIdx.x], RLX_AGENT);
        __syncthreads();
        if ((int)threadIdx.x < 256) { const int rl = (int)threadIdx.x >> 1, s = (int)threadIdx.x & 1; const LAS int* ri = rinfo + rl * 6 + 3 * s; const int e = ri[0], pos = lbase[e] + ri[1];
            WSP(int, WS_LIST)[e * LCAP + pos] = ((rb * 128 + rl) << 1) | s; WSP(float, WS_LGATE)[e * LCAP + pos] = __int_as_float(ri[2]); }
        __syncthreads();
    }
}
__device__ __forceinline__ void p_route(Frame& F) {
    const int tid = opq((int)threadIdx.x);
    LAS int* lcnt = (LAS int*)F.lds; LAS int* lbase = lcnt + 8; LAS int* rinfo = lcnt + 16;
    const float* pl = WSP(float, WS_PLOG);
    for (int rb = blockIdx.x; rb < NL / 128; rb += F.G) {
        if (tid < 8) lcnt[tid] = 0;
        __syncthreads();
        if (tid < 128) { const int r = rb * 128 + tid; float lg[8];
#pragma unroll
            for (int e = 0; e < 8; ++e) lg[e] = 0.f;
#pragma unroll
            for (int pn = 0; pn < 4; ++pn) { const f32x4 a = *(const f32x4*)(pl + ((size_t)pn * NL + r) * 8), b = *(const f32x4*)(pl + ((size_t)pn * NL + r) * 8 + 4);
                lg[0] += a[0]; lg[1] += a[1]; lg[2] += a[2]; lg[3] += a[3]; lg[4] += b[0]; lg[5] += b[1]; lg[6] += b[2]; lg[7] += b[3]; }
            int i1 = 0; float v1 = lg[0];
#pragma unroll
            for (int e = 1; e < 8; ++e) if (lg[e] > v1) { v1 = lg[e]; i1 = e; }
            int i2 = -1; float v2 = -3.0e38f;
#pragma unroll
            for (int e = 0; e < 8; ++e) if (e != i1 && lg[e] > v2) { v2 = lg[e]; i2 = e; }
            const float ex = __expf(v2 - v1), w1 = 1.0f / (1.0f + ex), w2 = ex / (1.0f + ex);
            const int p1 = __hip_atomic_fetch_add(lcnt + i1, 1, __ATOMIC_RELAXED, __HIP_MEMORY_SCOPE_WORKGROUP), p2 = __hip_atomic_fetch_add(lcnt + i2, 1, __ATOMIC_RELAXED, __HIP_MEMORY_SCOPE_WORKGROUP);
            LAS int* ri = rinfo + tid * 6; ri[0] = i1; ri[1] = p1; ri[2] = __float_as_int(w1); ri[3] = i2; ri[4] = p2; ri[5] = __float_as_int(w2); }
        __syncthreads();
        if (tid < 8) lbase[tid] = (int)__hip_atomic_fetch_add((unsigned*)(WSP(unsigned, WS_CTL) + CW_GCNT + 64 * tid), (unsigned)lcnt[tid], RLX_AGENT);
        __syncthreads();
        if (tid < 256) { const int rl = tid >> 1, s = tid & 1; const LAS int* ri = rinfo + rl * 6 + 3 * s; const int e = ri[0], pos = lbase[e] + ri[1];
            WSP(int, WS_LIST)[e * LCAP + pos] = ((rb * 128 + rl) << 1) | s; WSP(float, WS_LGATE)[e * LCAP + pos] = __int_as_float(ri[2]); }
        __syncthreads();
    }
}
__device__ __forceinline__ void p_ln2_l0(Frame& F) {
    const int lane = (opq((int)threadIdx.x) & 63), gw = F.vcu * NWAVES + F.wave, NGW = F.G * NWAVES;
#if ((REP_MASK) >> 12) & 1
    for (int r = gw; r < MT; r += NGW) { const int mr = r < NL ? (r >> 12) : 8;
        bf16* ar = WSP(bf16, WS_ACT) + (size_t)r * D;
        f32x4 v[4], y[4]; res_load(F, r, lane, v); row_load_bf16(ar, lane, y); const float* g2 = modp(F, 0, mr, 5);
#pragma unroll
        for (int j = 0; j < 4; ++j) v[j] = ALPHA * v[j] + *(const f32x4*)(g2 + 4 * lane + 256 * j) * y[j];
        row_ln(v, F.ln2_g, F.ln2_b, lane); row_store_bf16(WSP(bf16, WS_HID) + (size_t)r * D, lane, v);
        row_modulate(v, modp(F, 1, mr, 0), modp(F, 1, mr, 1), lane);
        row_store_q8(WSP(unsigned char, WS_HID) + 80 * MiB + (size_t)r * D, (float*)(WSP(unsigned char, WS_HID) + 120 * MiB) + r, lane, v); }
    __syncthreads();
#endif
    for (int r = gw; r < MT; r += NGW) { const int mr = r < NL ? (r >> 12) : 8;
        bf16* ar = WSP(bf16, WS_ACT) + (size_t)r * D;
        f32x4 v[4], y[4]; res_load(F, r, lane, v); row_load_bf16(ar, lane, y); const float* g2 = modp(F, 0, mr, 5);
#pragma unroll
        for (int j = 0; j < 4; ++j) v[j] = ALPHA * v[j] + *(const f32x4*)(g2 + 4 * lane + 256 * j) * y[j];
        row_ln(v, F.ln2_g, F.ln2_b, lane); if (PINGPONG) row_store_bf16((bf16*)F.out + (size_t)r * D, lane, v); else res_store(F, r, lane, v);
        row_modulate(v, modp(F, 1, mr, 0), modp(F, 1, mr, 1), lane);
#if INQ
        row_store_q8(WSP(unsigned char, WS_T8L0) + (size_t)r * D, WSP(float, WS_SH) + r, lane, v); }
#else
        row_store_bf16(ar, lane, v); }
#endif
}
__device__ __forceinline__ void p_final(Frame& F) {
    const int lane = (opq((int)threadIdx.x) & 63), gw = F.vcu * NWAVES + F.wave, NGW = F.G * NWAVES;
    for (int r = gw; r < NL; r += NGW) { const int mr = r >> 12; float* xo = F.out + (size_t)r * D;
        f32x4 v[4], y0[4], y1[4]; res_load(F, r, lane, v); row_load_bf16(WSP(bf16, WS_Y) + (size_t)r * D, lane, y0); row_load_bf16(WSP(bf16, WS_Y) + (size_t)(NL + r) * D, lane, y1); const float* g2 = modp(F, 1, mr, 5);
#pragma unroll
        for (int j = 0; j < 4; ++j) v[j] = ALPHA * v[j] + *(const f32x4*)(g2 + 4 * lane + 256 * j) * (y0[j] + y1[j]);
        row_ln(v, F.ln2_g + D, F.ln2_b + D, lane);
#if defined(ATTN_CHECK) || defined(MIX_CHECK)
        if ((__hip_atomic_load(WSP(unsigned, WS_CTL) + 8, RLX_AGENT) | __hip_atomic_load(WSP(unsigned, WS_CTL) + 9, RLX_AGENT) * CHK_POOL | __hip_atomic_load(WSP(unsigned, WS_CTL) + 10, RLX_AGENT) * CHK_KV | __hip_atomic_load(WSP(unsigned, WS_CTL) + 11, RLX_AGENT) * CHK_RET) != 0u) { const float qn = 0.0f;
#pragma unroll
            for (int j = 0; j < 4; ++j) v[j] = (f32x4){qn, qn, qn, qn}; }
#endif
        row_store_f32(xo, lane, v); }
}

__device__ __forceinline__ int chunk_row0(int b, int cid) { return cid < 2 ? NL + b * CTXL + cid * 128 : b * SEQ + (cid - 2) * 128; }
namespace att {
using bf16x8 = __attribute__((ext_vector_type(8))) short;
using s16x4 = __attribute__((ext_vector_type(4))) short;
using f32x16 = __attribute__((ext_vector_type(16))) float;
using u32x4 = __attribute__((ext_vector_type(4))) unsigned;
typedef short v4i16_t __attribute__((ext_vector_type(4)));
typedef __attribute__((address_space(3))) const char* lds_cptr;
constexpr int SLOTB = 8192, LDS_K = 0, LDS_V = 2 * SLOTB, LDS_WS = 4 * SLOTB, LDS_OST = LDS_WS + 8 * 256, LDS_TOTAL = LDS_OST + 8 * 4096;
constexpr float THR = 8.0f, NEGBIG = -1.0e30f;
__device__ __forceinline__ int crow(int r, int hi) { return (r & 3) + 8 * (r >> 2) + 4 * hi; }
__device__ __forceinline__ void glds16(const void* gsrc, unsigned lds_dst) { unsigned keep;
    asm volatile("s_mov_b32 %0, m0\n\ts_mov_b32 m0, %2\n\ts_nop 0\n\tglobal_load_lds_dwordx4 %1, off\n\ts_mov_b32 m0, %0" : "=&s"(keep) : "v"(gsrc), "s"(lds_dst) : "memory"); }
__device__ __forceinline__ s16x4 vtr(lds_cptr p) { return __builtin_bit_cast(s16x4, __builtin_amdgcn_ds_read_tr16_b64_v4i16((__attribute__((address_space(3))) v4i16_t*)p)); }
__device__ __forceinline__ unsigned cvtpk(float lo, float hi) { f32x2_t v = {lo, hi}; bf16x2_t b = __builtin_convertvector(v, bf16x2_t); return __builtin_bit_cast(unsigned, b); }

__device__ __forceinline__ void attn_unit(Frame& F, int layer, int b, int qb, int kvh, bool isctx) {
    const int tid = opq((int)threadIdx.x), lane = tid & 63, r32 = lane & 31, hi = lane >> 5; const int wid = __builtin_amdgcn_readfirstlane(tid >> 6);
    const int g = wid >> 1, qh = wid & 1, head = kvh * 4 + g;
    const bf16* P = WSP(bf16, WS_PROJ);
    const int qrow0 = (isctx ? NL + b * CTXL : b * SEQ) + qb * 128 + qh * 64;
    const int tlo = isctx ? 0 : (qb == 0 ? 2 : 0), thi = isctx ? 0 : (qb == SEQ / 128 - 1 ? 4 : 6), nloc = thi - tlo, ntiles = nloc + 4;
    const lds_cptr shm = (lds_cptr)F.lds; const unsigned lds0 = (unsigned)(uintptr_t)F.lds;
    LAS float* wsf = (LAS float*)(F.lds + LDS_WS) + wid * 64;
    bf16x8 qr[2][4];
#pragma unroll
    for (int rb = 0; rb < 2; ++rb)
#pragma unroll
        for (int d0 = 0; d0 < 4; ++d0) qr[rb][d0] = *(const bf16x8*)(P + (size_t)(qrow0 + 32 * rb + r32) * INW + head * 64 + d0 * 16 + hi * 8);
    __builtin_amdgcn_s_waitcnt(0x0F70);
    float m[2], l[2]; f32x16 o[2][2];
    { const float s0 = F.sink[layer * 8 + head] * LOG2E;
#pragma unroll
      for (int rb = 0; rb < 2; ++rb) { m[rb] = s0; l[rb] = hi == 0 ? 1.0f : 0.0f; o[rb][0] = f32x16{}; o[rb][1] = f32x16{}; } }
    auto tile_row = [&](int i) -> int { return i < nloc ? b * SEQ + qb * 128 - 128 + 64 * (tlo + i) : NL + b * CTXL + 64 * (i - nloc); };
    auto dma = [&](int i) { const int kr = tile_row(i); const unsigned slot = (unsigned)(i & 1) * SLOTB;
        glds16(P + (size_t)(kr + lane) * INW + C_K + kvh * 64 + wid * 8, (unsigned)__builtin_amdgcn_readfirstlane(lds0 + LDS_K + slot + wid * 1024));
        glds16(P + (size_t)(kr + 16 * (wid & 3) + (lane >> 2)) * INW + C_V + kvh * 64 + (wid >> 2) * 32 + (lane & 3) * 8, (unsigned)__builtin_amdgcn_readfirstlane(lds0 + LDS_V + slot + wid * 1024)); };
    dma(0);
    for (int i = 0; i < ntiles; ++i) {
        if (i + 1 < ntiles) { dma(i + 1); asm volatile("s_waitcnt vmcnt(2)\n\ts_barrier" ::: "memory"); }
        else asm volatile("s_waitcnt vmcnt(0)\n\ts_barrier" ::: "memory");
        const lds_cptr kp = shm + LDS_K + (i & 1) * SLOTB + hi * 1024 + r32 * 16;
        const lds_cptr vp = shm + LDS_V + (i & 1) * SLOTB + ((lane >> 4) & 1) * 32 + (lane & 3) * 8 + (4 * hi + ((lane & 15) >> 2)) * 64;
        const bool local = i < nloc; const int c = local ? 128 - 64 * (tlo + i) : 0;
        bool act[2], partial[2]; f32x16 p0[2], p1[2];
#pragma unroll
        for (int rb = 0; rb < 2; ++rb) { const int q0 = qh * 64 + rb * 32; act[rb] = true; partial[rb] = false;
            if (local) { const int dlo = q0 - 63 + c, dhi = q0 + 31 + c; act[rb] = !(dlo > 128 || dhi < -128); partial[rb] = !(dlo >= -128 && dhi <= 128); } }
#pragma unroll
        for (int rb = 0; rb < 2; ++rb) { if (!act[rb]) continue;
            { const float nm = -m[rb];
#pragma unroll
              for (int r = 0; r < 16; ++r) { p0[rb][r] = nm; p1[rb][r] = nm; } }
#pragma unroll
            for (int d0 = 0; d0 < 4; ++d0) { const bf16x8 k0 = *(const __attribute__((address_space(3))) bf16x8*)(kp + d0 * 2048), k1 = *(const __attribute__((address_space(3))) bf16x8*)(kp + d0 * 2048 + 512);
                p0[rb] = __builtin_amdgcn_mfma_f32_32x32x16_bf16(k0, qr[rb][d0], p0[rb], 0, 0, 0); p1[rb] = __builtin_amdgcn_mfma_f32_32x32x16_bf16(k1, qr[rb][d0], p1[rb], 0, 0, 0); } }
#pragma unroll
        for (int rb = 0; rb < 2; ++rb) { if (!act[rb]) continue;
            const int q0 = qh * 64 + rb * 32;
            if (partial[rb]) { const int qq = q0 + r32 + c;
#pragma unroll
                for (int r = 0; r < 16; ++r) { const int dl = qq - crow(r, hi); if (dl > 128 || dl < -128) p0[rb][r] = NEGBIG; if (dl - 32 > 128 || dl - 32 < -128) p1[rb][r] = NEGBIG; } }
            float rm = fmaxf(p0[rb][0], p1[rb][0]);
#pragma unroll
            for (int r = 1; r < 16; ++r) rm = fmaxf(rm, fmaxf(p0[rb][r], p1[rb][r]));
            { auto rr = __builtin_amdgcn_permlane32_swap(__float_as_uint(rm), __float_as_uint(rm), false, false); rm = fmaxf(__uint_as_float(rr[0]), __uint_as_float(rr[1])); }
            if (__any(rm > THR)) {
                const float dl = fmaxf(rm, 0.f); m[rb] += dl;
#pragma unroll
                for (int r = 0; r < 16; ++r) { p0[rb][r] -= dl; p1[rb][r] -= dl; }
                const float f = __builtin_amdgcn_exp2f(-dl); l[rb] *= f; if (hi == 0) wsf[r32] = f;
                asm volatile("s_waitcnt lgkmcnt(0)" ::: "memory");
#pragma unroll
                for (int r = 0; r < 16; ++r) { const float fr = wsf[crow(r, hi)]; o[rb][0][r] *= fr; o[rb][1][r] *= fr; }
            }
            float sacc = 0.f;
#pragma unroll
            for (int r = 0; r < 16; ++r) { p0[rb][r] = __builtin_amdgcn_exp2f(p0[rb][r]); p1[rb][r] = __builtin_amdgcn_exp2f(p1[rb][r]); sacc += p0[rb][r] + p1[rb][r]; }
            l[rb] += sacc;
            u32x4 pw[4];
#pragma unroll
            for (int k = 0; k < 4; ++k) { pw[0][k] = cvtpk(p0[rb][2 * k], p0[rb][2 * k + 1]); pw[1][k] = cvtpk(p0[rb][8 + 2 * k], p0[rb][9 + 2 * k]); pw[2][k] = cvtpk(p1[rb][2 * k], p1[rb][2 * k + 1]); pw[3][k] = cvtpk(p1[rb][8 + 2 * k], p1[rb][9 + 2 * k]); }
#pragma unroll
            for (int d0 = 0; d0 < 2; ++d0) {
#pragma unroll
                for (int ks = 0; ks < 4; ++ks) { const s16x4 lo = vtr(vp + d0 * 4096 + ks * 1024), hh = vtr(vp + d0 * 4096 + ks * 1024 + 512);
                    const bf16x8 vf = (bf16x8){lo[0], lo[1], lo[2], lo[3], hh[0], hh[1], hh[2], hh[3]};
                    o[rb][d0] = __builtin_amdgcn_mfma_f32_32x32x16_bf16(__builtin_bit_cast(bf16x8, pw[ks]), vf, o[rb][d0], 0, 0, 0); } }
        }
        asm volatile("s_waitcnt lgkmcnt(0)\n\ts_barrier" ::: "memory");
    }
    LAS bf16* stg = (LAS bf16*)(F.lds + LDS_OST) + wid * 2048;
#pragma unroll
    for (int rb = 0; rb < 2; ++rb) {
        float lt = l[rb]; { auto rr = __builtin_amdgcn_permlane32_swap(__float_as_uint(lt), __float_as_uint(lt), false, false); lt = __uint_as_float(rr[0]) + __uint_as_float(rr[1]); }
        if (hi == 0) wsf[r32] = 1.0f / lt;
        asm volatile("s_waitcnt lgkmcnt(0)" ::: "memory");
#pragma unroll
        for (int r = 0; r < 16; ++r) { const float rl = wsf[crow(r, hi)]; const int orow = crow(r, hi);
            stg[orow * 64 + r32] = (bf16)(pk2(o[rb][0][r] * rl, 0.f) & 0xffffu); stg[orow * 64 + 32 + r32] = (bf16)(pk2(o[rb][1][r] * rl, 0.f) & 0xffffu); }
        asm volatile("s_waitcnt lgkmcnt(0)" ::: "memory");
        bf16* Ow = WSP(bf16, WS_MIX) + (size_t)(qrow0 + 32 * rb) * D + head * 64;
#pragma unroll
        for (int k = 0; k < 4; ++k) { const int row = k * 8 + (lane >> 3), ch = lane & 7; const v4u v = *(const LAS v4u*)(stg + row * 64 + ch * 8); *(v4u*)(Ow + (size_t)row * D + ch * 8) = v; }
        asm volatile("s_waitcnt lgkmcnt(0)" ::: "memory");
    }
}
}
__device__ __forceinline__ void p_attn(Frame& F, int layer) {
    const int vcu = (blockIdx.x % 8) * (F.G / 8) + blockIdx.x / 8;
    for (int u = vcu * 2; u < 512; u += 2 * F.G) { att::attn_unit(F, layer, u >> 6, (u >> 1) & 31, u & 1, false); att::attn_unit(F, layer, (u + 1) >> 6, ((u + 1) >> 1) & 31, (u + 1) & 1, false); }
    if (layer == 0) for (int v = blockIdx.x; v < 32; v += F.G) att::attn_unit(F, layer, v >> 2, (v >> 1) & 1, v & 1, true);
}
namespace att2 {
using bf16=unsigned short;
using bf16x8=__attribute__((ext_vector_type(8)))short;
using s16x4=__attribute__((ext_vector_type(4)))short;
using f32x16=__attribute__((ext_vector_type(16)))float;
using u32x4=__attribute__((ext_vector_type(4)))unsigned;
constexpr int NW=8,QBLK=32,KVBLK=64;
__device__ __forceinline__ int crow(int r,int hi){return (r&3)+8*(r>>2)+4*hi;}
#define SBAR() __builtin_amdgcn_sched_barrier(0)
__device__ __forceinline__ void wmask(f32x16&p0,f32x16&p1,int c,int qq,int hi){
  const float NEG=-INFINITY; const int d0=qq+c-4*hi;
  #pragma unroll
  for(int r=0;r<16;++r){const int dl=d0-((r&3)+8*(r>>2)); if(dl>128||dl<-128)p0[r]=NEG; if(dl-32>128||dl-32<-128)p1[r]=NEG;}
}

constexpr int NSLOT=3, SLOTB=8192;
constexpr int LDS_K=0, LDS_V=NSLOT*SLOTB, LDS_WS=2*NSLOT*SLOTB, LDS_OST=LDS_WS+NW*64*4, LDS_BYTES=LDS_OST+NW*4096;
constexpr float C2=0.125f*1.4426950408889634f;
__device__ __forceinline__ void glds16(const void*gsrc,unsigned lds_dst){unsigned keep;
  asm volatile("s_mov_b32 %0, m0\n\ts_mov_b32 m0, %2\n\ts_nop 0\n\tglobal_load_lds_dwordx4 %1, off\n\ts_mov_b32 m0, %0":"=&s"(keep):"v"(gsrc),"s"(lds_dst):"memory");}
__device__ __forceinline__ float max3f(float a,float b,float c){float r;asm("v_max3_f32 %0, %1, %2, %3":"=v"(r):"v"(a),"v"(b),"v"(c));return r;}
__device__ __forceinline__ float max2f(float a,float b){float r;asm("v_max_f32_e32 %0, %1, %2":"=v"(r):"v"(a),"v"(b));return r;}
__device__ __forceinline__ float fadd_s(float a,float b){float r;asm("v_add_f32_e32 %0, %1, %2":"=v"(r):"v"(a),"v"(b));return r;}
__device__ __forceinline__ float fsub_s(float a,float b){float r;asm("v_sub_f32_e32 %0, %1, %2":"=v"(r):"v"(a),"v"(b));return r;}
typedef float f32x2_t __attribute__((ext_vector_type(2))); typedef __bf16 bf16x2_t __attribute__((ext_vector_type(2)));
__device__ __forceinline__ unsigned cvtpk_s(float lo,float hi){f32x2_t v={lo,hi};bf16x2_t b=__builtin_convertvector(v,bf16x2_t);return __builtin_bit_cast(unsigned,b);}
#define WAIT_BAR(N) asm volatile("s_waitcnt vmcnt(" #N ") lgkmcnt(0)\n\ts_barrier":::"memory")

typedef __attribute__((address_space(3))) const char* lds_cptr;
__device__ __forceinline__ void qkt(f32x16&p0,f32x16&p1,lds_cptr Kslot,const bf16x8*qr,const f32x16&negm,int r32,int hi){
  const lds_cptr kb=Kslot+hi*1024+r32*16;
  #pragma unroll
  for(int d0=0;d0<4;++d0){
    const bf16x8 b0=*(const __attribute__((address_space(3))) bf16x8*)(kb+d0*2048);
    const bf16x8 b1=*(const __attribute__((address_space(3))) bf16x8*)(kb+d0*2048+512);
    if(d0==0){p0=__builtin_amdgcn_mfma_f32_32x32x16_bf16(b0,qr[0],negm,0,0,0);p1=__builtin_amdgcn_mfma_f32_32x32x16_bf16(b1,qr[0],negm,0,0,0);}
    else{p0=__builtin_amdgcn_mfma_f32_32x32x16_bf16(b0,qr[d0],p0,0,0,0);p1=__builtin_amdgcn_mfma_f32_32x32x16_bf16(b1,qr[d0],p1,0,0,0);}}
}
typedef short v4i16_t __attribute__((ext_vector_type(4)));
__device__ __forceinline__ void kload8(bf16x8*kf,lds_cptr kp){
  kf[0]=*(const __attribute__((address_space(3))) bf16x8*)(kp);      kf[1]=*(const __attribute__((address_space(3))) bf16x8*)(kp+512);
  kf[2]=*(const __attribute__((address_space(3))) bf16x8*)(kp+2048); kf[3]=*(const __attribute__((address_space(3))) bf16x8*)(kp+2560);
  kf[4]=*(const __attribute__((address_space(3))) bf16x8*)(kp+4096); kf[5]=*(const __attribute__((address_space(3))) bf16x8*)(kp+4608);
  kf[6]=*(const __attribute__((address_space(3))) bf16x8*)(kp+6144); kf[7]=*(const __attribute__((address_space(3))) bf16x8*)(kp+6656);
}
__device__ __forceinline__ void kload2(bf16x8*kf,lds_cptr kp,int j){ kf[2*j]=*(const __attribute__((address_space(3))) bf16x8*)(kp+j*2048); kf[2*j+1]=*(const __attribute__((address_space(3))) bf16x8*)(kp+j*2048+512); }
__device__ __forceinline__ s16x4 vtr(lds_cptr p){ return __builtin_bit_cast(s16x4,__builtin_amdgcn_ds_read_tr16_b64_v4i16((__attribute__((address_space(3))) v4i16_t*)p)); }
__device__ __forceinline__ float rowmax(const f32x16&p0,const f32x16&p1){
  float a=max3f(p0[0],p0[1],p1[0]),b=max3f(p0[2],p0[3],p1[1]);a=max3f(a,p1[2],p1[3]);
  #pragma unroll
  for(int r=4;r<16;r+=4){a=max3f(a,p0[r],p0[r+1]);b=max3f(b,p0[r+2],p0[r+3]);a=max3f(a,p1[r],p1[r+1]);b=max3f(b,p1[r+2],p1[r+3]);}
  const float m=max2f(a,b);
  auto rr=__builtin_amdgcn_permlane32_swap(__float_as_uint(m),__float_as_uint(m),false,false);
  return max2f(__uint_as_float(rr[0]),__uint_as_float(rr[1]));
}
__device__ __forceinline__ void pv(f32x16*o,int vb,bf16x8 pa0,bf16x8 pa1,bf16x8 pa2,bf16x8 pa3){
  #pragma unroll
  for(int d0=0;d0<2;++d0){s16x4 lo[4],hi[4];
    #pragma unroll
    for(int ks=0;ks<4;++ks){
      asm volatile("ds_read_b64_tr_b16 %0,%1 offset:%c2":"=&v"(lo[ks]):"v"(vb),"i"(d0*4096+ks*1024):"memory");
      asm volatile("ds_read_b64_tr_b16 %0,%1 offset:%c2":"=&v"(hi[ks]):"v"(vb),"i"(d0*4096+ks*1024+512):"memory");}
    asm volatile("s_waitcnt lgkmcnt(0)":::"memory");SBAR();
    #define PK(k) (bf16x8){lo[k][0],lo[k][1],lo[k][2],lo[k][3],hi[k][0],hi[k][1],hi[k][2],hi[k][3]}
    o[d0]=__builtin_amdgcn_mfma_f32_32x32x16_bf16(pa0,PK(0),o[d0],0,0,0);
    o[d0]=__builtin_amdgcn_mfma_f32_32x32x16_bf16(pa1,PK(1),o[d0],0,0,0);
    o[d0]=__builtin_amdgcn_mfma_f32_32x32x16_bf16(pa2,PK(2),o[d0],0,0,0);
    o[d0]=__builtin_amdgcn_mfma_f32_32x32x16_bf16(pa3,PK(3),o[d0],0,0,0);
    #undef PK
  }
}

#ifndef ATTN_STORE16
#define ATTN_STORE16(p,v) (*(u32x4*)(p)=(v))
#endif
template<int THRL> __device__ __forceinline__ void attn_unit(int b,int qb,int kvh,int hp,bool isctx,const bf16*P,bf16*O,float sink_l2_h0,float sink_l2_h1,LAS unsigned char*shm){
  const int tid=threadIdx.x,lane=tid&63,r32=lane&31,hi=lane>>5; const int wid=__builtin_amdgcn_readfirstlane(tid>>6);
  const int head=kvh*4+hp*2+(wid>>2), rbk=wid&3;
  const long qrow0=(isctx?(long)NL+b*CTXL:(long)b*SEQ)+qb*128+rbk*QBLK;
  const bf16*Qw=P+qrow0*INW+head*64;
  const int nfull=isctx?0:2, nmask=isctx?0:((qb==0||qb==SEQ/128-1)?2:4);
  auto trow=[&](int t)->long{ if(t<nfull) return (long)b*SEQ+qb*128+64*t; if(t<nfull+4) return (long)NL+b*CTXL+64*(t-nfull);
    const int i=t-nfull-4; const int tl=(qb==0)?4+i:((i<2)?i:i+2); return (long)b*SEQ+qb*128-128+64*tl; };
  auto tcw=[&](int t)->int{ if(t<nfull+4) return 1<<20; const int i=t-nfull-4; const int tl=(qb==0)?4+i:((i<2)?i:i+2); return 128-64*tl; };
  const unsigned lds0=(unsigned)(uintptr_t)shm;
  LAS float*wsf=(LAS float*)(shm+LDS_WS)+wid*64;
  const unsigned koff=(unsigned)(lane*INW+C_K+kvh*64+wid*8)*2u;
  const unsigned voff=(unsigned)((16*(wid&3)+(lane>>2))*INW+C_V+kvh*64+(wid>>2)*32+(lane&3)*8)*2u;
  const unsigned kdst=lds0+LDS_K+wid*1024, vdst=lds0+LDS_V+wid*1024;
  #define DMA_K(t,slot) pg8::glds16s(koff,(const char*)P+trow(t)*(long)(INW*2),(unsigned)__builtin_amdgcn_readfirstlane(kdst+(slot)))
  #define DMA_V(t,slot) pg8::glds16s(voff,(const char*)P+trow(t)*(long)(INW*2),(unsigned)__builtin_amdgcn_readfirstlane(vdst+(slot)))
  const int vb0=(int)(lds0+LDS_V)+((lane>>4)&1)*32+(lane&3)*8+(4*hi+((lane&15)>>2))*64;
  const lds_cptr Kbase=(lds_cptr)shm+LDS_K; bf16x8 kf[8];
  const lds_cptr shm3=(lds_cptr)shm; const lds_cptr kp0=shm3+LDS_K+hi*1024+r32*16; const lds_cptr vp0=shm3+LDS_V+((lane>>4)&1)*32+(lane&3)*8+(4*hi+((lane&15)>>2))*64;
  const int NT=nfull+4+nmask;
  DMA_K(0,0);DMA_V(0,0);DMA_K(1,SLOTB);
  bf16x8 qr[4];
  #pragma unroll
  for(int d0=0;d0<4;++d0)qr[d0]=*reinterpret_cast<const bf16x8*>(&Qw[(long)r32*INW+d0*16+hi*8]);
  float mhat=0.f,l_reg=0.f;f32x16 o[2];o[0]=f32x16{};o[1]=f32x16{};f32x16 negm=f32x16{};asm volatile("":"+v"(negm));
  const int qq=rbk*QBLK+r32;
  #define CMASK(P0,P1,t) do{ if((t)>=NT-4){ const int cw_=tcw(t); if(cw_!=(1<<20)) wmask(P0,P1,cw_,qq,hi); } }while(0)
  bool resc=false;
  #define START(P0,P1) do{ const float rm=rowmax(P0,P1); resc=false; \
    { const float dl=rm; mhat=fadd_s(mhat,dl); \
      _Pragma("unroll") for(int r=0;r<16;++r){P0[r]=fsub_s(P0[r],dl);P1[r]=fsub_s(P1[r],dl);} \
      _Pragma("unroll") for(int r=0;r<16;++r)negm[r]=-mhat; asm volatile("":"+v"(negm)); } \
    _Pragma("unroll") for(int r=0;r<16;++r)P0[r]=__builtin_amdgcn_exp2f(P0[r]); }while(0)
  #define RESC() do{ if(resc){ asm volatile("s_waitcnt lgkmcnt(0)":::"memory"); \
      _Pragma("unroll") for(int d_=0;d_<2;++d_) _Pragma("unroll") for(int r=0;r<16;++r)o[d_][r]*=wsf[crow(r,hi)]; } }while(0)
  f32x16 pA0,pA1,pB0,pB1;
  int sl_prev=0,sl_cur=0,sl_next=SLOTB;
  #define ROT() do{sl_prev=sl_cur;sl_cur=sl_next;sl_next=(sl_next==(NSLOT-1)*SLOTB)?0:sl_next+SLOTB;}while(0)
  DMA_K(2,2*SLOTB);
  WAIT_BAR(3);
  qkt(pA0,pA1,Kbase,qr,negm,r32,hi);asm volatile("s_nop 15\n\ts_nop 7":"+v"(pA0),"+v"(pA1));CMASK(pA0,pA1,0);
  START(pA0,pA1);
  _Pragma("unroll") for(int r=0;r<16;++r)pA1[r]=__builtin_amdgcn_exp2f(pA1[r]);
  WAIT_BAR(0);
  DMA_K(3,0);DMA_V(1,SLOTB);
  ROT();
  kload8(kf,kp0+sl_cur);
  WAIT_BAR(2);
  s16x4 vlo[8],vhi[8]; u32x4 pw0,pw1,pw2,pw3;
  #define PKW(P,B) cvtpk_s(P[B],P[B+1])
  #define PAF(k) __builtin_bit_cast(bf16x8,pw##k)
  #define VFR(i) (bf16x8){vlo[i][0],vlo[i][1],vlo[i][2],vlo[i][3],vhi[i][0],vhi[i][1],vhi[i][2],vhi[i][3]}
  #define PIN(x) asm volatile("":"+v"(x))
  #define MX3(a,b,c) __builtin_fmaxf(__builtin_fmaxf((a),(b)),(c))
  #define GAPA(MF,A0,A1,A2,A3,W0,W1,PW) do{ MF; sacc+=A0; sacc+=A1; sacc+=A2; sacc+=A3; PIN(sacc); W0; W1; PIN(PW); SBAR(); }while(0)
  #define EX(v) __builtin_amdgcn_exp2f(v)
  #define GAPB(MF,X,B) do{ MF; X[B]=EX(X[B]); X[B+1]=EX(X[B+1]); X[B+2]=EX(X[B+2]); X[B+3]=EX(X[B+3]); PIN(X); SBAR(); }while(0)
  #define VRD(i) do{ vlo[i]=vtr(vp_+(((i)>>2)*4096+((i)&3)*1024)); vhi[i]=vtr(vp_+(((i)>>2)*4096+((i)&3)*1024+512)); }while(0)
  #define KRD(G,j) do{ if(G){ kload2(kf,kp0+sl_next,j); SBAR(); } }while(0)
  #define STEP(C0,C1,P0,P1,t,GK,GV,GL) do{ SBAR(); \
    const lds_cptr vp_=vp0+sl_prev; \
    VRD(0); SBAR(); float sacc=(P0[0]+P0[1]); \
    GAPA(C0=__builtin_amdgcn_mfma_f32_32x32x16_bf16(kf[0],qr[0],negm,0,0,0), P0[2],P0[3],P0[4],P0[5],     pw0[0]=PKW(P0,0), pw0[1]=PKW(P0,2), pw0); \
    VRD(4); SBAR(); GAPA(C1=__builtin_amdgcn_mfma_f32_32x32x16_bf16(kf[1],qr[0],negm,0,0,0), P0[6],P0[7],P0[8],P0[9],     pw0[2]=PKW(P0,4), pw0[3]=PKW(P0,6), pw0); \
    VRD(1); SBAR(); GAPA(C0=__builtin_amdgcn_mfma_f32_32x32x16_bf16(kf[2],qr[1],C0,0,0,0),   P0[10],P0[11],P0[12],P0[13], pw1[0]=PKW(P0,8), pw1[1]=PKW(P0,10), pw1); \
    VRD(5); SBAR(); GAPA(C1=__builtin_amdgcn_mfma_f32_32x32x16_bf16(kf[3],qr[1],C1,0,0,0),   P0[14],P0[15],P1[0],P1[1],   pw1[2]=PKW(P0,12),pw1[3]=PKW(P0,14), pw1); \
    VRD(2); SBAR(); GAPA(C0=__builtin_amdgcn_mfma_f32_32x32x16_bf16(kf[4],qr[2],C0,0,0,0),   P1[2],P1[3],P1[4],P1[5],     pw2[0]=PKW(P1,0), pw2[1]=PKW(P1,2), pw2); \
    VRD(6); SBAR(); GAPA(C1=__builtin_amdgcn_mfma_f32_32x32x16_bf16(kf[5],qr[2],C1,0,0,0),   P1[6],P1[7],P1[8],P1[9],     pw2[2]=PKW(P1,4), pw2[3]=PKW(P1,6), pw2); \
    VRD(3); SBAR(); GAPA(C0=__builtin_amdgcn_mfma_f32_32x32x16_bf16(kf[6],qr[3],C0,0,0,0),   P1[10],P1[11],P1[12],P1[13], pw3[0]=PKW(P1,8), pw3[1]=PKW(P1,10), pw3); \
    VRD(7); SBAR(); GAPA(C1=__builtin_amdgcn_mfma_f32_32x32x16_bf16(kf[7],qr[3],C1,0,0,0),   P1[14],P1[15],0.f,0.f,       pw3[2]=PKW(P1,12),pw3[3]=PKW(P1,14), pw3); \
    l_reg+=sacc; \
    if(GK){DMA_K((t)+3,sl_cur);} if(GV){DMA_V((t)+1,sl_next);} \
    CMASK(C0,C1,t); \
    { float a=MX3(C0[0],C0[1],C1[0]),b=MX3(C0[2],C0[3],C1[1]); a=MX3(a,C1[2],C1[3]); \
      _Pragma("unroll") for(int r=4;r<16;r+=4){a=MX3(a,C0[r],C0[r+1]);b=MX3(b,C0[r+2],C0[r+3]);a=MX3(a,C1[r],C1[r+1]);b=MX3(b,C1[r+2],C1[r+3]);} \
      float rm=__builtin_fmaxf(a,b); { auto rr=__builtin_amdgcn_permlane32_swap(__float_as_uint(rm),__float_as_uint(rm),false,false); rm=__builtin_fmaxf(__uint_as_float(rr[0]),__uint_as_float(rr[1])); } \
      resc=false; \
      if(__builtin_expect(__any(rm>(float)THRL),0)){ const float dl=__builtin_fmaxf(rm,0.f); mhat+=dl; \
        _Pragma("unroll") for(int r=0;r<16;++r){C0[r]-=dl;C1[r]-=dl;} \
        _Pragma("unroll") for(int r=0;r<16;++r)negm[r]=-mhat; asm volatile("":"+v"(negm)); \
        const float f=__builtin_amdgcn_exp2f(-dl); l_reg*=f; if(hi==0)wsf[r32]=f; resc=true; } } \
    SBAR(); \
    GAPB(o[0]=__builtin_amdgcn_mfma_f32_32x32x16_bf16(PAF(0),VFR(0),o[0],0,0,0), C0,0); \
    GAPB(o[1]=__builtin_amdgcn_mfma_f32_32x32x16_bf16(PAF(0),VFR(4),o[1],0,0,0), C0,4); \
    KRD(GL,0); GAPB(o[0]=__builtin_amdgcn_mfma_f32_32x32x16_bf16(PAF(1),VFR(1),o[0],0,0,0), C0,8); \
    KRD(GL,1); GAPB(o[1]=__builtin_amdgcn_mfma_f32_32x32x16_bf16(PAF(1),VFR(5),o[1],0,0,0), C0,12); \
    KRD(GL,2); GAPB(o[0]=__builtin_amdgcn_mfma_f32_32x32x16_bf16(PAF(2),VFR(2),o[0],0,0,0), C1,0); \
    KRD(GL,3); GAPB(o[1]=__builtin_amdgcn_mfma_f32_32x32x16_bf16(PAF(2),VFR(6),o[1],0,0,0), C1,4); \
    GAPB(o[0]=__builtin_amdgcn_mfma_f32_32x32x16_bf16(PAF(3),VFR(3),o[0],0,0,0), C1,8); \
    GAPB(o[1]=__builtin_amdgcn_mfma_f32_32x32x16_bf16(PAF(3),VFR(7),o[1],0,0,0), C1,12); \
    }while(0)
  int t=1;
  #undef CMASK
  #define CMASK(P0,P1,t) do{}while(0)
  for(;t+5<NT;t+=2){
    STEP(pB0,pB1,pA0,pA1,t,true,true,true);     WAIT_BAR(2); RESC(); ROT();
    STEP(pA0,pA1,pB0,pB1,t+1,true,true,true);   WAIT_BAR(2); RESC(); ROT();
  }
  #undef CMASK
  #define CMASK(P0,P1,t) do{ if((t)>=NT-4){ const int cw_=tcw(t); if(cw_!=(1<<20)) wmask(P0,P1,cw_,qq,hi); } }while(0)
  #define ENDW(tt) do{ if((tt)+3<NT){WAIT_BAR(2);} else if((tt)+2<NT){WAIT_BAR(1);} else {WAIT_BAR(0);} }while(0)
  for(;t+1<NT;t+=2){
    STEP(pB0,pB1,pA0,pA1,t,(t+3<NT),(t+1<NT),(t+1<NT));       ENDW(t);   RESC(); ROT();
    STEP(pA0,pA1,pB0,pB1,t+1,(t+4<NT),(t+2<NT),(t+2<NT));     ENDW(t+1); RESC(); ROT();
  }
  STEP(pB0,pB1,pA0,pA1,NT-1,false,false,false); RESC();
  { float sacc=pB0[0]+pB0[1]; _Pragma("unroll") for(int r=2;r<16;++r)sacc+=pB0[r]; _Pragma("unroll") for(int r=0;r<16;++r)sacc+=pB1[r]; l_reg+=sacc;
    pw0=(u32x4){PKW(pB0,0),PKW(pB0,2),PKW(pB0,4),PKW(pB0,6)};pw1=(u32x4){PKW(pB0,8),PKW(pB0,10),PKW(pB0,12),PKW(pB0,14)};pw2=(u32x4){PKW(pB1,0),PKW(pB1,2),PKW(pB1,4),PKW(pB1,6)};pw3=(u32x4){PKW(pB1,8),PKW(pB1,10),PKW(pB1,12),PKW(pB1,14)};
    SBAR(); pv(o,vb0+sl_cur,PAF(0),PAF(1),PAF(2),PAF(3)); }
  #undef PKW
  #undef PAF
  #undef VFR
  #undef PIN
  #undef MX3
  #undef GAPA
  #undef GAPB
  #undef EX
  #undef VRD
  #undef KRD
  #undef STEP
  #undef ENDW
  {auto rr=__builtin_amdgcn_permlane32_swap(__float_as_uint(l_reg),__float_as_uint(l_reg),false,false);l_reg=__uint_as_float(rr[0])+__uint_as_float(rr[1]);}
  l_reg+=__builtin_amdgcn_exp2f(((wid>>2)?sink_l2_h1:sink_l2_h0)-mhat);
  if(hi==0)wsf[32+r32]=l_reg;asm volatile("s_waitcnt lgkmcnt(0)":::"memory");
  float rli[16];
  #pragma unroll
  for(int r=0;r<16;++r)rli[r]=__builtin_amdgcn_rcpf(wsf[32+crow(r,hi)]);
  bf16*Ow=O+qrow0*(long)D+head*64;
  { LAS bf16*stg=(LAS bf16*)(shm+LDS_OST)+wid*2048;
    #pragma unroll
    for(int r=0;r<16;++r){const int orow=crow(r,hi);
      #pragma unroll
      for(int d0=0;d0<2;++d0)stg[orow*64+d0*32+r32]=(bf16)(cvtpk_s(o[d0][r]*rli[r],0.f)&0xffffu);}
    asm volatile("s_waitcnt lgkmcnt(0)":::"memory");
    #pragma unroll
    for(int i=0;i<4;++i){const int row=i*8+(lane>>3),ch=lane&7; const u32x4 v=*(const LAS u32x4*)(stg+row*64+ch*8); ATTN_STORE16(Ow+(long)row*D+ch*8,v);} }
  asm volatile("s_waitcnt lgkmcnt(0)\n\ts_barrier":::"memory");
  #undef DMA_K
  #undef DMA_V
  #undef CMASK
  #undef START
  #undef RESC
  #undef ROT
}
constexpr int ATTN_LDS_BYTES=LDS_BYTES;
#undef SBAR
#undef WAIT_BAR
}

__device__ __forceinline__ void p_attn2(Frame& F, int layer) {
    const int vcu = (blockIdx.x % 8) * (F.G / 8) + blockIdx.x / 8;
    const bf16* P = WSP(bf16, WS_PROJ); bf16* O = WSP(bf16, WS_MIX);
    for (int u = vcu * 4; u < 1024; u += 4 * F.G)
        for (int k = 0; k < (((REP_MASK) >> 3) & 1 ? 8 : 4); ++k) { const int uu = u + (k & 3), b = uu >> 7, qb = (uu >> 2) & 31, kvh = (uu >> 1) & 1, hp = uu & 1;
            att2::attn_unit<8>(b, qb, kvh, hp, false, P, O, F.sink[layer * 8 + kvh * 4 + hp * 2] * LOG2E, F.sink[layer * 8 + kvh * 4 + hp * 2 + 1] * LOG2E, F.lds); }
    if (layer == 0) for (int v = blockIdx.x; v < 64; v += F.G) { const int b = v >> 3, qb = (v >> 2) & 1, kvh = (v >> 1) & 1, hp = v & 1;
        att2::attn_unit<8>(b, qb, kvh, hp, true, P, O, F.sink[kvh * 4 + hp * 2] * LOG2E, F.sink[kvh * 4 + hp * 2 + 1] * LOG2E, F.lds); }
}
#ifndef ATT2
#define ATT2 1
#endif
#if ATT2
#define P_ATTN p_attn2
#else
#define P_ATTN p_attn
#endif
namespace mixb {
using att::bf16x8; using att::s16x4; using att::f32x16; using att::u32x4; using att::lds_cptr; using att::vtr; using att::crow; using att::cvtpk;
__device__ __forceinline__ bf16x8 tr_pair(lds_cptr p, int second_off) { const s16x4 lo = vtr(p), hh = vtr(p + second_off); return (bf16x8){lo[0], lo[1], lo[2], lo[3], hh[0], hh[1], hh[2], hh[3]}; }
__device__ __forceinline__ void unpack8(const v4u w, float (&f)[8]) { f[0] = bflo(w.x); f[1] = bfhi(w.x); f[2] = bflo(w.y); f[3] = bfhi(w.y); f[4] = bflo(w.z); f[5] = bfhi(w.z); f[6] = bflo(w.w); f[7] = bfhi(w.w); }
__device__ __forceinline__ v4u pack8(const float (&f)[8]) { v4u w; w.x = pk2(f[0], f[1]); w.y = pk2(f[2], f[3]); w.z = pk2(f[4], f[5]); w.w = pk2(f[6], f[7]); return w; }
__device__ __forceinline__ float half_sum(float v) {
#pragma unroll
    for (int o = 1; o < 32; o <<= 1) v += __shfl_xor(v, o);
    return v;
}
__device__ __forceinline__ void kv_unit(Frame& F, int layer, int b, int cid, int hp) {
    const int tid = opq((int)threadIdx.x), lane = tid & 63, r32 = lane & 31, hi = lane >> 5; const int wid = __builtin_amdgcn_readfirstlane(tid >> 6);
    const bf16* P = WSP(bf16, WS_PROJ); const int row0 = chunk_row0(b, cid);
    __syncthreads();
#pragma unroll
    for (int it = 0; it < 2; ++it) { const int idx = tid + it * NTHR, hs = idx >> 9, t = (idx >> 2) & 127, c = idx & 3, h = 2 * hp + hs;
        const v4u w = *(const v4u*)(P + (size_t)(row0 + t) * INW + C_RK + h * 32 + c * 8); float f[8], a[8], bb[8]; unpack8(w, f);
        const float wf = __expf(F.lgf[layer * 4 + h] * (float)(127 - t)), wb = __expf(F.lgb[layer * 4 + h] * (float)t);
#pragma unroll
        for (int j = 0; j < 8; ++j) { a[j] = f[j] * wf; bb[j] = f[j] * wb; }
        LAS unsigned char* d = F.lds + hs * 32768 + t * 64 + c * 16; *(LAS v4u*)d = pack8(a); *(LAS v4u*)(d + 8192) = pack8(bb); }
#pragma unroll
    for (int it = 0; it < 4; ++it) { const int idx = tid + it * NTHR, hs = idx >> 10, t = (idx >> 3) & 127, c = idx & 7, h = 2 * hp + hs;
        *(LAS v4u*)(F.lds + hs * 32768 + 16384 + (c >> 2) * 8192 + t * 64 + (c & 3) * 16) = *(const v4u*)(P + (size_t)(row0 + t) * INW + C_RV + h * 64 + c * 8); }
    __syncthreads();
    const int hs = wid >> 2, h = 2 * hp + hs, dir = (wid >> 1) & 1, eh = wid & 1;
    const int natoff = (8 * hi + ((lane & 15) >> 2)) * 64 + ((lane >> 4) & 1) * 32 + (lane & 3) * 8;
    const lds_cptr ab = (lds_cptr)F.lds + hs * 32768 + dir * 8192 + natoff, bb = (lds_cptr)F.lds + hs * 32768 + 16384 + eh * 8192 + natoff;
    f32x16 acc = f32x16{};
#pragma unroll
    for (int ks = 0; ks < 8; ++ks) acc = __builtin_amdgcn_mfma_f32_32x32x16_bf16(tr_pair(ab + ks * 1024, 256), tr_pair(bb + ks * 1024, 256), acc, 0, 0, 0);
    float* dst = WSP(float, WS_KVS) + ((size_t)((dir * 8 + b) * 4 + h) * NCHK + cid) * 2048 + 32 * eh + r32;
#pragma unroll
#if SCAN_FUSE
    for (int r = 0; r < 16; ++r) __hip_atomic_store(dst + crow(r, hi) * 64, acc[r], __ATOMIC_RELAXED, __HIP_MEMORY_SCOPE_AGENT);
#else
    for (int r = 0; r < 16; ++r) dst[crow(r, hi) * 64] = acc[r];
#endif
}
__device__ __forceinline__ void ret_unit(Frame& F, int layer, int b, int cid, int hp) {
    const int tid = opq((int)threadIdx.x), lane = tid & 63, r32 = lane & 31, hi = lane >> 5; const int wid = __builtin_amdgcn_readfirstlane(tid >> 6);
    const bf16* P = WSP(bf16, WS_PROJ); const int row0 = chunk_row0(b, cid);
    constexpr int HB = 40960;
    v4u qraw[2], rgraw[4];
    { const int hs_ = wid >> 2, h_ = 2 * hp + hs_, qb_ = wid & 3;
#pragma unroll
      for (int ks = 0; ks < 2; ++ks) qraw[ks] = *(const v4u*)(P + (size_t)(row0 + 32 * qb_ + r32) * INW + C_RQ + h_ * 32 + 16 * ks + 8 * hi);
#pragma unroll
      for (int k = 0; k < 4; ++k) rgraw[k] = *(const v4u*)(P + (size_t)(row0 + 32 * qb_ + k * 8 + (lane >> 3)) * INW + C_RG + h_ * 64 + (lane & 7) * 8); }
    __syncthreads();
#pragma unroll
    for (int it = 0; it < 2; ++it) { const int idx = tid + it * NTHR, hs = idx >> 9, t = (idx >> 2) & 127, c = idx & 3, h = 2 * hp + hs;
        const v4u w = *(const v4u*)(P + (size_t)(row0 + t) * INW + C_RK + h * 32 + c * 8); float f[8], a[8], bb[8]; unpack8(w, f);
        const float sf = __expf(-F.lgf[layer * 4 + h] * (float)t), sb = __expf(F.lgb[layer * 4 + h] * (float)t);
#pragma unroll
        for (int j = 0; j < 8; ++j) { a[j] = f[j] * sf; bb[j] = f[j] * sb; }
        LAS unsigned char* d = F.lds + hs * HB + c * 2048 + t * 16; *(LAS v4u*)d = pack8(a); *(LAS v4u*)(d + 8192) = pack8(bb); }
#pragma unroll
    for (int it = 0; it < 4; ++it) { const int idx = tid + it * NTHR, hs = idx >> 10, t = (idx >> 3) & 127, c = idx & 7, h = 2 * hp + hs;
        *(LAS v4u*)(F.lds + hs * HB + 16384 + (c >> 2) * 8192 + t * 64 + (c & 3) * 16) = *(const v4u*)(P + (size_t)(row0 + t) * INW + C_RV + h * 64 + c * 8); }
#pragma unroll
    for (int it = 0; it < 4; ++it) { const int idx = tid + it * NTHR, hs = idx >> 10, dir = (idx >> 9) & 1, d = (idx >> 4) & 31, e4 = idx & 15, h = 2 * hp + hs;
        const f32x4 v = *(const f32x4*)(WSP(float, WS_KVS) + ((size_t)((dir * 8 + b) * 4 + h) * NCHK + cid) * 2048 + d * 64 + e4 * 4);
        const float fac = dir ? __expf(F.lgb[layer * 4 + h] * 128.0f) : __expf(F.lgf[layer * 4 + h]);
        v2u w; w.x = pk2(v[0] * fac, v[1] * fac); w.y = pk2(v[2] * fac, v[3] * fac);
        *(LAS v2u*)(F.lds + hs * HB + 32768 + dir * 4096 + (e4 >> 3) * 2048 + d * 64 + (e4 & 7) * 8) = w; }
    __syncthreads();
    const int hs = wid >> 2, h = 2 * hp + hs, qb = wid & 3, n = 32 * qb + r32;
    const lds_cptr hb = (lds_cptr)F.lds + hs * HB;
    bf16x8 qf[2], qbk[2];
    { const float sf = __expf(F.lgf[layer * 4 + h] * (float)n), sb = __expf(-F.lgb[layer * 4 + h] * (float)n);
#pragma unroll
      for (int ks = 0; ks < 2; ++ks) { float f[8], a[8], bb[8]; unpack8(qraw[ks], f);
#pragma unroll
          for (int j = 0; j < 8; ++j) { a[j] = f[j] * sf; bb[j] = f[j] * sb; }
          qf[ks] = __builtin_bit_cast(bf16x8, pack8(a)); qbk[ks] = __builtin_bit_cast(bf16x8, pack8(bb)); } }
    const int qoff = ((lane & 15) >> 2) * 64 + ((lane >> 4) & 1) * 32 + (lane & 3) * 8;
    const int natoff = 8 * hi * 64 + qoff, permoff = 4 * hi * 64 + qoff;
    f32x16 o[2]; o[0] = f32x16{}; o[1] = f32x16{};
#pragma unroll
    for (int eh = 0; eh < 2; ++eh)
#pragma unroll
        for (int ks = 0; ks < 2; ++ks) {
            o[eh] = __builtin_amdgcn_mfma_f32_32x32x16_bf16(qf[ks], tr_pair(hb + 32768 + eh * 2048 + ks * 1024 + natoff, 256), o[eh], 0, 0, 0);
            o[eh] = __builtin_amdgcn_mfma_f32_32x32x16_bf16(qbk[ks], tr_pair(hb + 36864 + eh * 2048 + ks * 1024 + natoff, 256), o[eh], 0, 0, 0); }
#pragma unroll
    for (int kb = 0; kb < 4; ++kb) {
        f32x16 x = f32x16{};
        if (kb <= qb) { f32x16 xf = f32x16{};
#pragma unroll
            for (int ks = 0; ks < 2; ++ks) xf = __builtin_amdgcn_mfma_f32_32x32x16_bf16(*(const __attribute__((address_space(3))) bf16x8*)(hb + (2 * ks + hi) * 2048 + (32 * kb + r32) * 16), qf[ks], xf, 0, 0, 0);
            if (kb == qb) {
#pragma unroll
                for (int r = 0; r < 16; ++r) xf[r] = crow(r, hi) <= r32 ? xf[r] : 0.f; }
            x = xf; }
        if (kb >= qb) { f32x16 xb = f32x16{};
#pragma unroll
            for (int ks = 0; ks < 2; ++ks) xb = __builtin_amdgcn_mfma_f32_32x32x16_bf16(*(const __attribute__((address_space(3))) bf16x8*)(hb + 8192 + (2 * ks + hi) * 2048 + (32 * kb + r32) * 16), qbk[ks], xb, 0, 0, 0);
            if (kb == qb) {
#pragma unroll
                for (int r = 0; r < 16; ++r) xb[r] = crow(r, hi) >= r32 ? xb[r] : 0.f; }
            x = x + xb; }
        u32x4 pw[2];
#pragma unroll
        for (int k = 0; k < 4; ++k) { pw[0][k] = cvtpk(x[2 * k], x[2 * k + 1]); pw[1][k] = cvtpk(x[8 + 2 * k], x[9 + 2 * k]); }
#pragma unroll
        for (int eh = 0; eh < 2; ++eh)
#pragma unroll
            for (int k2 = 0; k2 < 2; ++k2) o[eh] = __builtin_amdgcn_mfma_f32_32x32x16_bf16(__builtin_bit_cast(bf16x8, pw[k2]), tr_pair(hb + 16384 + eh * 8192 + (32 * kb + 16 * k2) * 64 + permoff, 512), o[eh], 0, 0, 0);
    }
    LAS float* stg = (LAS float*)(F.lds + 2 * HB) + wid * 2048;
#pragma unroll
    for (int r = 0; r < 16; ++r) { stg[crow(r, hi) * 64 + r32] = o[0][r]; stg[crow(r, hi) * 64 + 32 + r32] = o[1][r]; }
    asm volatile("s_waitcnt lgkmcnt(0)" ::: "memory");
#pragma unroll
    for (int k = 0; k < 4; ++k) { const int row = k * 8 + (lane >> 3), ch = lane & 7; const size_t grow = (size_t)(row0 + 32 * qb + row);
        const f32x4 v0 = *(const LAS f32x4*)(stg + row * 64 + ch * 8), v1 = *(const LAS f32x4*)(stg + row * 64 + ch * 8 + 4);
        float s = (v0[0] + v0[1]) + (v0[2] + v0[3]) + (v1[0] + v1[1]) + (v1[2] + v1[3]);
        s += __shfl_xor(s, 1); s += __shfl_xor(s, 2); s += __shfl_xor(s, 4);
        const float mean = s * (1.0f / 64.0f); const f32x4 d0 = v0 - mean, d1 = v1 - mean;
        float q = (d0[0] * d0[0] + d0[1] * d0[1]) + (d0[2] * d0[2] + d0[3] * d0[3]) + (d1[0] * d1[0] + d1[1] * d1[1]) + (d1[2] * d1[2] + d1[3] * d1[3]);
        q += __shfl_xor(q, 1); q += __shfl_xor(q, 2); q += __shfl_xor(q, 4);
        const float rstd = 1.0f / sqrtf(q * (1.0f / 64.0f) + LN_EPS);
        float rg[8], y[8]; unpack8(rgraw[k], rg);
#pragma unroll
        for (int j = 0; j < 8; ++j) y[j] = rg[j] * __builtin_amdgcn_rcpf(1.0f + __builtin_amdgcn_exp2f(-LOG2E * rg[j])) * ((j < 4 ? d0[j] : d1[j - 4]) * rstd);
        *(v4u*)(WSP(bf16, WS_MIX) + grow * D + 768 + h * 64 + ch * 8) = pack8(y); }
}
__device__ __forceinline__ void pool_unit(Frame& F, int layer, int s, int blk) {
    const int tid = opq((int)threadIdx.x), lane = tid & 63, r32 = lane & 31, hi = lane >> 5; const int wid = __builtin_amdgcn_readfirstlane(tid >> 6);
    const bool isctx = s >= 8; const int b = s & 7, len = isctx ? CTXL : SEQ, row0 = isctx ? NL + b * CTXL : b * SEQ, t0 = blk * 128;
    const bf16* P = WSP(bf16, WS_PROJ);
    constexpr int UST = 528, PWB = 144 * UST, PST = 144;
    __syncthreads();
#pragma unroll
    for (int it = 0; it < 9; ++it) { const int idx = tid + it * NTHR, rr = idx >> 5, c = idx & 31, t = t0 - 8 + rr; v4u w = (v4u){0u, 0u, 0u, 0u};
        if (t >= 0 && t < len) w = *(const v4u*)(P + (size_t)(row0 + t) * INW + C_U + c * 8);
        *(LAS v4u*)(F.lds + rr * UST + c * 16) = w; }
    for (int idx = tid; idx < 16384; idx += NTHR) { const int g = idx >> 12, c = (idx >> 6) & 63, d = idx & 63;
        *(LAS bf16*)(F.lds + PWB + (g * 64 + d) * PST + c * 2) = (bf16)(pk2(F.pool_w[(size_t)layer * 16384 + idx], 0.f) & 0xffffu); }
    __syncthreads();
    const int rbk = wid & 3, ch = wid >> 2, t = 32 * rbk + r32, tt = t0 + t;
    const lds_cptr ub = (lds_cptr)F.lds + (t + 8) * UST + hi * 16;
    bf16* dstrow = WSP(bf16, WS_MIX) + (size_t)(row0 + tt) * D + 512 + 32 * ch + 4 * hi;
#pragma unroll
    for (int g = 0; g < 4; ++g) { const int hw = 1 << g; const float inv = 1.0f / (float)(min(tt + hw, len) - max(tt - hw, 0));
        f32x16 acc = f32x16{};
#pragma unroll
        for (int ks = 0; ks < 4; ++ks) { const lds_cptr up = ub + g * 128 + ks * 32; float sum[8], own[8];
#pragma unroll
            for (int j = 0; j < 8; ++j) sum[j] = 0.f;
#pragma unroll
            for (int dt = -hw; dt < hw; ++dt) { float f[8]; unpack8(*(const __attribute__((address_space(3))) v4u*)(up + dt * UST), f);
#pragma unroll
                for (int j = 0; j < 8; ++j) sum[j] += f[j]; }
            unpack8(*(const __attribute__((address_space(3))) v4u*)up, own);
#pragma unroll
            for (int j = 0; j < 8; ++j) sum[j] = sum[j] * inv - own[j];
            const bf16x8 df = __builtin_bit_cast(bf16x8, pack8(sum));
            const bf16x8 wf = *(const __attribute__((address_space(3))) bf16x8*)((lds_cptr)F.lds + PWB + (g * 64 + 32 * ch + r32) * PST + (16 * ks + 8 * hi) * 2);
            acc = __builtin_amdgcn_mfma_f32_32x32x16_bf16(wf, df, acc, 0, 0, 0); }
        const float* ps = F.pool_scale + layer * 256 + g * 64 + 32 * ch + 4 * hi;
#pragma unroll
        for (int rq = 0; rq < 4; ++rq) { const f32x4 sc = *(const f32x4*)(ps + 8 * rq); v2u w; w.x = pk2(acc[4 * rq] * sc[0], acc[4 * rq + 1] * sc[1]); w.y = pk2(acc[4 * rq + 2] * sc[2], acc[4 * rq + 3] * sc[3]);
            *(v2u*)(dstrow + g * 64 + 8 * rq) = w; }
    }
}
}
__device__ __forceinline__ void p_scan(Frame& F, int layer);
#if SCAN_FUSE
__device__ __forceinline__ void p_mix(Frame& F, int layer) {
    unsigned* cnt = WSP(unsigned, WS_CTL) + CW_SCAN + 16 * layer;
    for (int u = (blockIdx.x + F.G - 128) % F.G; u < 8 * NCHK * 2; u += F.G) mixb::kv_unit(F, layer, u / (NCHK * 2), (u >> 1) % NCHK, u & 1);
    __syncthreads();
    if (threadIdx.x == 0) __hip_atomic_fetch_add(cnt, 1u, __ATOMIC_RELAXED, __HIP_MEMORY_SCOPE_AGENT);
    P_ATTN(F, layer);
    const int n_pool = 256 + (layer == 0 ? 16 : 0);
    for (int u = (blockIdx.x + F.G - 64) % F.G; u < n_pool; u += F.G) { if (u < 256) mixb::pool_unit(F, layer, u >> 5, u & 31); else mixb::pool_unit(F, layer, 8 + ((u - 256) >> 1), (u - 256) & 1); }
    __syncthreads();
    if (threadIdx.x == 0) { unsigned sp = 0; while (__hip_atomic_load(cnt, __ATOMIC_RELAXED, __HIP_MEMORY_SCOPE_AGENT) < (unsigned)F.G) { __builtin_amdgcn_s_sleep(2); if (++sp > (1u << 24)) break; } }
    __syncthreads();
    p_scan(F, layer);
    __syncthreads();
}
#else
__device__ __forceinline__ void p_mix(Frame& F, int layer) {
#if !ATTN_LATE
    P_ATTN(F, layer);
#endif
    const int n_pool = 256 + (layer == 0 ? 16 : 0);
    REPEAT(4) for (int u = (blockIdx.x + F.G - 64) % F.G; u < n_pool; u += F.G) { if (u < 256) mixb::pool_unit(F, layer, u >> 5, u & 31); else mixb::pool_unit(F, layer, 8 + ((u - 256) >> 1), (u - 256) & 1); }
    REPEAT(7) for (int u = (blockIdx.x + F.G - 128) % F.G; u < 8 * NCHK * 2; u += F.G) mixb::kv_unit(F, layer, u / (NCHK * 2), (u >> 1) % NCHK, u & 1);
    __syncthreads();
}
#endif
__device__ __forceinline__ void p_ret(Frame& F, int layer) {
    if (layer == 0) { for (int u = blockIdx.x; u < 8 * NCHK * 2; u += F.G) mixb::ret_unit(F, layer, u / (NCHK * 2), (u >> 1) % NCHK, u & 1);
        if (CONV_SPREAD != 0 && (TAILQ & 1) != 0 && F.G == 256) { __syncthreads(); bg_convert(F, 32, 224, CV_A, CV_B); } }
    else { for (int u = blockIdx.x; u < 8 * 32 * 2; u += F.G) mixb::ret_unit(F, layer, u >> 6, 2 + ((u >> 1) & 31), u & 1); }
    __syncthreads();
#if ATTN_LATE
    P_ATTN(F, layer);
    __syncthreads();
#endif
}
#if defined(MIX_CHECK)
__device__ __forceinline__ void chk(Frame& F, float a, float ref, float abs_t, float rel_t, int word) { const float d = fabsf(a - ref); if (!(d <= abs_t + rel_t * fabsf(ref))) atomicOr(WSP(unsigned, WS_CTL) + word, 1u); }
#endif
__device__ __forceinline__ void attn_naive_unit(Frame& F, int layer, int b, int qb, int kvh, bool isctx) {
    const int tid = opq((int)threadIdx.x), qq = tid & 127, g = tid >> 7, head = kvh * 4 + g;
    const bf16* P = WSP(bf16, WS_PROJ);
    const int qrow = isctx ? NL + b * CTXL + qb * 128 + qq : b * SEQ + qb * 128 + qq;
    LAS unsigned* kt = (LAS unsigned*)F.lds;
    LAS unsigned* vt = kt + 64 * 32;
    unsigned q[32];
#pragma unroll
    for (int i = 0; i < 8; ++i) { const v4u w = *(const v4u*)(P + (size_t)qrow * INW + head * 64 + i * 8); q[4 * i] = w.x; q[4 * i + 1] = w.y; q[4 * i + 2] = w.z; q[4 * i + 3] = w.w; }
    float m = F.sink[layer * 8 + head] * LOG2E, l = 1.0f, o[64];
#pragma unroll
    for (int d = 0; d < 64; ++d) o[d] = 0.f;
    const int qpos = qb * 128 + qq;
    for (int tile = isctx ? 6 : 0; tile < 10; ++tile) {
        int krow0, kpos0 = 0; const bool local = tile < 6;
        if (local) { kpos0 = qb * 128 - 128 + 64 * tile; if (kpos0 < 0 || kpos0 >= SEQ) continue; krow0 = b * SEQ + kpos0; }
        else krow0 = NL + b * CTXL + 64 * (tile - 6);
        __syncthreads();
        { const int r = tid >> 3, ch = tid & 7; const bf16* src = P + (size_t)(krow0 + r) * INW + kvh * 64 + ch * 8;
          *(LAS v4u*)(kt + r * 32 + ch * 4) = *(const v4u*)(src + C_K); *(LAS v4u*)(vt + r * 32 + ch * 4) = *(const v4u*)(src + C_V); }
        __syncthreads();
        for (int j = 0; j < 64; ++j) {
            float s = 0.f;
#pragma unroll
            for (int i = 0; i < 32; ++i) s = dot2bf(q[i], kt[j * 32 + i], s);
            const int dlt = qpos - (kpos0 + j); const bool valid = !local || (dlt <= 128 && dlt >= -128);
            if (valid) {
                if (s > m) { const float f = __builtin_amdgcn_exp2f(m - s); l *= f;
#pragma unroll
                    for (int d = 0; d < 64; ++d) o[d] *= f;
                    m = s; }
                const float p = __builtin_amdgcn_exp2f(s - m); l += p;
#pragma unroll
                for (int i = 0; i < 32; ++i) { const unsigned w = vt[j * 32 + i]; o[2 * i] += p * bflo(w); o[2 * i + 1] += p * bfhi(w); }
            }
        }
    }
    const float rl = 1.0f / l;
    bf16* dst = WSP(bf16, WS_MIX) + (size_t)qrow * D + head * 64;
#if defined(ATTN_CHECK)
    { bool bad = false;
#pragma unroll
      for (int i = 0; i < 8; ++i) { const v4u w = *(const v4u*)(dst + 8 * i); const float r8[8] = {bflo(w.x), bfhi(w.x), bflo(w.y), bfhi(w.y), bflo(w.z), bfhi(w.z), bflo(w.w), bfhi(w.w)};
#pragma unroll
          for (int k = 0; k < 8; ++k) { const float a = o[8 * i + k] * rl, d = fabsf(a - r8[k]); if (!(d <= ATTN_CHECK_ABS + ATTN_CHECK_REL * fabsf(a))) bad = true; } }
      if (bad) atomicOr(WSP(unsigned, WS_CTL) + 8, 1u); }
#endif
#pragma unroll
    for (int i = 0; i < 8; ++i) { v4u w; w.x = pk2(o[8 * i] * rl, o[8 * i + 1] * rl); w.y = pk2(o[8 * i + 2] * rl, o[8 * i + 3] * rl); w.z = pk2(o[8 * i + 4] * rl, o[8 * i + 5] * rl); w.w = pk2(o[8 * i + 6] * rl, o[8 * i + 7] * rl); *(v4u*)(dst + 8 * i) = w; }
    __syncthreads();
}
__device__ __forceinline__ void pool_naive_unit(Frame& F, int layer, int s, int blk) {
    const int tid = opq((int)threadIdx.x); const bool isctx = s >= 8; const int b = s & 7, len = isctx ? CTXL : SEQ, row0 = isctx ? NL + b * CTXL : b * SEQ, t0 = blk * 128;
    const bf16* P = WSP(bf16, WS_PROJ);
    LAS float* ub = (LAS float*)F.lds;
    LAS float* pwb = ub + 144 * 64;
    LAS float* db = pwb + 64 * 64;
    for (int g = 0; g < 4; ++g) { const int hw = 1 << g;
        __syncthreads();
        for (int idx = tid; idx < 144 * 8; idx += NTHR) { const int rr = idx >> 3, ch = idx & 7, t = t0 - 8 + rr; v4u w = (v4u){0u, 0u, 0u, 0u};
            if (t >= 0 && t < len) w = *(const v4u*)(P + (size_t)(row0 + t) * INW + C_U + g * 64 + ch * 8);
            LAS float* d = ub + rr * 64 + ch * 8; d[0] = bflo(w.x); d[1] = bfhi(w.x); d[2] = bflo(w.y); d[3] = bfhi(w.y); d[4] = bflo(w.z); d[5] = bfhi(w.z); d[6] = bflo(w.w); d[7] = bfhi(w.w); }
        for (int idx = tid; idx < 4096; idx += NTHR) pwb[idx] = F.pool_w[(size_t)(layer * 4 + g) * 4096 + idx];
        __syncthreads();
        for (int idx = tid; idx < 8192; idx += NTHR) { const int t = idx >> 6, c = idx & 63, tt = t0 + t; const int lo = max(tt - hw, 0), hi = min(tt + hw, len); float sum = 0.f;
            for (int p = lo; p < hi; ++p) sum += ub[(p - t0 + 8) * 64 + c];
            db[t * 65 + c] = sum / (float)(hi - lo) - ub[(t + 8) * 64 + c]; }
        __syncthreads();
        const int t = tid & 127, dq = tid >> 7; float acc[16];
#pragma unroll
        for (int i = 0; i < 16; ++i) acc[i] = 0.f;
        for (int c = 0; c < 64; ++c) { const float xv = db[t * 65 + c];
#pragma unroll
            for (int i = 0; i < 16; ++i) acc[i] += xv * pwb[c * 64 + dq * 16 + i]; }
        const float* ps = F.pool_scale + layer * 256 + g * 64 + dq * 16;
        bf16* dst = WSP(bf16, WS_MIX) + (size_t)(row0 + t0 + t) * D + 512 + g * 64 + dq * 16;
#if defined(MIX_CHECK)
#pragma unroll
        for (int i = 0; i < 2; ++i) { const v4u w = *(const v4u*)(dst + 8 * i); const float r8[8] = {bflo(w.x), bfhi(w.x), bflo(w.y), bfhi(w.y), bflo(w.z), bfhi(w.z), bflo(w.w), bfhi(w.w)};
#pragma unroll
            for (int k = 0; k < 8; ++k) chk(F, r8[k], acc[8 * i + k] * ps[8 * i + k], 0.02f, 0.03f, 9); }
#endif
#pragma unroll
        for (int i = 0; i < 2; ++i) { v4u w; w.x = pk2(acc[8 * i] * ps[8 * i], acc[8 * i + 1] * ps[8 * i + 1]); w.y = pk2(acc[8 * i + 2] * ps[8 * i + 2], acc[8 * i + 3] * ps[8 * i + 3]);
            w.z = pk2(acc[8 * i + 4] * ps[8 * i + 4], acc[8 * i + 5] * ps[8 * i + 5]); w.w = pk2(acc[8 * i + 6] * ps[8 * i + 6], acc[8 * i + 7] * ps[8 * i + 7]); *(v4u*)(dst + 8 * i) = w; }
    }
    __syncthreads();
}
__device__ __forceinline__ void kv_naive_unit(Frame& F, int layer, int b, int h, int cid) {
    const int tid = opq((int)threadIdx.x); const bf16* P = WSP(bf16, WS_PROJ); const int row0 = chunk_row0(b, cid);
    LAS float* kf = (LAS float*)F.lds;
    LAS float* vf = kf + 128 * 32;
    LAS float* wf = vf + 128 * 64;
    const float lgf = F.lgf[layer * 4 + h], lgb = F.lgb[layer * 4 + h];
    __syncthreads();
    { const int r = tid >> 2, ch = tid & 3; const v4u w = *(const v4u*)(P + (size_t)(row0 + r) * INW + C_RK + h * 32 + ch * 8); LAS float* d = kf + r * 32 + ch * 8;
      d[0] = bflo(w.x); d[1] = bfhi(w.x); d[2] = bflo(w.y); d[3] = bfhi(w.y); d[4] = bflo(w.z); d[5] = bfhi(w.z); d[6] = bflo(w.w); d[7] = bfhi(w.w); }
    for (int idx = tid; idx < 1024; idx += NTHR) { const int r = idx >> 3, ch = idx & 7; const v4u w = *(const v4u*)(P + (size_t)(row0 + r) * INW + C_RV + h * 64 + ch * 8); LAS float* d = vf + r * 64 + ch * 8;
      d[0] = bflo(w.x); d[1] = bfhi(w.x); d[2] = bflo(w.y); d[3] = bfhi(w.y); d[4] = bflo(w.z); d[5] = bfhi(w.z); d[6] = bflo(w.w); d[7] = bfhi(w.w); }
    if (tid < 128) { wf[tid] = __expf(lgf * (float)(127 - tid)); wf[128 + tid] = __expf(lgb * (float)tid); }
    __syncthreads();
    const int i = tid >> 4, e0 = (tid & 15) * 4; f32x4 af = (f32x4){0.f, 0.f, 0.f, 0.f}, ab = af;
    for (int m = 0; m < 128; ++m) { const float kk = kf[m * 32 + i]; const f32x4 vv = *(const LAS f32x4*)(vf + m * 64 + e0); af += (kk * wf[m]) * vv; ab += (kk * wf[128 + m]) * vv; }
    float* dst = WSP(float, WS_KVS) + ((size_t)(b * 4 + h) * NCHK + cid) * 2048 + i * 64 + e0;
#if defined(MIX_CHECK)
    { const f32x4 cf = *(const f32x4*)dst, cb = *(const f32x4*)(dst + (size_t)32 * NCHK * 2048);
#pragma unroll
      for (int k = 0; k < 4; ++k) { chk(F, cf[k], af[k], 0.05f, 0.03f, 10); chk(F, cb[k], ab[k], 0.05f, 0.03f, 10); } }
#endif
    *(f32x4*)dst = af; *(f32x4*)(dst + (size_t)32 * NCHK * 2048) = ab;
    __syncthreads();
}
__device__ __forceinline__ void p_scan(Frame& F, int layer) {
    for (int gid = blockIdx.x * NTHR + opq((int)threadIdx.x); gid < 2 * 32 * 2048; gid += F.G * NTHR) {
        const int dir = gid >> 16, bh = (gid >> 11) & 31, e = gid & 2047; const float lg = (dir ? F.lgb : F.lgf)[layer * 4 + (bh & 3)]; const float G = __expf(lg * 128.0f);
        float* base = WSP(float, WS_KVS) + ((size_t)(dir * 32 + bh) * NCHK) * 2048 + e;
        float kv[NCHK];
#pragma unroll
#if SCAN_FUSE
        for (int c = 0; c < NCHK; ++c) kv[c] = __hip_atomic_load(base + (size_t)c * 2048, __ATOMIC_RELAXED, __HIP_MEMORY_SCOPE_AGENT);
#else
        for (int c = 0; c < NCHK; ++c) kv[c] = base[(size_t)c * 2048];
#endif
#if ((REP_MASK) >> 16) & 1
        { float* dm = WSP(float, WS_ACT) + ((size_t)(dir * 32 + bh) * NCHK) * 2048 + e; float S = 0.f;
          if (dir == 0) {
#pragma unroll
            for (int c = 0; c < NCHK; ++c) { dm[(size_t)c * 2048] = S; S = G * S + kv[c]; }
          } else { dm[2048] = S; S = G * S + kv[1]; dm[0] = S; S = G * S + kv[0];
#pragma unroll
            for (int c = NCHK - 1; c >= 2; --c) { dm[(size_t)c * 2048] = S; S = G * S + kv[c]; } }
          asm volatile("s_waitcnt vmcnt(0)" ::: "memory");
#pragma unroll
          for (int c = 0; c < NCHK; ++c) kv[c] = base[(size_t)c * 2048]; }
#endif
        float S = 0.f;
        if (dir == 0) {
#pragma unroll
            for (int c = 0; c < NCHK; ++c) { base[(size_t)c * 2048] = S; S = G * S + kv[c]; }
        } else {
            base[2048] = S; S = G * S + kv[1]; base[0] = S; S = G * S + kv[0];
#pragma unroll
            for (int c = NCHK - 1; c >= 2; --c) { base[(size_t)c * 2048] = S; S = G * S + kv[c]; }
        }
    }
}
__device__ __forceinline__ void ret_naive_unit(Frame& F, int layer, int b, int h, int cid) {
    const int tid = opq((int)threadIdx.x); const bf16* P = WSP(bf16, WS_PROJ); const int row0 = chunk_row0(b, cid);
    LAS float* kf = (LAS float*)F.lds;
    LAS float* qf = kf + 128 * 33;
    LAS float* vf = qf + 128 * 33;
    LAS float* Am = vf + 128 * 64;
    LAS float* Sf = Am + 128 * 129;
    LAS float* red = Sf + 2 * 2048;
    const float lgf = F.lgf[layer * 4 + h], lgb = F.lgb[layer * 4 + h];
    __syncthreads();
    { const int r = tid >> 2, ch = tid & 3; const v4u w = *(const v4u*)(P + (size_t)(row0 + r) * INW + C_RK + h * 32 + ch * 8); LAS float* d = kf + r * 33 + ch * 8;
      d[0] = bflo(w.x); d[1] = bfhi(w.x); d[2] = bflo(w.y); d[3] = bfhi(w.y); d[4] = bflo(w.z); d[5] = bfhi(w.z); d[6] = bflo(w.w); d[7] = bfhi(w.w); }
    { const int r = tid >> 2, ch = tid & 3; const v4u w = *(const v4u*)(P + (size_t)(row0 + r) * INW + C_RQ + h * 32 + ch * 8); LAS float* d = qf + r * 33 + ch * 8;
      d[0] = bflo(w.x); d[1] = bfhi(w.x); d[2] = bflo(w.y); d[3] = bfhi(w.y); d[4] = bflo(w.z); d[5] = bfhi(w.z); d[6] = bflo(w.w); d[7] = bfhi(w.w); }
    for (int idx = tid; idx < 1024; idx += NTHR) { const int r = idx >> 3, ch = idx & 7; const v4u w = *(const v4u*)(P + (size_t)(row0 + r) * INW + C_RV + h * 64 + ch * 8); LAS float* d = vf + r * 64 + ch * 8;
      d[0] = bflo(w.x); d[1] = bfhi(w.x); d[2] = bflo(w.y); d[3] = bfhi(w.y); d[4] = bflo(w.z); d[5] = bfhi(w.z); d[6] = bflo(w.w); d[7] = bfhi(w.w); }
    { const float* sp = WSP(float, WS_KVS) + ((size_t)(b * 4 + h) * NCHK + cid) * 2048;
      for (int idx = tid; idx < 2048; idx += NTHR) { Sf[idx] = sp[idx]; Sf[2048 + idx] = sp[(size_t)32 * NCHK * 2048 + idx]; } }
    const int n = tid & 127, qt = tid >> 7;
    __syncthreads();
#pragma unroll 1
    for (int mm = 0; mm < 32; ++mm) { const int m = qt * 32 + mm; float s = 0.f;
#pragma unroll 8
        for (int d = 0; d < 32; ++d) s += qf[n * 33 + d] * kf[m * 33 + d];
        const float w = m < n ? __expf(lgf * (float)(n - m)) : (m > n ? __expf(lgb * (float)(m - n)) : 2.0f);
        Am[n * 129 + m] = s * w; }
    __syncthreads();
    float o[16];
#pragma unroll
    for (int i = 0; i < 16; ++i) o[i] = 0.f;
#pragma unroll 2
    for (int m = 0; m < 128; ++m) { const float a = Am[n * 129 + m];
#pragma unroll
        for (int i = 0; i < 4; ++i) { const f32x4 vv = *(const LAS f32x4*)(vf + m * 64 + qt * 16 + 4 * i); o[4 * i] += a * vv[0]; o[4 * i + 1] += a * vv[1]; o[4 * i + 2] += a * vv[2]; o[4 * i + 3] += a * vv[3]; } }
    const float cf = __expf(lgf * (float)(n + 1)), cb = __expf(lgb * (float)(128 - n));
#pragma unroll 2
    for (int d = 0; d < 32; ++d) { const float qv = qf[n * 33 + d]; const float q1 = qv * cf, q2 = qv * cb;
#pragma unroll
        for (int i = 0; i < 4; ++i) { const f32x4 sf = *(const LAS f32x4*)(Sf + d * 64 + qt * 16 + 4 * i), sb = *(const LAS f32x4*)(Sf + 2048 + d * 64 + qt * 16 + 4 * i);
            o[4 * i] += q1 * sf[0] + q2 * sb[0]; o[4 * i + 1] += q1 * sf[1] + q2 * sb[1]; o[4 * i + 2] += q1 * sf[2] + q2 * sb[2]; o[4 * i + 3] += q1 * sf[3] + q2 * sb[3]; } }
    float s = 0.f;
#pragma unroll
    for (int i = 0; i < 16; ++i) s += o[i];
    red[n * 4 + qt] = s;
    __syncthreads();
    const float mean = (red[n * 4] + red[n * 4 + 1] + red[n * 4 + 2] + red[n * 4 + 3]) * (1.0f / 64.0f);
    __syncthreads();
    float qd = 0.f;
#pragma unroll
    for (int i = 0; i < 16; ++i) { o[i] -= mean; qd += o[i] * o[i]; }
    red[n * 4 + qt] = qd;
    __syncthreads();
    const float rstd = 1.0f / sqrtf((red[n * 4] + red[n * 4 + 1] + red[n * 4 + 2] + red[n * 4 + 3]) * (1.0f / 64.0f) + LN_EPS);
    const bf16* rgp = P + (size_t)(row0 + n) * INW + C_RG + h * 64 + qt * 16; bf16* dst = WSP(bf16, WS_MIX) + (size_t)(row0 + n) * D + 768 + h * 64 + qt * 16;
#pragma unroll
    for (int i = 0; i < 2; ++i) { const v4u w = *(const v4u*)(rgp + 8 * i); const float r8[8] = {bflo(w.x), bfhi(w.x), bflo(w.y), bfhi(w.y), bflo(w.z), bfhi(w.z), bflo(w.w), bfhi(w.w)}; float y8[8];
#pragma unroll
        for (int k = 0; k < 8; ++k) y8[k] = r8[k] / (1.0f + __expf(-r8[k])) * (o[8 * i + k] * rstd);
#if defined(MIX_CHECK)
        { const v4u cw = *(const v4u*)(dst + 8 * i); const float c8[8] = {bflo(cw.x), bfhi(cw.x), bflo(cw.y), bfhi(cw.y), bflo(cw.z), bfhi(cw.z), bflo(cw.w), bfhi(cw.w)};
#pragma unroll
          for (int k = 0; k < 8; ++k) chk(F, c8[k], y8[k], 0.03f, 0.04f, 11); }
#endif
        v4u ow; ow.x = pk2(y8[0], y8[1]); ow.y = pk2(y8[2], y8[3]); ow.z = pk2(y8[4], y8[5]); ow.w = pk2(y8[6], y8[7]); *(v4u*)(dst + 8 * i) = ow; }
    __syncthreads();
}
__device__ __forceinline__ void p_mix_naive(Frame& F, int layer, const XcdBarrier& bar) {
#if defined(MIX_CHECK)
    p_mix(F, layer); xcd_barrier(bar);
#endif
#if defined(ATTN_CHECK)
    P_ATTN(F, layer); xcd_barrier(bar);
#endif
#if defined(ATTN_NAIVE) || defined(ATTN_CHECK)
    const int n_att = 512 + (layer == 0 ? 32 : 0);
    for (int u = blockIdx.x; u < n_att; u += F.G) {
        if (u < 512) attn_naive_unit(F, layer, u >> 6, (u >> 1) & 31, u & 1, false);
        else { const int v = u - 512; attn_naive_unit(F, layer, v >> 2, (v >> 1) & 1, v & 1, true); }
    }
#elif !defined(MIX_CHECK)
    P_ATTN(F, layer);
#endif
    const int n_pool = 256 + (layer == 0 ? 16 : 0);
    for (int u = blockIdx.x; u < n_pool; u += F.G) { if (u < 256) pool_naive_unit(F, layer, u >> 5, u & 31); else pool_naive_unit(F, layer, 8 + ((u - 256) >> 1), (u - 256) & 1); }
    for (int u = blockIdx.x; u < 32 * NCHK; u += F.G) kv_naive_unit(F, layer, u / (4 * NCHK), (u / NCHK) & 3, u % NCHK);
}
__device__ __forceinline__ void p_ret_naive(Frame& F, int layer, const XcdBarrier& bar) {
#if defined(MIX_CHECK)
    p_ret(F, layer); xcd_barrier(bar);
#endif
    for (int u = blockIdx.x; u < 32 * NCHK; u += F.G) { const int cid = u % NCHK; if (layer == 1 && cid < 2) continue; ret_naive_unit(F, layer, u / (4 * NCHK), (u / NCHK) & 3, cid); }
}
#ifndef MK_N_LAUNCHES
#define MK_N_LAUNCHES 1
#endif
constexpr int NPHASE = 20;
struct Args { const float* in[24]; float* out; unsigned char* ws; int ph_lo, ph_hi; };

__device__ __forceinline__ int moe_tiles(Frame& F, volatile LAS unsigned* MISC) {
    __syncthreads();
    if (threadIdx.x == 0) { int acc = 0;
        for (int e = 0; e < NE; ++e) { const int c = (int)__hip_atomic_load(WSP(unsigned, WS_CTL) + CW_GCNT + 64 * e, RLX_AGENT); MISC[16 + NE + 1 + e] = (unsigned)c; MISC[16 + e] = (unsigned)acc; acc += (c + 255) >> 8; }
        MISC[16 + NE] = (unsigned)acc; }
    __syncthreads();
    return __builtin_amdgcn_readfirstlane((int)MISC[16 + NE]);
}

#ifndef TIME_MASK
#define TIME_MASK 0
#endif
#define TIC(k) unsigned long long tic_ = 0; if (((TIME_MASK) >> (k)) & 1) tic_ = wall_clock64();
#define TOC(k) if (((TIME_MASK) >> (k)) & 1) { __syncthreads(); const unsigned long long t1_ = wall_clock64(); while (wall_clock64() - t1_ < t1_ - tic_) __builtin_amdgcn_s_sleep(8); }
#define IN(k) (lo <= (k) && (k) < hi)
#define SEAM(k) do { if (IN(k) && IN((k) + 1)) { xcd_barrier(bar); REPEAT(13) xcd_barrier(bar); } } while (0)
template <int layer> __device__ __forceinline__ void layer_front(Frame& F, const XcdBarrier& bar, const int lo, const int hi) {
        const int pb = 2 + 9 * layer;
        if (IN(pb)) { TIC(pb)
#if INQ
            pg8::StaticOrder S; S.init(WSP(unsigned char, WS_T8L0), WSP(unsigned char, WS_WIN) + (size_t)layer * INW * D, MT, INW, D, F.G, (int)blockIdx.x); S.rev = (REV_MASK & 4) != 0;
            { LAS f32x4* rl_ = (LAS f32x4*)(F.lds + ROPE_LDS); rl_[threadIdx.x] = WSP(f32x4, WS_ROPE)[threadIdx.x]; __syncthreads(); }
            pg8::EpiInProj<true> E{WSP(bf16, WS_PROJ), (const LAS float*)(F.lds + ROPE_LDS), WSP(float, WS_SH), (const float*)(WSP(unsigned, WS_CTL) + CW_CMAX + CM_WIN + layer * INW)};
            REPEAT(2) pg8::gemm_phase<2>(F.lds, D, S, E);
            if constexpr (layer == 0 && CONV_SPREAD != 0) { if (F.G == 256) { __syncthreads(); bg_convert(F, 184, 72, 0, CV_A); __syncthreads(); } }
#else
            pg8::StaticOrder S; S.init(WSP(bf16, WS_ACT), WSP(bf16, WS_WIN) + (size_t)layer * INW * D, MT, INW, 2 * D, F.G, (int)blockIdx.x);
            { LAS f32x4* rl_ = (LAS f32x4*)(F.lds + ROPE_LDS); rl_[threadIdx.x] = WSP(f32x4, WS_ROPE)[threadIdx.x]; __syncthreads(); }
            pg8::EpiInProj<false> E{WSP(bf16, WS_PROJ), (const LAS float*)(F.lds + ROPE_LDS), nullptr, nullptr};
            pg8::gemm_phase<0>(F.lds, 2 * D, S, E);
#endif
        TOC(pb) } SEAM(pb);
#if defined(MIX_NAIVE) || defined(MIX_CHECK) || defined(ATTN_CHECK) || defined(ATTN_NAIVE)
        if (IN(pb + 1)) { TIC(pb + 1) p_mix_naive(F, layer, bar); TOC(pb + 1) } SEAM(pb + 1);
#else
        if (IN(pb + 1)) { TIC(pb + 1) p_mix(F, layer); TOC(pb + 1) } SEAM(pb + 1);
#endif
#if !SCAN_FUSE
        if (IN(pb + 2)) { TIC(pb + 2) p_scan(F, layer); TOC(pb + 2) } SEAM(pb + 2);
#endif
#if defined(MIX_NAIVE) || defined(MIX_CHECK) || defined(ATTN_CHECK) || defined(ATTN_NAIVE)
        if (IN(pb + 3)) { TIC(pb + 3) p_ret_naive(F, layer, bar); TOC(pb + 3) } SEAM(pb + 3);
#else
        if (IN(pb + 3)) { TIC(pb + 3) REPEAT(5) p_ret(F, layer); TOC(pb + 3) } SEAM(pb + 3);
#endif
#if FUSE_LN
        if (IN(pb + 4)) { TIC(pb + 4)
            constexpr int total = (layer == 0 ? MT : NL) / 256 * 4;
            const float* modl = WSP(float, WS_MOD) + (size_t)layer * 9 * 6144;
            pg8::PanelStats st{(unsigned*)(F.ws + WS_XB + (layer == 0 ? 0 : 2) * XB_BANK), WSP(unsigned, WS_CTL) + CW_SEAM + (layer == 0 ? 0 : 2) * SEAM_BANK, WSP(unsigned, WS_CTL) + CW_TMO, LN_EPS, 0x700u};
#pragma unroll
            for (int sl = 0; sl * 256 < total; ++sl) {
                pg8::SliceOrder S{sl * 256, total, F.vcu, 2 * D, (const char*)WSP(bf16, WS_MIX), (const char*)(WSP(bf16, WS_WOUT) + (size_t)layer * D * D)};
                if constexpr (layer == 0) {
                    pg8::EpiLN<FFN0_FP8 != 0, false> E{F.x, F.ctx, F.out, WSP(float, WS_XC), modl + 2 * 1024, modl + 3 * 1024, modl + 4 * 1024, F.ln1_g, F.ln1_b, WSP(bf16, WS_ACT), WSP(unsigned char, WS_T8), nullptr, nullptr, st};
                    pg8::gemm_phase<0>(F.lds, 2 * D, S, E);
                } else {
                    pg8::EpiLN<true, true> E{F.out, F.out, F.out, F.out, modl + 2 * 1024, modl + 3 * 1024, modl + 4 * 1024, F.ln1_g + D, F.ln1_b + D, nullptr, WSP(unsigned char, WS_T8), WSP(float, WS_PLOG), F.router, st};
                    pg8::gemm_phase<0>(F.lds, 2 * D, S, E);
                }
                __syncthreads();
            }
        TOC(pb + 4) } SEAM(pb + 4);
        if constexpr (layer == 1) { if (IN(pb + 5)) { TIC(pb + 5) p_route(F); TOC(pb + 5) } SEAM(pb + 5); }
#else
        if (IN(pb + 4)) { TIC(pb + 4)
            pg8::EpiBf16 E{WSP(bf16, WS_ACT), D, 1.0f};
            if constexpr (layer == 0 && OUT_SK != 0) {
                pg8::StaticOrderT<true> S; S.init(WSP(bf16, WS_MIX), WSP(bf16, WS_WOUT), MT, D, 2 * D, F.G, (int)blockIdx.x);
                S.sk.init((MT / 256) * (D / 256), 2 * D / 128, F.G, (int)blockIdx.x, F.out, WSP(unsigned, WS_CTL) + CW_SK, (unsigned)(pb + 4 + 1));
                pg8::gemm_phase<0>(F.lds, 2 * D, S, E);
            } else {
                pg8::StaticOrder S; S.init(WSP(bf16, WS_MIX), WSP(bf16, WS_WOUT) + (size_t)layer * D * D, layer == 0 ? MT : NL, D, 2 * D, F.G, (int)blockIdx.x, (TAILQ & 1) != 0); S.rev = (REV_MASK & 16) != 0;
                REPEAT(6) { pg8::gemm_phase<0, (PFA_MASK & 1) ? PFA_D : 0>(F.lds, 2 * D, S, E); if (TAILQ & 1) pg8::gemm_tail<0>(F.lds, 2 * D, S, E); }
                if constexpr (layer == 0 && CONV_SPREAD != 0 && (TAILQ & 1) != 0) { if (F.G == 256) { __syncthreads(); bg_convert(F, 128, 128, CV_B, CV_C); __syncthreads(); } }
            }
        TOC(pb + 4) } SEAM(pb + 4);
        if (IN(pb + 5)) { TIC(pb + 5) p_ln1(F, layer); TOC(pb + 5) } SEAM(pb + 5);
#endif
        if constexpr (layer == 0) {
#if FFN0_FP8
        if (IN(8)) { TIC(8)
            pg8::StaticOrder S; S.init(WSP(unsigned char, WS_T8), WSP(unsigned char, WS_FGU), MT, 2 * FF, D, F.G, (int)blockIdx.x);
            pg8::EpiSwiGLU8 E{WSP(unsigned char, WS_HID), FF, 1.0f / 128.0f, 4.0f};
            pg8::gemm_phase<1>(F.lds, D, S, E);
        TOC(8) } SEAM(8);
        if (IN(9)) { TIC(9)
            pg8::StaticOrder S; S.init(WSP(unsigned char, WS_HID), WSP(unsigned char, WS_FD), MT, D, FF, F.G, (int)blockIdx.x);
            pg8::EpiBf16 E{WSP(bf16, WS_ACT), D, 1.0f / 512.0f};
            pg8::gemm_phase<1>(F.lds, FF, S, E);
        TOC(9) } SEAM(9);
#else
        if (IN(8)) { TIC(8)
            pg8::StaticOrder S; S.init(WSP(unsigned char, WS_T8L0), WSP(unsigned char, WS_FGU), MT, 2 * FF, D, F.G, (int)blockIdx.x);
#if HID_FP8
            pg8::EpiSwiGLUq<true, false> E{WSP(unsigned char, WS_HID), FF, WSP(float, WS_ST), (const float*)(WSP(unsigned, WS_CTL) + CW_CMAX), nullptr, 4.0f};
#else
            pg8::EpiSwiGLUq<false, false> E{WSP(bf16, WS_HID), FF, WSP(float, WS_ST), (const float*)(WSP(unsigned, WS_CTL) + CW_CMAX), nullptr, 1.0f};
#endif
            REPEAT(8) pg8::gemm_phase<2>(F.lds, D, S, E);
            if constexpr (CONV_SPREAD != 0) { if (F.G == 256) { __syncthreads(); bg_convert(F, 176, 80, CV_C, CV_E); __syncthreads(); } }
        TOC(8) } SEAM(8);
#if FUSE_LN
        if (IN(9)) { TIC(9)
            const float* mod0 = WSP(float, WS_MOD), *mod1 = WSP(float, WS_MOD) + (size_t)9 * 6144;
            pg8::PanelStats st{(unsigned*)(F.ws + WS_XB + XB_BANK), WSP(unsigned, WS_CTL) + CW_SEAM + SEAM_BANK, WSP(unsigned, WS_CTL) + CW_TMO, LN_EPS, 0x740u};
#pragma unroll
            for (int sl = 0; sl < 3; ++sl) {
                pg8::SliceOrder S{sl * 256, MT / 256 * 4, F.vcu, 2 * FF, (const char*)WSP(bf16, WS_HID), (const char*)WSP(bf16, WS_FD)};
                pg8::EpiLN<false, false> E{F.out, WSP(float, WS_XC), F.out, WSP(float, WS_XC), mod0 + 5 * 1024, mod1 + 0 * 1024, mod1 + 1 * 1024, F.ln2_g, F.ln2_b, WSP(bf16, WS_ACT), nullptr, nullptr, nullptr, st};
                pg8::gemm_phase<0>(F.lds, 2 * FF, S, E);
                __syncthreads();
            }
        TOC(9) } SEAM(9);
#else
        if (IN(9)) { TIC(9)
#if FFD_SK
            pg8::StaticOrderT<true> S; S.init(WSP(bf16, WS_HID), WSP(bf16, WS_FD), MT, D, 2 * FF, F.G, (int)blockIdx.x);
            S.sk.init((MT / 256) * (D / 256), 2 * FF / 128, F.G, (int)blockIdx.x, F.out, WSP(unsigned, WS_CTL) + CW_SK, 10u);
            pg8::EpiBf16 E{WSP(bf16, WS_ACT), D, 1.0f};
            pg8::gemm_phase<0>(F.lds, 2 * FF, S, E);
#if BGCONV
            __syncthreads(); bg_convert(F, 0, F.G); __syncthreads();
#endif
#else
#if HID_FP8
            pg8::StaticOrder S; S.init(WSP(unsigned char, WS_HID), WSP(unsigned char, WS_FD), MT, D, FF, F.G, (int)blockIdx.x, (TAILQ & 2) != 0); S.rev = (REV_MASK & 1) != 0;
            pg8::EpiBf16 E{WSP(bf16, WS_ACT), D, 1.0f / 512.0f};
            REPEAT(9) { pg8::gemm_phase<1, (PFA_MASK & 2) ? PFA_D : 0>(F.lds, FF, S, E); if (TAILQ & 2) pg8::gemm_tail<1>(F.lds, FF, S, E); }
#else
            pg8::StaticOrder S; S.init(WSP(bf16, WS_HID), WSP(bf16, WS_FD), MT, D, 2 * FF, F.G, (int)blockIdx.x, (TAILQ & 2) != 0); S.rev = (REV_MASK & 1) != 0;
            pg8::EpiBf16 E{WSP(bf16, WS_ACT), D, 1.0f};
            REPEAT(9) { pg8::gemm_phase<0>(F.lds, 2 * FF, S, E); if (TAILQ & 2) pg8::gemm_tail<0>(F.lds, 2 * FF, S, E); }
#endif
#if BGCONV
            __syncthreads(); REPEAT(10) { const int cv0 = (CONV_SPREAD != 0 && (TAILQ & 1) != 0 && F.G == 256) ? CV_E : 0; if (F.G == 256 && !(TAILQ & 2)) bg_convert(F, 32, 224, cv0); else if (F.G == 256) bg_convert(F, -1, 256, cv0); else bg_convert(F, 0, F.G); __syncthreads(); }
#endif
#endif
        TOC(9) } SEAM(9);
#endif
#endif
#if !FUSE_LN
        if (IN(10)) { TIC(10) p_ln2_l0(F); TOC(10) } SEAM(10);
#endif
        }
}

__global__ void __launch_bounds__(NTHR, 2) hybrid_fwd(Args args) {
    extern __shared__ __attribute__((aligned(16))) unsigned char lds_raw[];
    Frame F;
    F.lds = (LAS unsigned char*)lds_raw;
    F.wave = __builtin_amdgcn_readfirstlane((int)threadIdx.x >> 6);
    F.G = gridDim.x; { const int bx = blockIdx.x; F.vcu = (F.G % 8 == 0) ? (bx % 8) * (F.G / 8) + bx / 8 : bx; }
    F.ws = args.ws; F.out = args.out;
    F.x = args.in[0]; F.c = args.in[1]; F.ctx = args.in[2]; F.c_ctx = args.in[3]; F.w_mod = args.in[4]; F.b_mod = args.in[5]; F.w_in = args.in[6]; F.sink = args.in[7];
    F.pool_w = args.in[8]; F.pool_scale = args.in[9]; F.lgf = args.in[10]; F.lgb = args.in[11]; F.w_out = args.in[12]; F.ln1_g = args.in[13]; F.ln1_b = args.in[14]; F.ln2_g = args.in[15]; F.ln2_b = args.in[16];
    F.fw_gate = args.in[17]; F.fw_up = args.in[18]; F.fw_down = args.in[19]; F.router = args.in[20]; F.mw_gate = args.in[21]; F.mw_up = args.in[22]; F.mw_down = args.in[23];
    volatile LAS unsigned* MISC = (volatile LAS unsigned*)(F.lds + MISC_OFF);
    if (threadIdx.x < 64) MISC[threadIdx.x] = 0u;
    __syncthreads();
    const int lo = args.ph_lo, hi = args.ph_hi;
    XcdBarrier bar; bar.bar = WSP(unsigned, WS_CTL) + CW_BAR; bar.x = 0; bar.st = nullptr;
    if (hi - lo > 1) bar = xcd_barrier_post(WSP(unsigned, WS_CTL) + CW_BAR, MISC + 8);

    if (IN(0)) { TIC(0) REPEAT(0) p_prep(F); TOC(0) } SEAM(0);
    if (IN(1)) { TIC(1) REPEAT(1) { p_h0(F); __syncthreads(); } REPEAT(11) { quant_dense_gu(F); REPSYNC(11) } TOC(1) } SEAM(1);
    layer_front<0>(F, bar, lo, hi);
    layer_front<1>(F, bar, lo, hi);
    if (IN(17)) { TIC(17)
        pg8::MoeOrder<true> S; S.nrt = moe_tiles(F, MISC); S.tbl = (const LAS int*)(MISC + 16);
        S.T0 = 0; S.nN = 2 * FF / 256; S.G = F.G; S.c = (int)blockIdx.x; S.KB = D;
        S.A = (const char*)WSP(unsigned char, WS_T8); S.Bt = (const char*)WSP(unsigned char, WS_MGU8); S.bstride = (size_t)2 * FF * D; S.list = WSP(int, WS_LIST);
#if MOEQ
        pg8::EpiSwiGLUq<true, true> E{WSP(unsigned char, WS_HID8), FF, WSP(float, WS_ST), (const float*)(WSP(unsigned, WS_CTL) + CW_CMAX) + 2 * FF, WSP(int, WS_LIST), 4.0f};
        pg8::gemm_phase<2>(F.lds, D, S, E);
#else
        pg8::EpiSwiGLU8 E{WSP(unsigned char, WS_HID8), FF, 1.0f / 128.0f, 4.0f};
#if ((REP_MASK) >> 13) & 2
        S.i0 = 0; S.i1 = 12; pg8::gemm_phase<1>(F.lds, D, S, E); xcd_barrier(bar); S.i0 = 12; S.i1 = 1 << 30; pg8::gemm_phase<1>(F.lds, D, S, E);
#else
        REPEAT(17) pg8::gemm_phase<1>(F.lds, D, S, E);
#endif
#endif
    TOC(17) } SEAM(17);
    if (IN(18)) { TIC(18)
        pg8::MoeOrder<false, MOE_SK != 0> S; S.nrt = moe_tiles(F, MISC); S.tbl = (const LAS int*)(MISC + 16);
        S.T0 = 0; S.nN = D / 256; S.G = F.G; S.c = (int)blockIdx.x; S.KB = FF;
        S.rev = (REV_MASK & 2) != 0;
        if constexpr (MOE_SK != 0) S.sk.init(S.nrt * (D / 256), FF / 128, F.G, (int)blockIdx.x, F.out, WSP(unsigned, WS_CTL) + CW_SK, 19u);
        S.A = (const char*)WSP(unsigned char, WS_HID8); S.Bt = (const char*)WSP(unsigned char, WS_MD8); S.bstride = (size_t)FF * D; S.list = WSP(int, WS_LIST);
        pg8::EpiMoeDown E{WSP(bf16, WS_Y), WSP(int, WS_LIST), WSP(float, WS_LGATE), 1.0f / 512.0f};
        S.tail.init(S.nrt * S.nN, F.G, (int)blockIdx.x, (TAILQ & 4) != 0);
        REPEAT(18) { pg8::gemm_phase<1, (PFA_MASK & 4) ? PFA_D : 0>(F.lds, FF, S, E); if (TAILQ & 4) pg8::gemm_tail<1>(F.lds, FF, S, E); }
    TOC(18) } SEAM(18);
    if (IN(19)) { TIC(19) REPEAT(19) p_final(F); TOC(19) }
#undef IN
#undef SEAM
}

extern "C" void kernel_launch(void* const* d_in, const int* in_sizes, int n_in, void* d_out, int out_size, void* d_ws, size_t ws_size, hipStream_t stream) {
    static int grid = 0;
    if (grid == 0) {
        if (n_in != 24 || out_size != NL * D || ws_size < WS_END) { fprintf(stderr, "kernel_launch: unexpected shapes (n_in %d, out %d, ws %zu < %zu); nothing launched\n", n_in, out_size, ws_size, (size_t)WS_END); grid = -1; return; }
        int dev = 0, cus = 0, per_cu = 0;
        if (hipGetDevice(&dev) != hipSuccess || hipDeviceGetAttribute(&cus, hipDeviceAttributeMultiprocessorCount, dev) != hipSuccess) { grid = -1; return; }
        if (hipFuncSetAttribute((const void*)hybrid_fwd, hipFuncAttributeMaxDynamicSharedMemorySize, LDS_BYTES) != hipSuccess) { fprintf(stderr, "kernel_launch: hipFuncSetAttribute failed\n"); grid = -1; return; }
        if (hipOccupancyMaxActiveBlocksPerMultiprocessor(&per_cu, (const void*)hybrid_fwd, NTHR, LDS_BYTES) != hipSuccess || per_cu < 1) { fprintf(stderr, "kernel_launch: occupancy query says %d\n", per_cu); }
        (void)hipGetLastError();
        grid = cus;
    }
    if (grid < 0) return;
    if (hipMemsetAsync((char*)d_ws + WS_CTL, 0, CTL_ZERO_BYTES, stream) != hipSuccess) return;
    Args a{};
    for (int i = 0; i < 24; ++i) a.in[i] = (const float*)d_in[i];
    a.out = (float*)d_out; a.ws = (unsigned char*)d_ws;
#if MK_N_LAUNCHES == 1
    a.ph_lo = 0; a.ph_hi = NPHASE;
    hipLaunchKernelGGL(hybrid_fwd, dim3(grid), dim3(NTHR), LDS_BYTES, stream, a);
#else
    for (int p = 0; p < NPHASE; ++p) { a.ph_lo = p; a.ph_hi = p + 1; hipLaunchKernelGGL(hybrid_fwd, dim3(grid), dim3(NTHR), LDS_BYTES, stream, a); }
#endif
}
```
